# Optimizing an MI355X kernel written in HIP

```python
import jax
import jax.numpy as jnp
from jax import lax
import numpy as np

D_MODEL = 1024
BATCH = 4
SEQ = 4096
DEPTH = 2

GRID_W = 64
CTX_LEN = 256
NORM_EPS = 1e-6
N_MOD = 6

ATT_HEADS = 8
ATT_KV_HEADS = 2
ATT_GROUP = ATT_HEADS // ATT_KV_HEADS
HEAD_DIM = 128
ATT_WIDTH = ATT_HEADS * HEAD_DIM
KV_WIDTH = ATT_KV_HEADS * HEAD_DIM
Q_BLOCK = 128
ROPE_THETA = 10000.0
ROPE_FREQS_PER_AXIS = HEAD_DIM // 4

HGRN_EXPAND = 128
HGRN_HEADS = D_MODEL // HGRN_EXPAND
HGRN_DV = D_MODEL // HGRN_HEADS
HGRN_WIDTH = HGRN_HEADS * HGRN_EXPAND
HGRN_VWIDTH = HGRN_HEADS * HGRN_DV
HGRN_CHUNK = 64

PROJ_SIZES = (ATT_WIDTH, KV_WIDTH, KV_WIDTH, HGRN_WIDTH, HGRN_WIDTH, HGRN_WIDTH,
              HGRN_VWIDTH, HGRN_VWIDTH, D_MODEL, D_MODEL)
PROJ_WIDTH = sum(PROJ_SIZES)
PROJ_SPLITS = tuple(int(v) for v in np.cumsum(PROJ_SIZES)[:-1])

D_FF_DENSE = 256 * ((8 * D_MODEL // 3 + 255) // 256)
N_EXPERTS = 8
TOP_K = 2
D_FF_EXPERT = 7 * D_MODEL // 2
MOE_BLOCK = 256
N_DENSE_LAYERS = (DEPTH + 1) // 2
N_MOE_LAYERS = DEPTH // 2

kernel_name = 'hybrid_gqa_hgrn2_moe_dit_prefix'


def rms_norm(x, gain):
    xf = x.astype(jnp.float32)
    y = xf * lax.rsqrt(jnp.mean(xf * xf, axis=-1, keepdims=True) + NORM_EPS)
    return (y * gain.astype(jnp.float32)).astype(x.dtype)


def modulate(h, shift, scale):
    return h * (1.0 + scale) + shift


def split_heads(t, n_heads):
    return t.reshape(*t.shape[:-1], n_heads, t.shape[-1] // n_heads)


def axial_rope_tables(n_tokens):
    rows = n_tokens // GRID_W
    row_ids = jnp.repeat(jnp.arange(rows), GRID_W).astype(jnp.float32)
    col_ids = jnp.tile(jnp.arange(GRID_W), rows).astype(jnp.float32)
    inv_freq = ROPE_THETA ** (-jnp.arange(ROPE_FREQS_PER_AXIS, dtype=jnp.float32) / ROPE_FREQS_PER_AXIS)
    ang = jnp.concatenate([row_ids[:, None] * inv_freq, col_ids[:, None] * inv_freq], axis=-1)
    ang = jnp.concatenate([ang, ang], axis=-1)
    return jnp.cos(ang), jnp.sin(ang)


def apply_rope(x, cos, sin):
    half = x.shape[-1] // 2
    xf = x.astype(jnp.float32)
    rot = jnp.concatenate([-xf[..., half:], xf[..., :half]], axis=-1)
    return (xf * cos[None, :, None, :] + rot * sin[None, :, None, :]).astype(x.dtype)


def gqa_softmax(q, k, v):
    s = jnp.einsum('bqkgd,bskd->bkgqs', q, k).astype(jnp.float32) * (HEAD_DIM ** -0.5)
    p = jax.nn.softmax(s, axis=-1).astype(v.dtype)
    return jnp.einsum('bkgqs,bskd->bqkgd', p, v)


def latent_attention(q, k_lat, v_lat, k_ctx, v_ctx):
    b, n = q.shape[:2]
    k_all = jnp.concatenate([k_ctx, k_lat], axis=1)
    v_all = jnp.concatenate([v_ctx, v_lat], axis=1)
    qb = q.reshape(b, n // Q_BLOCK, Q_BLOCK, ATT_KV_HEADS, ATT_GROUP, HEAD_DIM).transpose(1, 0, 2, 3, 4, 5)
    ob = lax.map(lambda blk: gqa_softmax(blk, k_all, v_all), qb)
    return ob.transpose(1, 0, 2, 3, 4, 5).reshape(b, n, ATT_WIDTH)


def context_attention(q, k_ctx, v_ctx):
    b, l = q.shape[:2]
    qg = q.reshape(b, l, ATT_KV_HEADS, ATT_GROUP, HEAD_DIM)
    return gqa_softmax(qg, k_ctx, v_ctx).reshape(b, l, ATT_WIDTH)


def hgrn_lower_bounds(logits):
    lb = jnp.cumsum(jax.nn.softmax(logits.astype(jnp.float32), axis=0), axis=0)
    return lb - lb[0:1]


def hgrn_forget(f_pre, lb):
    f = lb + (1.0 - lb) * jax.nn.sigmoid(f_pre.astype(jnp.float32))
    return split_heads(1.0 - f, HGRN_HEADS), split_heads(jnp.log(f), HGRN_HEADS)


def hgrn2_chunk_scan(q, k, v, log_f, state0):
    b, n, h, _ = q.shape
    dv = v.shape[-1]
    nc = n // HGRN_CHUNK

    def to_chunks(t):
        return t.astype(jnp.float32).reshape(b, nc, HGRN_CHUNK, h, t.shape[-1]).transpose(1, 0, 3, 2, 4)

    causal = jnp.tril(jnp.ones((HGRN_CHUNK, HGRN_CHUNK), dtype=bool))[:, :, None]

    def step(state, chunk):
        qc, kc, vc, gc = chunk
        cum = jnp.cumsum(gc, axis=2)
        rel = jnp.where(causal, cum[:, :, :, None, :] - cum[:, :, None, :, :], -jnp.inf)
        scores = jnp.einsum('bhtd,bhsd,bhtsd->bhts', qc, kc, jnp.exp(rel))
        out = (jnp.einsum('bhts,bhsv->bhtv', scores, vc)
               + jnp.einsum('bhtd,bhdv->bhtv', qc * jnp.exp(cum), state))
        tail = cum[:, :, -1:, :]
        new_state = (jnp.exp(tail[:, :, 0, :, None]) * state
                     + jnp.einsum('bhsd,bhsv->bhdv', kc * jnp.exp(tail - cum), vc))
        return new_state, out

    final, outs = lax.scan(step, state0, tuple(to_chunks(t) for t in (q, k, v, log_f)))
    o = outs.transpose(1, 0, 3, 2, 4).reshape(b, n, h, dv)
    return o.astype(v.dtype), final


def hgrn_readout(o, gate, gain):
    o = rms_norm(o, gain)
    return o.reshape(*o.shape[:2], HGRN_VWIDTH) * jax.nn.silu(gate)


def merge_branches(att_o, hg_o, gate_att, gate_hg, w_att_br, w_hg_br, w_out_l):
    y = (jax.nn.sigmoid(gate_att) * (att_o @ w_att_br)
         + jax.nn.sigmoid(gate_hg) * (hg_o @ w_hg_br))
    return y @ w_out_l


def swiglu(t, w_gate, w_up, w_down):
    return (jax.nn.silu(t @ w_gate) * (t @ w_up)) @ w_down


def moe_swiglu(t, w_router, w_gate, w_up, w_down):
    n_tok, d = t.shape
    logits = (t @ w_router).astype(jnp.float32)
    top_logits, top_idx = lax.top_k(logits, TOP_K)
    top_w = jax.nn.softmax(top_logits, axis=-1).astype(t.dtype)
    flat_e = top_idx.reshape(-1)
    n_assign = n_tok * TOP_K
    order = jnp.argsort(flat_e)
    sorted_e = flat_e[order]
    counts = jnp.bincount(flat_e, length=N_EXPERTS)
    padded = (counts + MOE_BLOCK - 1) // MOE_BLOCK * MOE_BLOCK
    start = jnp.cumsum(counts) - counts
    pend = jnp.cumsum(padded)
    pstart = pend - padded
    dest_sorted = (pstart[sorted_e] + jnp.arange(n_assign) - start[sorted_e]).astype(jnp.int32)
    n_blocks = -(-n_assign // MOE_BLOCK) + N_EXPERTS
    n_rows = n_blocks * MOE_BLOCK
    row_token = jnp.full((n_rows,), n_tok, jnp.int32).at[dest_sorted].set((order // TOP_K).astype(jnp.int32))
    block_expert = jnp.minimum(
        jnp.searchsorted(pend, jnp.arange(n_blocks) * MOE_BLOCK, side='right'), N_EXPERTS - 1)
    t_pad = jnp.concatenate([t, jnp.zeros((1, d), t.dtype)], axis=0)
    xb = t_pad[row_token].reshape(n_blocks, MOE_BLOCK, d)

    def expert_block(args):
        xblk, e = args
        return swiglu(xblk, w_gate[e], w_up[e], w_down[e])

    yb = lax.map(expert_block, (xb, block_expert)).reshape(n_rows, d)
    dest = jnp.zeros((n_assign,), jnp.int32).at[order].set(dest_sorted)
    y_sel = yb[dest].reshape(n_tok, TOP_K, d)
    return jnp.einsum('tk,tkd->td', top_w, y_sel)


def setup_inputs(seed: int = 0) -> dict:
    key = jax.random.key(seed)
    ks = iter(jax.random.split(key, 32))
    D = D_MODEL

    def nrm(shape, scale):
        return scale * jax.random.normal(next(ks), shape, jnp.float32)

    def gain(shape):
        return 1.0 + nrm(shape, 0.02)

    return {
        'x': nrm((BATCH, SEQ, D), 1.0),
        'c': nrm((BATCH, D), 1.0),
        'ctx': nrm((BATCH, CTX_LEN, D), 1.0),
        'c_ctx': nrm((D,), 1.0),
        'w_mod': nrm((DEPTH, D, N_MOD * D), 0.5 * D ** -0.5),
        'b_mod': nrm((DEPTH, N_MOD * D), 0.02),
        'pre_mix_norm': gain((DEPTH, D)),
        'post_mix_norm': gain((DEPTH, D)),
        'pre_ffn_norm': gain((DEPTH, D)),
        'post_ffn_norm': gain((DEPTH, D)),
        'w_in': nrm((DEPTH, D, PROJ_WIDTH), D ** -0.5),
        'q_norm': gain((DEPTH, HEAD_DIM)),
        'k_norm': gain((DEPTH, HEAD_DIM)),
        'hg_norm': gain((DEPTH, HGRN_DV)),
        'hg_lb_logits': nrm((DEPTH, HGRN_WIDTH), 1.0),
        'w_att_branch': nrm((DEPTH, ATT_WIDTH, D), ATT_WIDTH ** -0.5),
        'w_hg_branch': nrm((DEPTH, HGRN_VWIDTH, D), HGRN_VWIDTH ** -0.5),
        'w_out': nrm((DEPTH, D, D), D ** -0.5),
        'ffn_w_gate': nrm((N_DENSE_LAYERS, D, D_FF_DENSE), D ** -0.5),
        'ffn_w_up': nrm((N_DENSE_LAYERS, D, D_FF_DENSE), D ** -0.5),
        'ffn_w_down': nrm((N_DENSE_LAYERS, D_FF_DENSE, D), D_FF_DENSE ** -0.5),
        'moe_router': nrm((N_MOE_LAYERS, D, N_EXPERTS), D ** -0.5),
        'moe_w_gate': nrm((N_MOE_LAYERS, N_EXPERTS, D, D_FF_EXPERT), D ** -0.5),
        'moe_w_up': nrm((N_MOE_LAYERS, N_EXPERTS, D, D_FF_EXPERT), D ** -0.5),
        'moe_w_down': nrm((N_MOE_LAYERS, N_EXPERTS, D_FF_EXPERT, D), D_FF_EXPERT ** -0.5),
    }


def reference(x, c, ctx, c_ctx, w_mod, b_mod, pre_mix_norm, post_mix_norm, pre_ffn_norm,
              post_ffn_norm, w_in, q_norm, k_norm, hg_norm, hg_lb_logits, w_att_branch,
              w_hg_branch, w_out, ffn_w_gate, ffn_w_up, ffn_w_down, moe_router, moe_w_gate,
              moe_w_up, moe_w_down):
    b, n, d = x.shape
    l_ctx = ctx.shape[1]
    cos, sin = axial_rope_tables(n)
    lower_bounds = hgrn_lower_bounds(hg_lb_logits)
    zero_state = jnp.zeros((b, HGRN_HEADS, HGRN_EXPAND, HGRN_DV), jnp.float32)
    x_lat, x_ctx = x, ctx

    for layer in range(DEPTH):
        last = layer == DEPTH - 1
        mod_lat = (jax.nn.silu(c) @ w_mod[layer] + b_mod[layer])[:, None, :]
        mod_ctx = (jax.nn.silu(c_ctx) @ w_mod[layer] + b_mod[layer])[None, None, :]
        sh1, sc1, g1, sh2, sc2, g2 = jnp.split(mod_lat, N_MOD, axis=-1)
        csh1, csc1, cg1, csh2, csc2, cg2 = jnp.split(mod_ctx, N_MOD, axis=-1)
        lb = lower_bounds[layer]

        h_ctx = modulate(rms_norm(x_ctx, pre_mix_norm[layer]), csh1, csc1)
        h_lat = modulate(rms_norm(x_lat, pre_mix_norm[layer]), sh1, sc1)
        (aq_c, ak_c, av_c, hq_c, hff_c, hfb_c, hi_c, hg_c, ga_c, gh_c) = jnp.split(
            h_ctx @ w_in[layer], PROJ_SPLITS, axis=-1)
        (aq_l, ak_l, av_l, hq_l, hff_l, hfb_l, hi_l, hg_l, ga_l, gh_l) = jnp.split(
            h_lat @ w_in[layer], PROJ_SPLITS, axis=-1)

        k_ctx = rms_norm(split_heads(ak_c, ATT_KV_HEADS), k_norm[layer])
        v_ctx = split_heads(av_c, ATT_KV_HEADS)
        hq_ctx = split_heads(jax.nn.silu(hq_c), HGRN_HEADS)
        hv_ctx = split_heads(hi_c, HGRN_HEADS)
        kf_c, lf_c = hgrn_forget(hff_c, lb)
        kb_c, lb_c = hgrn_forget(hfb_c, lb)
        o_cf, state_f = hgrn2_chunk_scan(hq_ctx, kf_c, hv_ctx, lf_c, zero_state)
        o_cb, state_b = hgrn2_chunk_scan(jnp.flip(hq_ctx, 1), jnp.flip(kb_c, 1), jnp.flip(hv_ctx, 1),
                                         jnp.flip(lb_c, 1), zero_state)

        q_lat = apply_rope(rms_norm(split_heads(aq_l, ATT_HEADS), q_norm[layer]), cos, sin)
        k_lat = apply_rope(rms_norm(split_heads(ak_l, ATT_KV_HEADS), k_norm[layer]), cos, sin)
        v_lat = split_heads(av_l, ATT_KV_HEADS)
        att_lat = latent_attention(q_lat, k_lat, v_lat, k_ctx, v_ctx)
        hq_lat = split_heads(jax.nn.silu(hq_l), HGRN_HEADS)
        hv_lat = split_heads(hi_l, HGRN_HEADS)
        kf_l, lf_l = hgrn_forget(hff_l, lb)
        kb_l, lb_l = hgrn_forget(hfb_l, lb)
        o_lf, _ = hgrn2_chunk_scan(hq_lat, kf_l, hv_lat, lf_l, state_f)
        o_lb, _ = hgrn2_chunk_scan(jnp.flip(hq_lat, 1), jnp.flip(kb_l, 1), jnp.flip(hv_lat, 1),
                                   jnp.flip(lb_l, 1), state_b)
        hg_lat = hgrn_readout(o_lf + jnp.flip(o_lb, 1), hg_l, hg_norm[layer])
        mix_lat = merge_branches(att_lat, hg_lat, ga_l, gh_l, w_att_branch[layer],
                                 w_hg_branch[layer], w_out[layer])
        x_lat = x_lat + g1 * rms_norm(mix_lat, post_mix_norm[layer])

        if not last:
            q_ctx = rms_norm(split_heads(aq_c, ATT_HEADS), q_norm[layer])
            att_ctx = context_attention(q_ctx, k_ctx, v_ctx)
            hg_ctx = hgrn_readout(o_cf + jnp.flip(o_cb, 1), hg_c, hg_norm[layer])
            mix_ctx = merge_branches(att_ctx, hg_ctx, ga_c, gh_c, w_att_branch[layer],
                                     w_hg_branch[layer], w_out[layer])
            x_ctx = x_ctx + cg1 * rms_norm(mix_ctx, post_mix_norm[layer])

        f_lat = modulate(rms_norm(x_lat, pre_ffn_norm[layer]), sh2, sc2).reshape(b * n, d)
        if not last:
            f_ctx = modulate(rms_norm(x_ctx, pre_ffn_norm[layer]), csh2, csc2).reshape(b * l_ctx, d)
            tokens = jnp.concatenate([f_lat, f_ctx], axis=0)
        else:
            tokens = f_lat
        idx = layer // 2
        if layer % 2 == 0:
            y = swiglu(tokens, ffn_w_gate[idx], ffn_w_up[idx], ffn_w_down[idx])
        else:
            y = moe_swiglu(tokens, moe_router[idx], moe_w_gate[idx], moe_w_up[idx], moe_w_down[idx])
        y = rms_norm(y, post_ffn_norm[layer])
        x_lat = x_lat + g2 * y[:b * n].reshape(b, n, d)
        if not last:
            x_ctx = x_ctx + cg2 * y[b * n:].reshape(b, l_ctx, d)

    return x_lat
```

```cpp
#define MK_ONE_LAUNCH 1
#include <hip/hip_runtime.h>
#include <cstdio>
#include <cstdint>
#include <type_traits>

#define GAS __attribute__((address_space(1)))
#define LAS __attribute__((address_space(3)))
typedef unsigned short bf16_t;
typedef float f32x2 __attribute__((ext_vector_type(2)));
typedef unsigned u32x2 __attribute__((ext_vector_type(2)));
typedef GAS unsigned gu32;
#define RLX_AGENT __ATOMIC_RELAXED, __HIP_MEMORY_SCOPE_AGENT
#define LDS_WAIT() asm volatile("s_waitcnt lgkmcnt(0)" ::: "memory")
#define VM_WAIT() asm volatile("s_waitcnt vmcnt(0)" ::: "memory")

constexpr int DM = 1024, NB = 4, SEQ = 4096, CTXL = 256, NLAT = NB * SEQ, NCTX = NB * CTXL, R = NLAT + NCTX;
constexpr int PROJW = 8704, DFF = 2816, NEXP = 8, DFE = 3584, NMOD = 6 * DM;
constexpr int MOE_ROWS_MAX = (2 * NLAT / 256 + NEXP) * 256;
constexpr float NORM_EPS = 1e-6f;

extern __shared__ __attribute__((aligned(16))) unsigned char lds_raw[];
constexpr int LDS_CTL_OFF = 159744, WAVE_TAB_OFF = LDS_CTL_OFF + 1024;
__device__ __forceinline__ int hw_wave_slot() { return (int)__builtin_amdgcn_s_getreg((7 << 11) | 4) & 255; }
__device__ __forceinline__ int opaque_tid() {
    const int wv = *(const __attribute__((address_space(3))) int*)((__attribute__((address_space(3))) unsigned char*)lds_raw + WAVE_TAB_OFF + 4 * hw_wave_slot());
    int t = (wv << 6) | (int)__builtin_amdgcn_mbcnt_hi(~0u, __builtin_amdgcn_mbcnt_lo(~0u, 0u));
    asm volatile("" : "+v"(t)); return t; }
#ifndef PG8_ASM_STAGE
#define PG8_ASM_STAGE 1
#endif
namespace pg8 {
#define PG8_LAS __attribute__((address_space(3)))
typedef unsigned short bf16_t;
typedef short bf16x8 __attribute__((ext_vector_type(8)));
typedef float f32x4 __attribute__((ext_vector_type(4)));
typedef unsigned u32x4 __attribute__((ext_vector_type(4)));
constexpr int BM = 256, BK = 64, HALF = 128, HTB = HALF * BK * 2  , STAGE_BYTES = 8 * HTB, NXCD = 8, WGM = 8;

__host__ __device__ __forceinline__ int lds_byte(int r, int c) { const int st = (r >> 4) * 2 + (c >> 5), rr = r & 15, cc = c & 31, ob = rr * 64 + cc * 2; return st * 1024 + (ob ^ (((ob >> 9) & 1) << 5)); }
__host__ __device__ __forceinline__ void stage_rc(int b, int& R, int& C) { const int st = b / 1024, sb = b % 1024, swz = sb ^ (((sb >> 9) & 1) << 5); R = (st >> 1) * 16 + swz / 64; C = (st & 1) * 32 + (swz % 64) / 2; }
__host__ __device__ __forceinline__ int perm32(int rho) { const int n = rho >> 4, i = rho & 15; return 8 * (i >> 2) + 4 * n + (i & 3); }

struct Unit { int pm, pn, pb, pa; };
struct Gemm { const bf16_t* A; const bf16_t* Bt; int M, N, K; };

struct StaticOrder {
    int nM, nN, nwg, G, c, nfull;
    __host__ __device__ void init(int M, int N, int G_, int c_) { nM = M / BM; nN = N / BM; nwg = nM * nN; G = G_; c = c_; const int rem = nwg % G; nfull = (rem != 0 && rem * 4 <= G && nwg > G) ? nwg - rem : nwg; }
    __host__ __device__ void at(int L, Unit& u) const {
        int wgid = L; { const int q = nwg / NXCD, r = nwg % NXCD, xcd = wgid % NXCD, off = wgid / NXCD; wgid = (xcd < r ? xcd * (q + 1) : r * (q + 1) + (xcd - r) * q) + off; }
        const int nig = WGM * nN, gid = wgid / nig, fm = gid * WGM, gsz = (nM - fm) < WGM ? (nM - fm) : WGM;
        u.pm = fm + ((wgid % nig) % gsz); u.pn = (wgid % nig) / gsz; u.pb = u.pn; u.pa = u.pm;
    }
    __host__ __device__ bool next(int i, Unit& u) const { const long L = (long)i * G + c; if (L >= nfull) return false; at((int)L, u); return true; }
    __device__ __forceinline__ void a_ready(const Unit&) const {}
    __device__ __forceinline__ void done(const Unit&) const {}
};

template <class Epi, class Sched, bool ALIGN_EPI = false, bool SP2 = false, bool FP8 = false>
__device__ __forceinline__ void gemm_phase(PG8_LAS unsigned char* lds, const Gemm g, const Sched& S, const Epi& E) {
    const int tid = opaque_tid(), wid = __builtin_amdgcn_readfirstlane(tid >> 6), lane = tid & 63, wr = wid >> 2, wc = wid & 3, fr = lane & 15, fq = lane >> 4;
    const int K = g.K, RB = FP8 ? K : 2 * K  , nt = RB / (2 * BK);
    unsigned voffA[2], voffB[2];
#pragma unroll
    for (int i = 0; i < 2; ++i) { int R, C; stage_rc(tid * 16 + i * 8192, R, C); const int Rb = Epi::PERM ? ((R & ~31) + perm32(R & 31)) : R;
        voffA[i] = (unsigned)(R * RB + C * 2); voffB[i] = (unsigned)(Rb * RB + C * 2); }
    const size_t kstep = (size_t)(BK * 2);
    const size_t hstep = (size_t)HALF * RB;
    const size_t tstep = 2 * hstep;
    const unsigned ldsw = (unsigned)wid * 1024u;
    const int aoff = lds_byte(wr * 64 + fr, fq * 8), boff = lds_byte(wc * 32 + fr, fq * 8);
#define PG8_SA(b, h) (((b) * 2 + (h)) * HTB)
#define PG8_SB(b, h) ((4 + (b) * 2 + (h)) * HTB)
#define PG8_STAGE(bufoff, gbase, voff) do { _Pragma("unroll") for (int _i = 0; _i < 2; ++_i) { \
        if constexpr (FP8 || PG8_ASM_STAGE) { unsigned keep_; asm volatile("s_mov_b32 %0, m0\n\ts_mov_b32 m0, %3\n\ts_nop 0\n\tglobal_load_lds_dwordx4 %1, %2\n\ts_mov_b32 m0, %0" : "=&s"(keep_) : "v"((voff)[_i]), "s"((const char*)(gbase)), "s"((unsigned)(size_t)(lds + (bufoff) + ldsw + _i * 8192)) : "memory"); } \
        else __builtin_amdgcn_global_load_lds((const unsigned*)((const char*)(gbase) + (voff)[_i]), (PG8_LAS unsigned*)(lds + (bufoff) + ldsw + _i * 8192), 16, 0, 0); } } while (0)
#define PG8_LDA(dst, b, h) do { _Pragma("unroll") for (int m = 0; m < 4; ++m) { \
        if constexpr (FP8) { const v4i_t lo_ = *(const PG8_LAS v4i_t*)(lds + PG8_SA(b, h) + aoff + m * 2048), hi_ = *(const PG8_LAS v4i_t*)(lds + PG8_SA(b, h) + aoff + m * 2048 + 1024); dst[m] = __builtin_shufflevector(lo_, hi_, 0, 1, 2, 3, 4, 5, 6, 7); } \
        else { _Pragma("unroll") for (int k = 0; k < 2; ++k) dst[m].k[k] = *(const PG8_LAS bf16x8*)(lds + PG8_SA(b, h) + aoff + m * 2048 + k * 1024); } } } while (0)
#define PG8_LDB(dst, b, h) do { _Pragma("unroll") for (int n = 0; n < 2; ++n) { \
        if constexpr (FP8) { const v4i_t lo_ = *(const PG8_LAS v4i_t*)(lds + PG8_SB(b, h) + boff + n * 2048), hi_ = *(const PG8_LAS v4i_t*)(lds + PG8_SB(b, h) + boff + n * 2048 + 1024); dst[n] = __builtin_shufflevector(lo_, hi_, 0, 1, 2, 3, 4, 5, 6, 7); } \
        else { _Pragma("unroll") for (int k = 0; k < 2; ++k) dst[n].k[k] = *(const PG8_LAS bf16x8*)(lds + PG8_SB(b, h) + boff + n * 2048 + k * 1024); } } } while (0)
#define PG8_MMA(ai, bj, At, Bt) do { __builtin_amdgcn_s_setprio(1); \
        if constexpr (FP8) { _Pragma("unroll") for (int m = 0; m < 4; ++m) _Pragma("unroll") for (int n = 0; n < 2; ++n) \
            asm volatile("v_mfma_scale_f32_16x16x128_f8f6f4 %0, %1, %2, %0, %3, %3 op_sel_hi:[0,0,0]" : "+v"(acc[ai][bj][m][n]) : "v"(Bt[n]), "v"(At[m]), "v"(sclv)); } \
        else { _Pragma("unroll") for (int m = 0; m < 4; ++m) _Pragma("unroll") for (int n = 0; n < 2; ++n) _Pragma("unroll") for (int k = 0; k < 2; ++k) \
        acc[ai][bj][m][n] = __builtin_amdgcn_mfma_f32_16x16x32_bf16(Bt[n].k[k], At[m].k[k], acc[ai][bj][m][n], 0, 0, 0); } __builtin_amdgcn_s_setprio(0); } while (0)
#define PG8_WAIT_V(n) asm volatile("s_waitcnt vmcnt(" #n ")" ::: "memory")
#define PG8_WAIT_L(n) asm volatile("s_waitcnt lgkmcnt(" #n ")" ::: "memory")
#define PG8_BAR __builtin_amdgcn_s_barrier()
#define PG8_SCHED __builtin_amdgcn_sched_barrier(0)
    Unit cur, nxt; int ui = 0;
    if (!S.next(0, cur)) return;
    f32x4 acc[2][2][4][2];
#pragma unroll
    for (int a = 0; a < 2; ++a)
#pragma unroll
        for (int b = 0; b < 2; ++b)
#pragma unroll
            for (int m = 0; m < 4; ++m)
#pragma unroll
                for (int n = 0; n < 2; ++n) acc[a][b][m][n] = (f32x4){0.f, 0.f, 0.f, 0.f};
    struct Frag2 { bf16x8 k[2]; }; typedef int v8i_t __attribute__((ext_vector_type(8))); typedef int v4i_t __attribute__((ext_vector_type(4)));
    typename std::conditional<FP8, v8i_t, Frag2>::type At[4], B0[2], B1[2]; const int sclv = 0x7F7F7F7F; (void)sclv;
    const char* cA = (const char*)g.A + (size_t)cur.pa * tstep; const char* cB = (const char*)g.Bt + (size_t)cur.pb * tstep;
    S.a_ready(cur);
    if constexpr (SP2) {
        PG8_STAGE(PG8_SB(0, 0), cB, voffB); PG8_STAGE(PG8_SB(0, 1), cB + hstep, voffB); PG8_STAGE(PG8_SA(0, 0), cA, voffA); PG8_STAGE(PG8_SA(0, 1), cA + hstep, voffA);
        if (wr == 1) PG8_BAR;
        PG8_WAIT_V(2); PG8_BAR;
        PG8_STAGE(PG8_SB(1, 0), cB + kstep, voffB); PG8_STAGE(PG8_SA(1, 0), cA + kstep, voffA); PG8_STAGE(PG8_SB(1, 1), cB + hstep + kstep, voffB);
        PG8_WAIT_V(6); PG8_BAR;
    } else {
        PG8_STAGE(PG8_SB(0, 0), cB, voffB); PG8_STAGE(PG8_SA(0, 0), cA, voffA); PG8_STAGE(PG8_SB(0, 1), cB + hstep, voffB); PG8_STAGE(PG8_SA(0, 1), cA + hstep, voffA);
        if (wr == 1) PG8_BAR;
        PG8_WAIT_V(4); PG8_BAR;
        PG8_STAGE(PG8_SB(1, 0), cB + kstep, voffB); PG8_STAGE(PG8_SA(1, 0), cA + kstep, voffA); PG8_STAGE(PG8_SB(1, 1), cB + hstep + kstep, voffB);
        PG8_WAIT_V(6); PG8_BAR;
    }
    for (;;) {
        const bool has_next = S.next(ui + 1, nxt);
        const char* nA = has_next ? (const char*)g.A + (size_t)nxt.pa * tstep : cA; const char* nB = has_next ? (const char*)g.Bt + (size_t)nxt.pb * tstep : cB;
#pragma unroll 1
        for (int t = 0; t < nt; t += 2) {
            const bool last = (t == nt - 2);
            const char* a1 = cA + (size_t)(t + 1) * kstep;
            const char* a2 = last ? nA : cA + (size_t)(t + 2) * kstep; const char* b2 = last ? nB : cB + (size_t)(t + 2) * kstep;
            const char* a3 = a2 + kstep; const char* b3 = b2 + kstep;
            if (last && has_next) S.a_ready(nxt);
            if constexpr (SP2) {
            PG8_LDB(B0, 0, 0); PG8_LDB(B1, 0, 1); PG8_SCHED; PG8_LDA(At, 0, 0); PG8_STAGE(PG8_SA(1, 1), a1 + hstep, voffA);
            PG8_WAIT_V(8); PG8_WAIT_L(0); PG8_BAR; PG8_MMA(0, 0, At, B0); PG8_MMA(0, 1, At, B1); PG8_BAR; PG8_SCHED;
            PG8_LDA(At, 0, 1); PG8_STAGE(PG8_SB(0, 0), b2, voffB); PG8_STAGE(PG8_SB(0, 1), b2 + hstep, voffB); PG8_STAGE(PG8_SA(0, 0), a2, voffA);
            PG8_WAIT_V(8); PG8_WAIT_L(0); PG8_BAR; PG8_MMA(1, 0, At, B0); PG8_MMA(1, 1, At, B1); PG8_BAR; PG8_SCHED;
            PG8_LDB(B0, 1, 0); PG8_LDB(B1, 1, 1); PG8_SCHED; PG8_LDA(At, 1, 0); PG8_STAGE(PG8_SA(0, 1), a2 + hstep, voffA);
            PG8_WAIT_V(8); PG8_WAIT_L(0); PG8_BAR; PG8_MMA(0, 0, At, B0); PG8_MMA(0, 1, At, B1); PG8_BAR; PG8_SCHED;
            PG8_LDA(At, 1, 1); PG8_STAGE(PG8_SB(1, 0), b3, voffB); PG8_STAGE(PG8_SB(1, 1), b3 + hstep, voffB); PG8_STAGE(PG8_SA(1, 0), a3, voffA);
            PG8_WAIT_V(8); PG8_WAIT_L(0); PG8_BAR; PG8_MMA(1, 0, At, B0); PG8_MMA(1, 1, At, B1); PG8_BAR; PG8_SCHED;
            } else {
            PG8_LDB(B0, 0, 0); PG8_SCHED; PG8_LDA(At, 0, 0); PG8_STAGE(PG8_SA(1, 1), a1 + hstep, voffA);
            PG8_WAIT_L(8); PG8_BAR; PG8_WAIT_L(0); PG8_MMA(0, 0, At, B0); PG8_BAR; PG8_SCHED;
            PG8_LDB(B1, 0, 1); PG8_STAGE(PG8_SB(0, 0), b2, voffB);
            PG8_BAR; PG8_WAIT_L(0); PG8_MMA(0, 1, At, B1); PG8_BAR;
            PG8_LDA(At, 0, 1); PG8_STAGE(PG8_SA(0, 0), a2, voffA);
            PG8_BAR; PG8_WAIT_L(0); PG8_MMA(1, 0, At, B0); PG8_BAR; PG8_SCHED;
            PG8_STAGE(PG8_SB(0, 1), b2 + hstep, voffB);
            PG8_WAIT_V(6); PG8_BAR; PG8_MMA(1, 1, At, B1); PG8_BAR;
            PG8_LDB(B0, 1, 0); PG8_SCHED; PG8_LDA(At, 1, 0); PG8_STAGE(PG8_SA(0, 1), a2 + hstep, voffA);
            PG8_WAIT_L(8); PG8_BAR; PG8_WAIT_L(0); PG8_MMA(0, 0, At, B0); PG8_BAR; PG8_SCHED;
            PG8_LDB(B1, 1, 1); PG8_STAGE(PG8_SB(1, 0), b3, voffB);
            PG8_BAR; PG8_WAIT_L(0); PG8_MMA(0, 1, At, B1); PG8_BAR;
            PG8_LDA(At, 1, 1); PG8_STAGE(PG8_SA(1, 0), a3, voffA);
            PG8_BAR; PG8_WAIT_L(0); PG8_MMA(1, 0, At, B0); PG8_BAR; PG8_SCHED;
            PG8_STAGE(PG8_SB(1, 1), b3 + hstep, voffB);
            PG8_WAIT_V(6); PG8_BAR; PG8_MMA(1, 1, At, B1); PG8_BAR;
            }
        }
        if constexpr (ALIGN_EPI) { if (wr == 0) PG8_BAR; }
        if constexpr (FP8) asm volatile("s_nop 15\n\ts_nop 15" ::: "memory");
        if constexpr (!Epi::AFTER_DRAIN) { E(acc, cur, wr, wc, fr, fq); S.done(cur); }
        if (!has_next) break;
#pragma unroll
        for (int a = 0; a < 2; ++a)
#pragma unroll
            for (int b = 0; b < 2; ++b)
#pragma unroll
                for (int m = 0; m < 4; ++m)
#pragma unroll
                    for (int n = 0; n < 2; ++n) acc[a][b][m][n] = (f32x4){0.f, 0.f, 0.f, 0.f};
        cur = nxt; cA = nA; cB = nB; ++ui;
        if constexpr (ALIGN_EPI) { if (wr == 1) PG8_BAR; }
    }
    PG8_WAIT_V(0);
    if constexpr (!ALIGN_EPI) { if (wr == 0) PG8_BAR; }
    PG8_BAR;
    if constexpr (Epi::AFTER_DRAIN) { E.fused(acc, cur, wr, wc, fr, fq, lds, wid, lane); S.done(cur); }
#undef PG8_SA
#undef PG8_SB
#undef PG8_STAGE
#undef PG8_LDA
#undef PG8_LDB
#undef PG8_MMA
#undef PG8_WAIT_V
#undef PG8_WAIT_L
#undef PG8_BAR
#undef PG8_SCHED
}
}

using pg8::f32x4; using pg8::u32x4; using pg8::bf16x8; using pg8::Unit;
typedef __bf16 bf16x2_t __attribute__((ext_vector_type(2)));
__device__ __forceinline__ unsigned pk_bf16(float lo, float hi) { const f32x2 v = {lo, hi}; const bf16x2_t b = __builtin_convertvector(v, bf16x2_t); return __builtin_bit_cast(unsigned, b); }
__device__ __forceinline__ float bf_lo(unsigned u) { return __uint_as_float(u << 16); }
__device__ __forceinline__ float bf_hi(unsigned u) { return __uint_as_float(u & 0xffff0000u); }
typedef _Float16 h2_t __attribute__((ext_vector_type(2)));
__device__ __forceinline__ unsigned pk_f16(float lo, float hi) { h2_t h = {(_Float16)lo, (_Float16)hi}; return __builtin_bit_cast(unsigned, h); }
__device__ __forceinline__ f32x2 unpk_f16(unsigned u) { h2_t h = __builtin_bit_cast(h2_t, u); return (f32x2){(float)h.x, (float)h.y}; }
__device__ __forceinline__ float sigm(float x) { return __builtin_amdgcn_rcpf(1.f + __expf(-x)); }
__device__ __forceinline__ float silu_f(float x) { return x * sigm(x); }
__device__ __forceinline__ u32x4 pack8(const f32x4 a, const f32x4 b) { u32x4 w; w.x = pk_bf16(a[0], a[1]); w.y = pk_bf16(a[2], a[3]); w.z = pk_bf16(b[0], b[1]); w.w = pk_bf16(b[2], b[3]); return w; }
__device__ __forceinline__ void unpack8(const u32x4 w, f32x4& a, f32x4& b) { a = (f32x4){bf_lo(w.x), bf_hi(w.x), bf_lo(w.y), bf_hi(w.y)}; b = (f32x4){bf_lo(w.z), bf_hi(w.z), bf_lo(w.w), bf_hi(w.w)}; }

__device__ __forceinline__ void sigm8(const f32x4 a, const f32x4 b, f32x4& sa, f32x4& sb) {
    f32x4 ea, eb;
#pragma unroll
    for (int j = 0; j < 4; ++j) { ea[j] = __builtin_amdgcn_exp2f(a[j] * -1.4426950408889634f); eb[j] = __builtin_amdgcn_exp2f(b[j] * -1.4426950408889634f); }
#pragma unroll
    for (int j = 0; j < 4; ++j) { sa[j] = __builtin_amdgcn_rcpf(1.f + ea[j]); sb[j] = __builtin_amdgcn_rcpf(1.f + eb[j]); }
}
#ifndef EPI_NT
#define EPI_NT 0
#endif
#ifndef EPI_SC1
#define EPI_SC1 0
#endif
__device__ __forceinline__ void st16(void* p, u32x4 v) { if (EPI_SC1) *(volatile GAS u32x4*)p = v; else if (EPI_NT) __builtin_nontemporal_store(v, (u32x4*)p); else *(u32x4*)p = v; }
__device__ __forceinline__ void st8(void* p, u32x2 v) { if (EPI_SC1) *(volatile GAS u32x2*)p = v; else if (EPI_NT) __builtin_nontemporal_store(v, (u32x2*)p); else *(u32x2*)p = v; }
__device__ __forceinline__ float clamp448(float x) { return fminf(fmaxf(x, -448.f), 448.f); }
__device__ __forceinline__ unsigned pk4_fp8(float a, float b, float c, float d) { int w = 0; w = __builtin_amdgcn_cvt_pk_fp8_f32(clamp448(a), clamp448(b), w, false); w = __builtin_amdgcn_cvt_pk_fp8_f32(clamp448(c), clamp448(d), w, true); return (unsigned)w; }


struct EpiProj {
    static constexpr bool PERM = true, AFTER_DRAIN = false;
    bf16_t* proj; const float* lbv; int probe = 0;
    template <int MODE> __device__ __forceinline__ void emit(const f32x4 (&acc)[2][2][4][2], bf16_t* base, int ldc, const float* lbp) const {
        f32x4 lb[2][2];
        if (MODE == 3) {
#pragma unroll
            for (int bj = 0; bj < 2; ++bj)
#pragma unroll
                for (int n = 0; n < 2; ++n) lb[bj][n] = *(const f32x4*)(lbp + bj * 128 + 4 * n);
        }
#pragma unroll
        for (int ai = 0; ai < 2; ++ai)
#pragma unroll
            for (int m = 0; m < 4; ++m) { bf16_t* rowp = base + (size_t)(ai * 128 + m * 16) * ldc;
#pragma unroll
                for (int bj = 0; bj < 2; ++bj) { f32x4 v[2] = {acc[ai][bj][m][0], acc[ai][bj][m][1]}; u32x4 w;
                    if (MODE == 0) w = pack8(v[0], v[1]);
                    else { f32x4 s0, s1; sigm8(v[0], v[1], s0, s1);
                        if (MODE == 1) w = pack8(v[0] * s0, v[1] * s1);
                        else if (MODE == 2) w = pack8(s0, s1);
                        else { const f32x4 f0 = lb[bj][0] + (1.f - lb[bj][0]) * s0, f1 = lb[bj][1] + (1.f - lb[bj][1]) * s1; f32x4 g0, g1;
#pragma unroll
                            for (int j = 0; j < 4; ++j) { g0[j] = __builtin_amdgcn_logf(f0[j]); g1[j] = __builtin_amdgcn_logf(f1[j]); }
#pragma unroll
                            for (int j = 0; j < 4; ++j) { g0[j] = fmaxf(g0[j] * 0.6931471805599453f, -40.f); g1[j] = fmaxf(g1[j] * 0.6931471805599453f, -40.f); }
                            w.x = pk_f16(g0[0], g0[1]); w.y = pk_f16(g0[2], g0[3]); w.z = pk_f16(g1[0], g1[1]); w.w = pk_f16(g1[2], g1[3]); } }
                    st16(rowp + bj * 128, w); } }
    }
    __device__ __forceinline__ void operator()(const f32x4 (&acc)[2][2][4][2], const Unit& u, int wr, int wc, int fr, int fq) const {
        const int pn = u.pn; int seg, ct;
        if (pn < 4) { seg = 0; ct = pn; } else if (pn < 6) { seg = pn - 3; ct = 0; } else { seg = 3 + ((pn - 6) >> 2); ct = (pn - 6) & 3; }
        const size_t segoff = (seg == 0) ? (size_t)0 : (seg == 1) ? (size_t)R * 1024 : (seg == 2) ? (size_t)R * 1280 : (size_t)R * (size_t)(1536 + 1024 * (seg - 3));
        const int ldc = (seg == 1 || seg == 2) ? 256 : 1024;
        const int mode = (seg == 3 || seg == 7) ? 1 : (seg == 8 || seg == 9) ? 2 : (seg == 4 || seg == 5) ? 3 : 0;
        const int row0 = u.pm * 256 + wr * 64 + fr, col0 = ct * 256 + wc * 32 + 8 * fq;
        bf16_t* base = probe ? proj + (size_t)(wr * 64 + fr) * ldc + col0 : proj + segoff + (size_t)row0 * ldc + col0;
        if (mode == 0) emit<0>(acc, base, ldc, nullptr);
        else if (mode == 1) emit<1>(acc, base, ldc, nullptr);
        else if (mode == 2) emit<2>(acc, base, ldc, nullptr);
        else emit<3>(acc, base, ldc, lbv + col0);
    }
    __device__ __forceinline__ void put8(const Unit& u, int rt, int ctl, f32x4 v0, f32x4 v1) const {
        const int pn = u.pn; int seg, ct;
        if (pn < 4) { seg = 0; ct = pn; } else if (pn < 6) { seg = pn - 3; ct = 0; } else { seg = 3 + ((pn - 6) >> 2); ct = (pn - 6) & 3; }
        const size_t segoff = (seg == 0) ? (size_t)0 : (seg == 1) ? (size_t)R * 1024 : (seg == 2) ? (size_t)R * 1280 : (size_t)R * (size_t)(1536 + 1024 * (seg - 3));
        const int ldc = (seg == 1 || seg == 2) ? 256 : 1024;
        const int mode = (seg == 3 || seg == 7) ? 1 : (seg == 8 || seg == 9) ? 2 : (seg == 4 || seg == 5) ? 3 : 0;
        const int col = ct * 256 + ctl;
        u32x4 w;
        if (mode == 3) { const f32x4 l0 = *(const f32x4*)(lbv + col), l1 = *(const f32x4*)(lbv + col + 4); float g[8];
#pragma unroll
            for (int j = 0; j < 4; ++j) { g[j] = fmaxf(__builtin_amdgcn_logf(l0[j] + (1.f - l0[j]) * sigm(v0[j])) * 0.6931471805599453f, -40.f); g[4 + j] = fmaxf(__builtin_amdgcn_logf(l1[j] + (1.f - l1[j]) * sigm(v1[j])) * 0.6931471805599453f, -40.f); }
            w.x = pk_f16(g[0], g[1]); w.y = pk_f16(g[2], g[3]); w.z = pk_f16(g[4], g[5]); w.w = pk_f16(g[6], g[7]);
        } else {
#pragma unroll
            for (int j = 0; j < 4; ++j) { if (mode == 1) { v0[j] = silu_f(v0[j]); v1[j] = silu_f(v1[j]); } if (mode == 2) { v0[j] = sigm(v0[j]); v1[j] = sigm(v1[j]); } }
            w = pack8(v0, v1);
        }
        *(u32x4*)(proj + segoff + (size_t)(u.pm * 256 + rt) * ldc + col) = w;
    }
};
struct EpiSwiGLU {
    static constexpr bool PERM = true, AFTER_DRAIN = false;
    bf16_t* O; int ldc;
    __device__ __forceinline__ void operator()(const f32x4 (&acc)[2][2][4][2], const Unit& u, int wr, int wc, int fr, int fq) const {
        bf16_t* base = O + (size_t)(u.pm * 256 + wr * 64 + fr) * ldc + u.pn * 128 + wc * 32 + 8 * fq;
#pragma unroll
        for (int ai = 0; ai < 2; ++ai)
#pragma unroll
            for (int m = 0; m < 4; ++m) { f32x4 s0, s1; sigm8(acc[ai][0][m][0], acc[ai][0][m][1], s0, s1);
                st16(base + (size_t)(ai * 128 + m * 16) * ldc, pack8(acc[ai][0][m][0] * s0 * acc[ai][1][m][0], acc[ai][0][m][1] * s1 * acc[ai][1][m][1])); }
    }
    __device__ __forceinline__ void put8(const Unit&, int, int, f32x4, f32x4) const {}
};
struct EpiSwiGLU8 {
    static constexpr bool PERM = true, AFTER_DRAIN = false;
    unsigned char* O; int ldc;
    __device__ __forceinline__ void operator()(const f32x4 (&acc)[2][2][4][2], const Unit& u, int wr, int wc, int fr, int fq) const {
        unsigned char* base = O + (size_t)(u.pm * 256 + wr * 64 + fr) * ldc + u.pn * 128 + wc * 32 + 8 * fq;
#pragma unroll
        for (int ai = 0; ai < 2; ++ai)
#pragma unroll
            for (int m = 0; m < 4; ++m) { const f32x4 g0 = acc[ai][0][m][0] * 0.015625f, g1 = acc[ai][0][m][1] * 0.015625f; f32x4 s0, s1; sigm8(g0, g1, s0, s1);
                const f32x4 h0 = g0 * s0 * (acc[ai][1][m][0] * 0.015625f), h1 = g1 * s1 * (acc[ai][1][m][1] * 0.015625f);
                st8(base + (size_t)(ai * 128 + m * 16) * ldc, (u32x2){pk4_fp8(h0[0], h0[1], h0[2], h0[3]), pk4_fp8(h1[0], h1[1], h1[2], h1[3])}); }
    }
    __device__ __forceinline__ void put8(const Unit&, int, int, f32x4, f32x4) const {}
};
template <bool HAS_ADD> struct EpiGate {
    static constexpr bool PERM = true, AFTER_DRAIN = false;
    bf16_t* G; const bf16_t* ADD;
    __device__ __forceinline__ void operator()(const f32x4 (&acc)[2][2][4][2], const Unit& u, int wr, int wc, int fr, int fq) const {
        const size_t off0 = (size_t)(u.pm * 256 + wr * 64 + fr) * 1024 + u.pn * 256 + wc * 32 + 8 * fq;
#pragma unroll
        for (int ai = 0; ai < 2; ++ai) {
            u32x4 gv[4][2], av[4][2];
#pragma unroll
            for (int m = 0; m < 4; ++m)
#pragma unroll
                for (int bj = 0; bj < 2; ++bj) { const size_t off = off0 + (size_t)(ai * 128 + m * 16) * 1024 + bj * 128;
                    gv[m][bj] = *(const u32x4*)(G + off); if (HAS_ADD) av[m][bj] = *(const u32x4*)(ADD + off); }
#pragma unroll
            for (int m = 0; m < 4; ++m)
#pragma unroll
                for (int bj = 0; bj < 2; ++bj) { const size_t off = off0 + (size_t)(ai * 128 + m * 16) * 1024 + bj * 128;
                    f32x4 g0, g1; unpack8(gv[m][bj], g0, g1);
                    f32x4 o0 = g0 * acc[ai][bj][m][0], o1 = g1 * acc[ai][bj][m][1];
                    if (HAS_ADD) { f32x4 a0, a1; unpack8(av[m][bj], a0, a1); o0 += a0; o1 += a1; }
                    st16(G + off, pack8(o0, o1)); }
        }
    }
    __device__ __forceinline__ void put8(const Unit& u, int rt, int ctl, f32x4 v0, f32x4 v1) const {
        const size_t off = (size_t)(u.pm * 256 + rt) * 1024 + u.pn * 256 + ctl;
        f32x4 g0, g1; unpack8(*(const u32x4*)(G + off), g0, g1);
        f32x4 o0 = g0 * v0, o1 = g1 * v1;
        if (HAS_ADD) { f32x4 a0, a1; unpack8(*(const u32x4*)(ADD + off), a0, a1); o0 += a0; o1 += a1; }
        *(u32x4*)(G + off) = pack8(o0, o1);
    }
};
struct EpiPlain {
    static constexpr bool PERM = true, AFTER_DRAIN = false;
    bf16_t* O; int ldc; float scale = 1.f;
    __device__ __forceinline__ void operator()(const f32x4 (&acc)[2][2][4][2], const Unit& u, int wr, int wc, int fr, int fq) const {
        bf16_t* base = O + (size_t)(u.pm * 256 + wr * 64 + fr) * ldc + u.pn * 256 + wc * 32 + 8 * fq;
#pragma unroll
        for (int ai = 0; ai < 2; ++ai)
#pragma unroll
            for (int m = 0; m < 4; ++m)
#pragma unroll
                for (int bj = 0; bj < 2; ++bj) st16(base + (size_t)(ai * 128 + m * 16) * ldc + bj * 128, pack8(acc[ai][bj][m][0] * scale, acc[ai][bj][m][1] * scale));
    }
    __device__ __forceinline__ void put8(const Unit& u, int rt, int ctl, f32x4 v0, f32x4 v1) const {
        *(u32x4*)(O + (size_t)(u.pm * 256 + rt) * ldc + u.pn * 256 + ctl) = pack8(v0 * scale, v1 * scale);
    }
};
struct EpiNull {
    static constexpr bool PERM = true, AFTER_DRAIN = false;
    __device__ __forceinline__ void operator()(const f32x4 (&acc)[2][2][4][2], const Unit& u, int wr, int wc, int fr, int fq) const {
#pragma unroll
        for (int a = 0; a < 2; ++a)
#pragma unroll
            for (int b = 0; b < 2; ++b)
#pragma unroll
                for (int m = 0; m < 4; ++m) asm volatile("" :: "v"(acc[a][b][m][0]), "v"(acc[a][b][m][1])); }
    __device__ __forceinline__ void put8(const Unit&, int, int, f32x4, f32x4) const {}
};
struct MoeOrder {
    int nb[NEXP]; int nN, G, c, nwg, nfull, acap = 0;
    __device__ __forceinline__ void finish() { int t = 0;
#pragma unroll
        for (int e = 0; e < NEXP; ++e) t += nb[e] * nN;
        nwg = t; const int rem = t % G; nfull = (rem != 0 && rem * 4 <= G && t > G) ? t - rem : t; }
    __device__ __forceinline__ bool at(int L, Unit& u) const {
        int accu = 0, pbase = 0; bool found = false;
#pragma unroll
        for (int e = 0; e < NEXP; ++e) { const int ue = nb[e] * nN;
            if (!found && L < accu + ue) { const int loc = L - accu; const int q = loc / nb[e]; u.pn = q; u.pm = pbase + (loc - q * nb[e]); u.pb = e * nN + q; u.pa = acap ? e * acap + (loc - q * nb[e]) : u.pm; found = true; }
            accu += ue; pbase += nb[e]; }
        return found;
    }
    __device__ __forceinline__ bool next(int i, Unit& u) const { const int L = i * G + c; if (L >= nfull) return false; return at(L, u); }
    __device__ __forceinline__ void a_ready(const Unit&) const {}
    __device__ __forceinline__ void done(const Unit&) const {}
};

template <class Epi, class Sched>
__device__ __forceinline__ void gemm_mini(const pg8::Gemm g, const Sched& S, const Epi& E, int wgi, int nwgs) {
    const int nbig = S.nwg - S.nfull; if (nbig <= 0) return;
    const int tid = opaque_tid(), w = __builtin_amdgcn_readfirstlane(tid >> 6), lane = tid & 63, r = lane & 15, q4 = lane >> 4;
    const int wm = w >> 1, wn = w & 1; const int K = g.K;
    for (int m = wgi; m < nbig * 16; m += nwgs) {
        Unit u; S.at(S.nfull + (m >> 4), u); const int sub = m & 15, rt = (sub >> 2) * 64 + wm * 16 + r, ct = (sub & 3) * 64 + wn * 32;
        const bf16_t* ap = g.A + ((size_t)u.pm * 256 + rt) * K + 8 * q4;
        const bf16_t* bp0 = g.Bt + ((size_t)u.pb * 256 + ct + 8 * (r >> 2) + (r & 3)) * K + 8 * q4;
        const bf16_t* bp1 = bp0 + (size_t)4 * K;
        f32x4 c0 = (f32x4){0.f, 0.f, 0.f, 0.f}, c1 = (f32x4){0.f, 0.f, 0.f, 0.f};
        for (int ks = 0; ks < K / 32; ks += 8) {
            bf16x8 a[8], b0[8], b1[8];
#pragma unroll
            for (int i = 0; i < 8; ++i) { a[i] = *(const bf16x8*)(ap + 32 * (ks + i)); b0[i] = *(const bf16x8*)(bp0 + 32 * (ks + i)); b1[i] = *(const bf16x8*)(bp1 + 32 * (ks + i)); }
#pragma unroll
            for (int i = 0; i < 8; ++i) { c0 = __builtin_amdgcn_mfma_f32_16x16x32_bf16(b0[i], a[i], c0, 0, 0, 0); c1 = __builtin_amdgcn_mfma_f32_16x16x32_bf16(b1[i], a[i], c1, 0, 0, 0); }
        }
        E.put8(u, rt, ct + 8 * q4, c0, c1);
    }
}
template <class Epi, class Sched>
__device__ __forceinline__ void gemm_mini_ks(LAS unsigned char* lds, const pg8::Gemm g, const Sched& S, const Epi& E, int wgi, int nwgs) {
    const int nbig = S.nwg - S.nfull; if (nbig <= 0) return;
    constexpr int K = DM, PP = 68; static_assert(K / 32 == 32, "four K-steps per wave");
    const int tid = opaque_tid(), w = __builtin_amdgcn_readfirstlane(tid >> 6), lane = tid & 63, r = lane & 15, q4 = lane >> 4;
    LAS float* part = (LAS float*)lds + w * 64 * PP;
    __syncthreads();
    for (int m = wgi; m < nbig * 16; m += nwgs) {
        Unit u; S.at(S.nfull + (m >> 4), u); const int sub = m & 15, rt0 = (sub >> 2) * 64, ct0 = (sub & 3) * 64;
        const bf16_t* ap = g.A + ((size_t)u.pm * 256 + rt0) * K + (r * K + 8 * q4);
        const bf16_t* bp = g.Bt + ((size_t)u.pb * 256 + ct0) * K + (r * K + 8 * q4);
        f32x4 acc[4][4];
#pragma unroll
        for (int i = 0; i < 4; ++i)
#pragma unroll
            for (int j = 0; j < 4; ++j) acc[i][j] = (f32x4){0.f, 0.f, 0.f, 0.f};
        bf16x8 fa[2][4], fb[2][4];
#define MK_LOAD(s_, ks_) do { _Pragma("unroll") for (int t = 0; t < 4; ++t) { fa[s_][t] = *(const bf16x8*)(ap + (size_t)16 * t * K + 32 * (ks_)); fb[s_][t] = *(const bf16x8*)(bp + (size_t)16 * t * K + 32 * (ks_)); } } while (0)
#define MK_MMA(s_) do { _Pragma("unroll") for (int tm = 0; tm < 4; ++tm) _Pragma("unroll") for (int tn = 0; tn < 4; ++tn)                      \
            acc[tm][tn] = __builtin_amdgcn_mfma_f32_16x16x32_bf16(fb[s_][tn], fa[s_][tm], acc[tm][tn], 0, 0, 0); } while (0)
        MK_LOAD(0, w); MK_LOAD(1, w + 8);
        MK_MMA(0); MK_LOAD(0, w + 16);
        MK_MMA(1); MK_LOAD(1, w + 24);
        MK_MMA(0); MK_MMA(1);
#undef MK_LOAD
#undef MK_MMA
#pragma unroll
        for (int tm = 0; tm < 4; ++tm)
#pragma unroll
            for (int tn = 0; tn < 4; ++tn) *(LAS f32x4*)(part + (16 * tm + r) * PP + 16 * tn + 4 * q4) = acc[tm][tn];
        __syncthreads();
        { const int row = tid >> 3, cg = tid & 7; f32x4 v0 = (f32x4){0.f, 0.f, 0.f, 0.f}, v1 = v0;
#pragma unroll
          for (int ww = 0; ww < 8; ++ww) { const LAS float* p = (const LAS float*)lds + ww * 64 * PP + row * PP + 8 * cg; v0 += *(const LAS f32x4*)p; v1 += *(const LAS f32x4*)(p + 4); }
          E.put8(u, rt0 + row, ct0 + 8 * cg, v0, v1); }
        __syncthreads();
    }
}
template <int K, class Epi, class Sched>
__device__ __forceinline__ void gemm_mini8(LAS unsigned char* lds, const unsigned char* Ag, const unsigned char* Bg, const Sched& S, const Epi& E, int wgi, int nwgs) {
    const int nbig = S.nwg - S.nfull; if (nbig <= 0) return;
    typedef int v8i_t __attribute__((ext_vector_type(8))); typedef int v4i_t __attribute__((ext_vector_type(4)));
    const int tid = opaque_tid(), w = __builtin_amdgcn_readfirstlane(tid >> 6), lane = tid & 63, r = lane & 15, q4 = lane >> 4;
    const int sclv = 0x7F7F7F7F; constexpr int nks = K / 128; constexpr int PP = 68;
    LAS float* part = (LAS float*)lds + w * 64 * PP;
    __syncthreads();
    for (int m = wgi; m < nbig * 16; m += nwgs) {
        Unit u; S.at(S.nfull + (m >> 4), u); const int sub = m & 15, rt0 = (sub >> 2) * 64, ct0 = (sub & 3) * 64;
        const unsigned char* ap = Ag + ((size_t)u.pm * 256 + rt0) * K + (r * K + 32 * q4);
        const unsigned char* bp = Bg + ((size_t)u.pb * 256 + ct0) * K + (r * K + 32 * q4);
        f32x4 acc[4][4];
#pragma unroll
        for (int i = 0; i < 4; ++i)
#pragma unroll
            for (int j = 0; j < 4; ++j) acc[i][j] = (f32x4){0.f, 0.f, 0.f, 0.f};
        v8i_t fa[2][4], fb[4];
#define M8_LDA(s_, ks_) do { const size_t o = (size_t)128 * (ks_); _Pragma("unroll") for (int t = 0; t < 4; ++t) {                                    \
            const v4i_t al = *(const v4i_t*)(ap + (size_t)16 * t * K + o), ah = *(const v4i_t*)(ap + (size_t)16 * t * K + o + 16);                          \
            fa[s_][t] = __builtin_shufflevector(al, ah, 0, 1, 2, 3, 4, 5, 6, 7); } } while (0)
#define M8_LDB(ks_) do { const size_t o = (size_t)128 * (ks_); _Pragma("unroll") for (int t = 0; t < 4; ++t) {                                         \
            const v4i_t bl = *(const v4i_t*)(bp + (size_t)16 * t * K + o), bh = *(const v4i_t*)(bp + (size_t)16 * t * K + o + 16);                          \
            fb[t] = __builtin_shufflevector(bl, bh, 0, 1, 2, 3, 4, 5, 6, 7); } } while (0)
#define M8_MMA(s_) do { _Pragma("unroll") for (int tm = 0; tm < 4; ++tm) _Pragma("unroll") for (int tn = 0; tn < 4; ++tn)                                 \
            asm volatile("v_mfma_scale_f32_16x16x128_f8f6f4 %0, %1, %2, %0, %3, %3 op_sel_hi:[0,0,0]" : "+v"(acc[tm][tn]) : "v"(fb[tn]), "v"(fa[s_][tm]), "v"(sclv)); } while (0)
        const int k0 = w, k1 = w + 8, k2 = w + 16, k3 = (w + 24 < nks) ? w + 24 : w + 16;
        M8_LDA(0, k0); M8_LDB(k0); M8_LDA(1, k1);
        M8_MMA(0); M8_LDB(k1); M8_LDA(0, k2);
        M8_MMA(1); M8_LDB(k2); M8_LDA(1, k3);
        M8_MMA(0); M8_LDB(k3);
        if (w + 24 < nks) M8_MMA(1);
#undef M8_LDA
#undef M8_LDB
#undef M8_MMA
        asm volatile("s_nop 15\n\ts_nop 15" ::: "memory");
#pragma unroll
        for (int tm = 0; tm < 4; ++tm)
#pragma unroll
            for (int tn = 0; tn < 4; ++tn) *(LAS f32x4*)(part + (16 * tm + r) * PP + 16 * tn + 4 * q4) = acc[tm][tn];
        __syncthreads();
        { const int row = tid >> 3, cg = tid & 7; f32x4 v0 = (f32x4){0.f, 0.f, 0.f, 0.f}, v1 = v0;
#pragma unroll
          for (int ww = 0; ww < 8; ++ww) { const LAS float* p = (const LAS float*)lds + ww * 64 * PP + row * PP + 8 * cg; v0 += *(const LAS f32x4*)p; v1 += *(const LAS f32x4*)(p + 4); }
          E.put8(u, rt0 + row, ct0 + 8 * cg, v0, v1); }
        __syncthreads();
    }
}

namespace att {
using s16x4  = __attribute__((ext_vector_type(4))) short;
using f32x16 = __attribute__((ext_vector_type(16))) float;
constexpr int   D = 128, NW = 8, QBLK = 32, KVBLK = 64;
constexpr float SCALE = 0.088388347648318440f;
constexpr float THR = 8.f;
constexpr int SHM_V = KVBLK * D * 2, SHM_K = KVBLK * D * 2, SHM_ATTN = 2 * SHM_V + 2 * SHM_K + NW * 64 * 4;
#define KSWZ(row, colB) ((row) * 256 + ((colB) ^ (((row) & 15) << 4)))
#define SBAR() __builtin_amdgcn_sched_barrier(0)
__device__ __forceinline__ int crow(int r, int hi) { return (r & 3) + 8 * (r >> 2) + 4 * hi; }
__device__ __forceinline__ unsigned cvtpk(float lo, float hi) { unsigned r; asm volatile("v_cvt_pk_bf16_f32 %0, %1, %2" : "=v"(r) : "v"(lo), "v"(hi)); return r; }
template <int VAR> __device__ __forceinline__ void partialSM(f32x16& p0, f32x16& p1, float& m_reg, float& mn, float& alpha) {
  constexpr float C = SCALE * 1.4426950408889634f;
  if constexpr (VAR == 1) { mn = m_reg; alpha = 1.f; return; }
  float pmax = p0[0];
#pragma unroll
  for (int r = 1; r < 16; ++r) pmax = fmaxf(pmax, p0[r]);
#pragma unroll
  for (int r = 0; r < 16; ++r) pmax = fmaxf(pmax, p1[r]);
  { auto rr = __builtin_amdgcn_permlane32_swap(__float_as_uint(pmax), __float_as_uint(pmax), false, false);
    pmax = fmaxf(__uint_as_float(rr[0]), __uint_as_float(rr[1])); }
  if (__builtin_expect(__all(pmax - m_reg <= THR / SCALE), 1)) { mn = m_reg; alpha = 1.f; }
  else { mn = fmaxf(m_reg, pmax); alpha = __builtin_amdgcn_exp2f((m_reg - mn) * C); m_reg = mn; }
  float mnC = -mn * C;
#pragma unroll
  for (int r = 0; r < 16; ++r) p0[r] = fmaf(p0[r], C, mnC);
#pragma unroll
  for (int r = 0; r < 16; ++r) p1[r] = fmaf(p1[r], C, mnC);
#pragma unroll
  for (int r = 0; r < 16; ++r) p0[r] = __builtin_amdgcn_exp2f(p0[r]);
}
template <int VAR> __device__ __forceinline__ void finishSM(f32x16& p0, f32x16& p1, float alpha, float& l_reg, bf16x8& pa0, bf16x8& pa1, bf16x8& pa2, bf16x8& pa3) {
  float ps = 0;
  if constexpr (VAR != 1) {
#pragma unroll
  for (int r = 0; r < 16; ++r) p1[r] = __builtin_amdgcn_exp2f(p1[r]);
#pragma unroll
  for (int r = 0; r < 16; ++r) ps += p0[r];
#pragma unroll
  for (int r = 0; r < 16; ++r) ps += p1[r]; }
  { auto rr = __builtin_amdgcn_permlane32_swap(__float_as_uint(ps), __float_as_uint(ps), false, false);
    ps = __uint_as_float(rr[0]) + __uint_as_float(rr[1]); }
  l_reg = l_reg * alpha + ps;
#define PK4(P, BASE, OUT) do { unsigned a0 = cvtpk(P[BASE + 0], P[BASE + 1]), a1 = cvtpk(P[BASE + 2], P[BASE + 3]);   \
    unsigned b0 = cvtpk(P[BASE + 4], P[BASE + 5]), b1 = cvtpk(P[BASE + 6], P[BASE + 7]);                              \
    auto r0 = __builtin_amdgcn_permlane32_swap(a0, b0, false, false); auto r1 = __builtin_amdgcn_permlane32_swap(a1, b1, false, false); \
    u32x4 w = {r0[0], r1[0], r0[1], r1[1]}; OUT = *reinterpret_cast<bf16x8*>(&w); } while (0)
  PK4(p0, 0, pa0); PK4(p0, 8, pa1); PK4(p1, 0, pa2); PK4(p1, 8, pa3);
#undef PK4
}
template <int VAR> __device__ __forceinline__ void qkt(f32x16& p0, f32x16& p1, const bf16_t* Ks, const bf16x8* qr, int r32, int hi) {
  p0 = f32x16{}; p1 = f32x16{};
#pragma unroll
  for (int d0 = 0; d0 < 8; ++d0) { int cb = (d0 * 16 + hi * 8) * 2;
    bf16x8 b0, b1; if constexpr (VAR == 2) { b0 = qr[d0]; b1 = qr[7 - d0]; } else {
    b0 = *reinterpret_cast<const bf16x8*>((const char*)Ks + KSWZ(r32, cb));
    b1 = *reinterpret_cast<const bf16x8*>((const char*)Ks + KSWZ(32 + r32, cb)); }
    p0 = __builtin_amdgcn_mfma_f32_32x32x16_bf16(b0, qr[d0], p0, 0, 0, 0);
    p1 = __builtin_amdgcn_mfma_f32_32x32x16_bf16(b1, qr[d0], p1, 0, 0, 0); }
}
__device__ __forceinline__ int v_st(int k, int c) { const int kk = (k & ~0xC) | ((k & 4) << 1) | ((k & 8) >> 1); return ((kk >> 3) * 4 + (c >> 5)) * 512 + ((kk & 7) * 32 + (c & 31)) * 2; }
__device__ __forceinline__ int v_rd_base(int lane) { return ((lane & 3) << 3) | (((lane >> 2) & 3) << 6) | (((lane >> 4) & 1) << 5) | (((lane >> 5) & 1) << 8); }
constexpr int v_rd_off(int d0, int ks, int half) { return d0 * 512 + ks * 4096 + half * 2048; }
template <int OFF> __device__ __forceinline__ s16x4 tr_read(int vb) {
  s16x4 r; asm volatile("ds_read_b64_tr_b16 %0, %1 offset:%2" : "=&v"(r) : "v"(vb), "i"(OFF) : "memory"); return r;
}
template <int VAR, int D0> __device__ __forceinline__ void pv_one(f32x16& od, int vb, bf16x8 pa0, bf16x8 pa1, bf16x8 pa2, bf16x8 pa3) {
  if constexpr (VAR == 4) { od = __builtin_amdgcn_mfma_f32_32x32x16_bf16(pa0, pa1, od, 0, 0, 0); od = __builtin_amdgcn_mfma_f32_32x32x16_bf16(pa1, pa2, od, 0, 0, 0); od = __builtin_amdgcn_mfma_f32_32x32x16_bf16(pa2, pa3, od, 0, 0, 0); od = __builtin_amdgcn_mfma_f32_32x32x16_bf16(pa3, pa0, od, 0, 0, 0); return; }
  const s16x4 l0 = tr_read<v_rd_off(D0, 0, 0)>(vb), h0 = tr_read<v_rd_off(D0, 0, 1)>(vb), l1 = tr_read<v_rd_off(D0, 1, 0)>(vb), h1 = tr_read<v_rd_off(D0, 1, 1)>(vb);
  const s16x4 l2 = tr_read<v_rd_off(D0, 2, 0)>(vb), h2 = tr_read<v_rd_off(D0, 2, 1)>(vb), l3 = tr_read<v_rd_off(D0, 3, 0)>(vb), h3 = tr_read<v_rd_off(D0, 3, 1)>(vb);
  asm volatile("s_waitcnt lgkmcnt(0)" ::: "memory"); SBAR();
#define PK(L, H) (bf16x8){L[0], L[1], L[2], L[3], H[0], H[1], H[2], H[3]}
  od = __builtin_amdgcn_mfma_f32_32x32x16_bf16(pa0, PK(l0, h0), od, 0, 0, 0);
  od = __builtin_amdgcn_mfma_f32_32x32x16_bf16(pa1, PK(l1, h1), od, 0, 0, 0);
  od = __builtin_amdgcn_mfma_f32_32x32x16_bf16(pa2, PK(l2, h2), od, 0, 0, 0);
  od = __builtin_amdgcn_mfma_f32_32x32x16_bf16(pa3, PK(l3, h3), od, 0, 0, 0);
#undef PK
}
template <int VAR> __device__ __forceinline__ void pv_d0(f32x16* o, int vb, bf16x8 pa0, bf16x8 pa1, bf16x8 pa2, bf16x8 pa3) {
  pv_one<VAR, 0>(o[0], vb, pa0, pa1, pa2, pa3); pv_one<VAR, 1>(o[1], vb, pa0, pa1, pa2, pa3); pv_one<VAR, 2>(o[2], vb, pa0, pa1, pa2, pa3); pv_one<VAR, 3>(o[3], vb, pa0, pa1, pa2, pa3);
}
template <int LDQ, int LDK, int LDO, int VAR = 0>
__device__ __forceinline__ void attn_dense_body(const bf16_t* Qb, const bf16_t* __restrict__ Kh, const bf16_t* __restrict__ Vh,
                                                bf16_t* Ob, int seq, int nlat, int ctxoff, char* lds, const float* qgain, const float* cosT, const float* sinT, int t0, bool rope) {
  const int tid = opaque_tid(), wid = tid >> 6, lane = tid & 63, r32 = lane & 31, hi = lane >> 5;
  bf16_t* V_lds = (bf16_t*)lds; bf16_t* K_lds = (bf16_t*)(lds + 2 * SHM_V);
  float* ws = (float*)(lds + 2 * SHM_V + 2 * SHM_K) + wid * 64; float* li_l = ws; float* al_l = ws + 32;
  float m_reg = -1e30f, l_reg = 0; f32x16 o[4] = {}; bf16x8 qr[8];
  const bf16_t* Qw = Qb + (wid * QBLK + r32) * LDQ + hi * 8;
#pragma unroll 1
  for (int rep_ = 0; rep_ < (VAR == 8 ? 2 : 1); ++rep_) {
  asm volatile("" ::: "memory");
#pragma unroll
  for (int d0 = 0; d0 < 8; ++d0) qr[d0] = *reinterpret_cast<const bf16x8*>(Qw + d0 * 16);
  {
    float v[8][8]; float ss = 0.f;
#pragma unroll
    for (int d0 = 0; d0 < 8; ++d0) { const u32x4 w = *reinterpret_cast<const u32x4*>(&qr[d0]);
      v[d0][0] = bf_lo(w.x); v[d0][1] = bf_hi(w.x); v[d0][2] = bf_lo(w.y); v[d0][3] = bf_hi(w.y); v[d0][4] = bf_lo(w.z); v[d0][5] = bf_hi(w.z); v[d0][6] = bf_lo(w.w); v[d0][7] = bf_hi(w.w);
#pragma unroll
      for (int e = 0; e < 8; ++e) ss += v[d0][e] * v[d0][e]; }
    { auto rr = __builtin_amdgcn_permlane32_swap(__float_as_uint(ss), __float_as_uint(ss), false, false); ss = __uint_as_float(rr[0]) + __uint_as_float(rr[1]); }
    const float rstd = rsqrtf(ss * (1.f / 128.f) + 1e-6f);
#pragma unroll
    for (int d0 = 0; d0 < 8; ++d0) { const f32x4 g0 = *reinterpret_cast<const f32x4*>(qgain + d0 * 16 + hi * 8), g1 = *reinterpret_cast<const f32x4*>(qgain + d0 * 16 + hi * 8 + 4);
#pragma unroll
      for (int e = 0; e < 4; ++e) { v[d0][e] *= rstd * g0[e]; v[d0][4 + e] *= rstd * g1[e]; } }
    if (rope) { const float* cs = cosT + (size_t)(t0 + wid * QBLK + r32) * 64 + hi * 8; const float* sn = sinT + (size_t)(t0 + wid * QBLK + r32) * 64 + hi * 8;
#pragma unroll
      for (int d0 = 0; d0 < 4; ++d0) { const f32x4 c0 = *reinterpret_cast<const f32x4*>(cs + d0 * 16), c1 = *reinterpret_cast<const f32x4*>(cs + d0 * 16 + 4), s0 = *reinterpret_cast<const f32x4*>(sn + d0 * 16), s1 = *reinterpret_cast<const f32x4*>(sn + d0 * 16 + 4);
#pragma unroll
        for (int e = 0; e < 8; ++e) { const float c = e < 4 ? c0[e & 3] : c1[e & 3], sv = e < 4 ? s0[e & 3] : s1[e & 3]; const float lo = v[d0][e], hh = v[d0 + 4][e]; v[d0][e] = lo * c - hh * sv; v[d0 + 4][e] = hh * c + lo * sv; } } }
#pragma unroll
    for (int d0 = 0; d0 < 8; ++d0) { const u32x4 w = {cvtpk(v[d0][0], v[d0][1]), cvtpk(v[d0][2], v[d0][3]), cvtpk(v[d0][4], v[d0][5]), cvtpk(v[d0][6], v[d0][7])}; qr[d0] = *reinterpret_cast<const bf16x8*>(&w); }
  }
  }
  const int sr = tid >> 4, sc = (tid & 15) * 8, vst0 = v_st(sr, sc), vst1 = v_st(32 + sr, sc);
  const int vb0 = (int)(uintptr_t)V_lds + v_rd_base(lane);
  struct { bf16x8 vs0, vs1, ks0, ks1; } sr_[2];
#define KROW(k0) ((k0) + (((k0) >= nlat) ? ctxoff : 0))
#define SLOAD(i, k0) do { const int kr_ = KROW(k0); sr_[i].vs0 = *reinterpret_cast<const bf16x8*>(&Vh[(kr_ + sr) * LDK + sc]); sr_[i].vs1 = *reinterpret_cast<const bf16x8*>(&Vh[(kr_ + 32 + sr) * LDK + sc]); \
    sr_[i].ks0 = *reinterpret_cast<const bf16x8*>(&Kh[(kr_ + sr) * LDK + sc]); sr_[i].ks1 = *reinterpret_cast<const bf16x8*>(&Kh[(kr_ + 32 + sr) * LDK + sc]); } while (0)
#define SWRITE(b, i) do { *(bf16x8*)((char*)V_lds + (b) * SHM_V + vst0) = sr_[i].vs0;          \
    *(bf16x8*)((char*)V_lds + (b) * SHM_V + vst1) = sr_[i].vs1; int kc = sc * 2;               \
    *(bf16x8*)((char*)K_lds + (b) * SHM_K + KSWZ(sr, kc)) = sr_[i].ks0;                       \
    *(bf16x8*)((char*)K_lds + (b) * SHM_K + KSWZ(32 + sr, kc)) = sr_[i].ks1; } while (0)
#define SWAIT() asm volatile("s_waitcnt vmcnt(4)" ::: "memory")
#define RESC(a) do { if (__any((a) < 1.f)) { if (hi == 0) al_l[r32] = (a); asm volatile("s_waitcnt lgkmcnt(0)" ::: "memory"); \
    _Pragma("unroll") for (int d = 0; d < 4; ++d) _Pragma("unroll") for (int r = 0; r < 16; ++r) o[d][r] *= al_l[crow(r, hi)]; } } while (0)
#define ATT_SYNC() do { if (VAR != 3 && VAR != 5) __syncthreads(); } while (0)
  f32x16 pA0, pA1, pB0, pB1; float mnA, mnB, alA, alB; bf16x8 pa0, pa1, pa2, pa3; const int NT = seq / KVBLK;
  constexpr int SE = 0, SO = 1;
  SLOAD(SE, 0); asm volatile("s_waitcnt vmcnt(0)" ::: "memory"); SWRITE(0, SE); ATT_SYNC();
  qkt<VAR>(pA0, pA1, K_lds, qr, r32, hi); partialSM<VAR>(pA0, pA1, m_reg, mnA, alA);
  SLOAD(SO, KVBLK); if (2 < NT) SLOAD(SE, 2 * KVBLK);
  if (VAR != 3) { SWAIT(); SWRITE(1, SO); } ATT_SYNC();
  for (int j = 1; j + 1 < NT; j += 2) {
    SBAR(); qkt<VAR>(pB0, pB1, (bf16_t*)((char*)K_lds + SHM_K), qr, r32, hi);
    finishSM<VAR>(pA0, pA1, alA, l_reg, pa0, pa1, pa2, pa3); SBAR();
    if (VAR != 3 && VAR != 6) SLOAD(SO, (j + 2) * KVBLK); SBAR();
    pv_d0<VAR>(o, vb0, pa0, pa1, pa2, pa3); partialSM<VAR>(pB0, pB1, m_reg, mnB, alB);
    ATT_SYNC(); if (VAR != 3 && VAR != 6) { SWAIT(); SWRITE(0, SE); }
    RESC(alB); ATT_SYNC();
    SBAR(); qkt<VAR>(pA0, pA1, K_lds, qr, r32, hi);
    finishSM<VAR>(pB0, pB1, alB, l_reg, pa0, pa1, pa2, pa3); SBAR();
    if (VAR != 3 && VAR != 6 && j + 3 < NT) SLOAD(SE, (j + 3) * KVBLK); SBAR();
    pv_d0<VAR>(o, vb0 + (int)SHM_V, pa0, pa1, pa2, pa3); partialSM<VAR>(pA0, pA1, m_reg, mnA, alA);
    ATT_SYNC(); if (VAR != 3 && VAR != 6) { SWAIT(); SWRITE(1, SO); }
    RESC(alA); ATT_SYNC();
  }
  SBAR(); qkt<VAR>(pB0, pB1, (bf16_t*)((char*)K_lds + SHM_K), qr, r32, hi);
  finishSM<VAR>(pA0, pA1, alA, l_reg, pa0, pa1, pa2, pa3); SBAR();
  pv_d0<VAR>(o, vb0, pa0, pa1, pa2, pa3); partialSM<VAR>(pB0, pB1, m_reg, mnB, alB);
  ATT_SYNC(); RESC(alB);
  finishSM<VAR>(pB0, pB1, alB, l_reg, pa0, pa1, pa2, pa3); SBAR();
  pv_d0<VAR>(o, vb0 + (int)SHM_V, pa0, pa1, pa2, pa3);
#undef ATT_SYNC
  if (hi == 0) li_l[r32] = l_reg; asm volatile("s_waitcnt lgkmcnt(0)" ::: "memory");
  float rli[16];
#pragma unroll
  for (int r = 0; r < 16; ++r) rli[r] = __builtin_amdgcn_rcpf(li_l[crow(r, hi)]);
  bf16_t* Ow = Ob + (wid * QBLK) * LDO;
#pragma unroll
  for (int r = 0; r < 16; ++r) { int orow = crow(r, hi);
#pragma unroll
    for (int d0 = 0; d0 < 4; ++d0) { const __bf16 hb = (__bf16)(o[d0][r] * rli[r]); if constexpr (VAR == 7) { const bf16_t keep_ = __builtin_bit_cast(bf16_t, hb); asm volatile("" :: "v"(keep_)); } else Ow[orow * LDO + d0 * 32 + r32] = __builtin_bit_cast(bf16_t, hb); } }
  asm volatile("s_waitcnt vmcnt(0)" ::: "memory");
  __syncthreads();
#undef KROW
#undef SLOAD
#undef SWRITE
#undef SWAIT
#undef RESC
}
}

namespace scan {
constexpr int TS = 256, CS = 144;
#define TSW(row, cb) ((row) * TS + ((cb) ^ (((row) & 15) << 4)))
constexpr int I_QT = 0, I_KT = I_QT + 64 * TS, I_KH = I_KT + 64 * TS, I_VT = I_KH + 128 * CS, I_AV = I_VT + 32 * CS, IMG = I_AV + 512;
constexpr int OFF_ST = 2 * IMG, LDS_SCAN = OFF_ST + 2 * 32 * TS;
static_assert(LDS_SCAN <= LDS_CTL_OFF, "scan LDS");
#define SCAN_BAR() do { asm volatile("s_waitcnt lgkmcnt(0) ; SCANBAR" ::: "memory"); __builtin_amdgcn_s_barrier(); asm volatile("; SCANBAR_END" ::: "memory"); } while (0)
__device__ __forceinline__ float ex2(float x) { return __builtin_amdgcn_exp2f(x); }
typedef unsigned u32x2l __attribute__((ext_vector_type(2)));

__device__ __forceinline__ void scan_unit(LAS unsigned char* lds, const bf16_t* HQ, const bf16_t* G, const bf16_t* HV, bf16_t* O, int b, int h, int bwd, int dvs, bool store_ctx) {
    const int tid = opaque_tid(), w = __builtin_amdgcn_readfirstlane(tid >> 6), lane = tid & 63, r = lane & 15, q4 = lane >> 4;
    const long sgn = bwd ? -1 : 1;
#define SCAN_RB(cc_) (((cc_) < 4) ? (bwd ? (long)(NLAT + b * CTXL + CTXL - 1 - 64 * (cc_)) : (long)(NLAT + b * CTXL + 64 * (cc_))) \
                                  : (bwd ? (long)(b * SEQ + SEQ - 1 - 64 * ((cc_) - 4)) : (long)(b * SEQ + 64 * ((cc_) - 4))))
    for (int i = tid; i < 32 * TS / 4; i += 512) ((LAS unsigned*)(lds + OFF_ST))[i] = 0u;
    constexpr float L2E = 1.4426950408889634f;
    if (w < 4) {
        const int cp = lane & 15, tg = lane >> 4, et = w * 64 + lane, vtok = et >> 2, vdg = et & 3;
        const size_t colq = (size_t)h * 128 + 32 * w + 2 * cp, colv = (size_t)h * 128 + dvs * 32 + 8 * vdg;
        unsigned graw0[16], qraw0[16], graw1[16], qraw1[16]; u32x4 vraw0, vraw1;
#define SCAN_LOAD(cc_, graw, qraw, vraw) do { const long rb_ = SCAN_RB(cc_); \
        _Pragma("unroll") for (int j = 0; j < 16; ++j) { const long row_ = rb_ + sgn * (16 * tg + j); graw[j] = *(const unsigned*)(G + (size_t)row_ * 1024 + colq); qraw[j] = *(const unsigned*)(HQ + (size_t)row_ * 1024 + colq); } \
        { const long row_ = rb_ + sgn * vtok; vraw = *(const u32x4*)(HV + (size_t)row_ * 1024 + colv); } } while (0)
#define SCAN_IMAGE(cc, graw, qraw, vraw) do { \
        LAS unsigned char* img = lds + ((cc) & 1) * IMG; \
        f32x2 cs[16]; f32x2 run = {0.f, 0.f}; \
        _Pragma("unroll") for (int j = 0; j < 16; ++j) { run += unpk_f16(graw[j]); cs[j] = run; } \
        f32x2 inc = run; \
        { f32x2 y; y.x = __shfl_up(inc.x, 16); y.y = __shfl_up(inc.y, 16); if (lane >= 16) inc += y; \
          y.x = __shfl_up(inc.x, 32); y.y = __shfl_up(inc.y, 32); if (lane >= 32) inc += y; } \
        const f32x2 off = inc - run; \
        f32x2 all; all.x = __shfl(inc.x, 48 + cp); all.y = __shfl(inc.y, 48 + cp); \
        f32x2 ekp; ekp.x = ex2(fminf(-off.x, 80.f) * L2E); ekp.y = ex2(fminf(-off.y, 80.f) * L2E); \
        const f32x2 eall = {ex2(all.x * L2E), ex2(all.y * L2E)}; \
        unsigned w_kh[2][8]; \
        _Pragma("unroll") for (int j = 0; j < 16; ++j) { \
            const f32x2 q = {bf_lo(qraw[j]), bf_hi(qraw[j])}; \
            const f32x2 c = cs[j] + off; \
            f32x2 eq, ek; eq.x = ex2(c.x * L2E); eq.y = ex2(c.y * L2E); ek.x = ex2(fminf(-c.x, 80.f) * L2E); ek.y = ex2(fminf(-c.y, 80.f) * L2E); \
            f32x2 k = 1.f - eq * ekp; k.x = fmaxf(k.x, 0.f); k.y = fmaxf(k.y, 0.f); \
            ekp = ek; \
            const f32x2 qt = q * eq, kt = k * ek, kh = kt * eall; \
            const int tb = (16 * tg + j) * TS + (((32 * w + 2 * cp) * 2) ^ (j << 4)); \
            *(LAS unsigned*)(img + I_QT + tb) = pk_bf16(qt.x, qt.y); *(LAS unsigned*)(img + I_KT + tb) = pk_bf16(kt.x, kt.y); \
            if ((j & 1) == 0) { w_kh[0][j >> 1] = __float_as_uint(kh.x); w_kh[1][j >> 1] = __float_as_uint(kh.y); } \
            else { w_kh[0][j >> 1] = pk_bf16(__uint_as_float(w_kh[0][j >> 1]), kh.x); w_kh[1][j >> 1] = pk_bf16(__uint_as_float(w_kh[1][j >> 1]), kh.y); } \
        } \
        _Pragma("unroll") for (int c2 = 0; c2 < 2; ++c2) { LAS unsigned char* kp = img + I_KH + (32 * w + 2 * cp + c2) * CS + 32 * tg; \
            *(LAS u32x4*)kp = (u32x4){w_kh[c2][0], w_kh[c2][1], w_kh[c2][2], w_kh[c2][3]}; *(LAS u32x4*)(kp + 16) = (u32x4){w_kh[c2][4], w_kh[c2][5], w_kh[c2][6], w_kh[c2][7]}; } \
        if (tg == 0) *(LAS f32x2*)(img + I_AV + (32 * w + 2 * cp) * 4) = eall; \
        { LAS bf16_t* vt = (LAS bf16_t*)(img + I_VT) + vtok; const unsigned vv[4] = {vraw.x, vraw.y, vraw.z, vraw.w}; \
          _Pragma("unroll") for (int e = 0; e < 4; ++e) { vt[(8 * vdg + 2 * e) * (CS / 2)] = (bf16_t)(vv[e] & 0xffffu); vt[(8 * vdg + 2 * e + 1) * (CS / 2)] = (bf16_t)(vv[e] >> 16); } } \
    } while (0)
        SCAN_LOAD(0, graw0, qraw0, vraw0); SCAN_LOAD(1, graw1, qraw1, vraw1);
        SCAN_IMAGE(0, graw0, qraw0, vraw0); SCAN_LOAD(2, graw0, qraw0, vraw0);
        SCAN_BAR();
        for (int c2 = 0; c2 < 68; c2 += 2) {
            SCAN_IMAGE(c2 + 1, graw1, qraw1, vraw1); if (c2 + 3 < 68) SCAN_LOAD(c2 + 3, graw1, qraw1, vraw1);
            SCAN_BAR();
            if (c2 + 2 < 68) { SCAN_IMAGE(c2 + 2, graw0, qraw0, vraw0); if (c2 + 4 < 68) SCAN_LOAD(c2 + 4, graw0, qraw0, vraw0); }
            SCAN_BAR();
        }
#undef SCAN_LOAD
#undef SCAN_IMAGE
    } else {
        const int it = w - 4;
        int xo[4];
#pragma unroll
        for (int ks = 0; ks < 4; ++ks) xo[ks] = ((4 * ks + q4) ^ r) << 4;
        f32x4 sacc[2][2];
#pragma unroll
        for (int a = 0; a < 2; ++a)
#pragma unroll
            for (int d2 = 0; d2 < 2; ++d2) sacc[a][d2] = (f32x4){0.f, 0.f, 0.f, 0.f};
        SCAN_BAR();
        for (int cc = 0; cc < 68; ++cc) {
            const LAS unsigned char* img = lds + (cc & 1) * IMG; const int cur = cc & 1, nxt = cur ^ 1; const long rb = SCAN_RB(cc);
            bf16x8 qb[4];
#pragma unroll
            for (int ks = 0; ks < 4; ++ks) qb[ks] = *(const LAS bf16x8*)(img + I_QT + (16 * it + r) * TS + xo[ks]);
            f32x4 s4[4];
#pragma unroll
            for (int jt = 0; jt < 4; ++jt) { s4[jt] = (f32x4){0.f, 0.f, 0.f, 0.f};
                if (jt <= it) { bf16x8 ka[4];
#pragma unroll
                    for (int ks = 0; ks < 4; ++ks) ka[ks] = *(const LAS bf16x8*)(img + I_KT + (16 * jt + r) * TS + xo[ks]);
#pragma unroll
                    for (int ks = 0; ks < 4; ++ks) s4[jt] = __builtin_amdgcn_mfma_f32_16x16x32_bf16(ka[ks], qb[ks], s4[jt], 0, 0, 0);
                    if (jt == it) {
#pragma unroll
                        for (int e = 0; e < 4; ++e) if (4 * q4 + e > r) s4[jt][e] = 0.f;
                    } } }
            const u32x4 p01 = {pk_bf16(s4[0][0], s4[0][1]), pk_bf16(s4[0][2], s4[0][3]), pk_bf16(s4[1][0], s4[1][1]), pk_bf16(s4[1][2], s4[1][3])};
            const u32x4 p23 = {pk_bf16(s4[2][0], s4[2][1]), pk_bf16(s4[2][2], s4[2][3]), pk_bf16(s4[3][0], s4[3][1]), pk_bf16(s4[3][2], s4[3][3])};
#pragma unroll
            for (int dvt = 0; dvt < 2; ++dvt) {
                const LAS unsigned char* vrow = img + I_VT + (16 * dvt + r) * CS + 8 * q4;
                const u32x2l va0 = *(const LAS u32x2l*)(vrow), va1 = *(const LAS u32x2l*)(vrow + 32), va2 = *(const LAS u32x2l*)(vrow + 64), va3 = *(const LAS u32x2l*)(vrow + 96);
                bf16x8 sa[4];
#pragma unroll
                for (int ks = 0; ks < 4; ++ks) sa[ks] = *(const LAS bf16x8*)(lds + OFF_ST + cur * 32 * TS + (16 * dvt + r) * TS + xo[ks]);
                f32x4 o4 = (f32x4){0.f, 0.f, 0.f, 0.f}, o5 = (f32x4){0.f, 0.f, 0.f, 0.f};
                { const u32x4 a01 = {va0.x, va0.y, va1.x, va1.y}; o4 = __builtin_amdgcn_mfma_f32_16x16x32_bf16(__builtin_bit_cast(bf16x8, a01), __builtin_bit_cast(bf16x8, p01), o4, 0, 0, 0); }
                if (it >= 2) { const u32x4 a23 = {va2.x, va2.y, va3.x, va3.y}; o4 = __builtin_amdgcn_mfma_f32_16x16x32_bf16(__builtin_bit_cast(bf16x8, a23), __builtin_bit_cast(bf16x8, p23), o4, 0, 0, 0); }
                o5 = __builtin_amdgcn_mfma_f32_16x16x32_bf16(sa[0], qb[0], o5, 0, 0, 0); o5 = __builtin_amdgcn_mfma_f32_16x16x32_bf16(sa[1], qb[1], o5, 0, 0, 0);
                o4 = __builtin_amdgcn_mfma_f32_16x16x32_bf16(sa[2], qb[2], o4, 0, 0, 0); o5 = __builtin_amdgcn_mfma_f32_16x16x32_bf16(sa[3], qb[3], o5, 0, 0, 0);
                o4 += o5;
                if (store_ctx || cc >= 4) { const long row = rb + sgn * (16 * it + r);
                    *(u32x2*)(O + (size_t)row * 1024 + h * 128 + dvs * 32 + 16 * dvt + 4 * q4) = (u32x2){pk_bf16(o4[0], o4[1]), pk_bf16(o4[2], o4[3])}; }
            }
            {
                bf16x8 vb[2][2];
#pragma unroll
                for (int ks = 0; ks < 2; ++ks) { vb[0][ks] = *(const LAS bf16x8*)(img + I_VT + r * CS + (32 * ks + 8 * q4) * 2); vb[1][ks] = *(const LAS bf16x8*)(img + I_VT + (16 + r) * CS + (32 * ks + 8 * q4) * 2); }
#pragma unroll
                for (int a = 0; a < 2; ++a) { const int dt = 2 * it + a;
                    const f32x4 a4 = *(const LAS f32x4*)(img + I_AV + (16 * dt + 4 * q4) * 4);
                    const bf16x8 kh0 = *(const LAS bf16x8*)(img + I_KH + (16 * dt + r) * CS + (8 * q4) * 2), kh1 = *(const LAS bf16x8*)(img + I_KH + (16 * dt + r) * CS + (32 + 8 * q4) * 2);
#pragma unroll
                    for (int d2 = 0; d2 < 2; ++d2) { f32x4 s = sacc[a][d2] * a4;
                        s = __builtin_amdgcn_mfma_f32_16x16x32_bf16(kh0, vb[d2][0], s, 0, 0, 0); s = __builtin_amdgcn_mfma_f32_16x16x32_bf16(kh1, vb[d2][1], s, 0, 0, 0);
                        sacc[a][d2] = s;
                        *(LAS u32x2*)(lds + OFF_ST + nxt * 32 * TS + (16 * d2 + r) * TS + ((((2 * dt + (q4 >> 1)) ^ r) << 4) | ((q4 & 1) << 3))) = (u32x2){pk_bf16(s[0], s[1]), pk_bf16(s[2], s[3])}; } }
            }
            SCAN_BAR();
        }
    }
    VM_WAIT(); LDS_WAIT();
    __syncthreads();
#undef SCAN_RB
#undef TSW
}
}

constexpr size_t MiB = 1u << 20;
constexpr size_t WS_CTL = 0, CTL_ZERO_BYTES = 64 * 1024;
constexpr int CW_TMO = 0, CW_BAR = 4096, CW_CNT = 8192;
constexpr size_t WS_MOD = 256 * 1024;
constexpr size_t WS_LBV = 512 * 1024;
constexpr size_t WS_WGB = 576 * 1024;
constexpr size_t WS_COS = 1 * MiB, WS_SIN = 2 * MiB;
constexpr size_t WS_ROUTE = 3 * MiB;
constexpr size_t WS_XCTX = 4 * MiB;
constexpr size_t WS_H = 8 * MiB;
constexpr size_t WS_W = 42 * MiB;
constexpr size_t WL_STRIDE = 23 * MiB, WL_IN = 0, WL_ATT = 17 * MiB, WL_HG = 19 * MiB, WL_OUT = 21 * MiB;
constexpr size_t WS_WGU = WS_W + 46 * MiB, WS_WD = WS_W + 57 * MiB;
constexpr size_t WS_OF = 105 * MiB, WS_OB = 139 * MiB;
constexpr size_t WS_PROJ = 173 * MiB;
constexpr int XB_CAP = 16384;
constexpr size_t WS_MGU = 462 * MiB, WS_MD = 518 * MiB, WS_YB = 105 * MiB, WS_HIDM = 173 * MiB, WS_XB = 292 * MiB, WS_END = 546 * MiB;
static_assert(WS_WD + (size_t)DM * DFF * 2 <= WS_OF && WS_OB + (size_t)R * DM * 2 <= WS_PROJ && WS_PROJ + (size_t)R * PROJW * 2 <= WS_MGU, "ws map");
static_assert(WS_MGU + (size_t)NEXP * 2 * DFE * DM <= WS_MD && WS_MD + (size_t)NEXP * DM * DFE <= WS_END && WS_YB + (size_t)MOE_ROWS_MAX * DM * 2 <= WS_HIDM && WS_HIDM + (size_t)MOE_ROWS_MAX * DFE <= WS_XB && WS_XB + (size_t)NEXP * XB_CAP * DM <= WS_MGU, "ws map (moe)");
constexpr size_t PQ = 0, PK = (size_t)R * 1024, PV = (size_t)R * 1280, PHQ = (size_t)R * 1536, PGF = (size_t)R * 2560, PGB = (size_t)R * 3584, PHV = (size_t)R * 4608, PHG = (size_t)R * 5632, PGA = (size_t)R * 6656, PGH = (size_t)R * 7680;

constexpr int RING_BYTES = 131072, MISC_OFF = LDS_CTL_OFF + 320, LDS_BYTES = 163840;
constexpr int NWAVES = 8;

#define XB_TMO      128
#define XB_XCNT(j)  (256  + 64 * (j))
#define XB_XSUB(j)  (1280 + 64 * (j))
#define XB_XGEN(j)  (2304 + 64 * (j))
#define XB_TOP      3328
#define XB_TOPGEN   3392
#define XCD_BAR_WORDS 3456
#define XB_SPIN_CAP (1u << 18)
__device__ __forceinline__ unsigned xb_ld(unsigned* p)              { return __hip_atomic_load(p, __ATOMIC_RELAXED, __HIP_MEMORY_SCOPE_AGENT); }
__device__ __forceinline__ unsigned xb_add(unsigned* p, unsigned v) { return __hip_atomic_fetch_add(p, v, __ATOMIC_RELAXED, __HIP_MEMORY_SCOPE_AGENT); }
__device__ __forceinline__ unsigned xb_xcc_id() { return (unsigned)__builtin_amdgcn_s_getreg((3 << 11) | 20) & 0xFu; }
#define XB_SPIN(cond, bar) do { unsigned _sp = 0; while (cond) { __builtin_amdgcn_s_sleep(1); \
    if ((++_sp & 255u) == 0u) { if (xb_ld(&(bar)[XB_TMO])) break; if (_sp > XB_SPIN_CAP) { atomicAdd(&(bar)[XB_TMO], 1u); break; } } } } while (0)
struct XcdBarrier { unsigned* bar; unsigned x; volatile LAS unsigned* st; };
__device__ __forceinline__ XcdBarrier xcd_barrier_post(unsigned* bar, volatile LAS unsigned* st) {
    XcdBarrier b; b.bar = bar; b.x = xb_xcc_id(); b.st = st;
    if (threadIdx.x == 0) (void)xb_add(&bar[XB_XCNT(b.x)], 1u);
    return b;
}
__device__ __forceinline__ void xcd_barrier_complete(unsigned* bar, unsigned x, unsigned& nloc, unsigned& nx) {
    const unsigned G = gridDim.x * gridDim.y * gridDim.z;
    unsigned sum, cnt, mine, sp = 0u;
    for (;;) {
        sum = 0u; cnt = 0u; mine = 0u;
#pragma unroll
        for (unsigned j = 0; j < 16; ++j) { const unsigned c = xb_ld(&bar[XB_XCNT(j)]); sum += c; cnt += (c > 0u) ? 1u : 0u; mine = (j == x) ? c : mine; }
        if (sum == G) break;
        __builtin_amdgcn_s_sleep(1);
        if ((++sp & 255u) == 0u) { if (xb_ld(&bar[XB_TMO])) break; if (sp > XB_SPIN_CAP) { atomicAdd(&bar[XB_TMO], 1u); break; } }
    }
    nloc = mine > 0u ? mine : 1u; nx = cnt > 0u ? cnt : 1u;
}
__device__ __forceinline__ void xcd_barrier(const XcdBarrier& b) {
    asm volatile("s_waitcnt vmcnt(0)" ::: "memory");
    __syncthreads();
    if (opaque_tid() == 0) {
        unsigned* bar = b.bar;
        __builtin_amdgcn_s_waitcnt(0);
        unsigned nloc = b.st[0], nx = b.st[1];
        if (nloc == 0u) { xcd_barrier_complete(bar, b.x, nloc, nx); b.st[0] = nloc; b.st[1] = nx; }
        const unsigned old = xb_add(&bar[XB_XSUB(b.x)], 1u);
        const unsigned gen = old / nloc;
        if (old + 1u == (gen + 1u) * nloc) {
            __builtin_amdgcn_fence(__ATOMIC_RELEASE, "agent");
            asm volatile("s_waitcnt vmcnt(0)" ::: "memory");
            const unsigned og = xb_add(&bar[XB_TOP], 1u);
            const unsigned tg = og / nx;
            if (og + 1u == (tg + 1u) * nx) xb_add(&bar[XB_TOPGEN], 1u);
            else XB_SPIN(xb_ld(&bar[XB_TOPGEN]) == tg, bar);
            __builtin_amdgcn_fence(__ATOMIC_ACQUIRE, "agent");
            xb_add(&bar[XB_XGEN(b.x)], 1u);
            asm volatile("s_waitcnt vmcnt(0)" ::: "memory");
        } else {
            XB_SPIN(xb_ld(&bar[XB_XGEN(b.x)]) == gen, bar);
            __builtin_amdgcn_fence(__ATOMIC_ACQUIRE, "agent");
            asm volatile("s_waitcnt vmcnt(0)" ::: "memory");
        }
    }
    __syncthreads();
}

__device__ __forceinline__ float wave_sum(float v) {
#pragma unroll
    for (int o = 1; o < 64; o <<= 1) v += __shfl_xor(v, o);
    return v;
}
struct Row16 { f32x4 v[4]; };
__device__ __forceinline__ Row16 ld_f32_row(const float* p, int lane) { Row16 r;
#pragma unroll
    for (int j = 0; j < 4; ++j) r.v[j] = ((const f32x4*)p)[lane + 64 * j];
    return r; }
__device__ __forceinline__ void st_f32_row(float* p, int lane, const Row16& r) {
#pragma unroll
    for (int j = 0; j < 4; ++j) ((f32x4*)p)[lane + 64 * j] = r.v[j]; }
__device__ __forceinline__ Row16 ld_bf16_row(const bf16_t* p, int lane) { Row16 r;
#pragma unroll
    for (int j = 0; j < 4; ++j) { const u32x2 w = ((const u32x2*)p)[lane + 64 * j]; r.v[j] = (f32x4){bf_lo(w.x), bf_hi(w.x), bf_lo(w.y), bf_hi(w.y)}; }
    return r; }
#ifndef THIN_NT
#define THIN_NT 1
#endif
__device__ __forceinline__ void st_bf16_row_nt(bf16_t* p, int lane, const Row16& r) {
#pragma unroll
    for (int j = 0; j < 4; ++j) { const u32x2 w = (u32x2){pk_bf16(r.v[j][0], r.v[j][1]), pk_bf16(r.v[j][2], r.v[j][3])};
        if (THIN_NT) __builtin_nontemporal_store(w, (u32x2*)p + lane + 64 * j); else ((u32x2*)p)[lane + 64 * j] = w; } }
struct RawB { u32x2 v[4]; };
__device__ __forceinline__ RawB ld_raw_b(const bf16_t* p, int lane) { RawB r;
#pragma unroll
    for (int j = 0; j < 4; ++j) r.v[j] = ((const u32x2*)p)[lane + 64 * j];
    return r; }
#ifndef THIN_NTL
#define THIN_NTL 0
#endif
__device__ __forceinline__ RawB ld_raw_b_nt(const bf16_t* p, int lane) { RawB r;
#pragma unroll
    for (int j = 0; j < 4; ++j) r.v[j] = THIN_NTL ? __builtin_nontemporal_load((const u32x2*)p + lane + 64 * j) : ((const u32x2*)p)[lane + 64 * j];
    return r; }
__device__ __forceinline__ Row16 ld_f32_row_nt(const float* p, int lane) { Row16 r;
#pragma unroll
    for (int j = 0; j < 4; ++j) r.v[j] = THIN_NTL ? __builtin_nontemporal_load((const f32x4*)p + lane + 64 * j) : ((const f32x4*)p)[lane + 64 * j];
    return r; }
__device__ __forceinline__ Row16 unraw_b(const RawB& w) { Row16 r;
#pragma unroll
    for (int j = 0; j < 4; ++j) r.v[j] = (f32x4){bf_lo(w.v[j].x), bf_hi(w.v[j].x), bf_lo(w.v[j].y), bf_hi(w.v[j].y)};
    return r; }
__device__ __forceinline__ void st_bf16_row(bf16_t* p, int lane, const Row16& r) {
#pragma unroll
    for (int j = 0; j < 4; ++j) ((u32x2*)p)[lane + 64 * j] = (u32x2){pk_bf16(r.v[j][0], r.v[j][1]), pk_bf16(r.v[j][2], r.v[j][3])}; }
__device__ __forceinline__ float row_rstd(const Row16& r) { float s = 0.f;
#pragma unroll
    for (int j = 0; j < 4; ++j) s += (r.v[j][0] * r.v[j][0] + r.v[j][1] * r.v[j][1]) + (r.v[j][2] * r.v[j][2] + r.v[j][3] * r.v[j][3]);
    return rsqrtf(wave_sum(s) * (1.f / DM) + NORM_EPS); }
__device__ __forceinline__ Row16 norm_mod(const Row16& x, float rstd, const float* gain, const float* shift, const float* scale, int lane) { Row16 o;
#pragma unroll
    for (int j = 0; j < 4; ++j) { const f32x4 g = ((const f32x4*)gain)[lane + 64 * j], sh = ((const f32x4*)shift)[lane + 64 * j], sc = ((const f32x4*)scale)[lane + 64 * j];
        o.v[j] = (x.v[j] * rstd * g) * (sc + 1.f) + sh; }
    return o; }
__device__ __forceinline__ Row16 resid_add(const Row16& x, const Row16& y, float rstd, const float* gain, const float* gate, int lane) { Row16 o;
#pragma unroll
    for (int j = 0; j < 4; ++j) { const f32x4 g = ((const f32x4*)gain)[lane + 64 * j], gt = ((const f32x4*)gate)[lane + 64 * j];
        o.v[j] = x.v[j] + gt * (y.v[j] * rstd * g); }
    return o; }

__device__ __forceinline__ unsigned f2bf(float f) { unsigned u = __builtin_bit_cast(unsigned, f); return (u + 0x7fffu + ((u >> 16) & 1u)) >> 16; }
__device__ __forceinline__ unsigned pk2(float lo, float hi) { return f2bf(lo) | (f2bf(hi) << 16); }
struct TDesc { const float* W; unsigned char* WT; int K, N, il, item; };
__device__ __forceinline__ void t_load(const TDesc& d, float (&t_)[32], int lane) {
    const int nblk = d.N / 32, kb = d.item / nblk, nb = d.item - kb * nblk, k0 = 64 * kb, n0 = 32 * nb;
#pragma unroll
    for (int i = 0; i < 32; ++i) t_[i] = d.W[(size_t)(k0 + 2 * i + (lane >> 5)) * d.N + n0 + (lane & 31)];
}
template <bool FP8>
__device__ __forceinline__ void t_finish(const TDesc& d, const float (&t_)[32], LAS float* scr, int lane) {
    const int nblk = d.N / 32, kb = d.item / nblk, nb = d.item - kb * nblk, k0 = 64 * kb, n0 = 32 * nb;
    const int drow0 = d.il ? (256 * (n0 >> 7) + (n0 & 127) + (d.il == 2 ? 128 : 0)) : n0;
#pragma unroll
    for (int i = 0; i < 32; ++i) scr[(2 * i + (lane >> 5)) * 33 + (lane & 31)] = t_[i];
    LDS_WAIT(); asm volatile("" ::: "memory");
    const int c = lane & 7;
#pragma unroll
    for (int j = 0; j < 4; ++j) { const int n = (lane >> 3) + 8 * j; const LAS float* s = scr + (8 * c) * 33 + n;
        if constexpr (FP8) { u32x2 o; o.x = pk4_fp8(64.f * s[0 * 33], 64.f * s[1 * 33], 64.f * s[2 * 33], 64.f * s[3 * 33]); o.y = pk4_fp8(64.f * s[4 * 33], 64.f * s[5 * 33], 64.f * s[6 * 33], 64.f * s[7 * 33]);
            *(GAS u32x2*)(d.WT + (size_t)(drow0 + n) * d.K + k0 + 8 * c) = o; }
        else { u32x4 o; o.x = pk2(s[0 * 33], s[1 * 33]); o.y = pk2(s[2 * 33], s[3 * 33]); o.z = pk2(s[4 * 33], s[5 * 33]); o.w = pk2(s[6 * 33], s[7 * 33]);
            *(GAS u32x4*)((bf16_t*)d.WT + (size_t)(drow0 + n) * d.K + k0 + 8 * c) = o; } }
    LDS_WAIT(); asm volatile("" ::: "memory");
}
template <bool FP8, class Dec>
__device__ __forceinline__ void t_run(const Dec& dec, int first, int last, int stride, LAS float* scr, int lane) {
    int it = first; if (it >= last) return;
    TDesc dA, dB; float tA[32], tB[32]; dec(it, dA); t_load(dA, tA, lane);
    for (;;) {
        const int i1 = it + stride; const bool hasB = i1 < last; dec(hasB ? i1 : it, dB); t_load(dB, tB, lane);
        t_finish<FP8>(dA, tA, scr, lane);
        if (!hasB) break;
        const int i2 = i1 + stride; const bool hasA = i2 < last; dec(hasA ? i2 : i1, dA); t_load(dA, tA, lane);
        t_finish<FP8>(dB, tB, scr, lane);
        if (!hasA) break;
        it = i2;
    }
}
struct Args { const float* in[25]; float* out; unsigned char* ws; int ph_lo, ph_hi; };
constexpr int NPH = 14, NTOT = 2 * NPH;
typedef const __attribute__((address_space(4))) Args* KArgs;
__device__ __forceinline__ KArgs kargs() { auto p = __builtin_amdgcn_kernarg_segment_ptr(); asm volatile("" : "+s"(p)); return (KArgs)p; }
struct Geo { int G, bx, vcu; };
__device__ __forceinline__ Geo opaque_geo(Geo g) { asm volatile("" : "+s"(g.G), "+s"(g.bx), "+s"(g.vcu)); return g; }
enum { I_X = 0, I_C, I_CTX, I_CCTX, I_WMOD, I_BMOD, I_PREMIX, I_POSTMIX, I_PREFFN, I_POSTFFN, I_WIN, I_QN, I_KN, I_HGN, I_LBL, I_WATT, I_WHG, I_WOUT, I_FWG, I_FWU, I_FWD, I_ROUTER, I_MWG, I_MWU, I_MWD };

__device__ __forceinline__ void phase_prologue(LAS unsigned char* lds, const Geo geo_in) {
    const Geo geo = opaque_geo(geo_in);
    KArgs A = kargs(); unsigned char* ws = A->ws;
    const int tid = opaque_tid(), lane = tid & 63, wave = __builtin_amdgcn_readfirstlane(tid >> 6);
    const int G = geo.G, vcu = geo.vcu, gw = vcu * NWAVES + wave, NGW = G * NWAVES;
    LAS float* scr = (LAS float*)(lds + wave * 16384);
    constexpr int I_IN = 16 * (PROJW / 32), I_SQ = 16 * 32, I_GU = 16 * (DFF / 32), I_DN = (DFF / 64) * 32;
    constexpr int I_L = I_IN + 3 * I_SQ, NIT = 2 * I_L + 2 * I_GU + I_DN;
    const int ngv = (G > 96) ? 48 : 0;
    if (vcu >= ngv) {
        const auto dec = [&](int it, TDesc& d) { int r = it; d.il = 0;
            if (r < 2 * I_L) { const int l = r / I_L; r -= l * I_L; unsigned char* wl = ws + WS_W + l * WL_STRIDE; d.K = DM;
                if (r < I_IN) { d.W = A->in[I_WIN] + (size_t)l * DM * PROJW; d.N = PROJW; d.WT = wl + WL_IN; d.item = r; return; } r -= I_IN;
                d.N = DM; d.item = r & (I_SQ - 1); const int which = r / I_SQ;
                d.W = (which == 0 ? A->in[I_WATT] : which == 1 ? A->in[I_WHG] : A->in[I_WOUT]) + (size_t)l * DM * DM; d.WT = wl + (which == 0 ? WL_ATT : which == 1 ? WL_HG : WL_OUT); return; }
            r -= 2 * I_L;
            if (r < 2 * I_GU) { const int up = r >= I_GU; d.W = up ? A->in[I_FWU] : A->in[I_FWG]; d.K = DM; d.N = DFF; d.WT = ws + WS_WGU; d.il = 1 + up; d.item = r - up * I_GU; return; }
            d.W = A->in[I_FWD]; d.K = DFF; d.N = DM; d.WT = ws + WS_WD; d.item = r - 2 * I_GU; };
        t_run<false>(dec, (vcu - ngv) * NWAVES + wave, NIT, (G - ngv) * NWAVES, scr, lane);
    }
    {
        float* cosT = (float*)(ws + WS_COS); float* sinT = (float*)(ws + WS_SIN); float* lbv = (float*)(ws + WS_LBV); const float* lbl = A->in[I_LBL];
        for (int i = (vcu * 512 + tid); i < SEQ * 64; i += G * 512) { const int t = i >> 6, jj = i & 63; const int fi = jj & 31;
            const float inv = powf(10000.f, -(float)fi / 32.f); const float pos = (jj < 32) ? (float)(t >> 6) : (float)(t & 63); const float ang = pos * inv;
            cosT[i] = cosf(ang); sinT[i] = sinf(ang); }
        for (int i = (vcu * 512 + tid); i < 2 * DM; i += G * 512) { const int l = i >> 10, ch = i & 1023;
            lbv[i] = (l == 0) ? 0.f : 1.f / (1.f + expf(lbl[ch] - lbl[DM + ch])); }
    }
    __syncthreads();
    for (int it = vcu; it < 2 * 24; it += G) { const int l = it / 24, n0 = (it % 24) * 256;
        const float* c_in = A->in[I_C]; const float* cctx_in = A->in[I_CCTX]; float* modv = (float*)(ws + WS_MOD);
        LAS float* sv = (LAS float*)(lds + 65536) + wave * 5 * 128;
        const int k0 = wave * 128;
#pragma unroll
        for (int mi = 0; mi < 5; ++mi)
#pragma unroll
            for (int h2 = 0; h2 < 2; ++h2) { const int k = k0 + h2 * 64 + lane; const float cv = (mi < 4) ? c_in[mi * DM + k] : cctx_in[k]; sv[mi * 128 + h2 * 64 + lane] = cv / (1.f + expf(-cv)); }
        LDS_WAIT(); asm volatile("" ::: "memory");
        f32x4 a5[5];
#pragma unroll
        for (int mi = 0; mi < 5; ++mi) a5[mi] = (f32x4){0.f, 0.f, 0.f, 0.f};
        const float* wp = A->in[I_WMOD] + (size_t)l * DM * NMOD + (size_t)k0 * NMOD + n0 + 4 * lane;
        for (int kk0 = 0; kk0 < 128; kk0 += 16) { f32x4 wv[16];
#pragma unroll
            for (int j = 0; j < 16; ++j) wv[j] = *(const f32x4*)(wp + (size_t)(kk0 + j) * NMOD);
#pragma unroll
            for (int j = 0; j < 16; ++j)
#pragma unroll
                for (int mi = 0; mi < 5; ++mi) a5[mi] += wv[j] * sv[mi * 128 + kk0 + j]; }
        LAS float* red = (LAS float*)lds;
#pragma unroll
        for (int mi = 0; mi < 5; ++mi) *(LAS f32x4*)(red + (wave * 5 + mi) * 256 + 4 * lane) = a5[mi];
        __syncthreads();
        const float* b_mod = A->in[I_BMOD];
        for (int o = tid; o < 5 * 256; o += 512) { const int mi = o >> 8, cidx = o & 255; float s = b_mod[l * NMOD + n0 + cidx];
#pragma unroll
            for (int w8 = 0; w8 < 8; ++w8) s += red[(w8 * 5 + mi) * 256 + cidx];
            modv[((size_t)l * 5 + mi) * NMOD + n0 + cidx] = s; }
        __syncthreads();
    }
}

__device__ __forceinline__ void phase_premix0(const Geo geo_in) {
    const Geo geo = opaque_geo(geo_in);
    KArgs A = kargs(); unsigned char* ws = A->ws;
    const int tid = opaque_tid(), lane = tid & 63, wave = __builtin_amdgcn_readfirstlane(tid >> 6);
    const int gw = geo.vcu * NWAVES + wave, NGW = geo.G * NWAVES;
    const float* x_in = A->in[I_X]; const float* ctx_in = A->in[I_CTX]; const float* gain = A->in[I_PREMIX]; const float* modl = (const float*)(ws + WS_MOD);
    bf16_t* Hb = (bf16_t*)(ws + WS_H);
#define SRC_ROW(row_) (((row_) < NLAT) ? x_in + (size_t)(row_) * DM : ctx_in + (size_t)((row_) - NLAT) * DM)
#define P1_ROW(row_, cur_) do { const int rw_ = (row_); const float* md = modl + (size_t)((rw_ < NLAT) ? (rw_ >> 12) : 4) * NMOD;      \
        const Row16 h = norm_mod(cur_, row_rstd(cur_), gain, md + 0 * DM, md + 1 * DM, lane); st_bf16_row(Hb + (size_t)rw_ * DM, lane, h); } while (0)
    const int rc0 = NLAT + gw; Row16 cxc; if (rc0 < R) cxc = ld_f32_row(SRC_ROW(rc0), lane);
    for (int base = gw; base < NLAT; base += 8 * NGW) {
        Row16 rx[8];
#pragma unroll
        for (int k = 0; k < 8; ++k) rx[k] = ld_f32_row(SRC_ROW((base + k * NGW < NLAT) ? base + k * NGW : base), lane);
#pragma unroll
        for (int k = 0; k < 8; ++k) if (base + k * NGW < NLAT) P1_ROW(base + k * NGW, rx[k]);
    }
    if (rc0 < R) P1_ROW(rc0, cxc);
    for (int rc = rc0 + NGW; rc < R; rc += NGW) { const Row16 c2 = ld_f32_row(SRC_ROW(rc), lane); P1_ROW(rc, c2); }
#undef P1_ROW
#undef SRC_ROW
}

__device__ __forceinline__ void phase_proj(LAS unsigned char* lds, const Geo geo_in, int layer) {
    const Geo geo = opaque_geo(geo_in);
    KArgs A = kargs(); unsigned char* ws = A->ws;
    pg8::Gemm g{(const bf16_t*)(ws + WS_H), (const bf16_t*)(ws + WS_W + layer * WL_STRIDE + WL_IN), R, PROJW, DM}; pg8::StaticOrder S; S.init(R, PROJW, geo.G, geo.bx);
    EpiProj E{(bf16_t*)(ws + WS_PROJ), (const float*)(ws + WS_LBV) + layer * DM};
    pg8::gemm_phase<EpiProj, pg8::StaticOrder, true, true>(lds, g, S, E);
    gemm_mini_ks<EpiProj, pg8::StaticOrder>(lds, g, S, E, geo.vcu, geo.G);
}

__device__ __forceinline__ void phase_qknorm(const Geo geo_in, int layer) {
    const Geo geo = opaque_geo(geo_in);
    KArgs A = kargs(); unsigned char* ws = A->ws;
    const int tid = opaque_tid(), lane = tid & 63, wave = __builtin_amdgcn_readfirstlane(tid >> 6);
    const int gw = geo.vcu * NWAVES + wave, NGW = geo.G * NWAVES;
    const float* qn = A->in[I_QN] + layer * 128; const float* kn = A->in[I_KN] + layer * 128;
    const float* cosT = (const float*)(ws + WS_COS); const float* sinT = (const float*)(ws + WS_SIN); bf16_t* proj = (bf16_t*)(ws + WS_PROJ);
    const int nitems = R / 4;
    for (int it = gw; it < nitems; it += NGW) {
        const int row = it * 4 + (lane >> 4);
        const int lr = lane & 15;
        bf16_t* p = proj + PK + (size_t)row * 256 + 16 * lr;
        const float* gn = kn;
        const int j0 = (lr & 7) * 16;
        f32x4 v[4]; { f32x4 a, b2; unpack8(*(const u32x4*)p, a, b2); v[0] = a; v[1] = b2; unpack8(*(const u32x4*)(p + 8), a, b2); v[2] = a; v[3] = b2; }
        float ss = 0.f;
#pragma unroll
        for (int j = 0; j < 4; ++j) ss += (v[j][0] * v[j][0] + v[j][1] * v[j][1]) + (v[j][2] * v[j][2] + v[j][3] * v[j][3]);
        ss += __shfl_xor(ss, 1); ss += __shfl_xor(ss, 2); ss += __shfl_xor(ss, 4);
        const float rstd = rsqrtf(ss * (1.f / 128.f) + NORM_EPS);
#pragma unroll
        for (int j = 0; j < 4; ++j) v[j] = v[j] * rstd * *(const f32x4*)(gn + j0 + 4 * j);
        if (row < NLAT) {
            const int t = row & (SEQ - 1); const int jj0 = (lr & 3) * 16; const bool upper = (lr & 4) != 0;
#pragma unroll
            for (int j = 0; j < 4; ++j) { f32x4 pv;
#pragma unroll
                for (int e = 0; e < 4; ++e) pv[e] = __shfl_xor(v[j][e], 4);
                const f32x4 cs = *(const f32x4*)(cosT + (size_t)t * 64 + jj0 + 4 * j), sn = *(const f32x4*)(sinT + (size_t)t * 64 + jj0 + 4 * j);
                v[j] = upper ? (v[j] * cs + pv * sn) : (v[j] * cs - pv * sn); }
        }
        *(u32x4*)p = pack8(v[0], v[1]); *(u32x4*)(p + 8) = pack8(v[2], v[3]);
    }
}

__device__ __forceinline__ void phase_attn(unsigned char* lds_raw, const Geo geo_in, bool last, int layer) {
    const Geo geo = opaque_geo(geo_in);
    KArgs A = kargs(); unsigned char* ws = A->ws;
    bf16_t* Qp = (bf16_t*)(ws + WS_PROJ) + PQ; const bf16_t* Kp = (const bf16_t*)(ws + WS_PROJ) + PK; const bf16_t* Vp = (const bf16_t*)(ws + WS_PROJ) + PV;
    const float* qn = A->in[I_QN] + layer * 128;
    const int nun = last ? 512 : 544;
#ifndef ATT_UMAP
#define ATT_UMAP 0
#endif
#ifdef ATT_PROBE
    for (int u = (ATT_UMAP ? geo.bx : geo.vcu); u < nun; u += geo.G) {
        int qrow, krow, h, seq, nlat, ctxoff;
        if (u < 512) { const int grp = u >> 6, b = grp >> 1, kvh = grp & 1, gq = (u >> 4) & 3, qb = u & 15; h = kvh * 4 + gq;
            qrow = b * SEQ + qb * 256; krow = b * SEQ; seq = SEQ + CTXL; nlat = SEQ; ctxoff = (NLAT + b * CTXL) - (b * SEQ) - SEQ; }
        else { const int b = (u - 512) >> 3; h = (u - 512) & 7; qrow = NLAT + b * CTXL; krow = qrow; seq = CTXL; nlat = 1 << 30; ctxoff = 0; }
        bf16_t* Qb = Qp + (size_t)qrow * 1024 + h * 128; bf16_t* Os = (bf16_t*)(ws + WS_OF) + (size_t)qrow * 1024 + h * 128;
        const bf16_t* Kh = Kp + (size_t)krow * 256 + (h >> 2) * 128; const bf16_t* Vh = Vp + (size_t)krow * 256 + (h >> 2) * 128;
        att::attn_dense_body<1024, 256, 1024, ATT_PROBE>(Qb, Kh, Vh, Os, seq, nlat, ctxoff, (char*)lds_raw, qn, (const float*)(ws + WS_COS), (const float*)(ws + WS_SIN), qrow & (SEQ - 1), u < 512);
    }
#endif
    for (int u = (ATT_UMAP ? geo.bx : geo.vcu); u < nun; u += geo.G) {
        int qrow, krow, h, seq, nlat, ctxoff;
        if (u < 512) { const int grp = u >> 6, b = grp >> 1, kvh = grp & 1, gq = (u >> 4) & 3, qb = u & 15; h = kvh * 4 + gq;
            qrow = b * SEQ + qb * 256; krow = b * SEQ; seq = SEQ + CTXL; nlat = SEQ; ctxoff = (NLAT + b * CTXL) - (b * SEQ) - SEQ; }
        else { const int b = (u - 512) >> 3; h = (u - 512) & 7; qrow = NLAT + b * CTXL; krow = qrow; seq = CTXL; nlat = 1 << 30; ctxoff = 0; }
        bf16_t* Qb = Qp + (size_t)qrow * 1024 + h * 128;
        const bf16_t* Kh = Kp + (size_t)krow * 256 + (h >> 2) * 128; const bf16_t* Vh = Vp + (size_t)krow * 256 + (h >> 2) * 128;
        att::attn_dense_body<1024, 256, 1024>(Qb, Kh, Vh, Qb, seq, nlat, ctxoff, (char*)lds_raw, qn, (const float*)(ws + WS_COS), (const float*)(ws + WS_SIN), qrow & (SEQ - 1), u < 512);
    }
}
__device__ __forceinline__ void phase_scan(LAS unsigned char* lds, const Geo geo_in, bool last) {
    const Geo geo = opaque_geo(geo_in);
    KArgs A = kargs(); unsigned char* ws = A->ws;
    bf16_t* proj = (bf16_t*)(ws + WS_PROJ);
    for (int u = geo.vcu; u < 256; u += geo.G) {
        const int dvs = u & 3, bwd = (u >> 2) & 1, h = (u >> 3) & 7, b = u >> 6;
        scan::scan_unit(lds, proj + PHQ, bwd ? proj + PGB : proj + PGF, proj + PHV, bwd ? (bf16_t*)(ws + WS_OB) : (bf16_t*)(ws + WS_OF), b, h, bwd, dvs, !last);
    }
}

__device__ __forceinline__ void phase_readout(const Geo geo_in, int layer) {
    const Geo geo = opaque_geo(geo_in);
    KArgs A = kargs(); unsigned char* ws = A->ws;
    const int tid = opaque_tid(), lane = tid & 63, wave = __builtin_amdgcn_readfirstlane(tid >> 6);
    const int gw = geo.vcu * NWAVES + wave, NGW = geo.G * NWAVES;
    const float* hn = A->in[I_HGN] + layer * 128; const int nrows = (layer == 1) ? NLAT : R;
    const bf16_t* OFb = (const bf16_t*)(ws + WS_OF); const bf16_t* OBb = (const bf16_t*)(ws + WS_OB); bf16_t* HG = (bf16_t*)(ws + WS_PROJ) + PHG;
    const int j0 = (lane & 7) * 16;
    struct Raw { u32x4 f0, f1, b0, b1, g0, g1; };
#define RD_LOAD(dst, row_) do { const size_t off_ = (size_t)(row_) * 1024 + 16 * lane; dst.f0 = *(const u32x4*)(OFb + off_); dst.f1 = *(const u32x4*)(OFb + off_ + 8); \
        dst.b0 = *(const u32x4*)(OBb + off_); dst.b1 = *(const u32x4*)(OBb + off_ + 8); dst.g0 = *(const u32x4*)(HG + off_); dst.g1 = *(const u32x4*)(HG + off_ + 8); } while (0)
#define RD_ROW(row_, cur) do { const size_t off = (size_t)(row_) * 1024 + 16 * lane;                                                                   \
        f32x4 a[4], b4[4], g4[4];                                                                                                                  \
        unpack8(cur.f0, a[0], a[1]); unpack8(cur.f1, a[2], a[3]); unpack8(cur.b0, b4[0], b4[1]); unpack8(cur.b1, b4[2], b4[3]); unpack8(cur.g0, g4[0], g4[1]); unpack8(cur.g1, g4[2], g4[3]); \
        float ss = 0.f;                                                                                                                            \
        _Pragma("unroll") for (int j = 0; j < 4; ++j) { a[j] += b4[j]; ss += (a[j][0] * a[j][0] + a[j][1] * a[j][1]) + (a[j][2] * a[j][2] + a[j][3] * a[j][3]); } \
        ss += __shfl_xor(ss, 1); ss += __shfl_xor(ss, 2); ss += __shfl_xor(ss, 4);                                                                   \
        const float rstd = rsqrtf(ss * (1.f / 128.f) + NORM_EPS);                                                                                  \
        _Pragma("unroll") for (int j = 0; j < 4; ++j) a[j] = a[j] * rstd * *(const f32x4*)(hn + j0 + 4 * j) * g4[j];                                 \
        *(u32x4*)(HG + off) = pack8(a[0], a[1]); *(u32x4*)(HG + off + 8) = pack8(a[2], a[3]); } while (0)
    const int rc0 = NLAT + gw; Raw rcc; if (rc0 < nrows) RD_LOAD(rcc, rc0);
    for (int base = gw; base < NLAT; base += 8 * NGW) {
        Raw sl[6];
#define RD_LD(k_) RD_LOAD(sl[(k_) % 6], ((base + (k_) * NGW < NLAT) ? base + (k_) * NGW : base))
#pragma unroll
        for (int k = 0; k < 5; ++k) RD_LD(k);
#pragma unroll
        for (int k = 0; k < 8; ++k) {
            if (k + 5 < 8) RD_LD(k + 5);
            if (base + k * NGW < NLAT) RD_ROW(base + k * NGW, sl[k % 6]);
        }
#undef RD_LD
    }
    if (rc0 < nrows) RD_ROW(rc0, rcc);
    for (int rc = rc0 + NGW; rc < nrows; rc += NGW) { Raw r2; RD_LOAD(r2, rc); RD_ROW(rc, r2); }
#undef RD_ROW
#undef RD_LOAD
}

__device__ __forceinline__ void phase_merge_hg(LAS unsigned char* lds, const Geo geo_in, int layer) {
    const Geo geo = opaque_geo(geo_in);
    KArgs A = kargs(); unsigned char* ws = A->ws; const int M = (layer == 1) ? NLAT : R; bf16_t* proj = (bf16_t*)(ws + WS_PROJ);
    pg8::Gemm g{proj + PHG, (const bf16_t*)(ws + WS_W + layer * WL_STRIDE + WL_HG), M, DM, DM}; pg8::StaticOrder S; S.init(M, DM, geo.G, geo.bx);
    EpiGate<false> E{proj + PGH, nullptr};
    pg8::gemm_phase<EpiGate<false>, pg8::StaticOrder, true, true>(lds, g, S, E);
    gemm_mini_ks<EpiGate<false>, pg8::StaticOrder>(lds, g, S, E, geo.vcu, geo.G);
}
__device__ __forceinline__ void phase_merge_att(LAS unsigned char* lds, const Geo geo_in, int layer) {
    const Geo geo = opaque_geo(geo_in);
    KArgs A = kargs(); unsigned char* ws = A->ws; const int M = (layer == 1) ? NLAT : R; bf16_t* proj = (bf16_t*)(ws + WS_PROJ);
    pg8::Gemm g{proj + PQ, (const bf16_t*)(ws + WS_W + layer * WL_STRIDE + WL_ATT), M, DM, DM}; pg8::StaticOrder S; S.init(M, DM, geo.G, geo.bx);
    EpiGate<true> E{proj + PGA, proj + PGH};
    pg8::gemm_phase<EpiGate<true>, pg8::StaticOrder, true, true>(lds, g, S, E);
    gemm_mini_ks<EpiGate<true>, pg8::StaticOrder>(lds, g, S, E, geo.vcu, geo.G);
}
__device__ __forceinline__ void phase_wout(LAS unsigned char* lds, const Geo geo_in, int layer) {
    const Geo geo = opaque_geo(geo_in);
    KArgs A = kargs(); unsigned char* ws = A->ws; const int M = (layer == 1) ? NLAT : R; bf16_t* proj = (bf16_t*)(ws + WS_PROJ);
    pg8::Gemm g{proj + PGA, (const bf16_t*)(ws + WS_W + layer * WL_STRIDE + WL_OUT), M, DM, DM}; pg8::StaticOrder S; S.init(M, DM, geo.G, geo.bx);
    EpiPlain E{(bf16_t*)(ws + WS_H), DM};
    pg8::gemm_phase<EpiPlain, pg8::StaticOrder, true, true>(lds, g, S, E);
    gemm_mini_ks<EpiPlain, pg8::StaticOrder>(lds, g, S, E, geo.vcu, geo.G);
}

constexpr int XB_SPLIT = 15872;
__device__ __forceinline__ bf16_t* xa_row(unsigned char* ws, int row) { return (bf16_t*)(ws + WS_OB) + (size_t)row * DM; }
__device__ __forceinline__ bf16_t* xb_row(unsigned char* ws, int row) { return row < XB_SPLIT ? (bf16_t*)(ws + WS_END) + (size_t)row * DM : (bf16_t*)(ws + WS_WGU) + (size_t)(row - XB_SPLIT) * DM; }
__device__ __forceinline__ bf16_t* xc_row(unsigned char* ws, int row) { return (bf16_t*)(ws + WS_W) + (size_t)row * DM; }
__device__ __forceinline__ void phase_postmix0(const Geo geo_in, bool probe = false) {
    const Geo geo = opaque_geo(geo_in);
    KArgs A = kargs(); unsigned char* ws = A->ws;
    const int tid = opaque_tid(), lane = tid & 63, wave = __builtin_amdgcn_readfirstlane(tid >> 6);
    const int gw = geo.vcu * NWAVES + wave, NGW = geo.G * NWAVES;
    const float* x_in = A->in[I_X]; const float* ctx_in = A->in[I_CTX]; float* out = A->out; float* xctx = (float*)(ws + WS_XCTX);
    const float* pmn = A->in[I_POSTMIX]; const float* pfn = A->in[I_PREFFN]; const float* modl = (const float*)(ws + WS_MOD); bf16_t* Hb = (bf16_t*)(ws + WS_H);
#define SRC_ROW(row_) (((row_) < NLAT) ? x_in + (size_t)(row_) * DM : ctx_in + (size_t)((row_) - NLAT) * DM)
#define P9_ROW(row_, cx_, cm_) do { const int rw_ = (row_); const float* md = modl + (size_t)((rw_ < NLAT) ? (rw_ >> 12) : 4) * NMOD;      \
        const Row16 x1 = resid_add(cx_, cm_, row_rstd(cm_), pmn, md + 2 * DM, lane);                                                           \
        if (probe) st_bf16_row((bf16_t*)(ws + WS_OB) + (size_t)rw_ * DM, lane, x1);                                                            \
        else if (rw_ < NLAT) st_bf16_row_nt(xa_row(ws, rw_), lane, x1); else st_f32_row(xctx + (size_t)(rw_ - NLAT) * DM, lane, x1);                \
        const Row16 f = norm_mod(x1, row_rstd(x1), pfn, md + 3 * DM, md + 4 * DM, lane);                                                       \
        st_bf16_row((probe ? (bf16_t*)(ws + WS_OF) : Hb) + (size_t)rw_ * DM, lane, f); } while (0)
    const int rc0 = NLAT + gw; Row16 cxc; RawB cmc; if (rc0 < R) { cxc = ld_f32_row(SRC_ROW(rc0), lane); cmc = ld_raw_b(Hb + (size_t)rc0 * DM, lane); }
    for (int base = gw; base < NLAT; base += 8 * NGW) {
        Row16 fx[5]; RawB fm[5];
#define P9_LOAD(k_) do { const int rw_ = (base + (k_) * NGW < NLAT) ? base + (k_) * NGW : base; fx[(k_) % 5] = ld_f32_row_nt(SRC_ROW(rw_), lane); fm[(k_) % 5] = ld_raw_b_nt(Hb + (size_t)rw_ * DM, lane); } while (0)
#pragma unroll
        for (int k = 0; k < 4; ++k) P9_LOAD(k);
#pragma unroll
        for (int k = 0; k < 8; ++k) {
            if (k + 4 < 8) P9_LOAD(k + 4);
            if (base + k * NGW < NLAT) { const Row16 cm = unraw_b(fm[k % 5]); P9_ROW(base + k * NGW, fx[k % 5], cm); }
        }
#undef P9_LOAD
    }
    if (rc0 < R) { const Row16 cm = unraw_b(cmc); P9_ROW(rc0, cxc, cm); }
    for (int rc = rc0 + NGW; rc < R; rc += NGW) { const Row16 c2 = ld_f32_row(SRC_ROW(rc), lane), m2 = ld_bf16_row(Hb + (size_t)rc * DM, lane); P9_ROW(rc, c2, m2); }
#undef P9_ROW
#undef SRC_ROW
}
constexpr int MOE_I_E = 16 * (DFE / 32);
constexpr int MOE_CONV_TAILW = (256 - 16) * NWAVES;
#ifndef MOE_EARLY_PER_WAVE
#define MOE_EARLY_PER_WAVE 16
#endif
constexpr int MOE_CONV_EARLY = MOE_EARLY_PER_WAVE * MOE_CONV_TAILW;
__device__ __forceinline__ void moe_convert(unsigned char* ws, KArgs A, LAS unsigned char* scrbase, int first, int last, int wi, int nw, int wave, int lane) {
    LAS float* scr = (LAS float*)(scrbase + wave * 8704);
    unsigned char* MGU = ws + WS_MGU; unsigned char* MD = ws + WS_MD;
    const auto dec = [&](int it, TDesc& d) { const int e = it / (3 * MOE_I_E), r3 = it - e * 3 * MOE_I_E, m = r3 / MOE_I_E; d.item = r3 - m * MOE_I_E;
        if (m < 2) { d.W = (m == 0 ? A->in[I_MWG] : A->in[I_MWU]) + (size_t)e * DM * DFE; d.K = DM; d.N = DFE; d.WT = MGU + (size_t)e * 2 * DFE * DM; d.il = 1 + m; }
        else { d.W = A->in[I_MWD] + (size_t)e * DFE * DM; d.K = DFE; d.N = DM; d.WT = MD + (size_t)e * DM * DFE; d.il = 0; } };
    t_run<true>(dec, first + wi, last, nw, scr, lane);
}
__device__ __forceinline__ void phase_postmix1(LAS unsigned char* lds, const Geo geo_in) {
    const Geo geo = opaque_geo(geo_in);
    KArgs A = kargs(); unsigned char* ws = A->ws;
    const int tid = opaque_tid(), lane = tid & 63, wave = __builtin_amdgcn_readfirstlane(tid >> 6);
    const int G = geo.G, vcu = geo.vcu, gw = vcu * NWAVES + wave, NGW = G * NWAVES;
    float* out = A->out; const float* pmn = A->in[I_POSTMIX] + DM; const float* pfn = A->in[I_PREFFN] + DM; const float* modl = (const float*)(ws + WS_MOD) + (size_t)5 * NMOD;
    bf16_t* Hb = (bf16_t*)(ws + WS_H); unsigned* route = (unsigned*)(ws + WS_ROUTE); unsigned* wgb = (unsigned*)(ws + WS_WGB); unsigned* cnt = (unsigned*)(ws + WS_CTL) + CW_CNT;
    LAS float* wr = (LAS float*)lds; LAS unsigned* lcnt = (LAS unsigned*)(lds + 32768); LAS unsigned* lbase = lcnt + 8; unsigned char* XB = ws + WS_XB;
    { const float* moe_router = A->in[I_ROUTER]; for (int i = tid; i < DM * NEXP; i += 512) wr[i] = moe_router[i]; }
    if (tid < NEXP) lcnt[tid] = 0u;
    __syncthreads();
    for (int blk = vcu; blk < NLAT / 64; blk += G) {
        RawB rxr[8], rmx[8];
        unsigned fq8[8][4]; int re0[8], re1[8]; unsigned rp0[8], rp1[8];
#pragma unroll
        for (int i = 0; i < 8; ++i) { rxr[i] = ld_raw_b_nt(xb_row(ws, blk * 64 + wave * 8 + i), lane); rmx[i] = ld_raw_b_nt(Hb + (size_t)(blk * 64 + wave * 8 + i) * DM, lane); }
#pragma unroll
        for (int i = 0; i < 8; ++i) {
            const int row = blk * 64 + wave * 8 + i;
            const float* md = modl + (size_t)(row >> 12) * NMOD;
            const Row16 xr = unraw_b(rxr[i]), mx = unraw_b(rmx[i]);
            const Row16 x1 = resid_add(xr, mx, row_rstd(mx), pmn, md + 2 * DM, lane);
            st_bf16_row_nt(xc_row(ws, row), lane, x1);
            const Row16 f = norm_mod(x1, row_rstd(x1), pfn, md + 3 * DM, md + 4 * DM, lane);
#pragma unroll
            for (int j = 0; j < 4; ++j) fq8[i][j] = pk4_fp8(f.v[j][0], f.v[j][1], f.v[j][2], f.v[j][3]);
            float lg[NEXP];
#pragma unroll
            for (int e = 0; e < NEXP; ++e) lg[e] = 0.f;
#pragma unroll
            for (int j = 0; j < 4; ++j)
#pragma unroll
                for (int e4 = 0; e4 < 4; ++e4) { const int cidx = 4 * (lane + 64 * j) + e4; const f32x4 w0 = *(const LAS f32x4*)(wr + cidx * 8), w1 = *(const LAS f32x4*)(wr + cidx * 8 + 4); const float fv = f.v[j][e4];
                    lg[0] += fv * w0[0]; lg[1] += fv * w0[1]; lg[2] += fv * w0[2]; lg[3] += fv * w0[3]; lg[4] += fv * w1[0]; lg[5] += fv * w1[1]; lg[6] += fv * w1[2]; lg[7] += fv * w1[3]; }
#pragma unroll
            for (int e = 0; e < NEXP; ++e) lg[e] = wave_sum(lg[e]);
            int e0 = 0; float l0 = lg[0];
#pragma unroll
            for (int e = 1; e < NEXP; ++e) if (lg[e] > l0) { l0 = lg[e]; e0 = e; }
            int e1 = -1; float l1 = -3.0e38f;
#pragma unroll
            for (int e = 0; e < NEXP; ++e) if (e != e0 && lg[e] > l1) { l1 = lg[e]; e1 = e; }
            unsigned p0 = 0u, p1 = 0u;
            if (lane == 0) {
                p0 = __hip_atomic_fetch_add(lcnt + e0, 1u, __ATOMIC_RELAXED, __HIP_MEMORY_SCOPE_WORKGROUP);
                p1 = __hip_atomic_fetch_add(lcnt + e1, 1u, __ATOMIC_RELAXED, __HIP_MEMORY_SCOPE_WORKGROUP);
                const float w0 = 1.f / (1.f + expf(l1 - l0));
                unsigned* rr = route + (size_t)row * 8;
                rr[0] = (unsigned)e0 | ((unsigned)e1 << 8); rr[3] = __float_as_uint(w0); rr[4] = __float_as_uint(1.f - w0);
            }
            re0[i] = __builtin_amdgcn_readfirstlane(e0); re1[i] = __builtin_amdgcn_readfirstlane(e1); rp0[i] = __builtin_amdgcn_readfirstlane(p0); rp1[i] = __builtin_amdgcn_readfirstlane(p1);
        }
        __syncthreads();
        if (tid < NEXP) { const unsigned n = lcnt[tid]; lbase[tid] = __hip_atomic_fetch_add(cnt + 64 * tid, n, __ATOMIC_RELAXED, __HIP_MEMORY_SCOPE_AGENT); lcnt[tid] = 0u; }
        __syncthreads();
#pragma unroll
        for (int i = 0; i < 8; ++i) { const int row = blk * 64 + wave * 8 + i;
            const unsigned k0 = lbase[re0[i]] + rp0[i], k1 = lbase[re1[i]] + rp1[i];
            unsigned* d0 = (unsigned*)(XB + ((size_t)re0[i] * XB_CAP + k0) * DM); unsigned* d1 = (unsigned*)(XB + ((size_t)re1[i] * XB_CAP + k1) * DM);
#pragma unroll
            for (int j = 0; j < 4; ++j) { d0[lane + 64 * j] = fq8[i][j]; d1[lane + 64 * j] = fq8[i][j]; }
            if (lane == 0) { unsigned* rr = route + (size_t)row * 8; rr[5] = k0; rr[6] = k1; } }
        __syncthreads();
    }
    moe_convert(ws, A, lds + 49152, (G == 256) ? MOE_CONV_EARLY : 0, NEXP * 3 * MOE_I_E, gw, NGW, wave, lane);
}

struct MoeCounts { int nb[NEXP]; };
__device__ __forceinline__ MoeCounts moe_counts(unsigned char* ws) { MoeCounts c; unsigned* cnt = (unsigned*)(ws + WS_CTL) + CW_CNT;
#pragma unroll
    for (int e = 0; e < NEXP; ++e) { const unsigned n = __hip_atomic_load(cnt + 64 * e, __ATOMIC_RELAXED, __HIP_MEMORY_SCOPE_AGENT); c.nb[e] = (int)((n + 255u) >> 8); }
    return c; }

__device__ __forceinline__ void phase_gather(const Geo geo_in) {
    const Geo geo = opaque_geo(geo_in);
    KArgs A = kargs(); unsigned char* ws = A->ws;
    const int tid = opaque_tid(), lane = tid & 63, wave = __builtin_amdgcn_readfirstlane(tid >> 6);
    const int gw = geo.vcu * NWAVES + wave, NGW = geo.G * NWAVES;
    const MoeCounts mc = moe_counts(ws); int pst[NEXP]; { int a_ = 0;
#pragma unroll
        for (int e = 0; e < NEXP; ++e) { pst[e] = a_; a_ += mc.nb[e] * 256; } }
    unsigned* route = (unsigned*)(ws + WS_ROUTE); const unsigned* wgb = (const unsigned*)(ws + WS_WGB); const bf16_t* Hb = (const bf16_t*)(ws + WS_H); unsigned char* XB = ws + WS_XB;
    struct Rec { unsigned ee, p0, p1; }; struct Dat { unsigned b0, b1; u32x4 lo, hi; };
#define G_REC(dst, row_) do { const unsigned* rr_ = route + (size_t)(row_) * 8; dst.ee = rr_[0]; dst.p0 = rr_[1]; dst.p1 = rr_[2]; } while (0)
#define G_DAT(dst, rec, row_) do { dst.b0 = wgb[((row_) >> 6) * 8 + (rec.ee & 255)]; dst.b1 = wgb[((row_) >> 6) * 8 + ((rec.ee >> 8) & 255)]; \
        dst.lo = *(const u32x4*)(Hb + (size_t)(row_) * DM + 16 * lane); dst.hi = *(const u32x4*)(Hb + (size_t)(row_) * DM + 16 * lane + 8); } while (0)
    for (int base = gw; base < NLAT; base += 8 * NGW) {
        Rec rc[8]; Dat dt[8];
#pragma unroll
        for (int k = 0; k < 8; ++k) G_REC(rc[k], ((base + k * NGW < NLAT) ? base + k * NGW : base));
#pragma unroll
        for (int k = 0; k < 8; ++k) G_DAT(dt[k], rc[k], ((base + k * NGW < NLAT) ? base + k * NGW : base));
#pragma unroll
        for (int k = 0; k < 8; ++k) { const int row = base + k * NGW;
            if (row < NLAT) {
                const int e0 = rc[k].ee & 255, e1 = (rc[k].ee >> 8) & 255;
                int ps0 = 0, ps1 = 0;
#pragma unroll
                for (int e = 0; e < NEXP; ++e) { if (e == e0) ps0 = pst[e]; if (e == e1) ps1 = pst[e]; }
                const unsigned d0 = (unsigned)ps0 + dt[k].b0 + rc[k].p0, d1 = (unsigned)ps1 + dt[k].b1 + rc[k].p1;
                f32x4 v0, v1, v2, v3; unpack8(dt[k].lo, v0, v1); unpack8(dt[k].hi, v2, v3);
                const u32x4 q = {pk4_fp8(v0[0], v0[1], v0[2], v0[3]), pk4_fp8(v1[0], v1[1], v1[2], v1[3]), pk4_fp8(v2[0], v2[1], v2[2], v2[3]), pk4_fp8(v3[0], v3[1], v3[2], v3[3])};
                *(u32x4*)(XB + (size_t)d0 * DM + 16 * lane) = q; *(u32x4*)(XB + (size_t)d1 * DM + 16 * lane) = q;
                if (lane == 0) { unsigned* rr = route + (size_t)row * 8; rr[5] = d0; rr[6] = d1; }
            } }
    }
#undef G_REC
#undef G_DAT
}

__device__ __forceinline__ void phase_ffn_up0(LAS unsigned char* lds, const Geo geo_in) {
    const Geo geo = opaque_geo(geo_in);
    KArgs A = kargs(); unsigned char* ws = A->ws;
    pg8::Gemm g{(const bf16_t*)(ws + WS_H), (const bf16_t*)(ws + WS_WGU), R, 2 * DFF, DM}; pg8::StaticOrder S; S.init(R, 2 * DFF, geo.G, geo.bx); S.nfull = S.nwg;
    EpiSwiGLU E{(bf16_t*)(ws + WS_PROJ), DFF};
    pg8::gemm_phase<EpiSwiGLU, pg8::StaticOrder, true, true>(lds, g, S, E);
    gemm_mini<EpiSwiGLU, pg8::StaticOrder>(g, S, E, geo.vcu, geo.G);
}
__device__ __forceinline__ void phase_ffn_down0(LAS unsigned char* lds, const Geo geo_in) {
    const Geo geo = opaque_geo(geo_in);
    KArgs A = kargs(); unsigned char* ws = A->ws;
    pg8::Gemm g{(const bf16_t*)(ws + WS_PROJ), (const bf16_t*)(ws + WS_WD), R, DM, DFF}; pg8::StaticOrder S; S.init(R, DM, geo.G, geo.bx); S.nfull = S.nwg;
    EpiPlain E{(bf16_t*)(ws + WS_OF), DM};
    pg8::gemm_phase<EpiPlain, pg8::StaticOrder, true, true>(lds, g, S, E);
    if (geo.G == 256 && geo.bx >= 16) {
        const int tid = opaque_tid(), lane = tid & 63, wave = __builtin_amdgcn_readfirstlane(tid >> 6);
        moe_convert(ws, A, lds, 0, MOE_CONV_EARLY, (geo.bx - 16) * NWAVES + wave, MOE_CONV_TAILW, wave, lane);
    }
}
__device__ __forceinline__ void phase_ffn_up1(LAS unsigned char* lds, const Geo geo_in) {
    const Geo geo = opaque_geo(geo_in);
    KArgs A = kargs(); unsigned char* ws = A->ws; const MoeCounts mc = moe_counts(ws);
    pg8::Gemm g{(const bf16_t*)(ws + WS_XB), (const bf16_t*)(ws + WS_MGU), MOE_ROWS_MAX, 2 * DFE, DM}; MoeOrder S; S.acap = XB_CAP / 256;
#pragma unroll
    for (int e = 0; e < NEXP; ++e) S.nb[e] = mc.nb[e];
    S.nN = 2 * DFE / 256; S.G = geo.G; S.c = geo.vcu; S.finish(); S.nfull = S.nwg;
    EpiSwiGLU8 E{ws + WS_HIDM, DFE};
    pg8::gemm_phase<EpiSwiGLU8, MoeOrder, true, true, true>(lds, g, S, E);
}
__device__ __forceinline__ void phase_ffn_down1(LAS unsigned char* lds, const Geo geo_in) {
    const Geo geo = opaque_geo(geo_in);
    KArgs A = kargs(); unsigned char* ws = A->ws; const MoeCounts mc = moe_counts(ws);
    pg8::Gemm g{(const bf16_t*)(ws + WS_HIDM), (const bf16_t*)(ws + WS_MD), MOE_ROWS_MAX, DM, DFE}; MoeOrder S;
#pragma unroll
    for (int e = 0; e < NEXP; ++e) S.nb[e] = mc.nb[e];
    S.nN = DM / 256; S.G = geo.G; S.c = geo.vcu; S.finish();
#ifdef MOE_NO_MINI8
    S.nfull = S.nwg;
#endif
    EpiPlain E{(bf16_t*)(ws + WS_YB), DM, 0.015625f};
    pg8::gemm_phase<EpiPlain, MoeOrder, true, true, true>(lds, g, S, E);
    gemm_mini8<DFE, EpiPlain, MoeOrder>(lds, ws + WS_HIDM, ws + WS_MD, S, E, geo.vcu, geo.G);
}

__device__ __forceinline__ void phase_postffn0(const Geo geo_in, bool probe = false) {
    const Geo geo = opaque_geo(geo_in);
    KArgs A = kargs(); unsigned char* ws = A->ws;
    const int tid = opaque_tid(), lane = tid & 63, wave = __builtin_amdgcn_readfirstlane(tid >> 6);
    const int gw = geo.vcu * NWAVES + wave, NGW = geo.G * NWAVES;
    float* out = A->out; float* xctx = (float*)(ws + WS_XCTX); const float* pfn = A->in[I_POSTFFN]; const float* pmx = A->in[I_PREMIX] + DM;
    const float* modl = (const float*)(ws + WS_MOD); const bf16_t* FF = (const bf16_t*)(ws + WS_OF); bf16_t* Hb = (bf16_t*)(ws + WS_H);
#define X_LOAD(row_) (((row_) < NLAT) ? ld_bf16_row(xa_row(ws, (row_)), lane) : ld_f32_row(xctx + (size_t)((row_) - NLAT) * DM, lane))
#define P13_ROW(row_, cx_, cy_) do { const int rw_ = (row_); const int mi = (rw_ < NLAT) ? (rw_ >> 12) : 4;                                        \
        const Row16 x2 = resid_add(cx_, cy_, row_rstd(cy_), pfn, modl + (size_t)mi * NMOD + 5 * DM, lane);                                    \
        if (probe) st_bf16_row((bf16_t*)(ws + WS_PROJ) + (size_t)rw_ * DM, lane, x2);                                                          \
        else if (rw_ < NLAT) st_bf16_row_nt(xb_row(ws, rw_), lane, x2); else st_f32_row(xctx + (size_t)(rw_ - NLAT) * DM, lane, x2);                \
        const float* mdn = modl + (size_t)(5 + mi) * NMOD;                                                                                    \
        const Row16 h = norm_mod(x2, row_rstd(x2), pmx, mdn + 0 * DM, mdn + 1 * DM, lane);                                                    \
        st_bf16_row((probe ? (bf16_t*)(ws + WS_PROJ + 40 * MiB) : Hb) + (size_t)rw_ * DM, lane, h); } while (0)
    const int rc0 = NLAT + gw; Row16 cxc; RawB cyr; if (rc0 < R) { cxc = ld_f32_row(xctx + (size_t)(rc0 - NLAT) * DM, lane); cyr = ld_raw_b(FF + (size_t)rc0 * DM, lane); }
    for (int base = gw; base < NLAT; base += 8 * NGW) {
        RawB rx[8], ry[8];
#pragma unroll
        for (int k = 0; k < 8; ++k) { const int rw = (base + k * NGW < NLAT) ? base + k * NGW : base; rx[k] = ld_raw_b_nt(xa_row(ws, rw), lane); ry[k] = ld_raw_b_nt(FF + (size_t)rw * DM, lane); }
#pragma unroll
        for (int k = 0; k < 8; ++k) if (base + k * NGW < NLAT) { const Row16 cx = unraw_b(rx[k]), cy = unraw_b(ry[k]); P13_ROW(base + k * NGW, cx, cy); }
    }
    if (rc0 < R) { const Row16 cyc = unraw_b(cyr); P13_ROW(rc0, cxc, cyc); }
    for (int rc = rc0 + NGW; rc < R; rc += NGW) { const Row16 c2 = ld_f32_row(xctx + (size_t)(rc - NLAT) * DM, lane), y2 = ld_bf16_row(FF + (size_t)rc * DM, lane); P13_ROW(rc, c2, y2); }
#undef P13_ROW
#undef X_LOAD
}
__device__ __forceinline__ void phase_postffn1(const Geo geo_in) {
    const Geo geo = opaque_geo(geo_in);
    KArgs A = kargs(); unsigned char* ws = A->ws;
    const int tid = opaque_tid(), lane = tid & 63, wave = __builtin_amdgcn_readfirstlane(tid >> 6);
    const int gw = geo.vcu * NWAVES + wave, NGW = geo.G * NWAVES;
    float* out = A->out; const float* pfn = A->in[I_POSTFFN] + DM; const float* modl = (const float*)(ws + WS_MOD) + (size_t)5 * NMOD;
    const unsigned* route = (const unsigned*)(ws + WS_ROUTE); const bf16_t* YB = (const bf16_t*)(ws + WS_YB);
    const MoeCounts mc = moe_counts(ws); int pst[NEXP]; { int a_ = 0;
#pragma unroll
        for (int e = 0; e < NEXP; ++e) { pst[e] = a_; a_ += mc.nb[e] * 256; } }
    for (int base = gw; base < NLAT; base += 8 * NGW) {
        u32x4 rt[8];
#pragma unroll
        for (int k = 0; k < 8; ++k) { const unsigned* rr = route + (size_t)((base + k * NGW < NLAT) ? base + k * NGW : base) * 8; rt[k] = *(const u32x4*)(rr + 3); const unsigned ee = rr[0];
            const int e0 = ee & 255, e1 = (ee >> 8) & 255; int ps0 = 0, ps1 = 0;
#pragma unroll
            for (int e = 0; e < NEXP; ++e) { if (e == e0) ps0 = pst[e]; if (e == e1) ps1 = pst[e]; }
            rt[k].z += (unsigned)ps0; rt[k].w += (unsigned)ps1; }
        RawB fx[5], f0[5], f1[5];
#define P13L_LOAD(k_) do { const int rw_ = (base + (k_) * NGW < NLAT) ? base + (k_) * NGW : base; fx[(k_) % 5] = ld_raw_b_nt(xc_row(ws, rw_), lane);           \
        f0[(k_) % 5] = ld_raw_b_nt(YB + (size_t)rt[k_].z * DM, lane); f1[(k_) % 5] = ld_raw_b_nt(YB + (size_t)rt[k_].w * DM, lane); } while (0)
#pragma unroll
        for (int k = 0; k < 4; ++k) P13L_LOAD(k);
#pragma unroll
        for (int k = 0; k < 8; ++k) {
            if (k + 4 < 8) P13L_LOAD(k + 4);
            const int row = base + k * NGW;
            if (row < NLAT) {
                const float w0 = __uint_as_float(rt[k].x), w1 = __uint_as_float(rt[k].y);
                const Row16 cx = unraw_b(fx[k % 5]), c0 = unraw_b(f0[k % 5]), c1 = unraw_b(f1[k % 5]);
                Row16 y;
#pragma unroll
                for (int j = 0; j < 4; ++j) y.v[j] = c0.v[j] * w0 + c1.v[j] * w1;
                const Row16 x2 = resid_add(cx, y, row_rstd(y), pfn, modl + (size_t)(row >> 12) * NMOD + 5 * DM, lane);
                st_f32_row(out + (size_t)row * DM, lane, x2);
            }
        }
#undef P13L_LOAD
    }
}

__global__ void __launch_bounds__(NWAVES * 64, 2) fwd_kernel(Args args) {
    LAS unsigned char* lds = (LAS unsigned char*)lds_raw;
    volatile LAS unsigned* MISC = (volatile LAS unsigned*)(lds + MISC_OFF);
    Geo geo; geo.G = gridDim.x; geo.bx = blockIdx.x; geo.vcu = (geo.G % 8 == 0) ? (geo.bx % 8) * (geo.G / 8) + geo.bx / 8 : geo.bx;
    for (int u = threadIdx.x; u < (LDS_BYTES - LDS_CTL_OFF) / 4; u += NWAVES * 64) ((LAS unsigned*)(lds + LDS_CTL_OFF))[u] = 0u;
    __syncthreads();
    if ((threadIdx.x & 63) == 0) *(LAS int*)(lds + WAVE_TAB_OFF + 4 * hw_wave_slot()) = (int)(threadIdx.x >> 6);
    __syncthreads();
    const int lo = args.ph_lo, hi = args.ph_hi;
    XcdBarrier bar; bar.bar = (unsigned*)(args.ws + WS_CTL) + CW_BAR; bar.x = 0; bar.st = nullptr;
    if (hi - lo > 1) bar = xcd_barrier_post((unsigned*)(args.ws + WS_CTL) + CW_BAR, MISC + 8);
#ifndef PHASE_MASK
#define PHASE_MASK 0x3fff
#endif
#define IN(k) (((PHASE_MASK >> ((k) % NPH)) & 1) && lo <= (k) && (k) < hi)
#define SEAM(k) do { if (IN((k) + 1)) xcd_barrier(bar); } while (0)
#ifndef REP_ID
#define REP_ID (-1)
#endif
#define REP(k, call) do { call; if (REP_ID >= 0 && REP_ID == (k)) { if (hi - lo > 1) xcd_barrier(bar); call; } } while (0)
#pragma unroll 1
    for (int layer = 0; layer < 2; ++layer) {
        const int P = layer * NPH; const bool last = (layer == 1);
        if (!last && IN(P + 0)) { asm volatile("; PHASE_BEGIN_0" ::: "memory"); REP(P + 0, phase_prologue(lds, geo)); SEAM(P + 0); }
        if (!last && IN(P + 1)) { asm volatile("; PHASE_BEGIN_1" ::: "memory"); phase_premix0(geo); SEAM(P + 1); }
        if (IN(P + 2)) { asm volatile("; PHASE_BEGIN_2" ::: "memory"); REP(P + 2, phase_proj(lds, geo, layer));
            SEAM(P + 2); }
        if (IN(P + 3)) { asm volatile("; PHASE_BEGIN_3" ::: "memory"); phase_qknorm(geo, layer); SEAM(P + 3); }
        if (IN(P + 4)) { asm volatile("; PHASE_BEGIN_4" ::: "memory");
#ifndef NO_ATTN
            REP(P + 4, phase_attn(lds_raw, geo, last, layer));
#endif
#ifndef NO_SCAN
            REP(P + 4 + 100, phase_scan(lds, geo, last));
#endif
            SEAM(P + 4); }
        if (IN(P + 5)) { asm volatile("; PHASE_BEGIN_5" ::: "memory"); phase_readout(geo, layer); SEAM(P + 5); }
        if (IN(P + 6)) { asm volatile("; PHASE_BEGIN_6" ::: "memory"); phase_merge_hg(lds, geo, layer); VM_WAIT(); __syncthreads(); }
        if (IN(P + 7)) { asm volatile("; PHASE_BEGIN_7" ::: "memory"); phase_merge_att(lds, geo, layer); SEAM(P + 7); }
        if (IN(P + 8)) { asm volatile("; PHASE_BEGIN_8" ::: "memory"); REP(P + 8, phase_wout(lds, geo, layer)); SEAM(P + 8); }
        if (IN(P + 9)) { asm volatile("; PHASE_BEGIN_9" ::: "memory");
#if defined(THIN_PROBE)
            if (!last && THIN_PROBE == 9) { phase_postmix0(geo, true); xcd_barrier(bar); }
#endif
            if (!last) phase_postmix0(geo); else phase_postmix1(lds, geo); SEAM(P + 9); }
        if (IN(P + 11)) { asm volatile("; PHASE_BEGIN_11" ::: "memory"); if (!last) REP(P + 11, phase_ffn_up0(lds, geo)); else REP(P + 11, phase_ffn_up1(lds, geo)); SEAM(P + 11); }
        if (IN(P + 12)) { asm volatile("; PHASE_BEGIN_12" ::: "memory"); if (!last) REP(P + 12, phase_ffn_down0(lds, geo)); else REP(P + 12, phase_ffn_down1(lds, geo)); SEAM(P + 12); }
        if (IN(P + 13)) { asm volatile("; PHASE_BEGIN_13" ::: "memory");
#if defined(THIN_PROBE)
            if (!last && THIN_PROBE == 13) { phase_postffn0(geo, true); xcd_barrier(bar); }
#endif
            if (!last) { phase_postffn0(geo); SEAM(P + 13); } else phase_postffn1(geo); }
    }
#undef IN
#undef SEAM
}

__global__ void dump_kernel(const bf16_t* src, int pitch, float* out) {
    for (size_t i = (size_t)blockIdx.x * 256 + threadIdx.x; i < (size_t)NLAT * DM; i += (size_t)gridDim.x * 256) { const size_t row = i >> 10, c = i & 1023; out[i] = bf_lo((unsigned)src[row * pitch + c]); }
}
extern "C" void kernel_launch(void* const* d_in, const int* in_sizes, int n_in, void* d_out, int out_size, void* d_ws, size_t ws_size, hipStream_t stream) {
    static int grid = 0;
    if (grid == 0) {
        if (n_in != 25 || in_sizes[0] != NLAT * DM || out_size != NLAT * DM || ws_size < WS_END + 31 * MiB) { fprintf(stderr, "kernel_launch: unexpected shapes (n_in %d, in0 %d, out %d, ws %zu < %zu)\n", n_in, n_in > 0 ? in_sizes[0] : -1, out_size, ws_size, (size_t)(WS_END + 31 * MiB)); grid = -1; return; }
        int dev = 0, cus = 0, per_cu = 0;
        if (hipGetDevice(&dev) != hipSuccess || hipDeviceGetAttribute(&cus, hipDeviceAttributeMultiprocessorCount, dev) != hipSuccess) { grid = -1; return; }
        if (hipFuncSetAttribute((const void*)fwd_kernel, hipFuncAttributeMaxDynamicSharedMemorySize, LDS_BYTES) != hipSuccess) { fprintf(stderr, "kernel_launch: hipFuncSetAttribute failed\n"); grid = -1; return; }
        if (hipOccupancyMaxActiveBlocksPerMultiprocessor(&per_cu, (const void*)fwd_kernel, NWAVES * 64, LDS_BYTES) != hipSuccess || per_cu < 1) fprintf(stderr, "kernel_launch: occupancy query reports %d\n", per_cu);
        (void)hipGetLastError();
        grid = cus;
    }
    if (grid < 0) return;
    if (hipMemsetAsync((char*)d_ws + WS_CTL, 0, CTL_ZERO_BYTES, stream) != hipSuccess) return;
    Args a{};
    for (int i = 0; i < 25; ++i) a.in[i] = (const float*)d_in[i];
    a.out = (float*)d_out; a.ws = (unsigned char*)d_ws;
#ifndef MK_ONE_LAUNCH
#define MK_ONE_LAUNCH 0
#endif
    if (MK_ONE_LAUNCH) {
        a.ph_lo = 0; a.ph_hi = NTOT;
        hipLaunchKernelGGL(fwd_kernel, dim3(grid), dim3(NWAVES * 64), LDS_BYTES, stream, a);
    } else {
#ifndef LAST_PHASE
#define LAST_PHASE (NTOT - 1)
#endif
        for (int ph = 0; ph <= LAST_PHASE; ++ph) {
            const int p = ph % NPH, l = ph / NPH;
            if ((l == 1 && (p == 0 || p == 1)) || (l == 0 && p == 10)) continue;
            a.ph_lo = ph; a.ph_hi = ph + 1;
            hipLaunchKernelGGL(fwd_kernel, dim3(grid), dim3(NWAVES * 64), LDS_BYTES, stream, a);
        }
    }
#ifdef DUMP_OFF
    hipLaunchKernelGGL(dump_kernel, dim3(1024), dim3(256), 0, stream, (const bf16_t*)((const unsigned char*)d_ws + (size_t)(DUMP_OFF)), (int)(DUMP_PITCH), (float*)d_out);
#endif
    const hipError_t le = hipPeekAtLastError();
    if (le != hipSuccess) fprintf(stderr, "kernel_launch: launch failed: %s\n", hipGetErrorName(le));
}
```

```cpp
#define MK_ONE_LAUNCH 1
#include <hip/hip_runtime.h>
#include <cstdio>
#include <cstdint>
#include <type_traits>

#define GAS __attribute__((address_space(1)))
#define LAS __attribute__((address_space(3)))
typedef unsigned short bf16_t;
typedef float f32x2 __attribute__((ext_vector_type(2)));
typedef unsigned u32x2 __attribute__((ext_vector_type(2)));
typedef GAS unsigned gu32;
#define RLX_AGENT __ATOMIC_RELAXED, __HIP_MEMORY_SCOPE_AGENT
#define LDS_WAIT() asm volatile("s_waitcnt lgkmcnt(0)" ::: "memory")
#define VM_WAIT() asm volatile("s_waitcnt vmcnt(0)" ::: "memory")

constexpr int DM = 1024, NB = 4, SEQ = 4096, CTXL = 256, NLAT = NB * SEQ, NCTX = NB * CTXL, R = NLAT + NCTX;
constexpr int PROJW = 8704, DFF = 2816, NEXP = 8, DFE = 3584, NMOD = 6 * DM;
constexpr int MOE_ROWS_MAX = (2 * NLAT / 256 + NEXP) * 256;
constexpr float NORM_EPS = 1e-6f;

extern __shared__ __attribute__((aligned(16))) unsigned char lds_raw[];
constexpr int LDS_CTL_OFF = 159744, WAVE_TAB_OFF = LDS_CTL_OFF + 1024;
__device__ __forceinline__ int hw_wave_slot() { return (int)__builtin_amdgcn_s_getreg((7 << 11) | 4) & 255; }
__device__ __forceinline__ int opaque_tid() {
    const int wv = *(const __attribute__((address_space(3))) int*)((__attribute__((address_space(3))) unsigned char*)lds_raw + WAVE_TAB_OFF + 4 * hw_wave_slot());
    int t = (wv << 6) | (int)__builtin_amdgcn_mbcnt_hi(~0u, __builtin_amdgcn_mbcnt_lo(~0u, 0u));
    asm volatile("" : "+v"(t)); return t; }
#ifndef PG8_ASM_STAGE
#define PG8_ASM_STAGE 1
#endif
namespace pg8 {
#define PG8_LAS __attribute__((address_space(3)))
typedef unsigned short bf16_t;
typedef short bf16x8 __attribute__((ext_vector_type(8)));
typedef float f32x4 __attribute__((ext_vector_type(4)));
typedef unsigned u32x4 __attribute__((ext_vector_type(4)));
constexpr int BM = 256, BK = 64, HALF = 128, HTB = HALF * BK * 2  , STAGE_BYTES = 8 * HTB, NXCD = 8, WGM = 8;

__host__ __device__ __forceinline__ int lds_byte(int r, int c) { const int st = (r >> 4) * 2 + (c >> 5), rr = r & 15, cc = c & 31, ob = rr * 64 + cc * 2; return st * 1024 + (ob ^ (((ob >> 9) & 1) << 5)); }
__host__ __device__ __forceinline__ void stage_rc(int b, int& R, int& C) { const int st = b / 1024, sb = b % 1024, swz = sb ^ (((sb >> 9) & 1) << 5); R = (st >> 1) * 16 + swz / 64; C = (st & 1) * 32 + (swz % 64) / 2; }
__host__ __device__ __forceinline__ int perm32(int rho) { const int n = rho >> 4, i = rho & 15; return 8 * (i >> 2) + 4 * n + (i & 3); }

struct Unit { int pm, pn, pb, pa; };
struct Gemm { const bf16_t* A; const bf16_t* Bt; int M, N, K; };

struct StaticOrder {
    int nM, nN, nwg, G, c, nfull;
    __host__ __device__ void init(int M, int N, int G_, int c_) { nM = M / BM; nN = N / BM; nwg = nM * nN; G = G_; c = c_; const int rem = nwg % G; nfull = (rem != 0 && rem * 4 <= G && nwg > G) ? nwg - rem : nwg; }
    __host__ __device__ void at(int L, Unit& u) const {
        int wgid = L; { const int q = nwg / NXCD, r = nwg % NXCD, xcd = wgid % NXCD, off = wgid / NXCD; wgid = (xcd < r ? xcd * (q + 1) : r * (q + 1) + (xcd - r) * q) + off; }
        const int nig = WGM * nN, gid = wgid / nig, fm = gid * WGM, gsz = (nM - fm) < WGM ? (nM - fm) : WGM;
        u.pm = fm + ((wgid % nig) % gsz); u.pn = (wgid % nig) / gsz; u.pb = u.pn; u.pa = u.pm;
    }
    __host__ __device__ bool next(int i, Unit& u) const { const long L = (long)i * G + c; if (L >= nfull) return false; at((int)L, u); return true; }
    __device__ __forceinline__ void a_ready(const Unit&) const {}
    __device__ __forceinline__ void done(const Unit&) const {}
};

template <class Epi, class Sched, bool ALIGN_EPI = false, bool SP2 = false, bool FP8 = false>
__device__ __forceinline__ void gemm_phase(PG8_LAS unsigned char* lds, const Gemm g, const Sched& S, const Epi& E) {
    const int tid = opaque_tid(), wid = __builtin_amdgcn_readfirstlane(tid >> 6), lane = tid & 63, wr = wid >> 2, wc = wid & 3, fr = lane & 15, fq = lane >> 4;
    const int K = g.K, RB = FP8 ? K : 2 * K  , nt = RB / (2 * BK);
    unsigned voffA[2], voffB[2];
#pragma unroll
    for (int i = 0; i < 2; ++i) { int R, C; stage_rc(tid * 16 + i * 8192, R, C); const int Rb = Epi::PERM ? ((R & ~31) + perm32(R & 31)) : R;
        voffA[i] = (unsigned)(R * RB + C * 2); voffB[i] = (unsigned)(Rb * RB + C * 2); }
    const size_t kstep = (size_t)(BK * 2);
    const size_t hstep = (size_t)HALF * RB;
    const size_t tstep = 2 * hstep;
    const unsigned ldsw = (unsigned)wid * 1024u;
    const int aoff = lds_byte(wr * 64 + fr, fq * 8), boff = lds_byte(wc * 32 + fr, fq * 8);
#define PG8_SA(b, h) (((b) * 2 + (h)) * HTB)
#define PG8_SB(b, h) ((4 + (b) * 2 + (h)) * HTB)
#define PG8_STAGE(bufoff, gbase, voff) do { _Pragma("unroll") for (int _i = 0; _i < 2; ++_i) { \
        if constexpr (FP8 || PG8_ASM_STAGE) { unsigned keep_; asm volatile("s_mov_b32 %0, m0\n\ts_mov_b32 m0, %3\n\ts_nop 0\n\tglobal_load_lds_dwordx4 %1, %2\n\ts_mov_b32 m0, %0" : "=&s"(keep_) : "v"((voff)[_i]), "s"((const char*)(gbase)), "s"((unsigned)(size_t)(lds + (bufoff) + ldsw + _i * 8192)) : "memory"); } \
        else __builtin_amdgcn_global_load_lds((const unsigned*)((const char*)(gbase) + (voff)[_i]), (PG8_LAS unsigned*)(lds + (bufoff) + ldsw + _i * 8192), 16, 0, 0); } } while (0)
#define PG8_LDA(dst, b, h) do { _Pragma("unroll") for (int m = 0; m < 4; ++m) { \
        if constexpr (FP8) { const v4i_t lo_ = *(const PG8_LAS v4i_t*)(lds + PG8_SA(b, h) + aoff + m * 2048), hi_ = *(const PG8_LAS v4i_t*)(lds + PG8_SA(b, h) + aoff + m * 2048 + 1024); dst[m] = __builtin_shufflevector(lo_, hi_, 0, 1, 2, 3, 4, 5, 6, 7); } \
        else { _Pragma("unroll") for (int k = 0; k < 2; ++k) dst[m].k[k] = *(const PG8_LAS bf16x8*)(lds + PG8_SA(b, h) + aoff + m * 2048 + k * 1024); } } } while (0)
#define PG8_LDB(dst, b, h) do { _Pragma("unroll") for (int n = 0; n < 2; ++n) { \
        if constexpr (FP8) { const v4i_t lo_ = *(const PG8_LAS v4i_t*)(lds + PG8_SB(b, h) + boff + n * 2048), hi_ = *(const PG8_LAS v4i_t*)(lds + PG8_SB(b, h) + boff + n * 2048 + 1024); dst[n] = __builtin_shufflevector(lo_, hi_, 0, 1, 2, 3, 4, 5, 6, 7); } \
        else { _Pragma("unroll") for (int k = 0; k < 2; ++k) dst[n].k[k] = *(const PG8_LAS bf16x8*)(lds + PG8_SB(b, h) + boff + n * 2048 + k * 1024); } } } while (0)
#define PG8_MMA(ai, bj, At, Bt) do { __builtin_amdgcn_s_setprio(1); \
        if constexpr (FP8) { _Pragma("unroll") for (int m = 0; m < 4; ++m) _Pragma("unroll") for (int n = 0; n < 2; ++n) \
            asm volatile("v_mfma_scale_f32_16x16x128_f8f6f4 %0, %1, %2, %0, %3, %3 op_sel_hi:[0,0,0]" : "+v"(acc[ai][bj][m][n]) : "v"(Bt[n]), "v"(At[m]), "v"(sclv)); } \
        else { _Pragma("unroll") for (int m = 0; m < 4; ++m) _Pragma("unroll") for (int n = 0; n < 2; ++n) _Pragma("unroll") for (int k = 0; k < 2; ++k) \
        acc[ai][bj][m][n] = __builtin_amdgcn_mfma_f32_16x16x32_bf16(Bt[n].k[k], At[m].k[k], acc[ai][bj][m][n], 0, 0, 0); } __builtin_amdgcn_s_setprio(0); } while (0)
#define PG8_WAIT_V(n) asm volatile("s_waitcnt vmcnt(" #n ")" ::: "memory")
#define PG8_WAIT_L(n) asm volatile("s_waitcnt lgkmcnt(" #n ")" ::: "memory")
#define PG8_BAR __builtin_amdgcn_s_barrier()
#define PG8_SCHED __builtin_amdgcn_sched_barrier(0)
    Unit cur, nxt; int ui = 0;
    if (!S.next(0, cur)) return;
    f32x4 acc[2][2][4][2];
#pragma unroll
    for (int a = 0; a < 2; ++a)
#pragma unroll
        for (int b = 0; b < 2; ++b)
#pragma unroll
            for (int m = 0; m < 4; ++m)
#pragma unroll
                for (int n = 0; n < 2; ++n) acc[a][b][m][n] = (f32x4){0.f, 0.f, 0.f, 0.f};
    struct Frag2 { bf16x8 k[2]; }; typedef int v8i_t __attribute__((ext_vector_type(8))); typedef int v4i_t __attribute__((ext_vector_type(4)));
    typename std::conditional<FP8, v8i_t, Frag2>::type At[4], B0[2], B1[2]; const int sclv = 0x7F7F7F7F; (void)sclv;
    const char* cA = (const char*)g.A + (size_t)cur.pa * tstep; const char* cB = (const char*)g.Bt + (size_t)cur.pb * tstep;
    S.a_ready(cur);
    if constexpr (SP2) {
        PG8_STAGE(PG8_SB(0, 0), cB, voffB); PG8_STAGE(PG8_SB(0, 1), cB + hstep, voffB); PG8_STAGE(PG8_SA(0, 0), cA, voffA); PG8_STAGE(PG8_SA(0, 1), cA + hstep, voffA);
        if (wr == 1) PG8_BAR;
        PG8_WAIT_V(2); PG8_BAR;
        PG8_STAGE(PG8_SB(1, 0), cB + kstep, voffB); PG8_STAGE(PG8_SA(1, 0), cA + kstep, voffA); PG8_STAGE(PG8_SB(1, 1), cB + hstep + kstep, voffB);
        PG8_WAIT_V(6); PG8_BAR;
    } else {
        PG8_STAGE(PG8_SB(0, 0), cB, voffB); PG8_STAGE(PG8_SA(0, 0), cA, voffA); PG8_STAGE(PG8_SB(0, 1), cB + hstep, voffB); PG8_STAGE(PG8_SA(0, 1), cA + hstep, voffA);
        if (wr == 1) PG8_BAR;
        PG8_WAIT_V(4); PG8_BAR;
        PG8_STAGE(PG8_SB(1, 0), cB + kstep, voffB); PG8_STAGE(PG8_SA(1, 0), cA + kstep, voffA); PG8_STAGE(PG8_SB(1, 1), cB + hstep + kstep, voffB);
        PG8_WAIT_V(6); PG8_BAR;
    }
    for (;;) {
        const bool has_next = S.next(ui + 1, nxt);
        const char* nA = has_next ? (const char*)g.A + (size_t)nxt.pa * tstep : cA; const char* nB = has_next ? (const char*)g.Bt + (size_t)nxt.pb * tstep : cB;
#pragma unroll 1
        for (int t = 0; t < nt; t += 2) {
            const bool last = (t == nt - 2);
            const char* a1 = cA + (size_t)(t + 1) * kstep;
            const char* a2 = last ? nA : cA + (size_t)(t + 2) * kstep; const char* b2 = last ? nB : cB + (size_t)(t + 2) * kstep;
            const char* a3 = a2 + kstep; const char* b3 = b2 + kstep;
            if (last && has_next) S.a_ready(nxt);
            if constexpr (SP2) {
            PG8_LDB(B0, 0, 0); PG8_LDB(B1, 0, 1); PG8_SCHED; PG8_LDA(At, 0, 0); PG8_STAGE(PG8_SA(1, 1), a1 + hstep, voffA);
            PG8_WAIT_V(8); PG8_WAIT_L(0); PG8_BAR; PG8_MMA(0, 0, At, B0); PG8_MMA(0, 1, At, B1); PG8_BAR; PG8_SCHED;
            PG8_LDA(At, 0, 1); PG8_STAGE(PG8_SB(0, 0), b2, voffB); PG8_STAGE(PG8_SB(0, 1), b2 + hstep, voffB); PG8_STAGE(PG8_SA(0, 0), a2, voffA);
            PG8_WAIT_V(8); PG8_WAIT_L(0); PG8_BAR; PG8_MMA(1, 0, At, B0); PG8_MMA(1, 1, At, B1); PG8_BAR; PG8_SCHED;
            PG8_LDB(B0, 1, 0); PG8_LDB(B1, 1, 1); PG8_SCHED; PG8_LDA(At, 1, 0); PG8_STAGE(PG8_SA(0, 1), a2 + hstep, voffA);
            PG8_WAIT_V(8); PG8_WAIT_L(0); PG8_BAR; PG8_MMA(0, 0, At, B0); PG8_MMA(0, 1, At, B1); PG8_BAR; PG8_SCHED;
            PG8_LDA(At, 1, 1); PG8_STAGE(PG8_SB(1, 0), b3, voffB); PG8_STAGE(PG8_SB(1, 1), b3 + hstep, voffB); PG8_STAGE(PG8_SA(1, 0), a3, voffA);
            PG8_WAIT_V(8); PG8_WAIT_L(0); PG8_BAR; PG8_MMA(1, 0, At, B0); PG8_MMA(1, 1, At, B1); PG8_BAR; PG8_SCHED;
            } else {
            PG8_LDB(B0, 0, 0); PG8_SCHED; PG8_LDA(At, 0, 0); PG8_STAGE(PG8_SA(1, 1), a1 + hstep, voffA);
            PG8_WAIT_L(8); PG8_BAR; PG8_WAIT_L(0); PG8_MMA(0, 0, At, B0); PG8_BAR; PG8_SCHED;
            PG8_LDB(B1, 0, 1); PG8_STAGE(PG8_SB(0, 0), b2, voffB);
            PG8_BAR; PG8_WAIT_L(0); PG8_MMA(0, 1, At, B1); PG8_BAR;
            PG8_LDA(At, 0, 1); PG8_STAGE(PG8_SA(0, 0), a2, voffA);
            PG8_BAR; PG8_WAIT_L(0); PG8_MMA(1, 0, At, B0); PG8_BAR; PG8_SCHED;
            PG8_STAGE(PG8_SB(0, 1), b2 + hstep, voffB);
            PG8_WAIT_V(6); PG8_BAR; PG8_MMA(1, 1, At, B1); PG8_BAR;
            PG8_LDB(B0, 1, 0); PG8_SCHED; PG8_LDA(At, 1, 0); PG8_STAGE(PG8_SA(0, 1), a2 + hstep, voffA);
            PG8_WAIT_L(8); PG8_BAR; PG8_WAIT_L(0); PG8_MMA(0, 0, At, B0); PG8_BAR; PG8_SCHED;
            PG8_LDB(B1, 1, 1); PG8_STAGE(PG8_SB(1, 0), b3, voffB);
            PG8_BAR; PG8_WAIT_L(0); PG8_MMA(0, 1, At, B1); PG8_BAR;
            PG8_LDA(At, 1, 1); PG8_STAGE(PG8_SA(1, 0), a3, voffA);
            PG8_BAR; PG8_WAIT_L(0); PG8_MMA(1, 0, At, B0); PG8_BAR; PG8_SCHED;
            PG8_STAGE(PG8_SB(1, 1), b3 + hstep, voffB);
            PG8_WAIT_V(6); PG8_BAR; PG8_MMA(1, 1, At, B1); PG8_BAR;
            }
        }
        if constexpr (ALIGN_EPI) { if (wr == 0) PG8_BAR; }
        if constexpr (FP8) asm volatile("s_nop 15\n\ts_nop 15" ::: "memory");
        if constexpr (!Epi::AFTER_DRAIN) { E(acc, cur, wr, wc, fr, fq); S.done(cur); }
        if (!has_next) break;
#pragma unroll
        for (int a = 0; a < 2; ++a)
#pragma unroll
            for (int b = 0; b < 2; ++b)
#pragma unroll
                for (int m = 0; m < 4; ++m)
#pragma unroll
                    for (int n = 0; n < 2; ++n) acc[a][b][m][n] = (f32x4){0.f, 0.f, 0.f, 0.f};
        cur = nxt; cA = nA; cB = nB; ++ui;
        if constexpr (ALIGN_EPI) { if (wr == 1) PG8_BAR; }
    }
    PG8_WAIT_V(0);
    if constexpr (!ALIGN_EPI) { if (wr == 0) PG8_BAR; }
    PG8_BAR;
    if constexpr (Epi::AFTER_DRAIN) { E.fused(acc, cur, wr, wc, fr, fq, lds, wid, lane); S.done(cur); }
#undef PG8_SA
#undef PG8_SB
#undef PG8_STAGE
#undef PG8_LDA
#undef PG8_LDB
#undef PG8_MMA
#undef PG8_WAIT_V
#undef PG8_WAIT_L
#undef PG8_BAR
#undef PG8_SCHED
}
}

using pg8::f32x4; using pg8::u32x4; using pg8::bf16x8; using pg8::Unit;
typedef __bf16 bf16x2_t __attribute__((ext_vector_type(2)));
__device__ __forceinline__ unsigned pk_bf16(float lo, float hi) { const f32x2 v = {lo, hi}; const bf16x2_t b = __builtin_convertvector(v, bf16x2_t); return __builtin_bit_cast(unsigned, b); }
__device__ __forceinline__ float bf_lo(unsigned u) { return __uint_as_float(u << 16); }
__device__ __forceinline__ float bf_hi(unsigned u) { return __uint_as_float(u & 0xffff0000u); }
typedef _Float16 h2_t __attribute__((ext_vector_type(2)));
__device__ __forceinline__ unsigned pk_f16(float lo, float hi) { h2_t h = {(_Float16)lo, (_Float16)hi}; return __builtin_bit_cast(unsigned, h); }
__device__ __forceinline__ f32x2 unpk_f16(unsigned u) { h2_t h = __builtin_bit_cast(h2_t, u); return (f32x2){(float)h.x, (float)h.y}; }
__device__ __forceinline__ float sigm(float x) { return __builtin_amdgcn_rcpf(1.f + __expf(-x)); }
__device__ __forceinline__ float silu_f(float x) { return x * sigm(x); }
__device__ __forceinline__ u32x4 pack8(const f32x4 a, const f32x4 b) { u32x4 w; w.x = pk_bf16(a[0], a[1]); w.y = pk_bf16(a[2], a[3]); w.z = pk_bf16(b[0], b[1]); w.w = pk_bf16(b[2], b[3]); return w; }
__device__ __forceinline__ void unpack8(const u32x4 w, f32x4& a, f32x4& b) { a = (f32x4){bf_lo(w.x), bf_hi(w.x), bf_lo(w.y), bf_hi(w.y)}; b = (f32x4){bf_lo(w.z), bf_hi(w.z), bf_lo(w.w), bf_hi(w.w)}; }

__device__ __forceinline__ void sigm8(const f32x4 a, const f32x4 b, f32x4& sa, f32x4& sb) {
    f32x4 ea, eb;
#pragma unroll
    for (int j = 0; j < 4; ++j) { ea[j] = __builtin_amdgcn_exp2f(a[j] * -1.4426950408889634f); eb[j] = __builtin_amdgcn_exp2f(b[j] * -1.4426950408889634f); }
#pragma unroll
    for (int j = 0; j < 4; ++j) { sa[j] = __builtin_amdgcn_rcpf(1.f + ea[j]); sb[j] = __builtin_amdgcn_rcpf(1.f + eb[j]); }
}
#ifndef EPI_NT
#define EPI_NT 0
#endif
#ifndef EPI_SC1
#define EPI_SC1 0
#endif
__device__ __forceinline__ void st16(void* p, u32x4 v) { if (EPI_SC1) *(volatile GAS u32x4*)p = v; else if (EPI_NT) __builtin_nontemporal_store(v, (u32x4*)p); else *(u32x4*)p = v; }
__device__ __forceinline__ void st8(void* p, u32x2 v) { if (EPI_SC1) *(volatile GAS u32x2*)p = v; else if (EPI_NT) __builtin_nontemporal_store(v, (u32x2*)p); else *(u32x2*)p = v; }
__device__ __forceinline__ float clamp448(float x) { return fminf(fmaxf(x, -448.f), 448.f); }
__device__ __forceinline__ unsigned pk4_fp8(float a, float b, float c, float d) { int w = 0; w = __builtin_amdgcn_cvt_pk_fp8_f32(clamp448(a), clamp448(b), w, false); w = __builtin_amdgcn_cvt_pk_fp8_f32(clamp448(c), clamp448(d), w, true); return (unsigned)w; }


struct EpiProj {
    static constexpr bool PERM = true, AFTER_DRAIN = false;
    bf16_t* proj; const float* lbv; int probe = 0;
    template <int MODE> __device__ __forceinline__ void emit(const f32x4 (&acc)[2][2][4][2], bf16_t* base, int ldc, const float* lbp) const {
        f32x4 lb[2][2];
        if (MODE == 3) {
#pragma unroll
            for (int bj = 0; bj < 2; ++bj)
#pragma unroll
                for (int n = 0; n < 2; ++n) lb[bj][n] = *(const f32x4*)(lbp + bj * 128 + 4 * n);
        }
#pragma unroll
        for (int ai = 0; ai < 2; ++ai)
#pragma unroll
            for (int m = 0; m < 4; ++m) { bf16_t* rowp = base + (size_t)(ai * 128 + m * 16) * ldc;
#pragma unroll
                for (int bj = 0; bj < 2; ++bj) { f32x4 v[2] = {acc[ai][bj][m][0], acc[ai][bj][m][1]}; u32x4 w;
                    if (MODE == 0) w = pack8(v[0], v[1]);
                    else { f32x4 s0, s1; sigm8(v[0], v[1], s0, s1);
                        if (MODE == 1) w = pack8(v[0] * s0, v[1] * s1);
                        else if (MODE == 2) w = pack8(s0, s1);
                        else { const f32x4 f0 = lb[bj][0] + (1.f - lb[bj][0]) * s0, f1 = lb[bj][1] + (1.f - lb[bj][1]) * s1; f32x4 g0, g1;
#pragma unroll
                            for (int j = 0; j < 4; ++j) { g0[j] = __builtin_amdgcn_logf(f0[j]); g1[j] = __builtin_amdgcn_logf(f1[j]); }
#pragma unroll
                            for (int j = 0; j < 4; ++j) { g0[j] = fmaxf(g0[j], -57.f); g1[j] = fmaxf(g1[j], -57.f); }
                            w.x = pk_f16(g0[0], g0[1]); w.y = pk_f16(g0[2], g0[3]); w.z = pk_f16(g1[0], g1[1]); w.w = pk_f16(g1[2], g1[3]); } }
                    st16(rowp + bj * 128, w); } }
    }
    __device__ __forceinline__ void operator()(const f32x4 (&acc)[2][2][4][2], const Unit& u, int wr, int wc, int fr, int fq) const {
        const int pn = u.pn; int seg, ct;
        if (pn < 4) { seg = 0; ct = pn; } else if (pn < 6) { seg = pn - 3; ct = 0; } else { seg = 3 + ((pn - 6) >> 2); ct = (pn - 6) & 3; }
        const size_t segoff = (seg == 0) ? (size_t)0 : (seg == 1) ? (size_t)R * 1024 : (seg == 2) ? (size_t)R * 1280 : (size_t)R * (size_t)(1536 + 1024 * (seg - 3));
        const int ldc = (seg == 1 || seg == 2) ? 256 : 1024;
        const int mode = (seg == 3 || seg == 7) ? 1 : (seg == 8 || seg == 9) ? 2 : (seg == 4 || seg == 5) ? 3 : 0;
        const int row0 = u.pm * 256 + wr * 64 + fr, col0 = ct * 256 + wc * 32 + 8 * fq;
        bf16_t* base = probe ? proj + (size_t)(wr * 64 + fr) * ldc + col0 : proj + segoff + (size_t)row0 * ldc + col0;
        if (mode == 0) emit<0>(acc, base, ldc, nullptr);
        else if (mode == 1) emit<1>(acc, base, ldc, nullptr);
        else if (mode == 2) emit<2>(acc, base, ldc, nullptr);
        else emit<3>(acc, base, ldc, lbv + col0);
    }
    __device__ __forceinline__ void put8(const Unit& u, int rt, int ctl, f32x4 v0, f32x4 v1) const {
        const int pn = u.pn; int seg, ct;
        if (pn < 4) { seg = 0; ct = pn; } else if (pn < 6) { seg = pn - 3; ct = 0; } else { seg = 3 + ((pn - 6) >> 2); ct = (pn - 6) & 3; }
        const size_t segoff = (seg == 0) ? (size_t)0 : (seg == 1) ? (size_t)R * 1024 : (seg == 2) ? (size_t)R * 1280 : (size_t)R * (size_t)(1536 + 1024 * (seg - 3));
        const int ldc = (seg == 1 || seg == 2) ? 256 : 1024;
        const int mode = (seg == 3 || seg == 7) ? 1 : (seg == 8 || seg == 9) ? 2 : (seg == 4 || seg == 5) ? 3 : 0;
        const int col = ct * 256 + ctl;
        u32x4 w;
        if (mode == 3) { const f32x4 l0 = *(const f32x4*)(lbv + col), l1 = *(const f32x4*)(lbv + col + 4); float g[8];
#pragma unroll
            for (int j = 0; j < 4; ++j) { g[j] = fmaxf(__builtin_amdgcn_logf(l0[j] + (1.f - l0[j]) * sigm(v0[j])), -57.f); g[4 + j] = fmaxf(__builtin_amdgcn_logf(l1[j] + (1.f - l1[j]) * sigm(v1[j])), -57.f); }
            w.x = pk_f16(g[0], g[1]); w.y = pk_f16(g[2], g[3]); w.z = pk_f16(g[4], g[5]); w.w = pk_f16(g[6], g[7]);
        } else {
#pragma unroll
            for (int j = 0; j < 4; ++j) { if (mode == 1) { v0[j] = silu_f(v0[j]); v1[j] = silu_f(v1[j]); } if (mode == 2) { v0[j] = sigm(v0[j]); v1[j] = sigm(v1[j]); } }
            w = pack8(v0, v1);
        }
        *(u32x4*)(proj + segoff + (size_t)(u.pm * 256 + rt) * ldc + col) = w;
    }
};
struct EpiSwiGLU {
    static constexpr bool PERM = true, AFTER_DRAIN = false;
    bf16_t* O; int ldc;
    __device__ __forceinline__ void operator()(const f32x4 (&acc)[2][2][4][2], const Unit& u, int wr, int wc, int fr, int fq) const {
        bf16_t* base = O + (size_t)(u.pm * 256 + wr * 64 + fr) * ldc + u.pn * 128 + wc * 32 + 8 * fq;
#pragma unroll
        for (int ai = 0; ai < 2; ++ai)
#pragma unroll
            for (int m = 0; m < 4; ++m) { f32x4 s0, s1; sigm8(acc[ai][0][m][0], acc[ai][0][m][1], s0, s1);
                st16(base + (size_t)(ai * 128 + m * 16) * ldc, pack8(acc[ai][0][m][0] * s0 * acc[ai][1][m][0], acc[ai][0][m][1] * s1 * acc[ai][1][m][1])); }
    }
    __device__ __forceinline__ void put8(const Unit&, int, int, f32x4, f32x4) const {}
};
struct EpiSwiGLU8 {
    static constexpr bool PERM = true, AFTER_DRAIN = false;
    unsigned char* O; int ldc;
    __device__ __forceinline__ void operator()(const f32x4 (&acc)[2][2][4][2], const Unit& u, int wr, int wc, int fr, int fq) const {
        unsigned char* base = O + (size_t)(u.pm * 256 + wr * 64 + fr) * ldc + u.pn * 128 + wc * 32 + 8 * fq;
#pragma unroll
        for (int ai = 0; ai < 2; ++ai)
#pragma unroll
            for (int m = 0; m < 4; ++m) { const f32x4 g0 = acc[ai][0][m][0] * 0.015625f, g1 = acc[ai][0][m][1] * 0.015625f; f32x4 s0, s1; sigm8(g0, g1, s0, s1);
                const f32x4 h0 = g0 * s0 * (acc[ai][1][m][0] * 0.015625f), h1 = g1 * s1 * (acc[ai][1][m][1] * 0.015625f);
                st8(base + (size_t)(ai * 128 + m * 16) * ldc, (u32x2){pk4_fp8(h0[0], h0[1], h0[2], h0[3]), pk4_fp8(h1[0], h1[1], h1[2], h1[3])}); }
    }
    __device__ __forceinline__ void put8(const Unit&, int, int, f32x4, f32x4) const {}
};
template <bool HAS_ADD> struct EpiGate {
    static constexpr bool PERM = true, AFTER_DRAIN = false;
    bf16_t* G; const bf16_t* ADD;
    __device__ __forceinline__ void operator()(const f32x4 (&acc)[2][2][4][2], const Unit& u, int wr, int wc, int fr, int fq) const {
        const size_t off0 = (size_t)(u.pm * 256 + wr * 64 + fr) * 1024 + u.pn * 256 + wc * 32 + 8 * fq;
#pragma unroll
        for (int ai = 0; ai < 2; ++ai) {
            u32x4 gv[4][2], av[4][2];
#pragma unroll
            for (int m = 0; m < 4; ++m)
#pragma unroll
                for (int bj = 0; bj < 2; ++bj) { const size_t off = off0 + (size_t)(ai * 128 + m * 16) * 1024 + bj * 128;
                    gv[m][bj] = *(const u32x4*)(G + off); if (HAS_ADD) av[m][bj] = *(const u32x4*)(ADD + off); }
#pragma unroll
            for (int m = 0; m < 4; ++m)
#pragma unroll
                for (int bj = 0; bj < 2; ++bj) { const size_t off = off0 + (size_t)(ai * 128 + m * 16) * 1024 + bj * 128;
                    f32x4 g0, g1; unpack8(gv[m][bj], g0, g1);
                    f32x4 o0 = g0 * acc[ai][bj][m][0], o1 = g1 * acc[ai][bj][m][1];
                    if (HAS_ADD) { f32x4 a0, a1; unpack8(av[m][bj], a0, a1); o0 += a0; o1 += a1; }
                    st16(G + off, pack8(o0, o1)); }
        }
    }
    __device__ __forceinline__ void put8(const Unit& u, int rt, int ctl, f32x4 v0, f32x4 v1) const {
        const size_t off = (size_t)(u.pm * 256 + rt) * 1024 + u.pn * 256 + ctl;
        f32x4 g0, g1; unpack8(*(const u32x4*)(G + off), g0, g1);
        f32x4 o0 = g0 * v0, o1 = g1 * v1;
        if (HAS_ADD) { f32x4 a0, a1; unpack8(*(const u32x4*)(ADD + off), a0, a1); o0 += a0; o1 += a1; }
        *(u32x4*)(G + off) = pack8(o0, o1);
    }
};
struct EpiPlain {
    static constexpr bool PERM = true, AFTER_DRAIN = false;
    bf16_t* O; int ldc; float scale = 1.f;
    __device__ __forceinline__ void operator()(const f32x4 (&acc)[2][2][4][2], const Unit& u, int wr, int wc, int fr, int fq) const {
        bf16_t* base = O + (size_t)(u.pm * 256 + wr * 64 + fr) * ldc + u.pn * 256 + wc * 32 + 8 * fq;
#pragma unroll
        for (int ai = 0; ai < 2; ++ai)
#pragma unroll
            for (int m = 0; m < 4; ++m)
#pragma unroll
                for (int bj = 0; bj < 2; ++bj) st16(base + (size_t)(ai * 128 + m * 16) * ldc + bj * 128, pack8(acc[ai][bj][m][0] * scale, acc[ai][bj][m][1] * scale));
    }
    __device__ __forceinline__ void put8(const Unit& u, int rt, int ctl, f32x4 v0, f32x4 v1) const {
        *(u32x4*)(O + (size_t)(u.pm * 256 + rt) * ldc + u.pn * 256 + ctl) = pack8(v0 * scale, v1 * scale);
    }
};
struct EpiNull {
    static constexpr bool PERM = true, AFTER_DRAIN = false;
    __device__ __forceinline__ void operator()(const f32x4 (&acc)[2][2][4][2], const Unit& u, int wr, int wc, int fr, int fq) const {
#pragma unroll
        for (int a = 0; a < 2; ++a)
#pragma unroll
            for (int b = 0; b < 2; ++b)
#pragma unroll
                for (int m = 0; m < 4; ++m) asm volatile("" :: "v"(acc[a][b][m][0]), "v"(acc[a][b][m][1])); }
    __device__ __forceinline__ void put8(const Unit&, int, int, f32x4, f32x4) const {}
};
struct MoeOrder {
    int nb[NEXP]; int nN, G, c, nwg, nfull, acap = 0;
    __device__ __forceinline__ void finish() { int t = 0;
#pragma unroll
        for (int e = 0; e < NEXP; ++e) t += nb[e] * nN;
        nwg = t; const int rem = t % G; nfull = (rem != 0 && rem * 4 <= G && t > G) ? t - rem : t; }
    __device__ __forceinline__ bool at(int L, Unit& u) const {
        int accu = 0, pbase = 0; bool found = false;
#pragma unroll
        for (int e = 0; e < NEXP; ++e) { const int ue = nb[e] * nN;
            if (!found && L < accu + ue) { const int loc = L - accu; const int q = loc / nb[e]; u.pn = q; u.pm = pbase + (loc - q * nb[e]); u.pb = e * nN + q; u.pa = acap ? e * acap + (loc - q * nb[e]) : u.pm; found = true; }
            accu += ue; pbase += nb[e]; }
        return found;
    }
    __device__ __forceinline__ bool next(int i, Unit& u) const { const int L = i * G + c; if (L >= nfull) return false; return at(L, u); }
    __device__ __forceinline__ void a_ready(const Unit&) const {}
    __device__ __forceinline__ void done(const Unit&) const {}
};

template <class Epi, class Sched>
__device__ __forceinline__ void gemm_mini(const pg8::Gemm g, const Sched& S, const Epi& E, int wgi, int nwgs) {
    const int nbig = S.nwg - S.nfull; if (nbig <= 0) return;
    const int tid = opaque_tid(), w = __builtin_amdgcn_readfirstlane(tid >> 6), lane = tid & 63, r = lane & 15, q4 = lane >> 4;
    const int wm = w >> 1, wn = w & 1; const int K = g.K;
    for (int m = wgi; m < nbig * 16; m += nwgs) {
        Unit u; S.at(S.nfull + (m >> 4), u); const int sub = m & 15, rt = (sub >> 2) * 64 + wm * 16 + r, ct = (sub & 3) * 64 + wn * 32;
        const bf16_t* ap = g.A + ((size_t)u.pm * 256 + rt) * K + 8 * q4;
        const bf16_t* bp0 = g.Bt + ((size_t)u.pb * 256 + ct + 8 * (r >> 2) + (r & 3)) * K + 8 * q4;
        const bf16_t* bp1 = bp0 + (size_t)4 * K;
        f32x4 c0 = (f32x4){0.f, 0.f, 0.f, 0.f}, c1 = (f32x4){0.f, 0.f, 0.f, 0.f};
        for (int ks = 0; ks < K / 32; ks += 8) {
            bf16x8 a[8], b0[8], b1[8];
#pragma unroll
            for (int i = 0; i < 8; ++i) { a[i] = *(const bf16x8*)(ap + 32 * (ks + i)); b0[i] = *(const bf16x8*)(bp0 + 32 * (ks + i)); b1[i] = *(const bf16x8*)(bp1 + 32 * (ks + i)); }
#pragma unroll
            for (int i = 0; i < 8; ++i) { c0 = __builtin_amdgcn_mfma_f32_16x16x32_bf16(b0[i], a[i], c0, 0, 0, 0); c1 = __builtin_amdgcn_mfma_f32_16x16x32_bf16(b1[i], a[i], c1, 0, 0, 0); }
        }
        E.put8(u, rt, ct + 8 * q4, c0, c1);
    }
}
template <class Epi, class Sched>
__device__ __forceinline__ void gemm_mini_ks(LAS unsigned char* lds, const pg8::Gemm g, const Sched& S, const Epi& E, int wgi, int nwgs) {
    const int nbig = S.nwg - S.nfull; if (nbig <= 0) return;
    constexpr int K = DM, PP = 68; static_assert(K / 32 == 32, "four K-steps per wave");
    const int tid = opaque_tid(), w = __builtin_amdgcn_readfirstlane(tid >> 6), lane = tid & 63, r = lane & 15, q4 = lane >> 4;
    LAS float* part = (LAS float*)lds + w * 64 * PP;
    __syncthreads();
    for (int m = wgi; m < nbig * 16; m += nwgs) {
        Unit u; S.at(S.nfull + (m >> 4), u); const int sub = m & 15, rt0 = (sub >> 2) * 64, ct0 = (sub & 3) * 64;
        const bf16_t* ap = g.A + ((size_t)u.pm * 256 + rt0) * K + (r * K + 8 * q4);
        const bf16_t* bp = g.Bt + ((size_t)u.pb * 256 + ct0) * K + (r * K + 8 * q4);
        f32x4 acc[4][4];
#pragma unroll
        for (int i = 0; i < 4; ++i)
#pragma unroll
            for (int j = 0; j < 4; ++j) acc[i][j] = (f32x4){0.f, 0.f, 0.f, 0.f};
        bf16x8 fa[2][4], fb[2][4];
#define MK_LOAD(s_, ks_) do { _Pragma("unroll") for (int t = 0; t < 4; ++t) { fa[s_][t] = *(const bf16x8*)(ap + (size_t)16 * t * K + 32 * (ks_)); fb[s_][t] = *(const bf16x8*)(bp + (size_t)16 * t * K + 32 * (ks_)); } } while (0)
#define MK_MMA(s_) do { _Pragma("unroll") for (int tm = 0; tm < 4; ++tm) _Pragma("unroll") for (int tn = 0; tn < 4; ++tn)                      \
            acc[tm][tn] = __builtin_amdgcn_mfma_f32_16x16x32_bf16(fb[s_][tn], fa[s_][tm], acc[tm][tn], 0, 0, 0); } while (0)
        MK_LOAD(0, w); MK_LOAD(1, w + 8);
        MK_MMA(0); MK_LOAD(0, w + 16);
        MK_MMA(1); MK_LOAD(1, w + 24);
        MK_MMA(0); MK_MMA(1);
#undef MK_LOAD
#undef MK_MMA
#pragma unroll
        for (int tm = 0; tm < 4; ++tm)
#pragma unroll
            for (int tn = 0; tn < 4; ++tn) *(LAS f32x4*)(part + (16 * tm + r) * PP + 16 * tn + 4 * q4) = acc[tm][tn];
        __syncthreads();
        { const int row = tid >> 3, cg = tid & 7; f32x4 v0 = (f32x4){0.f, 0.f, 0.f, 0.f}, v1 = v0;
#pragma unroll
          for (int ww = 0; ww < 8; ++ww) { const LAS float* p = (const LAS float*)lds + ww * 64 * PP + row * PP + 8 * cg; v0 += *(const LAS f32x4*)p; v1 += *(const LAS f32x4*)(p + 4); }
          E.put8(u, rt0 + row, ct0 + 8 * cg, v0, v1); }
        __syncthreads();
    }
}
template <int K, class Epi, class Sched>
__device__ __forceinline__ void gemm_mini8(LAS unsigned char* lds, const unsigned char* Ag, const unsigned char* Bg, const Sched& S, const Epi& E, int wgi, int nwgs) {
    const int nbig = S.nwg - S.nfull; if (nbig <= 0) return;
    typedef int v8i_t __attribute__((ext_vector_type(8))); typedef int v4i_t __attribute__((ext_vector_type(4)));
    const int tid = opaque_tid(), w = __builtin_amdgcn_readfirstlane(tid >> 6), lane = tid & 63, r = lane & 15, q4 = lane >> 4;
    const int sclv = 0x7F7F7F7F; constexpr int nks = K / 128; constexpr int PP = 68;
    LAS float* part = (LAS float*)lds + w * 64 * PP;
    __syncthreads();
    for (int m = wgi; m < nbig * 16; m += nwgs) {
        Unit u; S.at(S.nfull + (m >> 4), u); const int sub = m & 15, rt0 = (sub >> 2) * 64, ct0 = (sub & 3) * 64;
        const unsigned char* ap = Ag + ((size_t)u.pm * 256 + rt0) * K + (r * K + 32 * q4);
        const unsigned char* bp = Bg + ((size_t)u.pb * 256 + ct0) * K + (r * K + 32 * q4);
        f32x4 acc[4][4];
#pragma unroll
        for (int i = 0; i < 4; ++i)
#pragma unroll
            for (int j = 0; j < 4; ++j) acc[i][j] = (f32x4){0.f, 0.f, 0.f, 0.f};
        v8i_t fa[2][4], fb[4];
#define M8_LDA(s_, ks_) do { const size_t o = (size_t)128 * (ks_); _Pragma("unroll") for (int t = 0; t < 4; ++t) {                                    \
            const v4i_t al = *(const v4i_t*)(ap + (size_t)16 * t * K + o), ah = *(const v4i_t*)(ap + (size_t)16 * t * K + o + 16);                          \
            fa[s_][t] = __builtin_shufflevector(al, ah, 0, 1, 2, 3, 4, 5, 6, 7); } } while (0)
#define M8_LDB(ks_) do { const size_t o = (size_t)128 * (ks_); _Pragma("unroll") for (int t = 0; t < 4; ++t) {                                         \
            const v4i_t bl = *(const v4i_t*)(bp + (size_t)16 * t * K + o), bh = *(const v4i_t*)(bp + (size_t)16 * t * K + o + 16);                          \
            fb[t] = __builtin_shufflevector(bl, bh, 0, 1, 2, 3, 4, 5, 6, 7); } } while (0)
#define M8_MMA(s_) do { _Pragma("unroll") for (int tm = 0; tm < 4; ++tm) _Pragma("unroll") for (int tn = 0; tn < 4; ++tn)                                 \
            asm volatile("v_mfma_scale_f32_16x16x128_f8f6f4 %0, %1, %2, %0, %3, %3 op_sel_hi:[0,0,0]" : "+v"(acc[tm][tn]) : "v"(fb[tn]), "v"(fa[s_][tm]), "v"(sclv)); } while (0)
        const int k0 = w, k1 = w + 8, k2 = w + 16, k3 = (w + 24 < nks) ? w + 24 : w + 16;
        M8_LDA(0, k0); M8_LDB(k0); M8_LDA(1, k1);
        M8_MMA(0); M8_LDB(k1); M8_LDA(0, k2);
        M8_MMA(1); M8_LDB(k2); M8_LDA(1, k3);
        M8_MMA(0); M8_LDB(k3);
        if (w + 24 < nks) M8_MMA(1);
#undef M8_LDA
#undef M8_LDB
#undef M8_MMA
        asm volatile("s_nop 15\n\ts_nop 15" ::: "memory");
#pragma unroll
        for (int tm = 0; tm < 4; ++tm)
#pragma unroll
            for (int tn = 0; tn < 4; ++tn) *(LAS f32x4*)(part + (16 * tm + r) * PP + 16 * tn + 4 * q4) = acc[tm][tn];
        __syncthreads();
        { const int row = tid >> 3, cg = tid & 7; f32x4 v0 = (f32x4){0.f, 0.f, 0.f, 0.f}, v1 = v0;
#pragma unroll
          for (int ww = 0; ww < 8; ++ww) { const LAS float* p = (const LAS float*)lds + ww * 64 * PP + row * PP + 8 * cg; v0 += *(const LAS f32x4*)p; v1 += *(const LAS f32x4*)(p + 4); }
          E.put8(u, rt0 + row, ct0 + 8 * cg, v0, v1); }
        __syncthreads();
    }
}

namespace att {
using s16x4  = __attribute__((ext_vector_type(4))) short;
using f32x16 = __attribute__((ext_vector_type(16))) float;
constexpr int   D = 128, NW = 8, QBLK = 32, KVBLK = 64;
constexpr float SCALE = 0.088388347648318440f;
constexpr float THR = 8.f;
constexpr int SHM_V = KVBLK * D * 2, SHM_K = KVBLK * D * 2, SHM_ATTN = 2 * SHM_V + 2 * SHM_K + NW * 64 * 4;
#define KSWZ(row, colB) ((row) * 256 + ((colB) ^ (((row) & 15) << 4)))
#define SBAR() __builtin_amdgcn_sched_barrier(0)
__device__ __forceinline__ int crow(int r, int hi) { return (r & 3) + 8 * (r >> 2) + 4 * hi; }
__device__ __forceinline__ unsigned cvtpk(float lo, float hi) { unsigned r; asm volatile("v_cvt_pk_bf16_f32 %0, %1, %2" : "=v"(r) : "v"(lo), "v"(hi)); return r; }
template <int VAR> __device__ __forceinline__ void partialSM(f32x16& p0, f32x16& p1, float& m_reg, float& mn, float& alpha) {
  constexpr float C = SCALE * 1.4426950408889634f;
  if constexpr (VAR == 1) { mn = m_reg; alpha = 1.f; return; }
  float pmax = p0[0];
#pragma unroll
  for (int r = 1; r < 16; ++r) pmax = fmaxf(pmax, p0[r]);
#pragma unroll
  for (int r = 0; r < 16; ++r) pmax = fmaxf(pmax, p1[r]);
  { auto rr = __builtin_amdgcn_permlane32_swap(__float_as_uint(pmax), __float_as_uint(pmax), false, false);
    pmax = fmaxf(__uint_as_float(rr[0]), __uint_as_float(rr[1])); }
  if (__builtin_expect(__all(pmax - m_reg <= THR / SCALE), 1)) { mn = m_reg; alpha = 1.f; }
  else { mn = fmaxf(m_reg, pmax); alpha = __builtin_amdgcn_exp2f((m_reg - mn) * C); m_reg = mn; }
  float mnC = -mn * C;
#pragma unroll
  for (int r = 0; r < 16; ++r) p0[r] = fmaf(p0[r], C, mnC);
#pragma unroll
  for (int r = 0; r < 16; ++r) p1[r] = fmaf(p1[r], C, mnC);
#pragma unroll
  for (int r = 0; r < 16; ++r) p0[r] = __builtin_amdgcn_exp2f(p0[r]);
}
template <int VAR> __device__ __forceinline__ void finishSM(f32x16& p0, f32x16& p1, float alpha, float& l_reg, bf16x8& pa0, bf16x8& pa1, bf16x8& pa2, bf16x8& pa3) {
  float ps = 0;
  if constexpr (VAR != 1) {
#pragma unroll
  for (int r = 0; r < 16; ++r) p1[r] = __builtin_amdgcn_exp2f(p1[r]);
#pragma unroll
  for (int r = 0; r < 16; ++r) ps += p0[r];
#pragma unroll
  for (int r = 0; r < 16; ++r) ps += p1[r]; }
  { auto rr = __builtin_amdgcn_permlane32_swap(__float_as_uint(ps), __float_as_uint(ps), false, false);
    ps = __uint_as_float(rr[0]) + __uint_as_float(rr[1]); }
  l_reg = l_reg * alpha + ps;
#define PK4(P, BASE, OUT) do { unsigned a0 = cvtpk(P[BASE + 0], P[BASE + 1]), a1 = cvtpk(P[BASE + 2], P[BASE + 3]);   \
    unsigned b0 = cvtpk(P[BASE + 4], P[BASE + 5]), b1 = cvtpk(P[BASE + 6], P[BASE + 7]);                              \
    auto r0 = __builtin_amdgcn_permlane32_swap(a0, b0, false, false); auto r1 = __builtin_amdgcn_permlane32_swap(a1, b1, false, false); \
    u32x4 w = {r0[0], r1[0], r0[1], r1[1]}; OUT = *reinterpret_cast<bf16x8*>(&w); } while (0)
  PK4(p0, 0, pa0); PK4(p0, 8, pa1); PK4(p1, 0, pa2); PK4(p1, 8, pa3);
#undef PK4
}
template <int VAR> __device__ __forceinline__ void qkt(f32x16& p0, f32x16& p1, const bf16_t* Ks, const bf16x8* qr, int r32, int hi) {
  p0 = f32x16{}; p1 = f32x16{};
#pragma unroll
  for (int d0 = 0; d0 < 8; ++d0) { int cb = (d0 * 16 + hi * 8) * 2;
    bf16x8 b0, b1; if constexpr (VAR == 2) { b0 = qr[d0]; b1 = qr[7 - d0]; } else {
    b0 = *reinterpret_cast<const bf16x8*>((const char*)Ks + KSWZ(r32, cb));
    b1 = *reinterpret_cast<const bf16x8*>((const char*)Ks + KSWZ(32 + r32, cb)); }
    p0 = __builtin_amdgcn_mfma_f32_32x32x16_bf16(b0, qr[d0], p0, 0, 0, 0);
    p1 = __builtin_amdgcn_mfma_f32_32x32x16_bf16(b1, qr[d0], p1, 0, 0, 0); }
}
__device__ __forceinline__ int v_st(int k, int c) { const int kk = (k & ~0xC) | ((k & 4) << 1) | ((k & 8) >> 1); return ((kk >> 3) * 4 + (c >> 5)) * 512 + ((kk & 7) * 32 + (c & 31)) * 2; }
__device__ __forceinline__ int v_rd_base(int lane) { return ((lane & 3) << 3) | (((lane >> 2) & 3) << 6) | (((lane >> 4) & 1) << 5) | (((lane >> 5) & 1) << 8); }
constexpr int v_rd_off(int d0, int ks, int half) { return d0 * 512 + ks * 4096 + half * 2048; }
template <int OFF> __device__ __forceinline__ s16x4 tr_read(int vb) {
  s16x4 r; asm volatile("ds_read_b64_tr_b16 %0, %1 offset:%2" : "=&v"(r) : "v"(vb), "i"(OFF) : "memory"); return r;
}
template <int VAR, int D0> __device__ __forceinline__ void pv_one(f32x16& od, int vb, bf16x8 pa0, bf16x8 pa1, bf16x8 pa2, bf16x8 pa3) {
  if constexpr (VAR == 4) { od = __builtin_amdgcn_mfma_f32_32x32x16_bf16(pa0, pa1, od, 0, 0, 0); od = __builtin_amdgcn_mfma_f32_32x32x16_bf16(pa1, pa2, od, 0, 0, 0); od = __builtin_amdgcn_mfma_f32_32x32x16_bf16(pa2, pa3, od, 0, 0, 0); od = __builtin_amdgcn_mfma_f32_32x32x16_bf16(pa3, pa0, od, 0, 0, 0); return; }
  const s16x4 l0 = tr_read<v_rd_off(D0, 0, 0)>(vb), h0 = tr_read<v_rd_off(D0, 0, 1)>(vb), l1 = tr_read<v_rd_off(D0, 1, 0)>(vb), h1 = tr_read<v_rd_off(D0, 1, 1)>(vb);
  const s16x4 l2 = tr_read<v_rd_off(D0, 2, 0)>(vb), h2 = tr_read<v_rd_off(D0, 2, 1)>(vb), l3 = tr_read<v_rd_off(D0, 3, 0)>(vb), h3 = tr_read<v_rd_off(D0, 3, 1)>(vb);
  asm volatile("s_waitcnt lgkmcnt(0)" ::: "memory"); SBAR();
#define PK(L, H) (bf16x8){L[0], L[1], L[2], L[3], H[0], H[1], H[2], H[3]}
  od = __builtin_amdgcn_mfma_f32_32x32x16_bf16(pa0, PK(l0, h0), od, 0, 0, 0);
  od = __builtin_amdgcn_mfma_f32_32x32x16_bf16(pa1, PK(l1, h1), od, 0, 0, 0);
  od = __builtin_amdgcn_mfma_f32_32x32x16_bf16(pa2, PK(l2, h2), od, 0, 0, 0);
  od = __builtin_amdgcn_mfma_f32_32x32x16_bf16(pa3, PK(l3, h3), od, 0, 0, 0);
#undef PK
}
template <int VAR> __device__ __forceinline__ void pv_d0(f32x16* o, int vb, bf16x8 pa0, bf16x8 pa1, bf16x8 pa2, bf16x8 pa3) {
  pv_one<VAR, 0>(o[0], vb, pa0, pa1, pa2, pa3); pv_one<VAR, 1>(o[1], vb, pa0, pa1, pa2, pa3); pv_one<VAR, 2>(o[2], vb, pa0, pa1, pa2, pa3); pv_one<VAR, 3>(o[3], vb, pa0, pa1, pa2, pa3);
}
template <int LDQ, int LDK, int LDO, int VAR = 0>
__device__ __forceinline__ void attn_dense_body(const bf16_t* Qb, const bf16_t* __restrict__ Kh, const bf16_t* __restrict__ Vh,
                                                bf16_t* Ob, int seq, int nlat, int ctxoff, char* lds, const float* qgain, const float* cosT, const float* sinT, int t0, bool rope) {
  const int tid = opaque_tid(), wid = tid >> 6, lane = tid & 63, r32 = lane & 31, hi = lane >> 5;
  bf16_t* V_lds = (bf16_t*)lds; bf16_t* K_lds = (bf16_t*)(lds + 2 * SHM_V);
  float* ws = (float*)(lds + 2 * SHM_V + 2 * SHM_K) + wid * 64; float* li_l = ws; float* al_l = ws + 32;
  float m_reg = -1e30f, l_reg = 0; f32x16 o[4] = {}; bf16x8 qr[8];
  const bf16_t* Qw = Qb + (wid * QBLK + r32) * LDQ + hi * 8;
#pragma unroll 1
  for (int rep_ = 0; rep_ < (VAR == 8 ? 2 : 1); ++rep_) {
  asm volatile("" ::: "memory");
#pragma unroll
  for (int d0 = 0; d0 < 8; ++d0) qr[d0] = *reinterpret_cast<const bf16x8*>(Qw + d0 * 16);
  {
    float v[8][8]; float ss = 0.f;
#pragma unroll
    for (int d0 = 0; d0 < 8; ++d0) { const u32x4 w = *reinterpret_cast<const u32x4*>(&qr[d0]);
      v[d0][0] = bf_lo(w.x); v[d0][1] = bf_hi(w.x); v[d0][2] = bf_lo(w.y); v[d0][3] = bf_hi(w.y); v[d0][4] = bf_lo(w.z); v[d0][5] = bf_hi(w.z); v[d0][6] = bf_lo(w.w); v[d0][7] = bf_hi(w.w);
#pragma unroll
      for (int e = 0; e < 8; ++e) ss += v[d0][e] * v[d0][e]; }
    { auto rr = __builtin_amdgcn_permlane32_swap(__float_as_uint(ss), __float_as_uint(ss), false, false); ss = __uint_as_float(rr[0]) + __uint_as_float(rr[1]); }
    const float rstd = rsqrtf(ss * (1.f / 128.f) + 1e-6f);
#pragma unroll
    for (int d0 = 0; d0 < 8; ++d0) { const f32x4 g0 = *reinterpret_cast<const f32x4*>(qgain + d0 * 16 + hi * 8), g1 = *reinterpret_cast<const f32x4*>(qgain + d0 * 16 + hi * 8 + 4);
#pragma unroll
      for (int e = 0; e < 4; ++e) { v[d0][e] *= rstd * g0[e]; v[d0][4 + e] *= rstd * g1[e]; } }
    if (rope) { const float* cs = cosT + (size_t)(t0 + wid * QBLK + r32) * 64 + hi * 8; const float* sn = sinT + (size_t)(t0 + wid * QBLK + r32) * 64 + hi * 8;
#pragma unroll
      for (int d0 = 0; d0 < 4; ++d0) { const f32x4 c0 = *reinterpret_cast<const f32x4*>(cs + d0 * 16), c1 = *reinterpret_cast<const f32x4*>(cs + d0 * 16 + 4), s0 = *reinterpret_cast<const f32x4*>(sn + d0 * 16), s1 = *reinterpret_cast<const f32x4*>(sn + d0 * 16 + 4);
#pragma unroll
        for (int e = 0; e < 8; ++e) { const float c = e < 4 ? c0[e & 3] : c1[e & 3], sv = e < 4 ? s0[e & 3] : s1[e & 3]; const float lo = v[d0][e], hh = v[d0 + 4][e]; v[d0][e] = lo * c - hh * sv; v[d0 + 4][e] = hh * c + lo * sv; } } }
#pragma unroll
    for (int d0 = 0; d0 < 8; ++d0) { const u32x4 w = {cvtpk(v[d0][0], v[d0][1]), cvtpk(v[d0][2], v[d0][3]), cvtpk(v[d0][4], v[d0][5]), cvtpk(v[d0][6], v[d0][7])}; qr[d0] = *reinterpret_cast<const bf16x8*>(&w); }
  }
  }
  const int sr = tid >> 4, sc = (tid & 15) * 8, vst0 = v_st(sr, sc), vst1 = v_st(32 + sr, sc);
  const int vb0 = (int)(uintptr_t)V_lds + v_rd_base(lane);
  struct { bf16x8 vs0, vs1, ks0, ks1; } sr_[2];
#define KROW(k0) ((k0) + (((k0) >= nlat) ? ctxoff : 0))
#define SLOAD(i, k0) do { const int kr_ = KROW(k0); sr_[i].vs0 = *reinterpret_cast<const bf16x8*>(&Vh[(kr_ + sr) * LDK + sc]); sr_[i].vs1 = *reinterpret_cast<const bf16x8*>(&Vh[(kr_ + 32 + sr) * LDK + sc]); \
    sr_[i].ks0 = *reinterpret_cast<const bf16x8*>(&Kh[(kr_ + sr) * LDK + sc]); sr_[i].ks1 = *reinterpret_cast<const bf16x8*>(&Kh[(kr_ + 32 + sr) * LDK + sc]); } while (0)
#define SWRITE(b, i) do { *(bf16x8*)((char*)V_lds + (b) * SHM_V + vst0) = sr_[i].vs0;          \
    *(bf16x8*)((char*)V_lds + (b) * SHM_V + vst1) = sr_[i].vs1; int kc = sc * 2;               \
    *(bf16x8*)((char*)K_lds + (b) * SHM_K + KSWZ(sr, kc)) = sr_[i].ks0;                       \
    *(bf16x8*)((char*)K_lds + (b) * SHM_K + KSWZ(32 + sr, kc)) = sr_[i].ks1; } while (0)
#define SWAIT() asm volatile("s_waitcnt vmcnt(4)" ::: "memory")
#define RESC(a) do { if (__any((a) < 1.f)) { if (hi == 0) al_l[r32] = (a); asm volatile("s_waitcnt lgkmcnt(0)" ::: "memory"); \
    _Pragma("unroll") for (int d = 0; d < 4; ++d) _Pragma("unroll") for (int r = 0; r < 16; ++r) o[d][r] *= al_l[crow(r, hi)]; } } while (0)
#define ATT_SYNC() do { if (VAR != 3 && VAR != 5) __syncthreads(); } while (0)
  f32x16 pA0, pA1, pB0, pB1; float mnA, mnB, alA, alB; bf16x8 pa0, pa1, pa2, pa3; const int NT = seq / KVBLK;
  constexpr int SE = 0, SO = 1;
  SLOAD(SE, 0); asm volatile("s_waitcnt vmcnt(0)" ::: "memory"); SWRITE(0, SE); ATT_SYNC();
  qkt<VAR>(pA0, pA1, K_lds, qr, r32, hi); partialSM<VAR>(pA0, pA1, m_reg, mnA, alA);
  SLOAD(SO, KVBLK); if (2 < NT) SLOAD(SE, 2 * KVBLK);
  if (VAR != 3) { SWAIT(); SWRITE(1, SO); } ATT_SYNC();
  for (int j = 1; j + 1 < NT; j += 2) {
    SBAR(); qkt<VAR>(pB0, pB1, (bf16_t*)((char*)K_lds + SHM_K), qr, r32, hi);
    finishSM<VAR>(pA0, pA1, alA, l_reg, pa0, pa1, pa2, pa3); SBAR();
    if (VAR != 3 && VAR != 6) SLOAD(SO, (j + 2) * KVBLK); SBAR();
    pv_d0<VAR>(o, vb0, pa0, pa1, pa2, pa3); partialSM<VAR>(pB0, pB1, m_reg, mnB, alB);
    ATT_SYNC(); if (VAR != 3 && VAR != 6) { SWAIT(); SWRITE(0, SE); }
    RESC(alB); ATT_SYNC();
    SBAR(); qkt<VAR>(pA0, pA1, K_lds, qr, r32, hi);
    finishSM<VAR>(pB0, pB1, alB, l_reg, pa0, pa1, pa2, pa3); SBAR();
    if (VAR != 3 && VAR != 6 && j + 3 < NT) SLOAD(SE, (j + 3) * KVBLK); SBAR();
    pv_d0<VAR>(o, vb0 + (int)SHM_V, pa0, pa1, pa2, pa3); partialSM<VAR>(pA0, pA1, m_reg, mnA, alA);
    ATT_SYNC(); if (VAR != 3 && VAR != 6) { SWAIT(); SWRITE(1, SO); }
    RESC(alA); ATT_SYNC();
  }
  SBAR(); qkt<VAR>(pB0, pB1, (bf16_t*)((char*)K_lds + SHM_K), qr, r32, hi);
  finishSM<VAR>(pA0, pA1, alA, l_reg, pa0, pa1, pa2, pa3); SBAR();
  pv_d0<VAR>(o, vb0, pa0, pa1, pa2, pa3); partialSM<VAR>(pB0, pB1, m_reg, mnB, alB);
  ATT_SYNC(); RESC(alB);
  finishSM<VAR>(pB0, pB1, alB, l_reg, pa0, pa1, pa2, pa3); SBAR();
  pv_d0<VAR>(o, vb0 + (int)SHM_V, pa0, pa1, pa2, pa3);
#undef ATT_SYNC
  if (hi == 0) li_l[r32] = l_reg; asm volatile("s_waitcnt lgkmcnt(0)" ::: "memory");
  float rli[16];
#pragma unroll
  for (int r = 0; r < 16; ++r) rli[r] = __builtin_amdgcn_rcpf(li_l[crow(r, hi)]);
  bf16_t* Ow = Ob + (wid * QBLK) * LDO;
#pragma unroll
  for (int r = 0; r < 16; ++r) { int orow = crow(r, hi);
#pragma unroll
    for (int d0 = 0; d0 < 4; ++d0) { const __bf16 hb = (__bf16)(o[d0][r] * rli[r]); if constexpr (VAR == 7) { const bf16_t keep_ = __builtin_bit_cast(bf16_t, hb); asm volatile("" :: "v"(keep_)); } else Ow[orow * LDO + d0 * 32 + r32] = __builtin_bit_cast(bf16_t, hb); } }
  asm volatile("s_waitcnt vmcnt(0)" ::: "memory");
  __syncthreads();
#undef KROW
#undef SLOAD
#undef SWRITE
#undef SWAIT
#undef RESC
}
}

namespace scan {
constexpr int TS = 256, CS = 144;
#define TSW(row, cb) ((row) * TS + ((cb) ^ (((row) & 15) << 4)))
constexpr int I_QT = 0, I_KT = I_QT + 64 * TS, I_KH = I_KT + 64 * TS, I_VT = I_KH + 128 * CS, I_AV = I_VT + 32 * CS, IMG = I_AV + 512;
constexpr int OFF_ST = 2 * IMG, LDS_SCAN = OFF_ST + 2 * 32 * TS;
static_assert(LDS_SCAN <= LDS_CTL_OFF, "scan LDS");
#define SCAN_BAR() do { asm volatile("s_waitcnt lgkmcnt(0) ; SCANBAR" ::: "memory"); __builtin_amdgcn_s_barrier(); asm volatile("; SCANBAR_END" ::: "memory"); } while (0)
__device__ __forceinline__ float ex2(float x) { return __builtin_amdgcn_exp2f(x); }
typedef unsigned u32x2l __attribute__((ext_vector_type(2)));

__device__ __forceinline__ void scan_unit(LAS unsigned char* lds, const bf16_t* HQ, const bf16_t* G, const bf16_t* HV, bf16_t* O, int b, int h, int bwd, int dvs, bool store_ctx) {
    const int tid = opaque_tid(), w = __builtin_amdgcn_readfirstlane(tid >> 6), lane = tid & 63, r = lane & 15, q4 = lane >> 4;
    const long sgn = bwd ? -1 : 1;
#define SCAN_RB(cc_) (((cc_) < 4) ? (bwd ? (long)(NLAT + b * CTXL + CTXL - 1 - 64 * (cc_)) : (long)(NLAT + b * CTXL + 64 * (cc_))) \
                                  : (bwd ? (long)(b * SEQ + SEQ - 1 - 64 * ((cc_) - 4)) : (long)(b * SEQ + 64 * ((cc_) - 4))))
    for (int i = tid; i < 32 * TS / 4; i += 512) ((LAS unsigned*)(lds + OFF_ST))[i] = 0u;
    if (w < 4) {
#ifndef SCAN_E_PRIO
#define SCAN_E_PRIO 0
#endif
        __builtin_amdgcn_s_setprio(SCAN_E_PRIO);
        const int cp = lane & 15, tg = lane >> 4, et = w * 64 + lane, vtok = et >> 2, vdg = et & 3;
        const size_t colq = (size_t)h * 128 + 32 * w + 2 * cp, colv = (size_t)h * 128 + dvs * 32 + 8 * vdg;
        unsigned graw0[16], qraw0[16], graw1[16], qraw1[16]; u32x4 vraw0, vraw1;
#define SCAN_LOAD(cc_, graw, qraw, vraw) do { const long rb_ = SCAN_RB(cc_); \
        _Pragma("unroll") for (int j = 0; j < 16; ++j) { const long row_ = rb_ + sgn * (16 * tg + j); graw[j] = *(const unsigned*)(G + (size_t)row_ * 1024 + colq); qraw[j] = *(const unsigned*)(HQ + (size_t)row_ * 1024 + colq); } \
        { const long row_ = rb_ + sgn * vtok; vraw = *(const u32x4*)(HV + (size_t)row_ * 1024 + colv); } } while (0)
#define SCAN_IMAGE(cc, graw, qraw, vraw) do { \
        LAS unsigned char* img = lds + ((cc) & 1) * IMG; \
        f32x2 cs[16]; f32x2 run = {0.f, 0.f}; \
        _Pragma("unroll") for (int j = 0; j < 16; ++j) { run += unpk_f16(graw[j]); cs[j] = run; } \
        f32x2 inc = run; \
        { f32x2 y; y.x = __shfl_up(inc.x, 16); y.y = __shfl_up(inc.y, 16); if (lane >= 16) inc += y; \
          y.x = __shfl_up(inc.x, 32); y.y = __shfl_up(inc.y, 32); if (lane >= 32) inc += y; } \
        const f32x2 off = inc - run; \
        f32x2 all; all.x = __shfl(inc.x, 48 + cp); all.y = __shfl(inc.y, 48 + cp); \
        f32x2 ekp; ekp.x = ex2(fminf(-off.x, 115.f)); ekp.y = ex2(fminf(-off.y, 115.f)); \
        const f32x2 eall = {ex2(all.x), ex2(all.y)}; \
        unsigned w_kh[2][8]; \
        _Pragma("unroll") for (int j = 0; j < 16; ++j) { \
            const f32x2 q = {bf_lo(qraw[j]), bf_hi(qraw[j])}; \
            const f32x2 c = cs[j] + off; \
            f32x2 eq, ek; eq.x = ex2(c.x); eq.y = ex2(c.y); ek.x = ex2(fminf(-c.x, 115.f)); ek.y = ex2(fminf(-c.y, 115.f)); \
            f32x2 k = 1.f - eq * ekp; k.x = fmaxf(k.x, 0.f); k.y = fmaxf(k.y, 0.f); \
            ekp = ek; \
            const f32x2 qt = q * eq, kt = k * ek, kh = kt * eall; \
            const int tb = (16 * tg + j) * TS + (((32 * w + 2 * cp) * 2) ^ (j << 4)); \
            *(LAS unsigned*)(img + I_QT + tb) = pk_bf16(qt.x, qt.y); *(LAS unsigned*)(img + I_KT + tb) = pk_bf16(kt.x, kt.y); \
            if ((j & 1) == 0) { w_kh[0][j >> 1] = __float_as_uint(kh.x); w_kh[1][j >> 1] = __float_as_uint(kh.y); } \
            else { w_kh[0][j >> 1] = pk_bf16(__uint_as_float(w_kh[0][j >> 1]), kh.x); w_kh[1][j >> 1] = pk_bf16(__uint_as_float(w_kh[1][j >> 1]), kh.y); } \
        } \
        _Pragma("unroll") for (int c2 = 0; c2 < 2; ++c2) { LAS unsigned char* kp = img + I_KH + (32 * w + 2 * cp + c2) * CS + 32 * tg; \
            *(LAS u32x4*)kp = (u32x4){w_kh[c2][0], w_kh[c2][1], w_kh[c2][2], w_kh[c2][3]}; *(LAS u32x4*)(kp + 16) = (u32x4){w_kh[c2][4], w_kh[c2][5], w_kh[c2][6], w_kh[c2][7]}; } \
        if (tg == 0) *(LAS f32x2*)(img + I_AV + (32 * w + 2 * cp) * 4) = eall; \
        { LAS bf16_t* vt = (LAS bf16_t*)(img + I_VT) + vtok; const unsigned vv[4] = {vraw.x, vraw.y, vraw.z, vraw.w}; \
          _Pragma("unroll") for (int e = 0; e < 4; ++e) { vt[(8 * vdg + 2 * e) * (CS / 2)] = (bf16_t)(vv[e] & 0xffffu); vt[(8 * vdg + 2 * e + 1) * (CS / 2)] = (bf16_t)(vv[e] >> 16); } } \
    } while (0)
        SCAN_LOAD(0, graw0, qraw0, vraw0); SCAN_LOAD(1, graw1, qraw1, vraw1);
        SCAN_IMAGE(0, graw0, qraw0, vraw0); SCAN_LOAD(2, graw0, qraw0, vraw0);
        SCAN_BAR();
        for (int c2 = 0; c2 < 68; c2 += 2) {
            SCAN_IMAGE(c2 + 1, graw1, qraw1, vraw1); if (c2 + 3 < 68) SCAN_LOAD(c2 + 3, graw1, qraw1, vraw1);
            SCAN_BAR();
            if (c2 + 2 < 68) { SCAN_IMAGE(c2 + 2, graw0, qraw0, vraw0); if (c2 + 4 < 68) SCAN_LOAD(c2 + 4, graw0, qraw0, vraw0); }
            SCAN_BAR();
        }
#undef SCAN_LOAD
#undef SCAN_IMAGE
        __builtin_amdgcn_s_setprio(0);
    } else {
        const int it = w - 4;
        int xo[4];
#pragma unroll
        for (int ks = 0; ks < 4; ++ks) xo[ks] = ((4 * ks + q4) ^ r) << 4;
        f32x4 sacc[2][2];
#pragma unroll
        for (int a = 0; a < 2; ++a)
#pragma unroll
            for (int d2 = 0; d2 < 2; ++d2) sacc[a][d2] = (f32x4){0.f, 0.f, 0.f, 0.f};
        SCAN_BAR();
        for (int cc = 0; cc < 68; ++cc) {
            const LAS unsigned char* img = lds + (cc & 1) * IMG; const int cur = cc & 1, nxt = cur ^ 1; const long rb = SCAN_RB(cc);
            bf16x8 qb[4];
#pragma unroll
            for (int ks = 0; ks < 4; ++ks) qb[ks] = *(const LAS bf16x8*)(img + I_QT + (16 * it + r) * TS + xo[ks]);
            f32x4 s4[4];
#pragma unroll
            for (int jt = 0; jt < 4; ++jt) { s4[jt] = (f32x4){0.f, 0.f, 0.f, 0.f};
                if (jt <= it) { bf16x8 ka[4];
#pragma unroll
                    for (int ks = 0; ks < 4; ++ks) ka[ks] = *(const LAS bf16x8*)(img + I_KT + (16 * jt + r) * TS + xo[ks]);
#pragma unroll
                    for (int ks = 0; ks < 4; ++ks) s4[jt] = __builtin_amdgcn_mfma_f32_16x16x32_bf16(ka[ks], qb[ks], s4[jt], 0, 0, 0);
                    if (jt == it) {
#pragma unroll
                        for (int e = 0; e < 4; ++e) if (4 * q4 + e > r) s4[jt][e] = 0.f;
                    } } }
            const u32x4 p01 = {pk_bf16(s4[0][0], s4[0][1]), pk_bf16(s4[0][2], s4[0][3]), pk_bf16(s4[1][0], s4[1][1]), pk_bf16(s4[1][2], s4[1][3])};
            const u32x4 p23 = {pk_bf16(s4[2][0], s4[2][1]), pk_bf16(s4[2][2], s4[2][3]), pk_bf16(s4[3][0], s4[3][1]), pk_bf16(s4[3][2], s4[3][3])};
#pragma unroll
            for (int dvt = 0; dvt < 2; ++dvt) {
                const LAS unsigned char* vrow = img + I_VT + (16 * dvt + r) * CS + 8 * q4;
                const u32x2l va0 = *(const LAS u32x2l*)(vrow), va1 = *(const LAS u32x2l*)(vrow + 32), va2 = *(const LAS u32x2l*)(vrow + 64), va3 = *(const LAS u32x2l*)(vrow + 96);
                bf16x8 sa[4];
#pragma unroll
                for (int ks = 0; ks < 4; ++ks) sa[ks] = *(const LAS bf16x8*)(lds + OFF_ST + cur * 32 * TS + (16 * dvt + r) * TS + xo[ks]);
                f32x4 o4 = (f32x4){0.f, 0.f, 0.f, 0.f}, o5 = (f32x4){0.f, 0.f, 0.f, 0.f};
                { const u32x4 a01 = {va0.x, va0.y, va1.x, va1.y}; o4 = __builtin_amdgcn_mfma_f32_16x16x32_bf16(__builtin_bit_cast(bf16x8, a01), __builtin_bit_cast(bf16x8, p01), o4, 0, 0, 0); }
                if (it >= 2) { const u32x4 a23 = {va2.x, va2.y, va3.x, va3.y}; o4 = __builtin_amdgcn_mfma_f32_16x16x32_bf16(__builtin_bit_cast(bf16x8, a23), __builtin_bit_cast(bf16x8, p23), o4, 0, 0, 0); }
                o5 = __builtin_amdgcn_mfma_f32_16x16x32_bf16(sa[0], qb[0], o5, 0, 0, 0); o5 = __builtin_amdgcn_mfma_f32_16x16x32_bf16(sa[1], qb[1], o5, 0, 0, 0);
                o4 = __builtin_amdgcn_mfma_f32_16x16x32_bf16(sa[2], qb[2], o4, 0, 0, 0); o5 = __builtin_amdgcn_mfma_f32_16x16x32_bf16(sa[3], qb[3], o5, 0, 0, 0);
                o4 += o5;
                if (store_ctx || cc >= 4) { const long row = rb + sgn * (16 * it + r);
                    *(u32x2*)(O + (size_t)row * 1024 + h * 128 + dvs * 32 + 16 * dvt + 4 * q4) = (u32x2){pk_bf16(o4[0], o4[1]), pk_bf16(o4[2], o4[3])}; }
            }
            {
                bf16x8 vb[2][2];
#pragma unroll
                for (int ks = 0; ks < 2; ++ks) { vb[0][ks] = *(const LAS bf16x8*)(img + I_VT + r * CS + (32 * ks + 8 * q4) * 2); vb[1][ks] = *(const LAS bf16x8*)(img + I_VT + (16 + r) * CS + (32 * ks + 8 * q4) * 2); }
#pragma unroll
                for (int a = 0; a < 2; ++a) { const int dt = 2 * it + a;
                    const f32x4 a4 = *(const LAS f32x4*)(img + I_AV + (16 * dt + 4 * q4) * 4);
                    const bf16x8 kh0 = *(const LAS bf16x8*)(img + I_KH + (16 * dt + r) * CS + (8 * q4) * 2), kh1 = *(const LAS bf16x8*)(img + I_KH + (16 * dt + r) * CS + (32 + 8 * q4) * 2);
#pragma unroll
                    for (int d2 = 0; d2 < 2; ++d2) { f32x4 s = sacc[a][d2] * a4;
                        s = __builtin_amdgcn_mfma_f32_16x16x32_bf16(kh0, vb[d2][0], s, 0, 0, 0); s = __builtin_amdgcn_mfma_f32_16x16x32_bf16(kh1, vb[d2][1], s, 0, 0, 0);
                        sacc[a][d2] = s;
                        *(LAS u32x2*)(lds + OFF_ST + nxt * 32 * TS + (16 * d2 + r) * TS + ((((2 * dt + (q4 >> 1)) ^ r) << 4) | ((q4 & 1) << 3))) = (u32x2){pk_bf16(s[0], s[1]), pk_bf16(s[2], s[3])}; } }
            }
            SCAN_BAR();
        }
    }
    VM_WAIT(); LDS_WAIT();
    __syncthreads();
#undef SCAN_RB
#undef TSW
}
}

constexpr size_t MiB = 1u << 20;
constexpr size_t WS_CTL = 0, CTL_ZERO_BYTES = 64 * 1024;
constexpr int CW_TMO = 0, CW_BAR = 4096, CW_CNT = 8192;
constexpr size_t WS_MOD = 256 * 1024;
constexpr size_t WS_LBV = 512 * 1024;
constexpr size_t WS_WGB = 576 * 1024;
constexpr size_t WS_COS = 1 * MiB, WS_SIN = 2 * MiB;
constexpr size_t WS_ROUTE = 3 * MiB;
constexpr size_t WS_XCTX = 4 * MiB;
constexpr size_t WS_H = 8 * MiB;
constexpr size_t WS_W = 42 * MiB;
constexpr size_t WL_STRIDE = 23 * MiB, WL_IN = 0, WL_ATT = 17 * MiB, WL_HG = 19 * MiB, WL_OUT = 21 * MiB;
constexpr size_t WS_WGU = WS_W + 46 * MiB, WS_WD = WS_W + 57 * MiB;
constexpr size_t WS_OF = 105 * MiB, WS_OB = 139 * MiB;
constexpr size_t WS_PROJ = 173 * MiB;
constexpr int XB_CAP = 16384;
constexpr size_t WS_MGU = 462 * MiB, WS_MD = 518 * MiB, WS_YB = 105 * MiB, WS_HIDM = 173 * MiB, WS_XB = 292 * MiB, WS_END = 546 * MiB;
static_assert(WS_WD + (size_t)DM * DFF * 2 <= WS_OF && WS_OB + (size_t)R * DM * 2 <= WS_PROJ && WS_PROJ + (size_t)R * PROJW * 2 <= WS_MGU, "ws map");
static_assert(WS_MGU + (size_t)NEXP * 2 * DFE * DM <= WS_MD && WS_MD + (size_t)NEXP * DM * DFE <= WS_END && WS_YB + (size_t)MOE_ROWS_MAX * DM * 2 <= WS_HIDM && WS_HIDM + (size_t)MOE_ROWS_MAX * DFE <= WS_XB && WS_XB + (size_t)NEXP * XB_CAP * DM <= WS_MGU, "ws map (moe)");
constexpr size_t PQ = 0, PK = (size_t)R * 1024, PV = (size_t)R * 1280, PHQ = (size_t)R * 1536, PGF = (size_t)R * 2560, PGB = (size_t)R * 3584, PHV = (size_t)R * 4608, PHG = (size_t)R * 5632, PGA = (size_t)R * 6656, PGH = (size_t)R * 7680;

constexpr int RING_BYTES = 131072, MISC_OFF = LDS_CTL_OFF + 320, LDS_BYTES = 163840;
constexpr int NWAVES = 8;

#define XB_TMO      128
#define XB_XCNT(j)  (256  + 64 * (j))
#define XB_XSUB(j)  (1280 + 64 * (j))
#define XB_XGEN(j)  (2304 + 64 * (j))
#define XB_TOP      3328
#define XB_TOPGEN   3392
#define XCD_BAR_WORDS 3456
#define XB_SPIN_CAP (1u << 18)
__device__ __forceinline__ unsigned xb_ld(unsigned* p)              { return __hip_atomic_load(p, __ATOMIC_RELAXED, __HIP_MEMORY_SCOPE_AGENT); }
__device__ __forceinline__ unsigned xb_add(unsigned* p, unsigned v) { return __hip_atomic_fetch_add(p, v, __ATOMIC_RELAXED, __HIP_MEMORY_SCOPE_AGENT); }
__device__ __forceinline__ unsigned xb_xcc_id() { return (unsigned)__builtin_amdgcn_s_getreg((3 << 11) | 20) & 0xFu; }
#define XB_SPIN(cond, bar) do { unsigned _sp = 0; while (cond) { __builtin_amdgcn_s_sleep(1); \
    if ((++_sp & 255u) == 0u) { if (xb_ld(&(bar)[XB_TMO])) break; if (_sp > XB_SPIN_CAP) { atomicAdd(&(bar)[XB_TMO], 1u); break; } } } } while (0)
struct XcdBarrier { unsigned* bar; unsigned x; volatile LAS unsigned* st; };
__device__ __forceinline__ XcdBarrier xcd_barrier_post(unsigned* bar, volatile LAS unsigned* st) {
    XcdBarrier b; b.bar = bar; b.x = xb_xcc_id(); b.st = st;
    if (threadIdx.x == 0) (void)xb_add(&bar[XB_XCNT(b.x)], 1u);
    return b;
}
__device__ __forceinline__ void xcd_barrier_complete(unsigned* bar, unsigned x, unsigned& nloc, unsigned& nx) {
    const unsigned G = gridDim.x * gridDim.y * gridDim.z;
    unsigned sum, cnt, mine, sp = 0u;
    for (;;) {
        sum = 0u; cnt = 0u; mine = 0u;
#pragma unroll
        for (unsigned j = 0; j < 16; ++j) { const unsigned c = xb_ld(&bar[XB_XCNT(j)]); sum += c; cnt += (c > 0u) ? 1u : 0u; mine = (j == x) ? c : mine; }
        if (sum == G) break;
        __builtin_amdgcn_s_sleep(1);
        if ((++sp & 255u) == 0u) { if (xb_ld(&bar[XB_TMO])) break; if (sp > XB_SPIN_CAP) { atomicAdd(&bar[XB_TMO], 1u); break; } }
    }
    nloc = mine > 0u ? mine : 1u; nx = cnt > 0u ? cnt : 1u;
}
__device__ __forceinline__ void xcd_barrier(const XcdBarrier& b) {
    asm volatile("s_waitcnt vmcnt(0)" ::: "memory");
    __syncthreads();
    if (opaque_tid() == 0) {
        unsigned* bar = b.bar;
        __builtin_amdgcn_s_waitcnt(0);
        unsigned nloc = b.st[0], nx = b.st[1];
        if (nloc == 0u) { xcd_barrier_complete(bar, b.x, nloc, nx); b.st[0] = nloc; b.st[1] = nx; }
        const unsigned old = xb_add(&bar[XB_XSUB(b.x)], 1u);
        const unsigned gen = old / nloc;
        if (old + 1u == (gen + 1u) * nloc) {
            __builtin_amdgcn_fence(__ATOMIC_RELEASE, "agent");
            asm volatile("s_waitcnt vmcnt(0)" ::: "memory");
            const unsigned og = xb_add(&bar[XB_TOP], 1u);
            const unsigned tg = og / nx;
            if (og + 1u == (tg + 1u) * nx) xb_add(&bar[XB_TOPGEN], 1u);
            else XB_SPIN(xb_ld(&bar[XB_TOPGEN]) == tg, bar);
            __builtin_amdgcn_fence(__ATOMIC_ACQUIRE, "agent");
            xb_add(&bar[XB_XGEN(b.x)], 1u);
            asm volatile("s_waitcnt vmcnt(0)" ::: "memory");
        } else {
            XB_SPIN(xb_ld(&bar[XB_XGEN(b.x)]) == gen, bar);
            __builtin_amdgcn_fence(__ATOMIC_ACQUIRE, "agent");
            asm volatile("s_waitcnt vmcnt(0)" ::: "memory");
        }
    }
    __syncthreads();
}

__device__ __forceinline__ float wave_sum(float v) {
#pragma unroll
    for (int o = 1; o < 64; o <<= 1) v += __shfl_xor(v, o);
    return v;
}
struct Row16 { f32x4 v[4]; };
__device__ __forceinline__ Row16 ld_f32_row(const float* p, int lane) { Row16 r;
#pragma unroll
    for (int j = 0; j < 4; ++j) r.v[j] = ((const f32x4*)p)[lane + 64 * j];
    return r; }
__device__ __forceinline__ void st_f32_row(float* p, int lane, const Row16& r) {
#pragma unroll
    for (int j = 0; j < 4; ++j) ((f32x4*)p)[lane + 64 * j] = r.v[j]; }
__device__ __forceinline__ Row16 ld_bf16_row(const bf16_t* p, int lane) { Row16 r;
#pragma unroll
    for (int j = 0; j < 4; ++j) { const u32x2 w = ((const u32x2*)p)[lane + 64 * j]; r.v[j] = (f32x4){bf_lo(w.x), bf_hi(w.x), bf_lo(w.y), bf_hi(w.y)}; }
    return r; }
#ifndef THIN_NT
#define THIN_NT 1
#endif
__device__ __forceinline__ void st_bf16_row_nt(bf16_t* p, int lane, const Row16& r) {
#pragma unroll
    for (int j = 0; j < 4; ++j) { const u32x2 w = (u32x2){pk_bf16(r.v[j][0], r.v[j][1]), pk_bf16(r.v[j][2], r.v[j][3])};
        if (THIN_NT) __builtin_nontemporal_store(w, (u32x2*)p + lane + 64 * j); else ((u32x2*)p)[lane + 64 * j] = w; } }
struct RawB { u32x2 v[4]; };
__device__ __forceinline__ RawB ld_raw_b(const bf16_t* p, int lane) { RawB r;
#pragma unroll
    for (int j = 0; j < 4; ++j) r.v[j] = ((const u32x2*)p)[lane + 64 * j];
    return r; }
#ifndef THIN_NTL
#define THIN_NTL 0
#endif
__device__ __forceinline__ RawB ld_raw_b_nt(const bf16_t* p, int lane) { RawB r;
#pragma unroll
    for (int j = 0; j < 4; ++j) r.v[j] = THIN_NTL ? __builtin_nontemporal_load((const u32x2*)p + lane + 64 * j) : ((const u32x2*)p)[lane + 64 * j];
    return r; }
__device__ __forceinline__ Row16 ld_f32_row_nt(const float* p, int lane) { Row16 r;
#pragma unroll
    for (int j = 0; j < 4; ++j) r.v[j] = THIN_NTL ? __builtin_nontemporal_load((const f32x4*)p + lane + 64 * j) : ((const f32x4*)p)[lane + 64 * j];
    return r; }
__device__ __forceinline__ Row16 unraw_b(const RawB& w) { Row16 r;
#pragma unroll
    for (int j = 0; j < 4; ++j) r.v[j] = (f32x4){bf_lo(w.v[j].x), bf_hi(w.v[j].x), bf_lo(w.v[j].y), bf_hi(w.v[j].y)};
    return r; }
__device__ __forceinline__ void st_bf16_row(bf16_t* p, int lane, const Row16& r) {
#pragma unroll
    for (int j = 0; j < 4; ++j) ((u32x2*)p)[lane + 64 * j] = (u32x2){pk_bf16(r.v[j][0], r.v[j][1]), pk_bf16(r.v[j][2], r.v[j][3])}; }
__device__ __forceinline__ float row_rstd(const Row16& r) { float s = 0.f;
#pragma unroll
    for (int j = 0; j < 4; ++j) s += (r.v[j][0] * r.v[j][0] + r.v[j][1] * r.v[j][1]) + (r.v[j][2] * r.v[j][2] + r.v[j][3] * r.v[j][3]);
    return rsqrtf(wave_sum(s) * (1.f / DM) + NORM_EPS); }
__device__ __forceinline__ Row16 norm_mod(const Row16& x, float rstd, const float* gain, const float* shift, const float* scale, int lane) { Row16 o;
#pragma unroll
    for (int j = 0; j < 4; ++j) { const f32x4 g = ((const f32x4*)gain)[lane + 64 * j], sh = ((const f32x4*)shift)[lane + 64 * j], sc = ((const f32x4*)scale)[lane + 64 * j];
        o.v[j] = (x.v[j] * rstd * g) * (sc + 1.f) + sh; }
    return o; }
__device__ __forceinline__ Row16 resid_add(const Row16& x, const Row16& y, float rstd, const float* gain, const float* gate, int lane) { Row16 o;
#pragma unroll
    for (int j = 0; j < 4; ++j) { const f32x4 g = ((const f32x4*)gain)[lane + 64 * j], gt = ((const f32x4*)gate)[lane + 64 * j];
        o.v[j] = x.v[j] + gt * (y.v[j] * rstd * g); }
    return o; }

__device__ __forceinline__ unsigned f2bf(float f) { unsigned u = __builtin_bit_cast(unsigned, f); return (u + 0x7fffu + ((u >> 16) & 1u)) >> 16; }
__device__ __forceinline__ unsigned pk2(float lo, float hi) { return f2bf(lo) | (f2bf(hi) << 16); }
struct TDesc { const float* W; unsigned char* WT; int K, N, il, item; };
__device__ __forceinline__ void t_load(const TDesc& d, float (&t_)[32], int lane) {
    const int nblk = d.N / 32, kb = d.item / nblk, nb = d.item - kb * nblk, k0 = 64 * kb, n0 = 32 * nb;
#pragma unroll
    for (int i = 0; i < 32; ++i) t_[i] = d.W[(size_t)(k0 + 2 * i + (lane >> 5)) * d.N + n0 + (lane & 31)];
}
template <bool FP8>
__device__ __forceinline__ void t_finish(const TDesc& d, const float (&t_)[32], LAS float* scr, int lane) {
    const int nblk = d.N / 32, kb = d.item / nblk, nb = d.item - kb * nblk, k0 = 64 * kb, n0 = 32 * nb;
    const int drow0 = d.il ? (256 * (n0 >> 7) + (n0 & 127) + (d.il == 2 ? 128 : 0)) : n0;
#pragma unroll
    for (int i = 0; i < 32; ++i) scr[(2 * i + (lane >> 5)) * 33 + (lane & 31)] = t_[i];
    LDS_WAIT(); asm volatile("" ::: "memory");
    const int c = lane & 7;
#pragma unroll
    for (int j = 0; j < 4; ++j) { const int n = (lane >> 3) + 8 * j; const LAS float* s = scr + (8 * c) * 33 + n;
        if constexpr (FP8) { u32x2 o; o.x = pk4_fp8(64.f * s[0 * 33], 64.f * s[1 * 33], 64.f * s[2 * 33], 64.f * s[3 * 33]); o.y = pk4_fp8(64.f * s[4 * 33], 64.f * s[5 * 33], 64.f * s[6 * 33], 64.f * s[7 * 33]);
            *(GAS u32x2*)(d.WT + (size_t)(drow0 + n) * d.K + k0 + 8 * c) = o; }
        else { u32x4 o; o.x = pk2(s[0 * 33], s[1 * 33]); o.y = pk2(s[2 * 33], s[3 * 33]); o.z = pk2(s[4 * 33], s[5 * 33]); o.w = pk2(s[6 * 33], s[7 * 33]);
            *(GAS u32x4*)((bf16_t*)d.WT + (size_t)(drow0 + n) * d.K + k0 + 8 * c) = o; } }
    LDS_WAIT(); asm volatile("" ::: "memory");
}
template <bool FP8, class Dec>
__device__ __forceinline__ void t_run(const Dec& dec, int first, int last, int stride, LAS float* scr, int lane) {
    int it = first; if (it >= last) return;
    TDesc dA, dB; float tA[32], tB[32]; dec(it, dA); t_load(dA, tA, lane);
    for (;;) {
        const int i1 = it + stride; const bool hasB = i1 < last; dec(hasB ? i1 : it, dB); t_load(dB, tB, lane);
        t_finish<FP8>(dA, tA, scr, lane);
        if (!hasB) break;
        const int i2 = i1 + stride; const bool hasA = i2 < last; dec(hasA ? i2 : i1, dA); t_load(dA, tA, lane);
        t_finish<FP8>(dB, tB, scr, lane);
        if (!hasA) break;
        it = i2;
    }
}
struct Args { const float* in[25]; float* out; unsigned char* ws; int ph_lo, ph_hi; };
constexpr int NPH = 14, NTOT = 2 * NPH;
typedef const __attribute__((address_space(4))) Args* KArgs;
__device__ __forceinline__ KArgs kargs() { auto p = __builtin_amdgcn_kernarg_segment_ptr(); asm volatile("" : "+s"(p)); return (KArgs)p; }
struct Geo { int G, bx, vcu; };
__device__ __forceinline__ Geo opaque_geo(Geo g) { asm volatile("" : "+s"(g.G), "+s"(g.bx), "+s"(g.vcu)); return g; }
enum { I_X = 0, I_C, I_CTX, I_CCTX, I_WMOD, I_BMOD, I_PREMIX, I_POSTMIX, I_PREFFN, I_POSTFFN, I_WIN, I_QN, I_KN, I_HGN, I_LBL, I_WATT, I_WHG, I_WOUT, I_FWG, I_FWU, I_FWD, I_ROUTER, I_MWG, I_MWU, I_MWD };

__device__ __forceinline__ void phase_prologue(LAS unsigned char* lds, const Geo geo_in) {
    const Geo geo = opaque_geo(geo_in);
    KArgs A = kargs(); unsigned char* ws = A->ws;
    const int tid = opaque_tid(), lane = tid & 63, wave = __builtin_amdgcn_readfirstlane(tid >> 6);
    const int G = geo.G, vcu = geo.vcu, gw = vcu * NWAVES + wave, NGW = G * NWAVES;
    LAS float* scr = (LAS float*)(lds + wave * 16384);
    constexpr int I_IN = 16 * (PROJW / 32), I_SQ = 16 * 32, I_GU = 16 * (DFF / 32), I_DN = (DFF / 64) * 32;
    constexpr int I_L = I_IN + 3 * I_SQ, NIT = 2 * I_L + 2 * I_GU + I_DN;
    const int ngv = (G > 96) ? 48 : 0;
    if (vcu >= ngv) {
        const auto dec = [&](int it, TDesc& d) { int r = it; d.il = 0;
            if (r < 2 * I_L) { const int l = r / I_L; r -= l * I_L; unsigned char* wl = ws + WS_W + l * WL_STRIDE; d.K = DM;
                if (r < I_IN) { d.W = A->in[I_WIN] + (size_t)l * DM * PROJW; d.N = PROJW; d.WT = wl + WL_IN; d.item = r; return; } r -= I_IN;
                d.N = DM; d.item = r & (I_SQ - 1); const int which = r / I_SQ;
                d.W = (which == 0 ? A->in[I_WATT] : which == 1 ? A->in[I_WHG] : A->in[I_WOUT]) + (size_t)l * DM * DM; d.WT = wl + (which == 0 ? WL_ATT : which == 1 ? WL_HG : WL_OUT); return; }
            r -= 2 * I_L;
            if (r < 2 * I_GU) { const int up = r >= I_GU; d.W = up ? A->in[I_FWU] : A->in[I_FWG]; d.K = DM; d.N = DFF; d.WT = ws + WS_WGU; d.il = 1 + up; d.item = r - up * I_GU; return; }
            d.W = A->in[I_FWD]; d.K = DFF; d.N = DM; d.WT = ws + WS_WD; d.item = r - 2 * I_GU; };
        t_run<false>(dec, (vcu - ngv) * NWAVES + wave, NIT, (G - ngv) * NWAVES, scr, lane);
    }
    {
        float* cosT = (float*)(ws + WS_COS); float* sinT = (float*)(ws + WS_SIN); float* lbv = (float*)(ws + WS_LBV); const float* lbl = A->in[I_LBL];
        for (int i = (vcu * 512 + tid); i < SEQ * 64; i += G * 512) { const int t = i >> 6, jj = i & 63; const int fi = jj & 31;
            const float inv = powf(10000.f, -(float)fi / 32.f); const float pos = (jj < 32) ? (float)(t >> 6) : (float)(t & 63); const float ang = pos * inv;
            cosT[i] = cosf(ang); sinT[i] = sinf(ang); }
        for (int i = (vcu * 512 + tid); i < 2 * DM; i += G * 512) { const int l = i >> 10, ch = i & 1023;
            lbv[i] = (l == 0) ? 0.f : 1.f / (1.f + expf(lbl[ch] - lbl[DM + ch])); }
    }
    __syncthreads();
    for (int it = vcu; it < 2 * 24; it += G) { const int l = it / 24, n0 = (it % 24) * 256;
        const float* c_in = A->in[I_C]; const float* cctx_in = A->in[I_CCTX]; float* modv = (float*)(ws + WS_MOD);
        LAS float* sv = (LAS float*)(lds + 65536) + wave * 5 * 128;
        const int k0 = wave * 128;
#pragma unroll
        for (int mi = 0; mi < 5; ++mi)
#pragma unroll
            for (int h2 = 0; h2 < 2; ++h2) { const int k = k0 + h2 * 64 + lane; const float cv = (mi < 4) ? c_in[mi * DM + k] : cctx_in[k]; sv[mi * 128 + h2 * 64 + lane] = cv / (1.f + expf(-cv)); }
        LDS_WAIT(); asm volatile("" ::: "memory");
        f32x4 a5[5];
#pragma unroll
        for (int mi = 0; mi < 5; ++mi) a5[mi] = (f32x4){0.f, 0.f, 0.f, 0.f};
        const float* wp = A->in[I_WMOD] + (size_t)l * DM * NMOD + (size_t)k0 * NMOD + n0 + 4 * lane;
        for (int kk0 = 0; kk0 < 128; kk0 += 16) { f32x4 wv[16];
#pragma unroll
            for (int j = 0; j < 16; ++j) wv[j] = *(const f32x4*)(wp + (size_t)(kk0 + j) * NMOD);
#pragma unroll
            for (int j = 0; j < 16; ++j)
#pragma unroll
                for (int mi = 0; mi < 5; ++mi) a5[mi] += wv[j] * sv[mi * 128 + kk0 + j]; }
        LAS float* red = (LAS float*)lds;
#pragma unroll
        for (int mi = 0; mi < 5; ++mi) *(LAS f32x4*)(red + (wave * 5 + mi) * 256 + 4 * lane) = a5[mi];
        __syncthreads();
        const float* b_mod = A->in[I_BMOD];
        for (int o = tid; o < 5 * 256; o += 512) { const int mi = o >> 8, cidx = o & 255; float s = b_mod[l * NMOD + n0 + cidx];
#pragma unroll
            for (int w8 = 0; w8 < 8; ++w8) s += red[(w8 * 5 + mi) * 256 + cidx];
            modv[((size_t)l * 5 + mi) * NMOD + n0 + cidx] = s; }
        __syncthreads();
    }
}

__device__ __forceinline__ void phase_premix0(const Geo geo_in) {
    const Geo geo = opaque_geo(geo_in);
    KArgs A = kargs(); unsigned char* ws = A->ws;
    const int tid = opaque_tid(), lane = tid & 63, wave = __builtin_amdgcn_readfirstlane(tid >> 6);
    const int gw = geo.vcu * NWAVES + wave, NGW = geo.G * NWAVES;
    const float* x_in = A->in[I_X]; const float* ctx_in = A->in[I_CTX]; const float* gain = A->in[I_PREMIX]; const float* modl = (const float*)(ws + WS_MOD);
    bf16_t* Hb = (bf16_t*)(ws + WS_H);
#define SRC_ROW(row_) (((row_) < NLAT) ? x_in + (size_t)(row_) * DM : ctx_in + (size_t)((row_) - NLAT) * DM)
#define P1_ROW(row_, cur_) do { const int rw_ = (row_); const float* md = modl + (size_t)((rw_ < NLAT) ? (rw_ >> 12) : 4) * NMOD;      \
        const Row16 h = norm_mod(cur_, row_rstd(cur_), gain, md + 0 * DM, md + 1 * DM, lane); st_bf16_row(Hb + (size_t)rw_ * DM, lane, h); } while (0)
    const int rc0 = NLAT + gw; Row16 cxc; if (rc0 < R) cxc = ld_f32_row(SRC_ROW(rc0), lane);
    for (int base = gw; base < NLAT; base += 8 * NGW) {
        Row16 rx[8];
#pragma unroll
        for (int k = 0; k < 8; ++k) rx[k] = ld_f32_row(SRC_ROW((base + k * NGW < NLAT) ? base + k * NGW : base), lane);
#pragma unroll
        for (int k = 0; k < 8; ++k) if (base + k * NGW < NLAT) P1_ROW(base + k * NGW, rx[k]);
    }
    if (rc0 < R) P1_ROW(rc0, cxc);
    for (int rc = rc0 + NGW; rc < R; rc += NGW) { const Row16 c2 = ld_f32_row(SRC_ROW(rc), lane); P1_ROW(rc, c2); }
#undef P1_ROW
#undef SRC_ROW
}

__device__ __forceinline__ void phase_proj(LAS unsigned char* lds, const Geo geo_in, int layer) {
    const Geo geo = opaque_geo(geo_in);
    KArgs A = kargs(); unsigned char* ws = A->ws;
    pg8::Gemm g{(const bf16_t*)(ws + WS_H), (const bf16_t*)(ws + WS_W + layer * WL_STRIDE + WL_IN), R, PROJW, DM}; pg8::StaticOrder S; S.init(R, PROJW, geo.G, geo.bx);
    EpiProj E{(bf16_t*)(ws + WS_PROJ), (const float*)(ws + WS_LBV) + layer * DM};
    pg8::gemm_phase<EpiProj, pg8::StaticOrder, true, true>(lds, g, S, E);
    gemm_mini_ks<EpiProj, pg8::StaticOrder>(lds, g, S, E, geo.vcu, geo.G);
}

__device__ __forceinline__ void phase_qknorm(const Geo geo_in, int layer) {
    const Geo geo = opaque_geo(geo_in);
    KArgs A = kargs(); unsigned char* ws = A->ws;
    const int tid = opaque_tid(), lane = tid & 63, wave = __builtin_amdgcn_readfirstlane(tid >> 6);
    const int gw = geo.vcu * NWAVES + wave, NGW = geo.G * NWAVES;
    const float* qn = A->in[I_QN] + layer * 128; const float* kn = A->in[I_KN] + layer * 128;
    const float* cosT = (const float*)(ws + WS_COS); const float* sinT = (const float*)(ws + WS_SIN); bf16_t* proj = (bf16_t*)(ws + WS_PROJ);
    const int nitems = R / 4;
    for (int it = gw; it < nitems; it += NGW) {
        const int row = it * 4 + (lane >> 4);
        const int lr = lane & 15;
        bf16_t* p = proj + PK + (size_t)row * 256 + 16 * lr;
        const float* gn = kn;
        const int j0 = (lr & 7) * 16;
        f32x4 v[4]; { f32x4 a, b2; unpack8(*(const u32x4*)p, a, b2); v[0] = a; v[1] = b2; unpack8(*(const u32x4*)(p + 8), a, b2); v[2] = a; v[3] = b2; }
        float ss = 0.f;
#pragma unroll
        for (int j = 0; j < 4; ++j) ss += (v[j][0] * v[j][0] + v[j][1] * v[j][1]) + (v[j][2] * v[j][2] + v[j][3] * v[j][3]);
        ss += __shfl_xor(ss, 1); ss += __shfl_xor(ss, 2); ss += __shfl_xor(ss, 4);
        const float rstd = rsqrtf(ss * (1.f / 128.f) + NORM_EPS);
#pragma unroll
        for (int j = 0; j < 4; ++j) v[j] = v[j] * rstd * *(const f32x4*)(gn + j0 + 4 * j);
        if (row < NLAT) {
            const int t = row & (SEQ - 1); const int jj0 = (lr & 3) * 16; const bool upper = (lr & 4) != 0;
#pragma unroll
            for (int j = 0; j < 4; ++j) { f32x4 pv;
#pragma unroll
                for (int e = 0; e < 4; ++e) pv[e] = __shfl_xor(v[j][e], 4);
                const f32x4 cs = *(const f32x4*)(cosT + (size_t)t * 64 + jj0 + 4 * j), sn = *(const f32x4*)(sinT + (size_t)t * 64 + jj0 + 4 * j);
                v[j] = upper ? (v[j] * cs + pv * sn) : (v[j] * cs - pv * sn); }
        }
        *(u32x4*)p = pack8(v[0], v[1]); *(u32x4*)(p + 8) = pack8(v[2], v[3]);
    }
}

__device__ __forceinline__ void phase_attn(unsigned char* lds_raw, const Geo geo_in, bool last, int layer) {
    const Geo geo = opaque_geo(geo_in);
    KArgs A = kargs(); unsigned char* ws = A->ws;
    bf16_t* Qp = (bf16_t*)(ws + WS_PROJ) + PQ; const bf16_t* Kp = (const bf16_t*)(ws + WS_PROJ) + PK; const bf16_t* Vp = (const bf16_t*)(ws + WS_PROJ) + PV;
    const float* qn = A->in[I_QN] + layer * 128;
    const int nun = last ? 512 : 544;
#ifndef ATT_UMAP
#define ATT_UMAP 0
#endif
#ifdef ATT_PROBE
    for (int u = (ATT_UMAP ? geo.bx : geo.vcu); u < nun; u += geo.G) {
        int qrow, krow, h, seq, nlat, ctxoff;
        if (u < 512) { const int grp = u >> 6, b = grp >> 1, kvh = grp & 1, gq = (u >> 4) & 3, qb = u & 15; h = kvh * 4 + gq;
            qrow = b * SEQ + qb * 256; krow = b * SEQ; seq = SEQ + CTXL; nlat = SEQ; ctxoff = (NLAT + b * CTXL) - (b * SEQ) - SEQ; }
        else { const int b = (u - 512) >> 3; h = (u - 512) & 7; qrow = NLAT + b * CTXL; krow = qrow; seq = CTXL; nlat = 1 << 30; ctxoff = 0; }
        bf16_t* Qb = Qp + (size_t)qrow * 1024 + h * 128; bf16_t* Os = (bf16_t*)(ws + WS_OF) + (size_t)qrow * 1024 + h * 128;
        const bf16_t* Kh = Kp + (size_t)krow * 256 + (h >> 2) * 128; const bf16_t* Vh = Vp + (size_t)krow * 256 + (h >> 2) * 128;
        att::attn_dense_body<1024, 256, 1024, ATT_PROBE>(Qb, Kh, Vh, Os, seq, nlat, ctxoff, (char*)lds_raw, qn, (const float*)(ws + WS_COS), (const float*)(ws + WS_SIN), qrow & (SEQ - 1), u < 512);
    }
#endif
    for (int u = (ATT_UMAP ? geo.bx : geo.vcu); u < nun; u += geo.G) {
        int qrow, krow, h, seq, nlat, ctxoff;
        if (u < 512) { const int grp = u >> 6, b = grp >> 1, kvh = grp & 1, gq = (u >> 4) & 3, qb = u & 15; h = kvh * 4 + gq;
            qrow = b * SEQ + qb * 256; krow = b * SEQ; seq = SEQ + CTXL; nlat = SEQ; ctxoff = (NLAT + b * CTXL) - (b * SEQ) - SEQ; }
        else { const int b = (u - 512) >> 3; h = (u - 512) & 7; qrow = NLAT + b * CTXL; krow = qrow; seq = CTXL; nlat = 1 << 30; ctxoff = 0; }
        bf16_t* Qb = Qp + (size_t)qrow * 1024 + h * 128;
        const bf16_t* Kh = Kp + (size_t)krow * 256 + (h >> 2) * 128; const bf16_t* Vh = Vp + (size_t)krow * 256 + (h >> 2) * 128;
        att::attn_dense_body<1024, 256, 1024>(Qb, Kh, Vh, Qb, seq, nlat, ctxoff, (char*)lds_raw, qn, (const float*)(ws + WS_COS), (const float*)(ws + WS_SIN), qrow & (SEQ - 1), u < 512);
    }
}
__device__ __forceinline__ void phase_scan(LAS unsigned char* lds, const Geo geo_in, bool last) {
    const Geo geo = opaque_geo(geo_in);
    KArgs A = kargs(); unsigned char* ws = A->ws;
    bf16_t* proj = (bf16_t*)(ws + WS_PROJ);
    for (int u = geo.vcu; u < 256; u += geo.G) {
        const int dvs = u & 3, bwd = (u >> 2) & 1, h = (u >> 3) & 7, b = u >> 6;
        scan::scan_unit(lds, proj + PHQ, bwd ? proj + PGB : proj + PGF, proj + PHV, bwd ? (bf16_t*)(ws + WS_OB) : (bf16_t*)(ws + WS_OF), b, h, bwd, dvs, !last);
    }
}

__device__ __forceinline__ void phase_readout(const Geo geo_in, int layer) {
    const Geo geo = opaque_geo(geo_in);
    KArgs A = kargs(); unsigned char* ws = A->ws;
    const int tid = opaque_tid(), lane = tid & 63, wave = __builtin_amdgcn_readfirstlane(tid >> 6);
    const int gw = geo.vcu * NWAVES + wave, NGW = geo.G * NWAVES;
    const float* hn = A->in[I_HGN] + layer * 128; const int nrows = (layer == 1) ? NLAT : R;
    const bf16_t* OFb = (const bf16_t*)(ws + WS_OF); const bf16_t* OBb = (const bf16_t*)(ws + WS_OB); bf16_t* HG = (bf16_t*)(ws + WS_PROJ) + PHG;
    const int j0 = (lane & 7) * 16;
    struct Raw { u32x4 f0, f1, b0, b1, g0, g1; };
#define RD_LOAD(dst, row_) do { const size_t off_ = (size_t)(row_) * 1024 + 16 * lane; dst.f0 = *(const u32x4*)(OFb + off_); dst.f1 = *(const u32x4*)(OFb + off_ + 8); \
        dst.b0 = *(const u32x4*)(OBb + off_); dst.b1 = *(const u32x4*)(OBb + off_ + 8); dst.g0 = *(const u32x4*)(HG + off_); dst.g1 = *(const u32x4*)(HG + off_ + 8); } while (0)
#define RD_ROW(row_, cur) do { const size_t off = (size_t)(row_) * 1024 + 16 * lane;                                                                   \
        f32x4 a[4], b4[4], g4[4];                                                                                                                  \
        unpack8(cur.f0, a[0], a[1]); unpack8(cur.f1, a[2], a[3]); unpack8(cur.b0, b4[0], b4[1]); unpack8(cur.b1, b4[2], b4[3]); unpack8(cur.g0, g4[0], g4[1]); unpack8(cur.g1, g4[2], g4[3]); \
        float ss = 0.f;                                                                                                                            \
        _Pragma("unroll") for (int j = 0; j < 4; ++j) { a[j] += b4[j]; ss += (a[j][0] * a[j][0] + a[j][1] * a[j][1]) + (a[j][2] * a[j][2] + a[j][3] * a[j][3]); } \
        ss += __shfl_xor(ss, 1); ss += __shfl_xor(ss, 2); ss += __shfl_xor(ss, 4);                                                                   \
        const float rstd = rsqrtf(ss * (1.f / 128.f) + NORM_EPS);                                                                                  \
        _Pragma("unroll") for (int j = 0; j < 4; ++j) a[j] = a[j] * rstd * *(const f32x4*)(hn + j0 + 4 * j) * g4[j];                                 \
        *(u32x4*)(HG + off) = pack8(a[0], a[1]); *(u32x4*)(HG + off + 8) = pack8(a[2], a[3]); } while (0)
    const int rc0 = NLAT + gw; Raw rcc; if (rc0 < nrows) RD_LOAD(rcc, rc0);
    for (int base = gw; base < NLAT; base += 8 * NGW) {
        Raw sl[6];
#define RD_LD(k_) RD_LOAD(sl[(k_) % 6], ((base + (k_) * NGW < NLAT) ? base + (k_) * NGW : base))
#pragma unroll
        for (int k = 0; k < 5; ++k) RD_LD(k);
#pragma unroll
        for (int k = 0; k < 8; ++k) {
            if (k + 5 < 8) RD_LD(k + 5);
            if (base + k * NGW < NLAT) RD_ROW(base + k * NGW, sl[k % 6]);
        }
#undef RD_LD
    }
    if (rc0 < nrows) RD_ROW(rc0, rcc);
    for (int rc = rc0 + NGW; rc < nrows; rc += NGW) { Raw r2; RD_LOAD(r2, rc); RD_ROW(rc, r2); }
#undef RD_ROW
#undef RD_LOAD
}

__device__ __forceinline__ void phase_merge_hg(LAS unsigned char* lds, const Geo geo_in, int layer) {
    const Geo geo = opaque_geo(geo_in);
    KArgs A = kargs(); unsigned char* ws = A->ws; const int M = (layer == 1) ? NLAT : R; bf16_t* proj = (bf16_t*)(ws + WS_PROJ);
    pg8::Gemm g{proj + PHG, (const bf16_t*)(ws + WS_W + layer * WL_STRIDE + WL_HG), M, DM, DM}; pg8::StaticOrder S; S.init(M, DM, geo.G, geo.bx);
    EpiGate<false> E{proj + PGH, nullptr};
    pg8::gemm_phase<EpiGate<false>, pg8::StaticOrder, true, true>(lds, g, S, E);
    gemm_mini_ks<EpiGate<false>, pg8::StaticOrder>(lds, g, S, E, geo.vcu, geo.G);
}
__device__ __forceinline__ void phase_merge_att(LAS unsigned char* lds, const Geo geo_in, int layer) {
    const Geo geo = opaque_geo(geo_in);
    KArgs A = kargs(); unsigned char* ws = A->ws; const int M = (layer == 1) ? NLAT : R; bf16_t* proj = (bf16_t*)(ws + WS_PROJ);
    pg8::Gemm g{proj + PQ, (const bf16_t*)(ws + WS_W + layer * WL_STRIDE + WL_ATT), M, DM, DM}; pg8::StaticOrder S; S.init(M, DM, geo.G, geo.bx);
    EpiGate<true> E{proj + PGA, proj + PGH};
    pg8::gemm_phase<EpiGate<true>, pg8::StaticOrder, true, true>(lds, g, S, E);
    gemm_mini_ks<EpiGate<true>, pg8::StaticOrder>(lds, g, S, E, geo.vcu, geo.G);
}
__device__ __forceinline__ void phase_wout(LAS unsigned char* lds, const Geo geo_in, int layer) {
    const Geo geo = opaque_geo(geo_in);
    KArgs A = kargs(); unsigned char* ws = A->ws; const int M = (layer == 1) ? NLAT : R; bf16_t* proj = (bf16_t*)(ws + WS_PROJ);
    pg8::Gemm g{proj + PGA, (const bf16_t*)(ws + WS_W + layer * WL_STRIDE + WL_OUT), M, DM, DM}; pg8::StaticOrder S; S.init(M, DM, geo.G, geo.bx);
    EpiPlain E{(bf16_t*)(ws + WS_H), DM};
    pg8::gemm_phase<EpiPlain, pg8::StaticOrder, true, true>(lds, g, S, E);
    gemm_mini_ks<EpiPlain, pg8::StaticOrder>(lds, g, S, E, geo.vcu, geo.G);
}

constexpr int XB_SPLIT = 15872;
__device__ __forceinline__ bf16_t* xa_row(unsigned char* ws, int row) { return (bf16_t*)(ws + WS_OB) + (size_t)row * DM; }
__device__ __forceinline__ bf16_t* xb_row(unsigned char* ws, int row) { return row < XB_SPLIT ? (bf16_t*)(ws + WS_END) + (size_t)row * DM : (bf16_t*)(ws + WS_WGU) + (size_t)(row - XB_SPLIT) * DM; }
__device__ __forceinline__ bf16_t* xc_row(unsigned char* ws, int row) { return (bf16_t*)(ws + WS_W) + (size_t)row * DM; }
__device__ __forceinline__ void phase_postmix0(const Geo geo_in, bool probe = false) {
    const Geo geo = opaque_geo(geo_in);
    KArgs A = kargs(); unsigned char* ws = A->ws;
    const int tid = opaque_tid(), lane = tid & 63, wave = __builtin_amdgcn_readfirstlane(tid >> 6);
    const int gw = geo.vcu * NWAVES + wave, NGW = geo.G * NWAVES;
    const float* x_in = A->in[I_X]; const float* ctx_in = A->in[I_CTX]; float* out = A->out; float* xctx = (float*)(ws + WS_XCTX);
    const float* pmn = A->in[I_POSTMIX]; const float* pfn = A->in[I_PREFFN]; const float* modl = (const float*)(ws + WS_MOD); bf16_t* Hb = (bf16_t*)(ws + WS_H);
#define SRC_ROW(row_) (((row_) < NLAT) ? x_in + (size_t)(row_) * DM : ctx_in + (size_t)((row_) - NLAT) * DM)
#define P9_ROW(row_, cx_, cm_) do { const int rw_ = (row_); const float* md = modl + (size_t)((rw_ < NLAT) ? (rw_ >> 12) : 4) * NMOD;      \
        const Row16 x1 = resid_add(cx_, cm_, row_rstd(cm_), pmn, md + 2 * DM, lane);                                                           \
        if (probe) st_bf16_row((bf16_t*)(ws + WS_OB) + (size_t)rw_ * DM, lane, x1);                                                            \
        else if (rw_ < NLAT) st_bf16_row_nt(xa_row(ws, rw_), lane, x1); else st_f32_row(xctx + (size_t)(rw_ - NLAT) * DM, lane, x1);                \
        const Row16 f = norm_mod(x1, row_rstd(x1), pfn, md + 3 * DM, md + 4 * DM, lane);                                                       \
        st_bf16_row((probe ? (bf16_t*)(ws + WS_OF) : Hb) + (size_t)rw_ * DM, lane, f); } while (0)
    const int rc0 = NLAT + gw; Row16 cxc; RawB cmc; if (rc0 < R) { cxc = ld_f32_row(SRC_ROW(rc0), lane); cmc = ld_raw_b(Hb + (size_t)rc0 * DM, lane); }
    for (int base = gw; base < NLAT; base += 8 * NGW) {
        Row16 fx[5]; RawB fm[5];
#define P9_LOAD(k_) do { const int rw_ = (base + (k_) * NGW < NLAT) ? base + (k_) * NGW : base; fx[(k_) % 5] = ld_f32_row_nt(SRC_ROW(rw_), lane); fm[(k_) % 5] = ld_raw_b_nt(Hb + (size_t)rw_ * DM, lane); } while (0)
#pragma unroll
        for (int k = 0; k < 4; ++k) P9_LOAD(k);
#pragma unroll
        for (int k = 0; k < 8; ++k) {
            if (k + 4 < 8) P9_LOAD(k + 4);
            if (base + k * NGW < NLAT) { const Row16 cm = unraw_b(fm[k % 5]); P9_ROW(base + k * NGW, fx[k % 5], cm); }
        }
#undef P9_LOAD
    }
    if (rc0 < R) { const Row16 cm = unraw_b(cmc); P9_ROW(rc0, cxc, cm); }
    for (int rc = rc0 + NGW; rc < R; rc += NGW) { const Row16 c2 = ld_f32_row(SRC_ROW(rc), lane), m2 = ld_bf16_row(Hb + (size_t)rc * DM, lane); P9_ROW(rc, c2, m2); }
#undef P9_ROW
#undef SRC_ROW
}
constexpr int MOE_I_E = 16 * (DFE / 32);
constexpr int MOE_CONV_TAILW = (256 - 16) * NWAVES;
#ifndef MOE_EARLY_PER_WAVE
#define MOE_EARLY_PER_WAVE 16
#endif
constexpr int MOE_CONV_EARLY = MOE_EARLY_PER_WAVE * MOE_CONV_TAILW;
__device__ __forceinline__ void moe_convert(unsigned char* ws, KArgs A, LAS unsigned char* scrbase, int first, int last, int wi, int nw, int wave, int lane) {
    LAS float* scr = (LAS float*)(scrbase + wave * 8704);
    unsigned char* MGU = ws + WS_MGU; unsigned char* MD = ws + WS_MD;
    const auto dec = [&](int it, TDesc& d) { const int e = it / (3 * MOE_I_E), r3 = it - e * 3 * MOE_I_E, m = r3 / MOE_I_E; d.item = r3 - m * MOE_I_E;
        if (m < 2) { d.W = (m == 0 ? A->in[I_MWG] : A->in[I_MWU]) + (size_t)e * DM * DFE; d.K = DM; d.N = DFE; d.WT = MGU + (size_t)e * 2 * DFE * DM; d.il = 1 + m; }
        else { d.W = A->in[I_MWD] + (size_t)e * DFE * DM; d.K = DFE; d.N = DM; d.WT = MD + (size_t)e * DM * DFE; d.il = 0; } };
    t_run<true>(dec, first + wi, last, nw, scr, lane);
}
__device__ __forceinline__ void phase_postmix1(LAS unsigned char* lds, const Geo geo_in) {
    const Geo geo = opaque_geo(geo_in);
    KArgs A = kargs(); unsigned char* ws = A->ws;
    const int tid = opaque_tid(), lane = tid & 63, wave = __builtin_amdgcn_readfirstlane(tid >> 6);
    const int G = geo.G, vcu = geo.vcu, gw = vcu * NWAVES + wave, NGW = G * NWAVES;
    float* out = A->out; const float* pmn = A->in[I_POSTMIX] + DM; const float* pfn = A->in[I_PREFFN] + DM; const float* modl = (const float*)(ws + WS_MOD) + (size_t)5 * NMOD;
    bf16_t* Hb = (bf16_t*)(ws + WS_H); unsigned* route = (unsigned*)(ws + WS_ROUTE); unsigned* wgb = (unsigned*)(ws + WS_WGB); unsigned* cnt = (unsigned*)(ws + WS_CTL) + CW_CNT;
    LAS float* wr = (LAS float*)lds; LAS unsigned* lcnt = (LAS unsigned*)(lds + 32768); LAS unsigned* lbase = lcnt + 8; unsigned char* XB = ws + WS_XB;
    { const float* moe_router = A->in[I_ROUTER]; for (int i = tid; i < DM * NEXP; i += 512) wr[i] = moe_router[i]; }
    if (tid < NEXP) lcnt[tid] = 0u;
    __syncthreads();
    for (int blk = vcu; blk < NLAT / 64; blk += G) {
        RawB rxr[8], rmx[8];
        unsigned fq8[8][4]; int re0[8], re1[8]; unsigned rp0[8], rp1[8];
#pragma unroll
        for (int i = 0; i < 8; ++i) { rxr[i] = ld_raw_b_nt(xb_row(ws, blk * 64 + wave * 8 + i), lane); rmx[i] = ld_raw_b_nt(Hb + (size_t)(blk * 64 + wave * 8 + i) * DM, lane); }
#pragma unroll
        for (int i = 0; i < 8; ++i) {
            const int row = blk * 64 + wave * 8 + i;
            const float* md = modl + (size_t)(row >> 12) * NMOD;
            const Row16 xr = unraw_b(rxr[i]), mx = unraw_b(rmx[i]);
            const Row16 x1 = resid_add(xr, mx, row_rstd(mx), pmn, md + 2 * DM, lane);
            st_bf16_row_nt(xc_row(ws, row), lane, x1);
            const Row16 f = norm_mod(x1, row_rstd(x1), pfn, md + 3 * DM, md + 4 * DM, lane);
#pragma unroll
            for (int j = 0; j < 4; ++j) fq8[i][j] = pk4_fp8(f.v[j][0], f.v[j][1], f.v[j][2], f.v[j][3]);
            float lg[NEXP];
#pragma unroll
            for (int e = 0; e < NEXP; ++e) lg[e] = 0.f;
#pragma unroll
            for (int j = 0; j < 4; ++j)
#pragma unroll
                for (int e4 = 0; e4 < 4; ++e4) { const int cidx = 4 * (lane + 64 * j) + e4; const f32x4 w0 = *(const LAS f32x4*)(wr + cidx * 8), w1 = *(const LAS f32x4*)(wr + cidx * 8 + 4); const float fv = f.v[j][e4];
                    lg[0] += fv * w0[0]; lg[1] += fv * w0[1]; lg[2] += fv * w0[2]; lg[3] += fv * w0[3]; lg[4] += fv * w1[0]; lg[5] += fv * w1[1]; lg[6] += fv * w1[2]; lg[7] += fv * w1[3]; }
#pragma unroll
            for (int e = 0; e < NEXP; ++e) lg[e] = wave_sum(lg[e]);
            int e0 = 0; float l0 = lg[0];
#pragma unroll
            for (int e = 1; e < NEXP; ++e) if (lg[e] > l0) { l0 = lg[e]; e0 = e; }
            int e1 = -1; float l1 = -3.0e38f;
#pragma unroll
            for (int e = 0; e < NEXP; ++e) if (e != e0 && lg[e] > l1) { l1 = lg[e]; e1 = e; }
            unsigned p0 = 0u, p1 = 0u;
            if (lane == 0) {
                p0 = __hip_atomic_fetch_add(lcnt + e0, 1u, __ATOMIC_RELAXED, __HIP_MEMORY_SCOPE_WORKGROUP);
                p1 = __hip_atomic_fetch_add(lcnt + e1, 1u, __ATOMIC_RELAXED, __HIP_MEMORY_SCOPE_WORKGROUP);
                const float w0 = 1.f / (1.f + expf(l1 - l0));
                unsigned* rr = route + (size_t)row * 8;
                rr[0] = (unsigned)e0 | ((unsigned)e1 << 8); rr[3] = __float_as_uint(w0); rr[4] = __float_as_uint(1.f - w0);
            }
            re0[i] = __builtin_amdgcn_readfirstlane(e0); re1[i] = __builtin_amdgcn_readfirstlane(e1); rp0[i] = __builtin_amdgcn_readfirstlane(p0); rp1[i] = __builtin_amdgcn_readfirstlane(p1);
        }
        __syncthreads();
        if (tid < NEXP) { const unsigned n = lcnt[tid]; lbase[tid] = __hip_atomic_fetch_add(cnt + 64 * tid, n, __ATOMIC_RELAXED, __HIP_MEMORY_SCOPE_AGENT); lcnt[tid] = 0u; }
        __syncthreads();
#pragma unroll
        for (int i = 0; i < 8; ++i) { const int row = blk * 64 + wave * 8 + i;
            const unsigned k0 = lbase[re0[i]] + rp0[i], k1 = lbase[re1[i]] + rp1[i];
            unsigned* d0 = (unsigned*)(XB + ((size_t)re0[i] * XB_CAP + k0) * DM); unsigned* d1 = (unsigned*)(XB + ((size_t)re1[i] * XB_CAP + k1) * DM);
#pragma unroll
            for (int j = 0; j < 4; ++j) { d0[lane + 64 * j] = fq8[i][j]; d1[lane + 64 * j] = fq8[i][j]; }
            if (lane == 0) { unsigned* rr = route + (size_t)row * 8; rr[5] = k0; rr[6] = k1; } }
        __syncthreads();
    }
    moe_convert(ws, A, lds + 49152, (G == 256) ? MOE_CONV_EARLY : 0, NEXP * 3 * MOE_I_E, gw, NGW, wave, lane);
}

struct MoeCounts { int nb[NEXP]; };
__device__ __forceinline__ MoeCounts moe_counts(unsigned char* ws) { MoeCounts c; unsigned* cnt = (unsigned*)(ws + WS_CTL) + CW_CNT;
#pragma unroll
    for (int e = 0; e < NEXP; ++e) { const unsigned n = __hip_atomic_load(cnt + 64 * e, __ATOMIC_RELAXED, __HIP_MEMORY_SCOPE_AGENT); c.nb[e] = (int)((n + 255u) >> 8); }
    return c; }

__device__ __forceinline__ void phase_gather(const Geo geo_in) {
    const Geo geo = opaque_geo(geo_in);
    KArgs A = kargs(); unsigned char* ws = A->ws;
    const int tid = opaque_tid(), lane = tid & 63, wave = __builtin_amdgcn_readfirstlane(tid >> 6);
    const int gw = geo.vcu * NWAVES + wave, NGW = geo.G * NWAVES;
    const MoeCounts mc = moe_counts(ws); int pst[NEXP]; { int a_ = 0;
#pragma unroll
        for (int e = 0; e < NEXP; ++e) { pst[e] = a_; a_ += mc.nb[e] * 256; } }
    unsigned* route = (unsigned*)(ws + WS_ROUTE); const unsigned* wgb = (const unsigned*)(ws + WS_WGB); const bf16_t* Hb = (const bf16_t*)(ws + WS_H); unsigned char* XB = ws + WS_XB;
    struct Rec { unsigned ee, p0, p1; }; struct Dat { unsigned b0, b1; u32x4 lo, hi; };
#define G_REC(dst, row_) do { const unsigned* rr_ = route + (size_t)(row_) * 8; dst.ee = rr_[0]; dst.p0 = rr_[1]; dst.p1 = rr_[2]; } while (0)
#define G_DAT(dst, rec, row_) do { dst.b0 = wgb[((row_) >> 6) * 8 + (rec.ee & 255)]; dst.b1 = wgb[((row_) >> 6) * 8 + ((rec.ee >> 8) & 255)]; \
        dst.lo = *(const u32x4*)(Hb + (size_t)(row_) * DM + 16 * lane); dst.hi = *(const u32x4*)(Hb + (size_t)(row_) * DM + 16 * lane + 8); } while (0)
    for (int base = gw; base < NLAT; base += 8 * NGW) {
        Rec rc[8]; Dat dt[8];
#pragma unroll
        for (int k = 0; k < 8; ++k) G_REC(rc[k], ((base + k * NGW < NLAT) ? base + k * NGW : base));
#pragma unroll
        for (int k = 0; k < 8; ++k) G_DAT(dt[k], rc[k], ((base + k * NGW < NLAT) ? base + k * NGW : base));
#pragma unroll
        for (int k = 0; k < 8; ++k) { const int row = base + k * NGW;
            if (row < NLAT) {
                const int e0 = rc[k].ee & 255, e1 = (rc[k].ee >> 8) & 255;
                int ps0 = 0, ps1 = 0;
#pragma unroll
                for (int e = 0; e < NEXP; ++e) { if (e == e0) ps0 = pst[e]; if (e == e1) ps1 = pst[e]; }
                const unsigned d0 = (unsigned)ps0 + dt[k].b0 + rc[k].p0, d1 = (unsigned)ps1 + dt[k].b1 + rc[k].p1;
                f32x4 v0, v1, v2, v3; unpack8(dt[k].lo, v0, v1); unpack8(dt[k].hi, v2, v3);
                const u32x4 q = {pk4_fp8(v0[0], v0[1], v0[2], v0[3]), pk4_fp8(v1[0], v1[1], v1[2], v1[3]), pk4_fp8(v2[0], v2[1], v2[2], v2[3]), pk4_fp8(v3[0], v3[1], v3[2], v3[3])};
                *(u32x4*)(XB + (size_t)d0 * DM + 16 * lane) = q; *(u32x4*)(XB + (size_t)d1 * DM + 16 * lane) = q;
                if (lane == 0) { unsigned* rr = route + (size_t)row * 8; rr[5] = d0; rr[6] = d1; }
            } }
    }
#undef G_REC
#undef G_DAT
}

__device__ __forceinline__ void phase_ffn_up0(LAS unsigned char* lds, const Geo geo_in) {
    const Geo geo = opaque_geo(geo_in);
    KArgs A = kargs(); unsigned char* ws = A->ws;
    pg8::Gemm g{(const bf16_t*)(ws + WS_H), (const bf16_t*)(ws + WS_WGU), R, 2 * DFF, DM}; pg8::StaticOrder S; S.init(R, 2 * DFF, geo.G, geo.bx); S.nfull = S.nwg;
    EpiSwiGLU E{(bf16_t*)(ws + WS_PROJ), DFF};
    pg8::gemm_phase<EpiSwiGLU, pg8::StaticOrder, true, true>(lds, g, S, E);
    gemm_mini<EpiSwiGLU, pg8::StaticOrder>(g, S, E, geo.vcu, geo.G);
}
__device__ __forceinline__ void phase_ffn_down0(LAS unsigned char* lds, const Geo geo_in) {
    const Geo geo = opaque_geo(geo_in);
    KArgs A = kargs(); unsigned char* ws = A->ws;
    pg8::Gemm g{(const bf16_t*)(ws + WS_PROJ), (const bf16_t*)(ws + WS_WD), R, DM, DFF}; pg8::StaticOrder S; S.init(R, DM, geo.G, geo.bx); S.nfull = S.nwg;
    EpiPlain E{(bf16_t*)(ws + WS_OF), DM};
    pg8::gemm_phase<EpiPlain, pg8::StaticOrder, true, true>(lds, g, S, E);
    if (geo.G == 256 && geo.bx >= 16) {
        const int tid = opaque_tid(), lane = tid & 63, wave = __builtin_amdgcn_readfirstlane(tid >> 6);
        moe_convert(ws, A, lds, 0, MOE_CONV_EARLY, (geo.bx - 16) * NWAVES + wave, MOE_CONV_TAILW, wave, lane);
    }
}
__device__ __forceinline__ void phase_ffn_up1(LAS unsigned char* lds, const Geo geo_in) {
    const Geo geo = opaque_geo(geo_in);
    KArgs A = kargs(); unsigned char* ws = A->ws; const MoeCounts mc = moe_counts(ws);
    pg8::Gemm g{(const bf16_t*)(ws + WS_XB), (const bf16_t*)(ws + WS_MGU), MOE_ROWS_MAX, 2 * DFE, DM}; MoeOrder S; S.acap = XB_CAP / 256;
#pragma unroll
    for (int e = 0; e < NEXP; ++e) S.nb[e] = mc.nb[e];
    S.nN = 2 * DFE / 256; S.G = geo.G; S.c = geo.vcu; S.finish(); S.nfull = S.nwg;
    EpiSwiGLU8 E{ws + WS_HIDM, DFE};
    pg8::gemm_phase<EpiSwiGLU8, MoeOrder, true, true, true>(lds, g, S, E);
}
__device__ __forceinline__ void phase_ffn_down1(LAS unsigned char* lds, const Geo geo_in) {
    const Geo geo = opaque_geo(geo_in);
    KArgs A = kargs(); unsigned char* ws = A->ws; const MoeCounts mc = moe_counts(ws);
    pg8::Gemm g{(const bf16_t*)(ws + WS_HIDM), (const bf16_t*)(ws + WS_MD), MOE_ROWS_MAX, DM, DFE}; MoeOrder S;
#pragma unroll
    for (int e = 0; e < NEXP; ++e) S.nb[e] = mc.nb[e];
    S.nN = DM / 256; S.G = geo.G; S.c = geo.vcu; S.finish();
#ifdef MOE_NO_MINI8
    S.nfull = S.nwg;
#endif
    EpiPlain E{(bf16_t*)(ws + WS_YB), DM, 0.015625f};
    pg8::gemm_phase<EpiPlain, MoeOrder, true, true, true>(lds, g, S, E);
    gemm_mini8<DFE, EpiPlain, MoeOrder>(lds, ws + WS_HIDM, ws + WS_MD, S, E, geo.vcu, geo.G);
}

__device__ __forceinline__ void phase_postffn0(const Geo geo_in, bool probe = false) {
    const Geo geo = opaque_geo(geo_in);
    KArgs A = kargs(); unsigned char* ws = A->ws;
    const int tid = opaque_tid(), lane = tid & 63, wave = __builtin_amdgcn_readfirstlane(tid >> 6);
    const int gw = geo.vcu * NWAVES + wave, NGW = geo.G * NWAVES;
    float* out = A->out; float* xctx = (float*)(ws + WS_XCTX); const float* pfn = A->in[I_POSTFFN]; const float* pmx = A->in[I_PREMIX] + DM;
    const float* modl = (const float*)(ws + WS_MOD); const bf16_t* FF = (const bf16_t*)(ws + WS_OF); bf16_t* Hb = (bf16_t*)(ws + WS_H);
#define X_LOAD(row_) (((row_) < NLAT) ? ld_bf16_row(xa_row(ws, (row_)), lane) : ld_f32_row(xctx + (size_t)((row_) - NLAT) * DM, lane))
#define P13_ROW(row_, cx_, cy_) do { const int rw_ = (row_); const int mi = (rw_ < NLAT) ? (rw_ >> 12) : 4;                                        \
        const Row16 x2 = resid_add(cx_, cy_, row_rstd(cy_), pfn, modl + (size_t)mi * NMOD + 5 * DM, lane);                                    \
        if (probe) st_bf16_row((bf16_t*)(ws + WS_PROJ) + (size_t)rw_ * DM, lane, x2);                                                          \
        else if (rw_ < NLAT) st_bf16_row_nt(xb_row(ws, rw_), lane, x2); else st_f32_row(xctx + (size_t)(rw_ - NLAT) * DM, lane, x2);                \
        const float* mdn = modl + (size_t)(5 + mi) * NMOD;                                                                                    \
        const Row16 h = norm_mod(x2, row_rstd(x2), pmx, mdn + 0 * DM, mdn + 1 * DM, lane);                                                    \
        st_bf16_row((probe ? (bf16_t*)(ws + WS_PROJ + 40 * MiB) : Hb) + (size_t)rw_ * DM, lane, h); } while (0)
    const int rc0 = NLAT + gw; Row16 cxc; RawB cyr; if (rc0 < R) { cxc = ld_f32_row(xctx + (size_t)(rc0 - NLAT) * DM, lane); cyr = ld_raw_b(FF + (size_t)rc0 * DM, lane); }
    for (int base = gw; base < NLAT; base += 8 * NGW) {
        RawB rx[8], ry[8];
#pragma unroll
        for (int k = 0; k < 8; ++k) { const int rw = (base + k * NGW < NLAT) ? base + k * NGW : base; rx[k] = ld_raw_b_nt(xa_row(ws, rw), lane); ry[k] = ld_raw_b_nt(FF + (size_t)rw * DM, lane); }
#pragma unroll
        for (int k = 0; k < 8; ++k) if (base + k * NGW < NLAT) { const Row16 cx = unraw_b(rx[k]), cy = unraw_b(ry[k]); P13_ROW(base + k * NGW, cx, cy); }
    }
    if (rc0 < R) { const Row16 cyc = unraw_b(cyr); P13_ROW(rc0, cxc, cyc); }
    for (int rc = rc0 + NGW; rc < R; rc += NGW) { const Row16 c2 = ld_f32_row(xctx + (size_t)(rc - NLAT) * DM, lane), y2 = ld_bf16_row(FF + (size_t)rc * DM, lane); P13_ROW(rc, c2, y2); }
#undef P13_ROW
#undef X_LOAD
}
__device__ __forceinline__ void phase_postffn1(const Geo geo_in) {
    const Geo geo = opaque_geo(geo_in);
    KArgs A = kargs(); unsigned char* ws = A->ws;
    const int tid = opaque_tid(), lane = tid & 63, wave = __builtin_amdgcn_readfirstlane(tid >> 6);
    const int gw = geo.vcu * NWAVES + wave, NGW = geo.G * NWAVES;
    float* out = A->out; const float* pfn = A->in[I_POSTFFN] + DM; const float* modl = (const float*)(ws + WS_MOD) + (size_t)5 * NMOD;
    const unsigned* route = (const unsigned*)(ws + WS_ROUTE); const bf16_t* YB = (const bf16_t*)(ws + WS_YB);
    const MoeCounts mc = moe_counts(ws); int pst[NEXP]; { int a_ = 0;
#pragma unroll
        for (int e = 0; e < NEXP; ++e) { pst[e] = a_; a_ += mc.nb[e] * 256; } }
    for (int base = gw; base < NLAT; base += 8 * NGW) {
        u32x4 rt[8];
#pragma unroll
        for (int k = 0; k < 8; ++k) { const unsigned* rr = route + (size_t)((base + k * NGW < NLAT) ? base + k * NGW : base) * 8; rt[k] = *(const u32x4*)(rr + 3); const unsigned ee = rr[0];
            const int e0 = ee & 255, e1 = (ee >> 8) & 255; int ps0 = 0, ps1 = 0;
#pragma unroll
            for (int e = 0; e < NEXP; ++e) { if (e == e0) ps0 = pst[e]; if (e == e1) ps1 = pst[e]; }
            rt[k].z += (unsigned)ps0; rt[k].w += (unsigned)ps1; }
        RawB fx[5], f0[5], f1[5];
#define P13L_LOAD(k_) do { const int rw_ = (base + (k_) * NGW < NLAT) ? base + (k_) * NGW : base; fx[(k_) % 5] = ld_raw_b_nt(xc_row(ws, rw_), lane);           \
        f0[(k_) % 5] = ld_raw_b_nt(YB + (size_t)rt[k_].z * DM, lane); f1[(k_) % 5] = ld_raw_b_nt(YB + (size_t)rt[k_].w * DM, lane); } while (0)
#pragma unroll
        for (int k = 0; k < 4; ++k) P13L_LOAD(k);
#pragma unroll
        for (int k = 0; k < 8; ++k) {
            if (k + 4 < 8) P13L_LOAD(k + 4);
            const int row = base + k * NGW;
            if (row < NLAT) {
                const float w0 = __uint_as_float(rt[k].x), w1 = __uint_as_float(rt[k].y);
                const Row16 cx = unraw_b(fx[k % 5]), c0 = unraw_b(f0[k % 5]), c1 = unraw_b(f1[k % 5]);
                Row16 y;
#pragma unroll
                for (int j = 0; j < 4; ++j) y.v[j] = c0.v[j] * w0 + c1.v[j] * w1;
                const Row16 x2 = resid_add(cx, y, row_rstd(y), pfn, modl + (size_t)(row >> 12) * NMOD + 5 * DM, lane);
                st_f32_row(out + (size_t)row * DM, lane, x2);
            }
        }
#undef P13L_LOAD
    }
}

__global__ void __launch_bounds__(NWAVES * 64, 2) fwd_kernel(Args args) {
    LAS unsigned char* lds = (LAS unsigned char*)lds_raw;
    volatile LAS unsigned* MISC = (volatile LAS unsigned*)(lds + MISC_OFF);
    Geo geo; geo.G = gridDim.x; geo.bx = blockIdx.x; geo.vcu = (geo.G % 8 == 0) ? (geo.bx % 8) * (geo.G / 8) + geo.bx / 8 : geo.bx;
    for (int u = threadIdx.x; u < (LDS_BYTES - LDS_CTL_OFF) / 4; u += NWAVES * 64) ((LAS unsigned*)(lds + LDS_CTL_OFF))[u] = 0u;
    __syncthreads();
    if ((threadIdx.x & 63) == 0) *(LAS int*)(lds + WAVE_TAB_OFF + 4 * hw_wave_slot()) = (int)(threadIdx.x >> 6);
    __syncthreads();
    const int lo = args.ph_lo, hi = args.ph_hi;
    XcdBarrier bar; bar.bar = (unsigned*)(args.ws + WS_CTL) + CW_BAR; bar.x = 0; bar.st = nullptr;
    if (hi - lo > 1) bar = xcd_barrier_post((unsigned*)(args.ws + WS_CTL) + CW_BAR, MISC + 8);
#ifndef PHASE_MASK
#define PHASE_MASK 0x3fff
#endif
#define IN(k) (((PHASE_MASK >> ((k) % NPH)) & 1) && lo <= (k) && (k) < hi)
#define SEAM(k) do { if (IN((k) + 1)) xcd_barrier(bar); } while (0)
#ifndef REP_ID
#define REP_ID (-1)
#endif
#define REP(k, call) do { call; if (REP_ID >= 0 && REP_ID == (k)) { if (hi - lo > 1) xcd_barrier(bar); call; } } while (0)
#pragma unroll 1
    for (int layer = 0; layer < 2; ++layer) {
        const int P = layer * NPH; const bool last = (layer == 1);
        if (!last && IN(P + 0)) { asm volatile("; PHASE_BEGIN_0" ::: "memory"); REP(P + 0, phase_prologue(lds, geo)); SEAM(P + 0); }
        if (!last && IN(P + 1)) { asm volatile("; PHASE_BEGIN_1" ::: "memory"); phase_premix0(geo); SEAM(P + 1); }
        if (IN(P + 2)) { asm volatile("; PHASE_BEGIN_2" ::: "memory"); REP(P + 2, phase_proj(lds, geo, layer));
            SEAM(P + 2); }
        if (IN(P + 3)) { asm volatile("; PHASE_BEGIN_3" ::: "memory"); phase_qknorm(geo, layer); SEAM(P + 3); }
        if (IN(P + 4)) { asm volatile("; PHASE_BEGIN_4" ::: "memory");
#ifndef NO_ATTN
            REP(P + 4, phase_attn(lds_raw, geo, last, layer));
#endif
#ifndef NO_SCAN
            REP(P + 4 + 100, phase_scan(lds, geo, last));
#endif
            SEAM(P + 4); }
        if (IN(P + 5)) { asm volatile("; PHASE_BEGIN_5" ::: "memory"); phase_readout(geo, layer); SEAM(P + 5); }
        if (IN(P + 6)) { asm volatile("; PHASE_BEGIN_6" ::: "memory"); phase_merge_hg(lds, geo, layer); VM_WAIT(); __syncthreads(); }
        if (IN(P + 7)) { asm volatile("; PHASE_BEGIN_7" ::: "memory"); phase_merge_att(lds, geo, layer); SEAM(P + 7); }
        if (IN(P + 8)) { asm volatile("; PHASE_BEGIN_8" ::: "memory"); REP(P + 8, phase_wout(lds, geo, layer)); SEAM(P + 8); }
        if (IN(P + 9)) { asm volatile("; PHASE_BEGIN_9" ::: "memory");
#if defined(THIN_PROBE)
            if (!last && THIN_PROBE == 9) { phase_postmix0(geo, true); xcd_barrier(bar); }
#endif
            if (!last) phase_postmix0(geo); else phase_postmix1(lds, geo); SEAM(P + 9); }
        if (IN(P + 11)) { asm volatile("; PHASE_BEGIN_11" ::: "memory"); if (!last) REP(P + 11, phase_ffn_up0(lds, geo)); else REP(P + 11, phase_ffn_up1(lds, geo)); SEAM(P + 11); }
        if (IN(P + 12)) { asm volatile("; PHASE_BEGIN_12" ::: "memory"); if (!last) REP(P + 12, phase_ffn_down0(lds, geo)); else REP(P + 12, phase_ffn_down1(lds, geo)); SEAM(P + 12); }
        if (IN(P + 13)) { asm volatile("; PHASE_BEGIN_13" ::: "memory");
#if defined(THIN_PROBE)
            if (!last && THIN_PROBE == 13) { phase_postffn0(geo, true); xcd_barrier(bar); }
#endif
            if (!last) { phase_postffn0(geo); SEAM(P + 13); } else phase_postffn1(geo); }
    }
#undef IN
#undef SEAM
}

__global__ void dump_kernel(const bf16_t* src, int pitch, float* out) {
    for (size_t i = (size_t)blockIdx.x * 256 + threadIdx.x; i < (size_t)NLAT * DM; i += (size_t)gridDim.x * 256) { const size_t row = i >> 10, c = i & 1023; out[i] = bf_lo((unsigned)src[row * pitch + c]); }
}
extern "C" void kernel_launch(void* const* d_in, const int* in_sizes, int n_in, void* d_out, int out_size, void* d_ws, size_t ws_size, hipStream_t stream) {
    static int grid = 0;
    if (grid == 0) {
        if (n_in != 25 || in_sizes[0] != NLAT * DM || out_size != NLAT * DM || ws_size < WS_END + 31 * MiB) { fprintf(stderr, "kernel_launch: unexpected shapes (n_in %d, in0 %d, out %d, ws %zu < %zu)\n", n_in, n_in > 0 ? in_sizes[0] : -1, out_size, ws_size, (size_t)(WS_END + 31 * MiB)); grid = -1; return; }
        int dev = 0, cus = 0, per_cu = 0;
        if (hipGetDevice(&dev) != hipSuccess || hipDeviceGetAttribute(&cus, hipDeviceAttributeMultiprocessorCount, dev) != hipSuccess) { grid = -1; return; }
        if (hipFuncSetAttribute((const void*)fwd_kernel, hipFuncAttributeMaxDynamicSharedMemorySize, LDS_BYTES) != hipSuccess) { fprintf(stderr, "kernel_launch: hipFuncSetAttribute failed\n"); grid = -1; return; }
        if (hipOccupancyMaxActiveBlocksPerMultiprocessor(&per_cu, (const void*)fwd_kernel, NWAVES * 64, LDS_BYTES) != hipSuccess || per_cu < 1) fprintf(stderr, "kernel_launch: occupancy query reports %d\n", per_cu);
        (void)hipGetLastError();
        grid = cus;
    }
    if (grid < 0) return;
    if (hipMemsetAsync((char*)d_ws + WS_CTL, 0, CTL_ZERO_BYTES, stream) != hipSuccess) return;
    Args a{};
    for (int i = 0; i < 25; ++i) a.in[i] = (const float*)d_in[i];
    a.out = (float*)d_out; a.ws = (unsigned char*)d_ws;
#ifndef MK_ONE_LAUNCH
#define MK_ONE_LAUNCH 0
#endif
    if (MK_ONE_LAUNCH) {
        a.ph_lo = 0; a.ph_hi = NTOT;
        hipLaunchKernelGGL(fwd_kernel, dim3(grid), dim3(NWAVES * 64), LDS_BYTES, stream, a);
    } else {
#ifndef LAST_PHASE
#define LAST_PHASE (NTOT - 1)
#endif
        for (int ph = 0; ph <= LAST_PHASE; ++ph) {
            const int p = ph % NPH, l = ph / NPH;
            if ((l == 1 && (p == 0 || p == 1)) || (l == 0 && p == 10)) continue;
            a.ph_lo = ph; a.ph_hi = ph + 1;
            hipLaunchKernelGGL(fwd_kernel, dim3(grid), dim3(NWAVES * 64), LDS_BYTES, stream, a);
        }
    }
#ifdef DUMP_OFF
    hipLaunchKernelGGL(dump_kernel, dim3(1024), dim3(256), 0, stream, (const bf16_t*)((const unsigned char*)d_ws + (size_t)(DUMP_OFF)), (int)(DUMP_PITCH), (float*)d_out);
#endif
    const hipError_t le = hipPeekAtLastError();
    if (le != hipSuccess) fprintf(stderr, "kernel_launch: launch failed: %s\n", hipGetErrorName(le));
}
```

```cpp
#define MK_ONE_LAUNCH 1
#include <hip/hip_runtime.h>
#include <cstdio>
#include <cstdint>
#include <type_traits>

#define GAS __attribute__((address_space(1)))
#define LAS __attribute__((address_space(3)))
typedef unsigned short bf16_t;
typedef float f32x2 __attribute__((ext_vector_type(2)));
typedef unsigned u32x2 __attribute__((ext_vector_type(2)));
typedef GAS unsigned gu32;
#define RLX_AGENT __ATOMIC_RELAXED, __HIP_MEMORY_SCOPE_AGENT
#define LDS_WAIT() asm volatile("s_waitcnt lgkmcnt(0)" ::: "memory")
#define VM_WAIT() asm volatile("s_waitcnt vmcnt(0)" ::: "memory")

constexpr int DM = 1024, NB = 4, SEQ = 4096, CTXL = 256, NLAT = NB * SEQ, NCTX = NB * CTXL, R = NLAT + NCTX;
constexpr int PROJW = 8704, DFF = 2816, NEXP = 8, DFE = 3584, NMOD = 6 * DM;
constexpr int MOE_ROWS_MAX = (2 * NLAT / 256 + NEXP) * 256;
constexpr float NORM_EPS = 1e-6f;

extern __shared__ __attribute__((aligned(16))) unsigned char lds_raw[];
constexpr int LDS_CTL_OFF = 159744, WAVE_TAB_OFF = LDS_CTL_OFF + 1024;
__device__ __forceinline__ int hw_wave_slot() { return (int)__builtin_amdgcn_s_getreg((7 << 11) | 4) & 255; }
__device__ __forceinline__ int opaque_tid() {
    const int wv = *(const __attribute__((address_space(3))) int*)((__attribute__((address_space(3))) unsigned char*)lds_raw + WAVE_TAB_OFF + 4 * hw_wave_slot());
    int t = (wv << 6) | (int)__builtin_amdgcn_mbcnt_hi(~0u, __builtin_amdgcn_mbcnt_lo(~0u, 0u));
    asm volatile("" : "+v"(t)); return t; }
#ifndef PG8_ASM_STAGE
#define PG8_ASM_STAGE 1
#endif
namespace pg8 {
#define PG8_LAS __attribute__((address_space(3)))
typedef unsigned short bf16_t;
typedef short bf16x8 __attribute__((ext_vector_type(8)));
typedef float f32x4 __attribute__((ext_vector_type(4)));
typedef unsigned u32x4 __attribute__((ext_vector_type(4)));
constexpr int BM = 256, BK = 64, HALF = 128, HTB = HALF * BK * 2  , STAGE_BYTES = 8 * HTB, NXCD = 8, WGM = 8;

__host__ __device__ __forceinline__ int lds_byte(int r, int c) { const int st = (r >> 4) * 2 + (c >> 5), rr = r & 15, cc = c & 31, ob = rr * 64 + cc * 2; return st * 1024 + (ob ^ (((ob >> 9) & 1) << 5)); }
__host__ __device__ __forceinline__ void stage_rc(int b, int& R, int& C) { const int st = b / 1024, sb = b % 1024, swz = sb ^ (((sb >> 9) & 1) << 5); R = (st >> 1) * 16 + swz / 64; C = (st & 1) * 32 + (swz % 64) / 2; }
__host__ __device__ __forceinline__ int perm32(int rho) { const int n = rho >> 4, i = rho & 15; return 8 * (i >> 2) + 4 * n + (i & 3); }

struct Unit { int pm, pn, pb, pa; };
struct Gemm { const bf16_t* A; const bf16_t* Bt; int M, N, K; };

struct StaticOrder {
    int nM, nN, nwg, G, c, nfull;
    __host__ __device__ void init(int M, int N, int G_, int c_) { nM = M / BM; nN = N / BM; nwg = nM * nN; G = G_; c = c_; const int rem = nwg % G; nfull = (rem != 0 && rem * 4 <= G && nwg > G) ? nwg - rem : nwg; }
    __host__ __device__ void at(int L, Unit& u) const {
        int wgid = L; { const int q = nwg / NXCD, r = nwg % NXCD, xcd = wgid % NXCD, off = wgid / NXCD; wgid = (xcd < r ? xcd * (q + 1) : r * (q + 1) + (xcd - r) * q) + off; }
        const int nig = WGM * nN, gid = wgid / nig, fm = gid * WGM, gsz = (nM - fm) < WGM ? (nM - fm) : WGM;
        u.pm = fm + ((wgid % nig) % gsz); u.pn = (wgid % nig) / gsz; u.pb = u.pn; u.pa = u.pm;
    }
    __host__ __device__ bool next(int i, Unit& u) const { const long L = (long)i * G + c; if (L >= nfull) return false; at((int)L, u); return true; }
    __device__ __forceinline__ void a_ready(const Unit&) const {}
    __device__ __forceinline__ void done(const Unit&) const {}
};

template <class Epi, class Sched, bool ALIGN_EPI = false, bool SP2 = false, bool FP8 = false>
__device__ __forceinline__ void gemm_phase(PG8_LAS unsigned char* lds, const Gemm g, const Sched& S, const Epi& E) {
    const int tid = opaque_tid(), wid = __builtin_amdgcn_readfirstlane(tid >> 6), lane = tid & 63, wr = wid >> 2, wc = wid & 3, fr = lane & 15, fq = lane >> 4;
    const int K = g.K, RB = FP8 ? K : 2 * K  , nt = RB / (2 * BK);
    unsigned voffA[2], voffB[2];
#pragma unroll
    for (int i = 0; i < 2; ++i) { int R, C; stage_rc(tid * 16 + i * 8192, R, C); const int Rb = Epi::PERM ? ((R & ~31) + perm32(R & 31)) : R;
        voffA[i] = (unsigned)(R * RB + C * 2); voffB[i] = (unsigned)(Rb * RB + C * 2); }
    const size_t kstep = (size_t)(BK * 2);
    const size_t hstep = (size_t)HALF * RB;
    const size_t tstep = 2 * hstep;
    const unsigned ldsw = (unsigned)wid * 1024u;
    const int aoff = lds_byte(wr * 64 + fr, fq * 8), boff = lds_byte(wc * 32 + fr, fq * 8);
#define PG8_SA(b, h) (((b) * 2 + (h)) * HTB)
#define PG8_SB(b, h) ((4 + (b) * 2 + (h)) * HTB)
#define PG8_STAGE(bufoff, gbase, voff) do { _Pragma("unroll") for (int _i = 0; _i < 2; ++_i) { \
        if constexpr (FP8 || PG8_ASM_STAGE) { unsigned keep_; asm volatile("s_mov_b32 %0, m0\n\ts_mov_b32 m0, %3\n\ts_nop 0\n\tglobal_load_lds_dwordx4 %1, %2\n\ts_mov_b32 m0, %0" : "=&s"(keep_) : "v"((voff)[_i]), "s"((const char*)(gbase)), "s"((unsigned)(size_t)(lds + (bufoff) + ldsw + _i * 8192)) : "memory"); } \
        else __builtin_amdgcn_global_load_lds((const unsigned*)((const char*)(gbase) + (voff)[_i]), (PG8_LAS unsigned*)(lds + (bufoff) + ldsw + _i * 8192), 16, 0, 0); } } while (0)
#define PG8_LDA(dst, b, h) do { _Pragma("unroll") for (int m = 0; m < 4; ++m) { \
        if constexpr (FP8) { const v4i_t lo_ = *(const PG8_LAS v4i_t*)(lds + PG8_SA(b, h) + aoff + m * 2048), hi_ = *(const PG8_LAS v4i_t*)(lds + PG8_SA(b, h) + aoff + m * 2048 + 1024); dst[m] = __builtin_shufflevector(lo_, hi_, 0, 1, 2, 3, 4, 5, 6, 7); } \
        else { _Pragma("unroll") for (int k = 0; k < 2; ++k) dst[m].k[k] = *(const PG8_LAS bf16x8*)(lds + PG8_SA(b, h) + aoff + m * 2048 + k * 1024); } } } while (0)
#define PG8_LDB(dst, b, h) do { _Pragma("unroll") for (int n = 0; n < 2; ++n) { \
        if constexpr (FP8) { const v4i_t lo_ = *(const PG8_LAS v4i_t*)(lds + PG8_SB(b, h) + boff + n * 2048), hi_ = *(const PG8_LAS v4i_t*)(lds + PG8_SB(b, h) + boff + n * 2048 + 1024); dst[n] = __builtin_shufflevector(lo_, hi_, 0, 1, 2, 3, 4, 5, 6, 7); } \
        else { _Pragma("unroll") for (int k = 0; k < 2; ++k) dst[n].k[k] = *(const PG8_LAS bf16x8*)(lds + PG8_SB(b, h) + boff + n * 2048 + k * 1024); } } } while (0)
#define PG8_MMA(ai, bj, At, Bt) do { __builtin_amdgcn_s_setprio(1); \
        if constexpr (FP8) { _Pragma("unroll") for (int m = 0; m < 4; ++m) _Pragma("unroll") for (int n = 0; n < 2; ++n) \
            asm volatile("v_mfma_scale_f32_16x16x128_f8f6f4 %0, %1, %2, %0, %3, %3 op_sel_hi:[0,0,0]" : "+v"(acc[ai][bj][m][n]) : "v"(Bt[n]), "v"(At[m]), "v"(sclv)); } \
        else { _Pragma("unroll") for (int m = 0; m < 4; ++m) _Pragma("unroll") for (int n = 0; n < 2; ++n) _Pragma("unroll") for (int k = 0; k < 2; ++k) \
        acc[ai][bj][m][n] = __builtin_amdgcn_mfma_f32_16x16x32_bf16(Bt[n].k[k], At[m].k[k], acc[ai][bj][m][n], 0, 0, 0); } __builtin_amdgcn_s_setprio(0); } while (0)
#define PG8_WAIT_V(n) asm volatile("s_waitcnt vmcnt(" #n ")" ::: "memory")
#define PG8_WAIT_L(n) asm volatile("s_waitcnt lgkmcnt(" #n ")" ::: "memory")
#define PG8_BAR __builtin_amdgcn_s_barrier()
#define PG8_SCHED __builtin_amdgcn_sched_barrier(0)
    Unit cur, nxt; int ui = 0;
    if (!S.next(0, cur)) return;
    f32x4 acc[2][2][4][2];
#pragma unroll
    for (int a = 0; a < 2; ++a)
#pragma unroll
        for (int b = 0; b < 2; ++b)
#pragma unroll
            for (int m = 0; m < 4; ++m)
#pragma unroll
                for (int n = 0; n < 2; ++n) acc[a][b][m][n] = (f32x4){0.f, 0.f, 0.f, 0.f};
    struct Frag2 { bf16x8 k[2]; }; typedef int v8i_t __attribute__((ext_vector_type(8))); typedef int v4i_t __attribute__((ext_vector_type(4)));
    typename std::conditional<FP8, v8i_t, Frag2>::type At[4], B0[2], B1[2]; const int sclv = 0x7F7F7F7F; (void)sclv;
    const char* cA = (const char*)g.A + (size_t)cur.pa * tstep; const char* cB = (const char*)g.Bt + (size_t)cur.pb * tstep;
    S.a_ready(cur);
    if constexpr (SP2) {
        PG8_STAGE(PG8_SB(0, 0), cB, voffB); PG8_STAGE(PG8_SB(0, 1), cB + hstep, voffB); PG8_STAGE(PG8_SA(0, 0), cA, voffA); PG8_STAGE(PG8_SA(0, 1), cA + hstep, voffA);
        if (wr == 1) PG8_BAR;
        PG8_WAIT_V(2); PG8_BAR;
        PG8_STAGE(PG8_SB(1, 0), cB + kstep, voffB); PG8_STAGE(PG8_SA(1, 0), cA + kstep, voffA); PG8_STAGE(PG8_SB(1, 1), cB + hstep + kstep, voffB);
        PG8_WAIT_V(6); PG8_BAR;
    } else {
        PG8_STAGE(PG8_SB(0, 0), cB, voffB); PG8_STAGE(PG8_SA(0, 0), cA, voffA); PG8_STAGE(PG8_SB(0, 1), cB + hstep, voffB); PG8_STAGE(PG8_SA(0, 1), cA + hstep, voffA);
        if (wr == 1) PG8_BAR;
        PG8_WAIT_V(4); PG8_BAR;
        PG8_STAGE(PG8_SB(1, 0), cB + kstep, voffB); PG8_STAGE(PG8_SA(1, 0), cA + kstep, voffA); PG8_STAGE(PG8_SB(1, 1), cB + hstep + kstep, voffB);
        PG8_WAIT_V(6); PG8_BAR;
    }
    for (;;) {
        const bool has_next = S.next(ui + 1, nxt);
        const char* nA = has_next ? (const char*)g.A + (size_t)nxt.pa * tstep : cA; const char* nB = has_next ? (const char*)g.Bt + (size_t)nxt.pb * tstep : cB;
#pragma unroll 1
        for (int t = 0; t < nt; t += 2) {
            const bool last = (t == nt - 2);
            const char* a1 = cA + (size_t)(t + 1) * kstep;
            const char* a2 = last ? nA : cA + (size_t)(t + 2) * kstep; const char* b2 = last ? nB : cB + (size_t)(t + 2) * kstep;
            const char* a3 = a2 + kstep; const char* b3 = b2 + kstep;
            if (last && has_next) S.a_ready(nxt);
            if constexpr (SP2) {
            PG8_LDB(B0, 0, 0); PG8_LDB(B1, 0, 1); PG8_SCHED; PG8_LDA(At, 0, 0); PG8_STAGE(PG8_SA(1, 1), a1 + hstep, voffA);
            PG8_WAIT_V(8); PG8_WAIT_L(0); PG8_BAR; PG8_MMA(0, 0, At, B0); PG8_MMA(0, 1, At, B1); PG8_BAR; PG8_SCHED;
            PG8_LDA(At, 0, 1); PG8_STAGE(PG8_SB(0, 0), b2, voffB); PG8_STAGE(PG8_SB(0, 1), b2 + hstep, voffB); PG8_STAGE(PG8_SA(0, 0), a2, voffA);
            PG8_WAIT_V(8); PG8_WAIT_L(0); PG8_BAR; PG8_MMA(1, 0, At, B0); PG8_MMA(1, 1, At, B1); PG8_BAR; PG8_SCHED;
            PG8_LDB(B0, 1, 0); PG8_LDB(B1, 1, 1); PG8_SCHED; PG8_LDA(At, 1, 0); PG8_STAGE(PG8_SA(0, 1), a2 + hstep, voffA);
            PG8_WAIT_V(8); PG8_WAIT_L(0); PG8_BAR; PG8_MMA(0, 0, At, B0); PG8_MMA(0, 1, At, B1); PG8_BAR; PG8_SCHED;
            PG8_LDA(At, 1, 1); PG8_STAGE(PG8_SB(1, 0), b3, voffB); PG8_STAGE(PG8_SB(1, 1), b3 + hstep, voffB); PG8_STAGE(PG8_SA(1, 0), a3, voffA);
            PG8_WAIT_V(8); PG8_WAIT_L(0); PG8_BAR; PG8_MMA(1, 0, At, B0); PG8_MMA(1, 1, At, B1); PG8_BAR; PG8_SCHED;
            } else {
            PG8_LDB(B0, 0, 0); PG8_SCHED; PG8_LDA(At, 0, 0); PG8_STAGE(PG8_SA(1, 1), a1 + hstep, voffA);
            PG8_WAIT_L(8); PG8_BAR; PG8_WAIT_L(0); PG8_MMA(0, 0, At, B0); PG8_BAR; PG8_SCHED;
            PG8_LDB(B1, 0, 1); PG8_STAGE(PG8_SB(0, 0), b2, voffB);
            PG8_BAR; PG8_WAIT_L(0); PG8_MMA(0, 1, At, B1); PG8_BAR;
            PG8_LDA(At, 0, 1); PG8_STAGE(PG8_SA(0, 0), a2, voffA);
            PG8_BAR; PG8_WAIT_L(0); PG8_MMA(1, 0, At, B0); PG8_BAR; PG8_SCHED;
            PG8_STAGE(PG8_SB(0, 1), b2 + hstep, voffB);
            PG8_WAIT_V(6); PG8_BAR; PG8_MMA(1, 1, At, B1); PG8_BAR;
            PG8_LDB(B0, 1, 0); PG8_SCHED; PG8_LDA(At, 1, 0); PG8_STAGE(PG8_SA(0, 1), a2 + hstep, voffA);
            PG8_WAIT_L(8); PG8_BAR; PG8_WAIT_L(0); PG8_MMA(0, 0, At, B0); PG8_BAR; PG8_SCHED;
            PG8_LDB(B1, 1, 1); PG8_STAGE(PG8_SB(1, 0), b3, voffB);
            PG8_BAR; PG8_WAIT_L(0); PG8_MMA(0, 1, At, B1); PG8_BAR;
            PG8_LDA(At, 1, 1); PG8_STAGE(PG8_SA(1, 0), a3, voffA);
            PG8_BAR; PG8_WAIT_L(0); PG8_MMA(1, 0, At, B0); PG8_BAR; PG8_SCHED;
            PG8_STAGE(PG8_SB(1, 1), b3 + hstep, voffB);
            PG8_WAIT_V(6); PG8_BAR; PG8_MMA(1, 1, At, B1); PG8_BAR;
            }
        }
        if constexpr (ALIGN_EPI) { if (wr == 0) PG8_BAR; }
        if constexpr (FP8) asm volatile("s_nop 15\n\ts_nop 15" ::: "memory");
        if constexpr (!Epi::AFTER_DRAIN) { E(acc, cur, wr, wc, fr, fq); S.done(cur); }
        if (!has_next) break;
#pragma unroll
        for (int a = 0; a < 2; ++a)
#pragma unroll
            for (int b = 0; b < 2; ++b)
#pragma unroll
                for (int m = 0; m < 4; ++m)
#pragma unroll
                    for (int n = 0; n < 2; ++n) acc[a][b][m][n] = (f32x4){0.f, 0.f, 0.f, 0.f};
        cur = nxt; cA = nA; cB = nB; ++ui;
        if constexpr (ALIGN_EPI) { if (wr == 1) PG8_BAR; }
    }
    PG8_WAIT_V(0);
    if constexpr (!ALIGN_EPI) { if (wr == 0) PG8_BAR; }
    PG8_BAR;
    if constexpr (Epi::AFTER_DRAIN) { E.fused(acc, cur, wr, wc, fr, fq, lds, wid, lane); S.done(cur); }
#undef PG8_SA
#undef PG8_SB
#undef PG8_STAGE
#undef PG8_LDA
#undef PG8_LDB
#undef PG8_MMA
#undef PG8_WAIT_V
#undef PG8_WAIT_L
#undef PG8_BAR
#undef PG8_SCHED
}
}

using pg8::f32x4; using pg8::u32x4; using pg8::bf16x8; using pg8::Unit;
typedef __bf16 bf16x2_t __attribute__((ext_vector_type(2)));
__device__ __forceinline__ unsigned pk_bf16(float lo, float hi) { const f32x2 v = {lo, hi}; const bf16x2_t b = __builtin_convertvector(v, bf16x2_t); return __builtin_bit_cast(unsigned, b); }
__device__ __forceinline__ float bf_lo(unsigned u) { return __uint_as_float(u << 16); }
__device__ __forceinline__ float bf_hi(unsigned u) { return __uint_as_float(u & 0xffff0000u); }
typedef _Float16 h2_t __attribute__((ext_vector_type(2)));
__device__ __forceinline__ unsigned pk_f16(float lo, float hi) { h2_t h = {(_Float16)lo, (_Float16)hi}; return __builtin_bit_cast(unsigned, h); }
__device__ __forceinline__ f32x2 unpk_f16(unsigned u) { h2_t h = __builtin_bit_cast(h2_t, u); return (f32x2){(float)h.x, (float)h.y}; }
__device__ __forceinline__ float sigm(float x) { return __builtin_amdgcn_rcpf(1.f + __expf(-x)); }
__device__ __forceinline__ float silu_f(float x) { return x * sigm(x); }
__device__ __forceinline__ u32x4 pack8(const f32x4 a, const f32x4 b) { u32x4 w; w.x = pk_bf16(a[0], a[1]); w.y = pk_bf16(a[2], a[3]); w.z = pk_bf16(b[0], b[1]); w.w = pk_bf16(b[2], b[3]); return w; }
__device__ __forceinline__ void unpack8(const u32x4 w, f32x4& a, f32x4& b) { a = (f32x4){bf_lo(w.x), bf_hi(w.x), bf_lo(w.y), bf_hi(w.y)}; b = (f32x4){bf_lo(w.z), bf_hi(w.z), bf_lo(w.w), bf_hi(w.w)}; }

__device__ __forceinline__ void sigm8(const f32x4 a, const f32x4 b, f32x4& sa, f32x4& sb) {
    f32x4 ea, eb;
#pragma unroll
    for (int j = 0; j < 4; ++j) { ea[j] = __builtin_amdgcn_exp2f(a[j] * -1.4426950408889634f); eb[j] = __builtin_amdgcn_exp2f(b[j] * -1.4426950408889634f); }
#pragma unroll
    for (int j = 0; j < 4; ++j) { sa[j] = __builtin_amdgcn_rcpf(1.f + ea[j]); sb[j] = __builtin_amdgcn_rcpf(1.f + eb[j]); }
}
#ifndef EPI_NT
#define EPI_NT 0
#endif
#ifndef EPI_SC1
#define EPI_SC1 0
#endif
__device__ __forceinline__ void st16(void* p, u32x4 v) { if (EPI_SC1) *(volatile GAS u32x4*)p = v; else if (EPI_NT) __builtin_nontemporal_store(v, (u32x4*)p); else *(u32x4*)p = v; }
__device__ __forceinline__ void st8(void* p, u32x2 v) { if (EPI_SC1) *(volatile GAS u32x2*)p = v; else if (EPI_NT) __builtin_nontemporal_store(v, (u32x2*)p); else *(u32x2*)p = v; }
__device__ __forceinline__ float clamp448(float x) { return fminf(fmaxf(x, -448.f), 448.f); }
__device__ __forceinline__ unsigned pk4_fp8(float a, float b, float c, float d) { int w = 0; w = __builtin_amdgcn_cvt_pk_fp8_f32(clamp448(a), clamp448(b), w, false); w = __builtin_amdgcn_cvt_pk_fp8_f32(clamp448(c), clamp448(d), w, true); return (unsigned)w; }


struct EpiProj {
    static constexpr bool PERM = true, AFTER_DRAIN = false;
    bf16_t* proj; const float* lbv; int probe = 0;
    template <int MODE> __device__ __forceinline__ void emit(const f32x4 (&acc)[2][2][4][2], bf16_t* base, int ldc, const float* lbp) const {
        f32x4 lb[2][2];
        if (MODE == 3) {
#pragma unroll
            for (int bj = 0; bj < 2; ++bj)
#pragma unroll
                for (int n = 0; n < 2; ++n) lb[bj][n] = *(const f32x4*)(lbp + bj * 128 + 4 * n);
        }
#pragma unroll
        for (int ai = 0; ai < 2; ++ai)
#pragma unroll
            for (int m = 0; m < 4; ++m) { bf16_t* rowp = base + (size_t)(ai * 128 + m * 16) * ldc;
#pragma unroll
                for (int bj = 0; bj < 2; ++bj) { f32x4 v[2] = {acc[ai][bj][m][0], acc[ai][bj][m][1]}; u32x4 w;
                    if (MODE == 0) w = pack8(v[0], v[1]);
                    else { f32x4 s0, s1; sigm8(v[0], v[1], s0, s1);
                        if (MODE == 1) w = pack8(v[0] * s0, v[1] * s1);
                        else if (MODE == 2) w = pack8(s0, s1);
                        else { const f32x4 f0 = lb[bj][0] + (1.f - lb[bj][0]) * s0, f1 = lb[bj][1] + (1.f - lb[bj][1]) * s1; f32x4 g0, g1;
#pragma unroll
                            for (int j = 0; j < 4; ++j) { g0[j] = __builtin_amdgcn_logf(f0[j]); g1[j] = __builtin_amdgcn_logf(f1[j]); }
#pragma unroll
                            for (int j = 0; j < 4; ++j) { g0[j] = fmaxf(g0[j], -57.f); g1[j] = fmaxf(g1[j], -57.f); }
                            w.x = pk_f16(g0[0], g0[1]); w.y = pk_f16(g0[2], g0[3]); w.z = pk_f16(g1[0], g1[1]); w.w = pk_f16(g1[2], g1[3]); } }
                    st16(rowp + bj * 128, w); } }
    }
    __device__ __forceinline__ void operator()(const f32x4 (&acc)[2][2][4][2], const Unit& u, int wr, int wc, int fr, int fq) const {
        const int pn = u.pn; int seg, ct;
        if (pn < 4) { seg = 0; ct = pn; } else if (pn < 6) { seg = pn - 3; ct = 0; } else { seg = 3 + ((pn - 6) >> 2); ct = (pn - 6) & 3; }
        const size_t segoff = (seg == 0) ? (size_t)0 : (seg == 1) ? (size_t)R * 1024 : (seg == 2) ? (size_t)R * 1280 : (size_t)R * (size_t)(1536 + 1024 * (seg - 3));
        const int ldc = (seg == 1 || seg == 2) ? 256 : 1024;
        const int mode = (seg == 3 || seg == 7) ? 1 : (seg == 8 || seg == 9) ? 2 : (seg == 4 || seg == 5) ? 3 : 0;
        const int row0 = u.pm * 256 + wr * 64 + fr, col0 = ct * 256 + wc * 32 + 8 * fq;
        bf16_t* base = probe ? proj + (size_t)(wr * 64 + fr) * ldc + col0 : proj + segoff + (size_t)row0 * ldc + col0;
        if (mode == 0) emit<0>(acc, base, ldc, nullptr);
        else if (mode == 1) emit<1>(acc, base, ldc, nullptr);
        else if (mode == 2) emit<2>(acc, base, ldc, nullptr);
        else emit<3>(acc, base, ldc, lbv + col0);
    }
    __device__ __forceinline__ void put8(const Unit& u, int rt, int ctl, f32x4 v0, f32x4 v1) const {
        const int pn = u.pn; int seg, ct;
        if (pn < 4) { seg = 0; ct = pn; } else if (pn < 6) { seg = pn - 3; ct = 0; } else { seg = 3 + ((pn - 6) >> 2); ct = (pn - 6) & 3; }
        const size_t segoff = (seg == 0) ? (size_t)0 : (seg == 1) ? (size_t)R * 1024 : (seg == 2) ? (size_t)R * 1280 : (size_t)R * (size_t)(1536 + 1024 * (seg - 3));
        const int ldc = (seg == 1 || seg == 2) ? 256 : 1024;
        const int mode = (seg == 3 || seg == 7) ? 1 : (seg == 8 || seg == 9) ? 2 : (seg == 4 || seg == 5) ? 3 : 0;
        const int col = ct * 256 + ctl;
        u32x4 w;
        if (mode == 3) { const f32x4 l0 = *(const f32x4*)(lbv + col), l1 = *(const f32x4*)(lbv + col + 4); float g[8];
#pragma unroll
            for (int j = 0; j < 4; ++j) { g[j] = fmaxf(__builtin_amdgcn_logf(l0[j] + (1.f - l0[j]) * sigm(v0[j])), -57.f); g[4 + j] = fmaxf(__builtin_amdgcn_logf(l1[j] + (1.f - l1[j]) * sigm(v1[j])), -57.f); }
            w.x = pk_f16(g[0], g[1]); w.y = pk_f16(g[2], g[3]); w.z = pk_f16(g[4], g[5]); w.w = pk_f16(g[6], g[7]);
        } else {
#pragma unroll
            for (int j = 0; j < 4; ++j) { if (mode == 1) { v0[j] = silu_f(v0[j]); v1[j] = silu_f(v1[j]); } if (mode == 2) { v0[j] = sigm(v0[j]); v1[j] = sigm(v1[j]); } }
            w = pack8(v0, v1);
        }
        *(u32x4*)(proj + segoff + (size_t)(u.pm * 256 + rt) * ldc + col) = w;
    }
};
struct EpiSwiGLU {
    static constexpr bool PERM = true, AFTER_DRAIN = false;
    bf16_t* O; int ldc;
    __device__ __forceinline__ void operator()(const f32x4 (&acc)[2][2][4][2], const Unit& u, int wr, int wc, int fr, int fq) const {
        bf16_t* base = O + (size_t)(u.pm * 256 + wr * 64 + fr) * ldc + u.pn * 128 + wc * 32 + 8 * fq;
#pragma unroll
        for (int ai = 0; ai < 2; ++ai)
#pragma unroll
            for (int m = 0; m < 4; ++m) { f32x4 s0, s1; sigm8(acc[ai][0][m][0], acc[ai][0][m][1], s0, s1);
                st16(base + (size_t)(ai * 128 + m * 16) * ldc, pack8(acc[ai][0][m][0] * s0 * acc[ai][1][m][0], acc[ai][0][m][1] * s1 * acc[ai][1][m][1])); }
    }
    __device__ __forceinline__ void put8(const Unit&, int, int, f32x4, f32x4) const {}
};
struct EpiSwiGLU8 {
    static constexpr bool PERM = true, AFTER_DRAIN = false;
    unsigned char* O; int ldc;
    __device__ __forceinline__ void operator()(const f32x4 (&acc)[2][2][4][2], const Unit& u, int wr, int wc, int fr, int fq) const {
        unsigned char* base = O + (size_t)(u.pm * 256 + wr * 64 + fr) * ldc + u.pn * 128 + wc * 32 + 8 * fq;
#pragma unroll
        for (int ai = 0; ai < 2; ++ai)
#pragma unroll
            for (int m = 0; m < 4; ++m) { const f32x4 g0 = acc[ai][0][m][0] * 0.015625f, g1 = acc[ai][0][m][1] * 0.015625f; f32x4 s0, s1; sigm8(g0, g1, s0, s1);
                const f32x4 h0 = g0 * s0 * (acc[ai][1][m][0] * 0.015625f), h1 = g1 * s1 * (acc[ai][1][m][1] * 0.015625f);
                st8(base + (size_t)(ai * 128 + m * 16) * ldc, (u32x2){pk4_fp8(h0[0], h0[1], h0[2], h0[3]), pk4_fp8(h1[0], h1[1], h1[2], h1[3])}); }
    }
    __device__ __forceinline__ void put8(const Unit&, int, int, f32x4, f32x4) const {}
};
template <bool HAS_ADD> struct EpiGate {
    static constexpr bool PERM = true, AFTER_DRAIN = false;
    bf16_t* G; const bf16_t* ADD;
    __device__ __forceinline__ void operator()(const f32x4 (&acc)[2][2][4][2], const Unit& u, int wr, int wc, int fr, int fq) const {
        const size_t off0 = (size_t)(u.pm * 256 + wr * 64 + fr) * 1024 + u.pn * 256 + wc * 32 + 8 * fq;
#pragma unroll
        for (int ai = 0; ai < 2; ++ai) {
            u32x4 gv[4][2], av[4][2];
#pragma unroll
            for (int m = 0; m < 4; ++m)
#pragma unroll
                for (int bj = 0; bj < 2; ++bj) { const size_t off = off0 + (size_t)(ai * 128 + m * 16) * 1024 + bj * 128;
                    gv[m][bj] = *(const u32x4*)(G + off); if (HAS_ADD) av[m][bj] = *(const u32x4*)(ADD + off); }
#pragma unroll
            for (int m = 0; m < 4; ++m)
#pragma unroll
                for (int bj = 0; bj < 2; ++bj) { const size_t off = off0 + (size_t)(ai * 128 + m * 16) * 1024 + bj * 128;
                    f32x4 g0, g1; unpack8(gv[m][bj], g0, g1);
                    f32x4 o0 = g0 * acc[ai][bj][m][0], o1 = g1 * acc[ai][bj][m][1];
                    if (HAS_ADD) { f32x4 a0, a1; unpack8(av[m][bj], a0, a1); o0 += a0; o1 += a1; }
                    st16(G + off, pack8(o0, o1)); }
        }
    }
    __device__ __forceinline__ void put8(const Unit& u, int rt, int ctl, f32x4 v0, f32x4 v1) const {
        const size_t off = (size_t)(u.pm * 256 + rt) * 1024 + u.pn * 256 + ctl;
        f32x4 g0, g1; unpack8(*(const u32x4*)(G + off), g0, g1);
        f32x4 o0 = g0 * v0, o1 = g1 * v1;
        if (HAS_ADD) { f32x4 a0, a1; unpack8(*(const u32x4*)(ADD + off), a0, a1); o0 += a0; o1 += a1; }
        *(u32x4*)(G + off) = pack8(o0, o1);
    }
};
struct EpiPlain {
    static constexpr bool PERM = true, AFTER_DRAIN = false;
    bf16_t* O; int ldc; float scale = 1.f;
    __device__ __forceinline__ void operator()(const f32x4 (&acc)[2][2][4][2], const Unit& u, int wr, int wc, int fr, int fq) const {
        bf16_t* base = O + (size_t)(u.pm * 256 + wr * 64 + fr) * ldc + u.pn * 256 + wc * 32 + 8 * fq;
#pragma unroll
        for (int ai = 0; ai < 2; ++ai)
#pragma unroll
            for (int m = 0; m < 4; ++m)
#pragma unroll
                for (int bj = 0; bj < 2; ++bj) st16(base + (size_t)(ai * 128 + m * 16) * ldc + bj * 128, pack8(acc[ai][bj][m][0] * scale, acc[ai][bj][m][1] * scale));
    }
    __device__ __forceinline__ void put8(const Unit& u, int rt, int ctl, f32x4 v0, f32x4 v1) const {
        *(u32x4*)(O + (size_t)(u.pm * 256 + rt) * ldc + u.pn * 256 + ctl) = pack8(v0 * scale, v1 * scale);
    }
};
struct EpiNull {
    static constexpr bool PERM = true, AFTER_DRAIN = false;
    __device__ __forceinline__ void operator()(const f32x4 (&acc)[2][2][4][2], const Unit& u, int wr, int wc, int fr, int fq) const {
#pragma unroll
        for (int a = 0; a < 2; ++a)
#pragma unroll
            for (int b = 0; b < 2; ++b)
#pragma unroll
                for (int m = 0; m < 4; ++m) asm volatile("" :: "v"(acc[a][b][m][0]), "v"(acc[a][b][m][1])); }
    __device__ __forceinline__ void put8(const Unit&, int, int, f32x4, f32x4) const {}
};
struct MoeOrder {
    int nb[NEXP]; int nN, G, c, nwg, nfull, acap = 0;
    __device__ __forceinline__ void finish() { int t = 0;
#pragma unroll
        for (int e = 0; e < NEXP; ++e) t += nb[e] * nN;
        nwg = t; const int rem = t % G; nfull = (rem != 0 && rem * 4 <= G && t > G) ? t - rem : t; }
    __device__ __forceinline__ bool at(int L, Unit& u) const {
        int accu = 0, pbase = 0; bool found = false;
#pragma unroll
        for (int e = 0; e < NEXP; ++e) { const int ue = nb[e] * nN;
            if (!found && L < accu + ue) { const int loc = L - accu; const int q = loc / nb[e]; u.pn = q; u.pm = pbase + (loc - q * nb[e]); u.pb = e * nN + q; u.pa = acap ? e * acap + (loc - q * nb[e]) : u.pm; found = true; }
            accu += ue; pbase += nb[e]; }
        return found;
    }
    __device__ __forceinline__ bool next(int i, Unit& u) const { const int L = i * G + c; if (L >= nfull) return false; return at(L, u); }
    __device__ __forceinline__ void a_ready(const Unit&) const {}
    __device__ __forceinline__ void done(const Unit&) const {}
};

template <class Epi, class Sched>
__device__ __forceinline__ void gemm_mini(const pg8::Gemm g, const Sched& S, const Epi& E, int wgi, int nwgs) {
    const int nbig = S.nwg - S.nfull; if (nbig <= 0) return;
    const int tid = opaque_tid(), w = __builtin_amdgcn_readfirstlane(tid >> 6), lane = tid & 63, r = lane & 15, q4 = lane >> 4;
    const int wm = w >> 1, wn = w & 1; const int K = g.K;
    for (int m = wgi; m < nbig * 16; m += nwgs) {
        Unit u; S.at(S.nfull + (m >> 4), u); const int sub = m & 15, rt = (sub >> 2) * 64 + wm * 16 + r, ct = (sub & 3) * 64 + wn * 32;
        const bf16_t* ap = g.A + ((size_t)u.pm * 256 + rt) * K + 8 * q4;
        const bf16_t* bp0 = g.Bt + ((size_t)u.pb * 256 + ct + 8 * (r >> 2) + (r & 3)) * K + 8 * q4;
        const bf16_t* bp1 = bp0 + (size_t)4 * K;
        f32x4 c0 = (f32x4){0.f, 0.f, 0.f, 0.f}, c1 = (f32x4){0.f, 0.f, 0.f, 0.f};
        for (int ks = 0; ks < K / 32; ks += 8) {
            bf16x8 a[8], b0[8], b1[8];
#pragma unroll
            for (int i = 0; i < 8; ++i) { a[i] = *(const bf16x8*)(ap + 32 * (ks + i)); b0[i] = *(const bf16x8*)(bp0 + 32 * (ks + i)); b1[i] = *(const bf16x8*)(bp1 + 32 * (ks + i)); }
#pragma unroll
            for (int i = 0; i < 8; ++i) { c0 = __builtin_amdgcn_mfma_f32_16x16x32_bf16(b0[i], a[i], c0, 0, 0, 0); c1 = __builtin_amdgcn_mfma_f32_16x16x32_bf16(b1[i], a[i], c1, 0, 0, 0); }
        }
        E.put8(u, rt, ct + 8 * q4, c0, c1);
    }
}
template <class Epi, class Sched>
__device__ __forceinline__ void gemm_mini_ks(LAS unsigned char* lds, const pg8::Gemm g, const Sched& S, const Epi& E, int wgi, int nwgs) {
    const int nbig = S.nwg - S.nfull; if (nbig <= 0) return;
    constexpr int K = DM, PP = 68; static_assert(K / 32 == 32, "four K-steps per wave");
    const int tid = opaque_tid(), w = __builtin_amdgcn_readfirstlane(tid >> 6), lane = tid & 63, r = lane & 15, q4 = lane >> 4;
    LAS float* part = (LAS float*)lds + w * 64 * PP;
    __syncthreads();
    for (int m = wgi; m < nbig * 16; m += nwgs) {
        Unit u; S.at(S.nfull + (m >> 4), u); const int sub = m & 15, rt0 = (sub >> 2) * 64, ct0 = (sub & 3) * 64;
        const bf16_t* ap = g.A + ((size_t)u.pm * 256 + rt0) * K + (r * K + 8 * q4);
        const bf16_t* bp = g.Bt + ((size_t)u.pb * 256 + ct0) * K + (r * K + 8 * q4);
        f32x4 acc[4][4];
#pragma unroll
        for (int i = 0; i < 4; ++i)
#pragma unroll
            for (int j = 0; j < 4; ++j) acc[i][j] = (f32x4){0.f, 0.f, 0.f, 0.f};
        bf16x8 fa[2][4], fb[2][4];
#define MK_LOAD(s_, ks_) do { _Pragma("unroll") for (int t = 0; t < 4; ++t) { fa[s_][t] = *(const bf16x8*)(ap + (size_t)16 * t * K + 32 * (ks_)); fb[s_][t] = *(const bf16x8*)(bp + (size_t)16 * t * K + 32 * (ks_)); } } while (0)
#define MK_MMA(s_) do { _Pragma("unroll") for (int tm = 0; tm < 4; ++tm) _Pragma("unroll") for (int tn = 0; tn < 4; ++tn)                      \
            acc[tm][tn] = __builtin_amdgcn_mfma_f32_16x16x32_bf16(fb[s_][tn], fa[s_][tm], acc[tm][tn], 0, 0, 0); } while (0)
        MK_LOAD(0, w); MK_LOAD(1, w + 8);
        MK_MMA(0); MK_LOAD(0, w + 16);
        MK_MMA(1); MK_LOAD(1, w + 24);
        MK_MMA(0); MK_MMA(1);
#undef MK_LOAD
#undef MK_MMA
#pragma unroll
        for (int tm = 0; tm < 4; ++tm)
#pragma unroll
            for (int tn = 0; tn < 4; ++tn) *(LAS f32x4*)(part + (16 * tm + r) * PP + 16 * tn + 4 * q4) = acc[tm][tn];
        __syncthreads();
        { const int row = tid >> 3, cg = tid & 7; f32x4 v0 = (f32x4){0.f, 0.f, 0.f, 0.f}, v1 = v0;
#pragma unroll
          for (int ww = 0; ww < 8; ++ww) { const LAS float* p = (const LAS float*)lds + ww * 64 * PP + row * PP + 8 * cg; v0 += *(const LAS f32x4*)p; v1 += *(const LAS f32x4*)(p + 4); }
          E.put8(u, rt0 + row, ct0 + 8 * cg, v0, v1); }
        __syncthreads();
    }
}
template <int K, class Epi, class Sched>
__device__ __forceinline__ void gemm_mini8(LAS unsigned char* lds, const unsigned char* Ag, const unsigned char* Bg, const Sched& S, const Epi& E, int wgi, int nwgs) {
    const int nbig = S.nwg - S.nfull; if (nbig <= 0) return;
    typedef int v8i_t __attribute__((ext_vector_type(8))); typedef int v4i_t __attribute__((ext_vector_type(4)));
    const int tid = opaque_tid(), w = __builtin_amdgcn_readfirstlane(tid >> 6), lane = tid & 63, r = lane & 15, q4 = lane >> 4;
    const int sclv = 0x7F7F7F7F; constexpr int nks = K / 128; constexpr int PP = 68;
    LAS float* part = (LAS float*)lds + w * 64 * PP;
    __syncthreads();
    for (int m = wgi; m < nbig * 16; m += nwgs) {
        Unit u; S.at(S.nfull + (m >> 4), u); const int sub = m & 15, rt0 = (sub >> 2) * 64, ct0 = (sub & 3) * 64;
        const unsigned char* ap = Ag + ((size_t)u.pm * 256 + rt0) * K + (r * K + 32 * q4);
        const unsigned char* bp = Bg + ((size_t)u.pb * 256 + ct0) * K + (r * K + 32 * q4);
        f32x4 acc[4][4];
#pragma unroll
        for (int i = 0; i < 4; ++i)
#pragma unroll
            for (int j = 0; j < 4; ++j) acc[i][j] = (f32x4){0.f, 0.f, 0.f, 0.f};
        v8i_t fa[2][4], fb[4];
#define M8_LDA(s_, ks_) do { const size_t o = (size_t)128 * (ks_); _Pragma("unroll") for (int t = 0; t < 4; ++t) {                                    \
            const v4i_t al = *(const v4i_t*)(ap + (size_t)16 * t * K + o), ah = *(const v4i_t*)(ap + (size_t)16 * t * K + o + 16);                          \
            fa[s_][t] = __builtin_shufflevector(al, ah, 0, 1, 2, 3, 4, 5, 6, 7); } } while (0)
#define M8_LDB(ks_) do { const size_t o = (size_t)128 * (ks_); _Pragma("unroll") for (int t = 0; t < 4; ++t) {                                         \
            const v4i_t bl = *(const v4i_t*)(bp + (size_t)16 * t * K + o), bh = *(const v4i_t*)(bp + (size_t)16 * t * K + o + 16);                          \
            fb[t] = __builtin_shufflevector(bl, bh, 0, 1, 2, 3, 4, 5, 6, 7); } } while (0)
#define M8_MMA(s_) do { _Pragma("unroll") for (int tm = 0; tm < 4; ++tm) _Pragma("unroll") for (int tn = 0; tn < 4; ++tn)                                 \
            asm volatile("v_mfma_scale_f32_16x16x128_f8f6f4 %0, %1, %2, %0, %3, %3 op_sel_hi:[0,0,0]" : "+v"(acc[tm][tn]) : "v"(fb[tn]), "v"(fa[s_][tm]), "v"(sclv)); } while (0)
        const int k0 = w, k1 = w + 8, k2 = w + 16, k3 = (w + 24 < nks) ? w + 24 : w + 16;
        M8_LDA(0, k0); M8_LDB(k0); M8_LDA(1, k1);
        M8_MMA(0); M8_LDB(k1); M8_LDA(0, k2);
        M8_MMA(1); M8_LDB(k2); M8_LDA(1, k3);
        M8_MMA(0); M8_LDB(k3);
        if (w + 24 < nks) M8_MMA(1);
#undef M8_LDA
#undef M8_LDB
#undef M8_MMA
        asm volatile("s_nop 15\n\ts_nop 15" ::: "memory");
#pragma unroll
        for (int tm = 0; tm < 4; ++tm)
#pragma unroll
            for (int tn = 0; tn < 4; ++tn) *(LAS f32x4*)(part + (16 * tm + r) * PP + 16 * tn + 4 * q4) = acc[tm][tn];
        __syncthreads();
        { const int row = tid >> 3, cg = tid & 7; f32x4 v0 = (f32x4){0.f, 0.f, 0.f, 0.f}, v1 = v0;
#pragma unroll
          for (int ww = 0; ww < 8; ++ww) { const LAS float* p = (const LAS float*)lds + ww * 64 * PP + row * PP + 8 * cg; v0 += *(const LAS f32x4*)p; v1 += *(const LAS f32x4*)(p + 4); }
          E.put8(u, rt0 + row, ct0 + 8 * cg, v0, v1); }
        __syncthreads();
    }
}

namespace att {
using s16x4  = __attribute__((ext_vector_type(4))) short;
using f32x16 = __attribute__((ext_vector_type(16))) float;
constexpr int   D = 128, NW = 8, QBLK = 32, KVBLK = 64;
constexpr float SCALE = 0.088388347648318440f;
constexpr float THR = 8.f;
constexpr int SHM_V = KVBLK * D * 2, SHM_K = KVBLK * D * 2, SHM_ATTN = 2 * SHM_V + 2 * SHM_K + NW * 64 * 4;
#define KSWZ(row, colB) ((row) * 256 + ((colB) ^ (((row) & 15) << 4)))
#define SBAR() __builtin_amdgcn_sched_barrier(0)
__device__ __forceinline__ int crow(int r, int hi) { return (r & 3) + 8 * (r >> 2) + 4 * hi; }
__device__ __forceinline__ unsigned cvtpk(float lo, float hi) { unsigned r; asm volatile("v_cvt_pk_bf16_f32 %0, %1, %2" : "=v"(r) : "v"(lo), "v"(hi)); return r; }
template <int VAR> __device__ __forceinline__ void partialSM(f32x16& p0, f32x16& p1, float& m_reg, float& mn, float& alpha) {
  constexpr float C = SCALE * 1.4426950408889634f;
  if constexpr (VAR == 1) { mn = m_reg; alpha = 1.f; return; }
  float pmax = p0[0];
#pragma unroll
  for (int r = 1; r < 16; ++r) pmax = fmaxf(pmax, p0[r]);
#pragma unroll
  for (int r = 0; r < 16; ++r) pmax = fmaxf(pmax, p1[r]);
  { auto rr = __builtin_amdgcn_permlane32_swap(__float_as_uint(pmax), __float_as_uint(pmax), false, false);
    pmax = fmaxf(__uint_as_float(rr[0]), __uint_as_float(rr[1])); }
  if (__builtin_expect(__all(pmax - m_reg <= THR / SCALE), 1)) { mn = m_reg; alpha = 1.f; }
  else { mn = fmaxf(m_reg, pmax); alpha = __builtin_amdgcn_exp2f((m_reg - mn) * C); m_reg = mn; }
  float mnC = -mn * C;
#pragma unroll
  for (int r = 0; r < 16; ++r) p0[r] = fmaf(p0[r], C, mnC);
#pragma unroll
  for (int r = 0; r < 16; ++r) p1[r] = fmaf(p1[r], C, mnC);
#pragma unroll
  for (int r = 0; r < 16; ++r) p0[r] = __builtin_amdgcn_exp2f(p0[r]);
}
template <int VAR> __device__ __forceinline__ void finishSM(f32x16& p0, f32x16& p1, float alpha, float& l_reg, bf16x8& pa0, bf16x8& pa1, bf16x8& pa2, bf16x8& pa3) {
  float ps = 0;
  if constexpr (VAR != 1) {
#pragma unroll
  for (int r = 0; r < 16; ++r) p1[r] = __builtin_amdgcn_exp2f(p1[r]);
#pragma unroll
  for (int r = 0; r < 16; ++r) ps += p0[r];
#pragma unroll
  for (int r = 0; r < 16; ++r) ps += p1[r]; }
  { auto rr = __builtin_amdgcn_permlane32_swap(__float_as_uint(ps), __float_as_uint(ps), false, false);
    ps = __uint_as_float(rr[0]) + __uint_as_float(rr[1]); }
  l_reg = l_reg * alpha + ps;
#define PK4(P, BASE, OUT) do { unsigned a0 = cvtpk(P[BASE + 0], P[BASE + 1]), a1 = cvtpk(P[BASE + 2], P[BASE + 3]);   \
    unsigned b0 = cvtpk(P[BASE + 4], P[BASE + 5]), b1 = cvtpk(P[BASE + 6], P[BASE + 7]);                              \
    auto r0 = __builtin_amdgcn_permlane32_swap(a0, b0, false, false); auto r1 = __builtin_amdgcn_permlane32_swap(a1, b1, false, false); \
    u32x4 w = {r0[0], r1[0], r0[1], r1[1]}; OUT = *reinterpret_cast<bf16x8*>(&w); } while (0)
  PK4(p0, 0, pa0); PK4(p0, 8, pa1); PK4(p1, 0, pa2); PK4(p1, 8, pa3);
#undef PK4
}
template <int VAR> __device__ __forceinline__ void qkt(f32x16& p0, f32x16& p1, const bf16_t* Ks, const bf16x8* qr, int r32, int hi) {
  p0 = f32x16{}; p1 = f32x16{};
#pragma unroll
  for (int d0 = 0; d0 < 8; ++d0) { int cb = (d0 * 16 + hi * 8) * 2;
    bf16x8 b0, b1; if constexpr (VAR == 2) { b0 = qr[d0]; b1 = qr[7 - d0]; } else {
    b0 = *reinterpret_cast<const bf16x8*>((const char*)Ks + KSWZ(r32, cb));
    b1 = *reinterpret_cast<const bf16x8*>((const char*)Ks + KSWZ(32 + r32, cb)); }
    p0 = __builtin_amdgcn_mfma_f32_32x32x16_bf16(b0, qr[d0], p0, 0, 0, 0);
    p1 = __builtin_amdgcn_mfma_f32_32x32x16_bf16(b1, qr[d0], p1, 0, 0, 0); }
}
__device__ __forceinline__ int v_st(int k, int c) { const int kk = (k & ~0xC) | ((k & 4) << 1) | ((k & 8) >> 1); return ((kk >> 3) * 4 + (c >> 5)) * 512 + ((kk & 7) * 32 + (c & 31)) * 2; }
__device__ __forceinline__ int v_rd_base(int lane) { return ((lane & 3) << 3) | (((lane >> 2) & 3) << 6) | (((lane >> 4) & 1) << 5) | (((lane >> 5) & 1) << 8); }
constexpr int v_rd_off(int d0, int ks, int half) { return d0 * 512 + ks * 4096 + half * 2048; }
template <int OFF> __device__ __forceinline__ s16x4 tr_read(int vb) {
  s16x4 r; asm volatile("ds_read_b64_tr_b16 %0, %1 offset:%2" : "=&v"(r) : "v"(vb), "i"(OFF) : "memory"); return r;
}
template <int VAR, int D0> __device__ __forceinline__ void pv_one(f32x16& od, int vb, bf16x8 pa0, bf16x8 pa1, bf16x8 pa2, bf16x8 pa3) {
  if constexpr (VAR == 4) { od = __builtin_amdgcn_mfma_f32_32x32x16_bf16(pa0, pa1, od, 0, 0, 0); od = __builtin_amdgcn_mfma_f32_32x32x16_bf16(pa1, pa2, od, 0, 0, 0); od = __builtin_amdgcn_mfma_f32_32x32x16_bf16(pa2, pa3, od, 0, 0, 0); od = __builtin_amdgcn_mfma_f32_32x32x16_bf16(pa3, pa0, od, 0, 0, 0); return; }
  const s16x4 l0 = tr_read<v_rd_off(D0, 0, 0)>(vb), h0 = tr_read<v_rd_off(D0, 0, 1)>(vb), l1 = tr_read<v_rd_off(D0, 1, 0)>(vb), h1 = tr_read<v_rd_off(D0, 1, 1)>(vb);
  const s16x4 l2 = tr_read<v_rd_off(D0, 2, 0)>(vb), h2 = tr_read<v_rd_off(D0, 2, 1)>(vb), l3 = tr_read<v_rd_off(D0, 3, 0)>(vb), h3 = tr_read<v_rd_off(D0, 3, 1)>(vb);
  asm volatile("s_waitcnt lgkmcnt(0)" ::: "memory"); SBAR();
#define PK(L, H) (bf16x8){L[0], L[1], L[2], L[3], H[0], H[1], H[2], H[3]}
  od = __builtin_amdgcn_mfma_f32_32x32x16_bf16(pa0, PK(l0, h0), od, 0, 0, 0);
  od = __builtin_amdgcn_mfma_f32_32x32x16_bf16(pa1, PK(l1, h1), od, 0, 0, 0);
  od = __builtin_amdgcn_mfma_f32_32x32x16_bf16(pa2, PK(l2, h2), od, 0, 0, 0);
  od = __builtin_amdgcn_mfma_f32_32x32x16_bf16(pa3, PK(l3, h3), od, 0, 0, 0);
#undef PK
}
template <int VAR> __device__ __forceinline__ void pv_d0(f32x16* o, int vb, bf16x8 pa0, bf16x8 pa1, bf16x8 pa2, bf16x8 pa3) {
  pv_one<VAR, 0>(o[0], vb, pa0, pa1, pa2, pa3); pv_one<VAR, 1>(o[1], vb, pa0, pa1, pa2, pa3); pv_one<VAR, 2>(o[2], vb, pa0, pa1, pa2, pa3); pv_one<VAR, 3>(o[3], vb, pa0, pa1, pa2, pa3);
}
template <int LDQ, int LDK, int LDO, int VAR = 0>
__device__ __forceinline__ void attn_dense_body(const bf16_t* Qb, const bf16_t* __restrict__ Kh, const bf16_t* __restrict__ Vh,
                                                bf16_t* Ob, int seq, int nlat, int ctxoff, char* lds, const float* qgain, const float* cosT, const float* sinT, int t0, bool rope) {
  const int tid = opaque_tid(), wid = tid >> 6, lane = tid & 63, r32 = lane & 31, hi = lane >> 5;
  bf16_t* V_lds = (bf16_t*)lds; bf16_t* K_lds = (bf16_t*)(lds + 2 * SHM_V);
  float* ws = (float*)(lds + 2 * SHM_V + 2 * SHM_K) + wid * 64; float* li_l = ws; float* al_l = ws + 32;
  float m_reg = -1e30f, l_reg = 0; f32x16 o[4] = {}; bf16x8 qr[8];
  const bf16_t* Qw = Qb + (wid * QBLK + r32) * LDQ + hi * 8;
#pragma unroll 1
  for (int rep_ = 0; rep_ < (VAR == 8 ? 2 : 1); ++rep_) {
  asm volatile("" ::: "memory");
#pragma unroll
  for (int d0 = 0; d0 < 8; ++d0) qr[d0] = *reinterpret_cast<const bf16x8*>(Qw + d0 * 16);
  {
    float v[8][8]; float ss = 0.f;
#pragma unroll
    for (int d0 = 0; d0 < 8; ++d0) { const u32x4 w = *reinterpret_cast<const u32x4*>(&qr[d0]);
      v[d0][0] = bf_lo(w.x); v[d0][1] = bf_hi(w.x); v[d0][2] = bf_lo(w.y); v[d0][3] = bf_hi(w.y); v[d0][4] = bf_lo(w.z); v[d0][5] = bf_hi(w.z); v[d0][6] = bf_lo(w.w); v[d0][7] = bf_hi(w.w);
#pragma unroll
      for (int e = 0; e < 8; ++e) ss += v[d0][e] * v[d0][e]; }
    { auto rr = __builtin_amdgcn_permlane32_swap(__float_as_uint(ss), __float_as_uint(ss), false, false); ss = __uint_as_float(rr[0]) + __uint_as_float(rr[1]); }
    const float rstd = rsqrtf(ss * (1.f / 128.f) + 1e-6f);
#pragma unroll
    for (int d0 = 0; d0 < 8; ++d0) { const f32x4 g0 = *reinterpret_cast<const f32x4*>(qgain + d0 * 16 + hi * 8), g1 = *reinterpret_cast<const f32x4*>(qgain + d0 * 16 + hi * 8 + 4);
#pragma unroll
      for (int e = 0; e < 4; ++e) { v[d0][e] *= rstd * g0[e]; v[d0][4 + e] *= rstd * g1[e]; } }
    if (rope) { const float* cs = cosT + (size_t)(t0 + wid * QBLK + r32) * 64 + hi * 8; const float* sn = sinT + (size_t)(t0 + wid * QBLK + r32) * 64 + hi * 8;
#pragma unroll
      for (int d0 = 0; d0 < 4; ++d0) { const f32x4 c0 = *reinterpret_cast<const f32x4*>(cs + d0 * 16), c1 = *reinterpret_cast<const f32x4*>(cs + d0 * 16 + 4), s0 = *reinterpret_cast<const f32x4*>(sn + d0 * 16), s1 = *reinterpret_cast<const f32x4*>(sn + d0 * 16 + 4);
#pragma unroll
        for (int e = 0; e < 8; ++e) { const float c = e < 4 ? c0[e & 3] : c1[e & 3], sv = e < 4 ? s0[e & 3] : s1[e & 3]; const float lo = v[d0][e], hh = v[d0 + 4][e]; v[d0][e] = lo * c - hh * sv; v[d0 + 4][e] = hh * c + lo * sv; } } }
#pragma unroll
    for (int d0 = 0; d0 < 8; ++d0) { const u32x4 w = {cvtpk(v[d0][0], v[d0][1]), cvtpk(v[d0][2], v[d0][3]), cvtpk(v[d0][4], v[d0][5]), cvtpk(v[d0][6], v[d0][7])}; qr[d0] = *reinterpret_cast<const bf16x8*>(&w); }
  }
  }
  const int sr = tid >> 4, sc = (tid & 15) * 8, vst0 = v_st(sr, sc), vst1 = v_st(32 + sr, sc);
  const int vb0 = (int)(uintptr_t)V_lds + v_rd_base(lane);
  struct { bf16x8 vs0, vs1, ks0, ks1; } sr_[2];
#define KROW(k0) ((k0) + (((k0) >= nlat) ? ctxoff : 0))
#define SLOAD(i, k0) do { const int kr_ = KROW(k0); sr_[i].vs0 = *reinterpret_cast<const bf16x8*>(&Vh[(kr_ + sr) * LDK + sc]); sr_[i].vs1 = *reinterpret_cast<const bf16x8*>(&Vh[(kr_ + 32 + sr) * LDK + sc]); \
    sr_[i].ks0 = *reinterpret_cast<const bf16x8*>(&Kh[(kr_ + sr) * LDK + sc]); sr_[i].ks1 = *reinterpret_cast<const bf16x8*>(&Kh[(kr_ + 32 + sr) * LDK + sc]); } while (0)
#define SWRITE(b, i) do { *(bf16x8*)((char*)V_lds + (b) * SHM_V + vst0) = sr_[i].vs0;          \
    *(bf16x8*)((char*)V_lds + (b) * SHM_V + vst1) = sr_[i].vs1; int kc = sc * 2;               \
    *(bf16x8*)((char*)K_lds + (b) * SHM_K + KSWZ(sr, kc)) = sr_[i].ks0;                       \
    *(bf16x8*)((char*)K_lds + (b) * SHM_K + KSWZ(32 + sr, kc)) = sr_[i].ks1; } while (0)
#define SWAIT() asm volatile("s_waitcnt vmcnt(4)" ::: "memory")
#define RESC(a) do { if (__any((a) < 1.f)) { if (hi == 0) al_l[r32] = (a); asm volatile("s_waitcnt lgkmcnt(0)" ::: "memory"); \
    _Pragma("unroll") for (int d = 0; d < 4; ++d) _Pragma("unroll") for (int r = 0; r < 16; ++r) o[d][r] *= al_l[crow(r, hi)]; } } while (0)
#define ATT_SYNC() do { if (VAR != 3 && VAR != 5) __syncthreads(); } while (0)
  f32x16 pA0, pA1, pB0, pB1; float mnA, mnB, alA, alB; bf16x8 pa0, pa1, pa2, pa3; const int NT = seq / KVBLK;
  constexpr int SE = 0, SO = 1;
  SLOAD(SE, 0); asm volatile("s_waitcnt vmcnt(0)" ::: "memory"); SWRITE(0, SE); ATT_SYNC();
  qkt<VAR>(pA0, pA1, K_lds, qr, r32, hi); partialSM<VAR>(pA0, pA1, m_reg, mnA, alA);
  SLOAD(SO, KVBLK); if (2 < NT) SLOAD(SE, 2 * KVBLK);
  if (VAR != 3) { SWAIT(); SWRITE(1, SO); } ATT_SYNC();
  for (int j = 1; j + 1 < NT; j += 2) {
    SBAR(); qkt<VAR>(pB0, pB1, (bf16_t*)((char*)K_lds + SHM_K), qr, r32, hi);
    finishSM<VAR>(pA0, pA1, alA, l_reg, pa0, pa1, pa2, pa3); SBAR();
    if (VAR != 3 && VAR != 6) SLOAD(SO, (j + 2) * KVBLK); SBAR();
    pv_d0<VAR>(o, vb0, pa0, pa1, pa2, pa3); partialSM<VAR>(pB0, pB1, m_reg, mnB, alB);
    ATT_SYNC(); if (VAR != 3 && VAR != 6) { SWAIT(); SWRITE(0, SE); }
    RESC(alB); ATT_SYNC();
    SBAR(); qkt<VAR>(pA0, pA1, K_lds, qr, r32, hi);
    finishSM<VAR>(pB0, pB1, alB, l_reg, pa0, pa1, pa2, pa3); SBAR();
    if (VAR != 3 && VAR != 6 && j + 3 < NT) SLOAD(SE, (j + 3) * KVBLK); SBAR();
    pv_d0<VAR>(o, vb0 + (int)SHM_V, pa0, pa1, pa2, pa3); partialSM<VAR>(pA0, pA1, m_reg, mnA, alA);
    ATT_SYNC(); if (VAR != 3 && VAR != 6) { SWAIT(); SWRITE(1, SO); }
    RESC(alA); ATT_SYNC();
  }
  SBAR(); qkt<VAR>(pB0, pB1, (bf16_t*)((char*)K_lds + SHM_K), qr, r32, hi);
  finishSM<VAR>(pA0, pA1, alA, l_reg, pa0, pa1, pa2, pa3); SBAR();
  pv_d0<VAR>(o, vb0, pa0, pa1, pa2, pa3); partialSM<VAR>(pB0, pB1, m_reg, mnB, alB);
  ATT_SYNC(); RESC(alB);
  finishSM<VAR>(pB0, pB1, alB, l_reg, pa0, pa1, pa2, pa3); SBAR();
  pv_d0<VAR>(o, vb0 + (int)SHM_V, pa0, pa1, pa2, pa3);
#undef ATT_SYNC
  if (hi == 0) li_l[r32] = l_reg; asm volatile("s_waitcnt lgkmcnt(0)" ::: "memory");
  float rli[16];
#pragma unroll
  for (int r = 0; r < 16; ++r) rli[r] = __builtin_amdgcn_rcpf(li_l[crow(r, hi)]);
  bf16_t* Ow = Ob + (wid * QBLK) * LDO;
#pragma unroll
  for (int r = 0; r < 16; ++r) { int orow = crow(r, hi);
#pragma unroll
    for (int d0 = 0; d0 < 4; ++d0) { const __bf16 hb = (__bf16)(o[d0][r] * rli[r]); if constexpr (VAR == 7) { const bf16_t keep_ = __builtin_bit_cast(bf16_t, hb); asm volatile("" :: "v"(keep_)); } else Ow[orow * LDO + d0 * 32 + r32] = __builtin_bit_cast(bf16_t, hb); } }
  asm volatile("s_waitcnt vmcnt(0)" ::: "memory");
  __syncthreads();
#undef KROW
#undef SLOAD
#undef SWRITE
#undef SWAIT
#undef RESC
}
}

namespace scan {
#ifndef SCAN_XOR
#define SCAN_XOR 1
#endif
#if SCAN_XOR
constexpr int TS = 256, CS = 144;
#else
constexpr int TS = 272, CS = 144;
#endif
constexpr int I_QT = 0, I_KT = I_QT + 64 * TS, I_KH = I_KT + 64 * TS, I_VT = I_KH + 128 * CS, I_AV = I_VT + 32 * CS, IMG = I_AV + 512;
constexpr int OFF_ST = 2 * IMG, LDS_SCAN = OFF_ST + 2 * 32 * TS;
static_assert(LDS_SCAN <= LDS_CTL_OFF, "scan LDS");
#define SCAN_BAR() do { asm volatile("s_waitcnt lgkmcnt(0) ; SCANBAR" ::: "memory"); __builtin_amdgcn_s_barrier(); asm volatile("; SCANBAR_END" ::: "memory"); } while (0)
__device__ __forceinline__ float ex2(float x) { return __builtin_amdgcn_exp2f(x); }
typedef unsigned u32x2l __attribute__((ext_vector_type(2)));

__device__ __forceinline__ void scan_unit(LAS unsigned char* lds, const bf16_t* HQ, const bf16_t* G, const bf16_t* HV, bf16_t* O, int b, int h, int bwd, int dvs, bool store_ctx) {
    const int tid = opaque_tid(), w = __builtin_amdgcn_readfirstlane(tid >> 6), lane = tid & 63, r = lane & 15, q4 = lane >> 4;
    const long sgn = bwd ? -1 : 1;
#define SCAN_RB(cc_) (((cc_) < 4) ? (bwd ? (long)(NLAT + b * CTXL + CTXL - 1 - 64 * (cc_)) : (long)(NLAT + b * CTXL + 64 * (cc_))) \
                                  : (bwd ? (long)(b * SEQ + SEQ - 1 - 64 * ((cc_) - 4)) : (long)(b * SEQ + 64 * ((cc_) - 4))))
    for (int i = tid; i < 32 * TS / 4; i += 512) ((LAS unsigned*)(lds + OFF_ST))[i] = 0u;
    if (w < 4) {
#ifndef SCAN_E_PRIO
#define SCAN_E_PRIO 0
#endif
        __builtin_amdgcn_s_setprio(SCAN_E_PRIO);
        const int cp = lane & 15, tg = lane >> 4, et = w * 64 + lane, vtok = et >> 2, vdg = et & 3;
        const size_t colq = (size_t)h * 128 + 32 * w + 2 * cp, colv = (size_t)h * 128 + dvs * 32 + 8 * vdg;
        unsigned graw0[16], qraw0[16], graw1[16], qraw1[16]; u32x4 vraw0, vraw1;
        const unsigned lo_ = (unsigned)((bwd ? 63 - 16 * tg : 16 * tg) * 2048) + (unsigned)colq * 2u;
        const unsigned lov_ = (unsigned)((bwd ? 63 - vtok : vtok) * 2048) + (unsigned)colv * 2u;
#define SCAN_LOAD(cc_, graw, qraw, vraw) do { const long rb_ = SCAN_RB(cc_); const long r0_ = bwd ? rb_ - 63 : rb_; \
        const GAS char* gB_ = (const GAS char*)G + (size_t)r0_ * 2048; const GAS char* qB_ = (const GAS char*)HQ + (size_t)r0_ * 2048; \
        _Pragma("unroll") for (int j = 0; j < 16; ++j) { const long dj_ = (long)(bwd ? -j : j) * 2048; const GAS char* gj_ = gB_ + dj_; const GAS char* qj_ = qB_ + dj_; asm volatile("" : "+s"(gj_), "+s"(qj_)); \
            graw[j] = *(const GAS unsigned*)(gj_ + lo_); qraw[j] = *(const GAS unsigned*)(qj_ + lo_); } \
        vraw = *(const GAS u32x4*)((const GAS char*)HV + (size_t)r0_ * 2048 + lov_); } while (0)
#define SCAN_IMAGE(cc, graw, qraw, vraw) do { \
        LAS unsigned char* img = lds + ((cc) & 1) * IMG; \
        f32x2 cs[16]; f32x2 run = {0.f, 0.f}; \
        _Pragma("unroll") for (int j = 0; j < 16; ++j) { run += unpk_f16(graw[j]); cs[j] = run; } \
        f32x2 inc = run; \
        { f32x2 y; y.x = __shfl_up(inc.x, 16); y.y = __shfl_up(inc.y, 16); if (lane >= 16) inc += y; \
          y.x = __shfl_up(inc.x, 32); y.y = __shfl_up(inc.y, 32); if (lane >= 32) inc += y; } \
        const f32x2 off = inc - run; \
        f32x2 all; all.x = __shfl(inc.x, 48 + cp); all.y = __shfl(inc.y, 48 + cp); \
        f32x2 ekp; ekp.x = ex2(fminf(-off.x, 115.f)); ekp.y = ex2(fminf(-off.y, 115.f)); \
        const f32x2 eall = {ex2(all.x), ex2(all.y)}; \
        unsigned w_kh[2][8]; \
        _Pragma("unroll") for (int j = 0; j < 16; ++j) { \
            const f32x2 q = {bf_lo(qraw[j]), bf_hi(qraw[j])}; \
            const f32x2 c = cs[j] + off; \
            f32x2 eq, ek; eq.x = ex2(c.x); eq.y = ex2(c.y); ek.x = ex2(fminf(-c.x, 115.f)); ek.y = ex2(fminf(-c.y, 115.f)); \
            const f32x2 k = 1.f - eq * ekp;        \
            ekp = ek; \
            const f32x2 qt = q * eq, kt = k * ek, kh = kt * eall; \
            const int tb = (16 * tg + j) * TS + (SCAN_XOR ? (((32 * w + 2 * cp) * 2) ^ (j << 4)) : ((32 * w + 2 * cp) * 2)); \
            *(LAS unsigned*)(img + I_QT + tb) = pk_bf16(qt.x, qt.y); *(LAS unsigned*)(img + I_KT + tb) = pk_bf16(kt.x, kt.y); \
            if ((j & 1) == 0) { w_kh[0][j >> 1] = __float_as_uint(kh.x); w_kh[1][j >> 1] = __float_as_uint(kh.y); } \
            else { w_kh[0][j >> 1] = pk_bf16(__uint_as_float(w_kh[0][j >> 1]), kh.x); w_kh[1][j >> 1] = pk_bf16(__uint_as_float(w_kh[1][j >> 1]), kh.y); } \
        } \
        _Pragma("unroll") for (int c2 = 0; c2 < 2; ++c2) { LAS unsigned char* kp = img + I_KH + (32 * w + 2 * cp + c2) * CS + 32 * tg; \
            *(LAS u32x4*)kp = (u32x4){w_kh[c2][0], w_kh[c2][1], w_kh[c2][2], w_kh[c2][3]}; *(LAS u32x4*)(kp + 16) = (u32x4){w_kh[c2][4], w_kh[c2][5], w_kh[c2][6], w_kh[c2][7]}; } \
        if (tg == 0) *(LAS f32x2*)(img + I_AV + (32 * w + 2 * cp) * 4) = eall; \
        { LAS bf16_t* vt = (LAS bf16_t*)(img + I_VT) + vtok; const unsigned vv[4] = {vraw.x, vraw.y, vraw.z, vraw.w}; \
          _Pragma("unroll") for (int e = 0; e < 4; ++e) { vt[(8 * vdg + 2 * e) * (CS / 2)] = (bf16_t)(vv[e] & 0xffffu); vt[(8 * vdg + 2 * e + 1) * (CS / 2)] = (bf16_t)(vv[e] >> 16); } } \
    } while (0)
        SCAN_LOAD(0, graw0, qraw0, vraw0); SCAN_LOAD(1, graw1, qraw1, vraw1);
        SCAN_IMAGE(0, graw0, qraw0, vraw0); SCAN_LOAD(2, graw0, qraw0, vraw0);
        SCAN_BAR();
        for (int c2 = 0; c2 < 68; c2 += 2) {
            SCAN_IMAGE(c2 + 1, graw1, qraw1, vraw1); if (c2 + 3 < 68) SCAN_LOAD(c2 + 3, graw1, qraw1, vraw1);
            SCAN_BAR();
            if (c2 + 2 < 68) { SCAN_IMAGE(c2 + 2, graw0, qraw0, vraw0); if (c2 + 4 < 68) SCAN_LOAD(c2 + 4, graw0, qraw0, vraw0); }
            SCAN_BAR();
        }
#undef SCAN_LOAD
#undef SCAN_IMAGE
        __builtin_amdgcn_s_setprio(0);
    } else {
        const int it = w - 4;
        int xo[4];
#pragma unroll
        for (int ks = 0; ks < 4; ++ks) xo[ks] = SCAN_XOR ? (((4 * ks + q4) ^ r) << 4) : ((4 * ks + q4) << 4);
        f32x4 sacc[2][2];
#pragma unroll
        for (int a = 0; a < 2; ++a)
#pragma unroll
            for (int d2 = 0; d2 < 2; ++d2) sacc[a][d2] = (f32x4){0.f, 0.f, 0.f, 0.f};
        SCAN_BAR();
        for (int cc = 0; cc < 68; ++cc) {
            const LAS unsigned char* img = lds + (cc & 1) * IMG; const int cur = cc & 1, nxt = cur ^ 1; const long rb = SCAN_RB(cc);
            bf16x8 qb[4];
#pragma unroll
            for (int ks = 0; ks < 4; ++ks) qb[ks] = *(const LAS bf16x8*)(img + I_QT + (16 * it + r) * TS + xo[ks]);
            f32x4 s4[4];
#pragma unroll
            for (int jt = 0; jt < 4; ++jt) { s4[jt] = (f32x4){0.f, 0.f, 0.f, 0.f};
                if (jt <= it) { bf16x8 ka[4];
#pragma unroll
                    for (int ks = 0; ks < 4; ++ks) ka[ks] = *(const LAS bf16x8*)(img + I_KT + (16 * jt + r) * TS + xo[ks]);
#pragma unroll
                    for (int ks = 0; ks < 4; ++ks) s4[jt] = __builtin_amdgcn_mfma_f32_16x16x32_bf16(ka[ks], qb[ks], s4[jt], 0, 0, 0);
                    if (jt == it) {
#pragma unroll
                        for (int e = 0; e < 4; ++e) if (4 * q4 + e > r) s4[jt][e] = 0.f;
                    } } }
            const u32x4 p01 = {pk_bf16(s4[0][0], s4[0][1]), pk_bf16(s4[0][2], s4[0][3]), pk_bf16(s4[1][0], s4[1][1]), pk_bf16(s4[1][2], s4[1][3])};
            const u32x4 p23 = {pk_bf16(s4[2][0], s4[2][1]), pk_bf16(s4[2][2], s4[2][3]), pk_bf16(s4[3][0], s4[3][1]), pk_bf16(s4[3][2], s4[3][3])};
#pragma unroll
            for (int dvt = 0; dvt < 2; ++dvt) {
                const LAS unsigned char* vrow = img + I_VT + (16 * dvt + r) * CS + 8 * q4;
                const u32x2l va0 = *(const LAS u32x2l*)(vrow), va1 = *(const LAS u32x2l*)(vrow + 32), va2 = *(const LAS u32x2l*)(vrow + 64), va3 = *(const LAS u32x2l*)(vrow + 96);
                bf16x8 sa[4];
#pragma unroll
                for (int ks = 0; ks < 4; ++ks) sa[ks] = *(const LAS bf16x8*)(lds + OFF_ST + cur * 32 * TS + (16 * dvt + r) * TS + xo[ks]);
                f32x4 o4 = (f32x4){0.f, 0.f, 0.f, 0.f}, o5 = (f32x4){0.f, 0.f, 0.f, 0.f};
                { const u32x4 a01 = {va0.x, va0.y, va1.x, va1.y}; o4 = __builtin_amdgcn_mfma_f32_16x16x32_bf16(__builtin_bit_cast(bf16x8, a01), __builtin_bit_cast(bf16x8, p01), o4, 0, 0, 0); }
                if (it >= 2) { const u32x4 a23 = {va2.x, va2.y, va3.x, va3.y}; o4 = __builtin_amdgcn_mfma_f32_16x16x32_bf16(__builtin_bit_cast(bf16x8, a23), __builtin_bit_cast(bf16x8, p23), o4, 0, 0, 0); }
                o5 = __builtin_amdgcn_mfma_f32_16x16x32_bf16(sa[0], qb[0], o5, 0, 0, 0); o5 = __builtin_amdgcn_mfma_f32_16x16x32_bf16(sa[1], qb[1], o5, 0, 0, 0);
                o4 = __builtin_amdgcn_mfma_f32_16x16x32_bf16(sa[2], qb[2], o4, 0, 0, 0); o5 = __builtin_amdgcn_mfma_f32_16x16x32_bf16(sa[3], qb[3], o5, 0, 0, 0);
                o4 += o5;
                if (store_ctx || cc >= 4) { const long row = rb + sgn * (16 * it + r);
                    *(u32x2*)(O + (size_t)row * 1024 + h * 128 + dvs * 32 + 16 * dvt + 4 * q4) = (u32x2){pk_bf16(o4[0], o4[1]), pk_bf16(o4[2], o4[3])}; }
            }
            {
                bf16x8 vb[2][2];
#pragma unroll
                for (int ks = 0; ks < 2; ++ks) { vb[0][ks] = *(const LAS bf16x8*)(img + I_VT + r * CS + (32 * ks + 8 * q4) * 2); vb[1][ks] = *(const LAS bf16x8*)(img + I_VT + (16 + r) * CS + (32 * ks + 8 * q4) * 2); }
#pragma unroll
                for (int a = 0; a < 2; ++a) { const int dt = 2 * it + a;
                    const f32x4 a4 = *(const LAS f32x4*)(img + I_AV + (16 * dt + 4 * q4) * 4);
                    const bf16x8 kh0 = *(const LAS bf16x8*)(img + I_KH + (16 * dt + r) * CS + (8 * q4) * 2), kh1 = *(const LAS bf16x8*)(img + I_KH + (16 * dt + r) * CS + (32 + 8 * q4) * 2);
#pragma unroll
                    for (int d2 = 0; d2 < 2; ++d2) { f32x4 s = sacc[a][d2] * a4;
                        s = __builtin_amdgcn_mfma_f32_16x16x32_bf16(kh0, vb[d2][0], s, 0, 0, 0); s = __builtin_amdgcn_mfma_f32_16x16x32_bf16(kh1, vb[d2][1], s, 0, 0, 0);
                        sacc[a][d2] = s;
                        *(LAS u32x2*)(lds + OFF_ST + nxt * 32 * TS + (16 * d2 + r) * TS + (SCAN_XOR ? ((((2 * dt + (q4 >> 1)) ^ r) << 4) | ((q4 & 1) << 3)) : ((16 * dt + 4 * q4) * 2))) = (u32x2){pk_bf16(s[0], s[1]), pk_bf16(s[2], s[3])}; } }
            }
            SCAN_BAR();
        }
    }
    VM_WAIT(); LDS_WAIT();
    __syncthreads();
#undef SCAN_RB
}
}

constexpr size_t MiB = 1u << 20;
constexpr size_t WS_CTL = 0, CTL_ZERO_BYTES = 64 * 1024;
constexpr int CW_TMO = 0, CW_BAR = 4096, CW_CNT = 8192;
constexpr size_t WS_MOD = 256 * 1024;
constexpr size_t WS_LBV = 512 * 1024;
constexpr size_t WS_WGB = 576 * 1024;
constexpr size_t WS_COS = 1 * MiB, WS_SIN = 2 * MiB;
constexpr size_t WS_ROUTE = 3 * MiB;
constexpr size_t WS_XCTX = 4 * MiB;
constexpr size_t WS_H = 8 * MiB;
constexpr size_t WS_W = 42 * MiB;
constexpr size_t WL_STRIDE = 23 * MiB, WL_IN = 0, WL_ATT = 17 * MiB, WL_HG = 19 * MiB, WL_OUT = 21 * MiB;
constexpr size_t WS_WGU = WS_W + 46 * MiB, WS_WD = WS_W + 57 * MiB;
constexpr size_t WS_OF = 105 * MiB, WS_OB = 139 * MiB;
constexpr size_t WS_PROJ = 173 * MiB;
constexpr int XB_CAP = 16384;
constexpr size_t WS_MGU = 462 * MiB, WS_MD = 518 * MiB, WS_YB = 105 * MiB, WS_HIDM = 173 * MiB, WS_XB = 292 * MiB, WS_END = 546 * MiB;
static_assert(WS_WD + (size_t)DM * DFF * 2 <= WS_OF && WS_OB + (size_t)R * DM * 2 <= WS_PROJ && WS_PROJ + (size_t)R * PROJW * 2 <= WS_MGU, "ws map");
static_assert(WS_MGU + (size_t)NEXP * 2 * DFE * DM <= WS_MD && WS_MD + (size_t)NEXP * DM * DFE <= WS_END && WS_YB + (size_t)MOE_ROWS_MAX * DM * 2 <= WS_HIDM && WS_HIDM + (size_t)MOE_ROWS_MAX * DFE <= WS_XB && WS_XB + (size_t)NEXP * XB_CAP * DM <= WS_MGU, "ws map (moe)");
constexpr size_t PQ = 0, PK = (size_t)R * 1024, PV = (size_t)R * 1280, PHQ = (size_t)R * 1536, PGF = (size_t)R * 2560, PGB = (size_t)R * 3584, PHV = (size_t)R * 4608, PHG = (size_t)R * 5632, PGA = (size_t)R * 6656, PGH = (size_t)R * 7680;

constexpr int RING_BYTES = 131072, MISC_OFF = LDS_CTL_OFF + 320, LDS_BYTES = 163840;
constexpr int NWAVES = 8;

#define XB_TMO      128
#define XB_XCNT(j)  (256  + 64 * (j))
#define XB_XSUB(j)  (1280 + 64 * (j))
#define XB_XGEN(j)  (2304 + 64 * (j))
#define XB_TOP      3328
#define XB_TOPGEN   3392
#define XCD_BAR_WORDS 3456
#define XB_SPIN_CAP (1u << 18)
__device__ __forceinline__ unsigned xb_ld(unsigned* p)              { return __hip_atomic_load(p, __ATOMIC_RELAXED, __HIP_MEMORY_SCOPE_AGENT); }
__device__ __forceinline__ unsigned xb_add(unsigned* p, unsigned v) { return __hip_atomic_fetch_add(p, v, __ATOMIC_RELAXED, __HIP_MEMORY_SCOPE_AGENT); }
__device__ __forceinline__ unsigned xb_xcc_id() { return (unsigned)__builtin_amdgcn_s_getreg((3 << 11) | 20) & 0xFu; }
#define XB_SPIN(cond, bar) do { unsigned _sp = 0; while (cond) { __builtin_amdgcn_s_sleep(1); \
    if ((++_sp & 255u) == 0u) { if (xb_ld(&(bar)[XB_TMO])) break; if (_sp > XB_SPIN_CAP) { atomicAdd(&(bar)[XB_TMO], 1u); break; } } } } while (0)
struct XcdBarrier { unsigned* bar; unsigned x; volatile LAS unsigned* st; };
__device__ __forceinline__ XcdBarrier xcd_barrier_post(unsigned* bar, volatile LAS unsigned* st) {
    XcdBarrier b; b.bar = bar; b.x = xb_xcc_id(); b.st = st;
    if (threadIdx.x == 0) (void)xb_add(&bar[XB_XCNT(b.x)], 1u);
    return b;
}
__device__ __forceinline__ void xcd_barrier_complete(unsigned* bar, unsigned x, unsigned& nloc, unsigned& nx) {
    const unsigned G = gridDim.x * gridDim.y * gridDim.z;
    unsigned sum, cnt, mine, sp = 0u;
    for (;;) {
        sum = 0u; cnt = 0u; mine = 0u;
#pragma unroll
        for (unsigned j = 0; j < 16; ++j) { const unsigned c = xb_ld(&bar[XB_XCNT(j)]); sum += c; cnt += (c > 0u) ? 1u : 0u; mine = (j == x) ? c : mine; }
        if (sum == G) break;
        __builtin_amdgcn_s_sleep(1);
        if ((++sp & 255u) == 0u) { if (xb_ld(&bar[XB_TMO])) break; if (sp > XB_SPIN_CAP) { atomicAdd(&bar[XB_TMO], 1u); break; } }
    }
    nloc = mine > 0u ? mine : 1u; nx = cnt > 0u ? cnt : 1u;
}
__device__ __forceinline__ void xcd_barrier(const XcdBarrier& b) {
    asm volatile("s_waitcnt vmcnt(0)" ::: "memory");
    __syncthreads();
    if (opaque_tid() == 0) {
        unsigned* bar = b.bar;
        __builtin_amdgcn_s_waitcnt(0);
        unsigned nloc = b.st[0], nx = b.st[1];
        if (nloc == 0u) { xcd_barrier_complete(bar, b.x, nloc, nx); b.st[0] = nloc; b.st[1] = nx; }
        const unsigned old = xb_add(&bar[XB_XSUB(b.x)], 1u);
        const unsigned gen = old / nloc;
        if (old + 1u == (gen + 1u) * nloc) {
            __builtin_amdgcn_fence(__ATOMIC_RELEASE, "agent");
            asm volatile("s_waitcnt vmcnt(0)" ::: "memory");
            const unsigned og = xb_add(&bar[XB_TOP], 1u);
            const unsigned tg = og / nx;
            if (og + 1u == (tg + 1u) * nx) xb_add(&bar[XB_TOPGEN], 1u);
            else XB_SPIN(xb_ld(&bar[XB_TOPGEN]) == tg, bar);
            __builtin_amdgcn_fence(__ATOMIC_ACQUIRE, "agent");
            xb_add(&bar[XB_XGEN(b.x)], 1u);
            asm volatile("s_waitcnt vmcnt(0)" ::: "memory");
        } else {
            XB_SPIN(xb_ld(&bar[XB_XGEN(b.x)]) == gen, bar);
            __builtin_amdgcn_fence(__ATOMIC_ACQUIRE, "agent");
            asm volatile("s_waitcnt vmcnt(0)" ::: "memory");
        }
    }
    __syncthreads();
}

__device__ __forceinline__ float wave_sum(float v) {
#pragma unroll
    for (int o = 1; o < 64; o <<= 1) v += __shfl_xor(v, o);
    return v;
}
struct Row16 { f32x4 v[4]; };
__device__ __forceinline__ Row16 ld_f32_row(const float* p, int lane) { Row16 r;
#pragma unroll
    for (int j = 0; j < 4; ++j) r.v[j] = ((const f32x4*)p)[lane + 64 * j];
    return r; }
__device__ __forceinline__ void st_f32_row(float* p, int lane, const Row16& r) {
#pragma unroll
    for (int j = 0; j < 4; ++j) ((f32x4*)p)[lane + 64 * j] = r.v[j]; }
__device__ __forceinline__ Row16 ld_bf16_row(const bf16_t* p, int lane) { Row16 r;
#pragma unroll
    for (int j = 0; j < 4; ++j) { const u32x2 w = ((const u32x2*)p)[lane + 64 * j]; r.v[j] = (f32x4){bf_lo(w.x), bf_hi(w.x), bf_lo(w.y), bf_hi(w.y)}; }
    return r; }
#ifndef THIN_NT
#define THIN_NT 1
#endif
__device__ __forceinline__ void st_bf16_row_nt(bf16_t* p, int lane, const Row16& r) {
#pragma unroll
    for (int j = 0; j < 4; ++j) { const u32x2 w = (u32x2){pk_bf16(r.v[j][0], r.v[j][1]), pk_bf16(r.v[j][2], r.v[j][3])};
        if (THIN_NT) __builtin_nontemporal_store(w, (u32x2*)p + lane + 64 * j); else ((u32x2*)p)[lane + 64 * j] = w; } }
struct RawB { u32x2 v[4]; };
__device__ __forceinline__ RawB ld_raw_b(const bf16_t* p, int lane) { RawB r;
#pragma unroll
    for (int j = 0; j < 4; ++j) r.v[j] = ((const u32x2*)p)[lane + 64 * j];
    return r; }
#ifndef THIN_NTL
#define THIN_NTL 0
#endif
__device__ __forceinline__ RawB ld_raw_b_nt(const bf16_t* p, int lane) { RawB r;
#pragma unroll
    for (int j = 0; j < 4; ++j) r.v[j] = THIN_NTL ? __builtin_nontemporal_load((const u32x2*)p + lane + 64 * j) : ((const u32x2*)p)[lane + 64 * j];
    return r; }
__device__ __forceinline__ Row16 ld_f32_row_nt(const float* p, int lane) { Row16 r;
#pragma unroll
    for (int j = 0; j < 4; ++j) r.v[j] = THIN_NTL ? __builtin_nontemporal_load((const f32x4*)p + lane + 64 * j) : ((const f32x4*)p)[lane + 64 * j];
    return r; }
__device__ __forceinline__ Row16 unraw_b(const RawB& w) { Row16 r;
#pragma unroll
    for (int j = 0; j < 4; ++j) r.v[j] = (f32x4){bf_lo(w.v[j].x), bf_hi(w.v[j].x), bf_lo(w.v[j].y), bf_hi(w.v[j].y)};
    return r; }
__device__ __forceinline__ void st_bf16_row(bf16_t* p, int lane, const Row16& r) {
#pragma unroll
    for (int j = 0; j < 4; ++j) ((u32x2*)p)[lane + 64 * j] = (u32x2){pk_bf16(r.v[j][0], r.v[j][1]), pk_bf16(r.v[j][2], r.v[j][3])}; }
__device__ __forceinline__ float row_rstd(const Row16& r) { float s = 0.f;
#pragma unroll
    for (int j = 0; j < 4; ++j) s += (r.v[j][0] * r.v[j][0] + r.v[j][1] * r.v[j][1]) + (r.v[j][2] * r.v[j][2] + r.v[j][3] * r.v[j][3]);
    return rsqrtf(wave_sum(s) * (1.f / DM) + NORM_EPS); }
__device__ __forceinline__ Row16 norm_mod(const Row16& x, float rstd, const float* gain, const float* shift, const float* scale, int lane) { Row16 o;
#pragma unroll
    for (int j = 0; j < 4; ++j) { const f32x4 g = ((const f32x4*)gain)[lane + 64 * j], sh = ((const f32x4*)shift)[lane + 64 * j], sc = ((const f32x4*)scale)[lane + 64 * j];
        o.v[j] = (x.v[j] * rstd * g) * (sc + 1.f) + sh; }
    return o; }
__device__ __forceinline__ Row16 resid_add(const Row16& x, const Row16& y, float rstd, const float* gain, const float* gate, int lane) { Row16 o;
#pragma unroll
    for (int j = 0; j < 4; ++j) { const f32x4 g = ((const f32x4*)gain)[lane + 64 * j], gt = ((const f32x4*)gate)[lane + 64 * j];
        o.v[j] = x.v[j] + gt * (y.v[j] * rstd * g); }
    return o; }

__device__ __forceinline__ unsigned f2bf(float f) { unsigned u = __builtin_bit_cast(unsigned, f); return (u + 0x7fffu + ((u >> 16) & 1u)) >> 16; }
__device__ __forceinline__ unsigned pk2(float lo, float hi) { return f2bf(lo) | (f2bf(hi) << 16); }
struct TDesc { const float* W; unsigned char* WT; int K, N, il, item; };
__device__ __forceinline__ void t_load(const TDesc& d, float (&t_)[32], int lane) {
    const int nblk = d.N / 32, kb = d.item / nblk, nb = d.item - kb * nblk, k0 = 64 * kb, n0 = 32 * nb;
#pragma unroll
    for (int i = 0; i < 32; ++i) t_[i] = d.W[(size_t)(k0 + 2 * i + (lane >> 5)) * d.N + n0 + (lane & 31)];
}
template <bool FP8>
__device__ __forceinline__ void t_finish(const TDesc& d, const float (&t_)[32], LAS float* scr, int lane) {
    const int nblk = d.N / 32, kb = d.item / nblk, nb = d.item - kb * nblk, k0 = 64 * kb, n0 = 32 * nb;
    const int drow0 = d.il ? (256 * (n0 >> 7) + (n0 & 127) + (d.il == 2 ? 128 : 0)) : n0;
#pragma unroll
    for (int i = 0; i < 32; ++i) scr[(2 * i + (lane >> 5)) * 33 + (lane & 31)] = t_[i];
    LDS_WAIT(); asm volatile("" ::: "memory");
    const int c = lane & 7;
#pragma unroll
    for (int j = 0; j < 4; ++j) { const int n = (lane >> 3) + 8 * j; const LAS float* s = scr + (8 * c) * 33 + n;
        if constexpr (FP8) { u32x2 o; o.x = pk4_fp8(64.f * s[0 * 33], 64.f * s[1 * 33], 64.f * s[2 * 33], 64.f * s[3 * 33]); o.y = pk4_fp8(64.f * s[4 * 33], 64.f * s[5 * 33], 64.f * s[6 * 33], 64.f * s[7 * 33]);
            *(GAS u32x2*)(d.WT + (size_t)(drow0 + n) * d.K + k0 + 8 * c) = o; }
        else { u32x4 o; o.x = pk2(s[0 * 33], s[1 * 33]); o.y = pk2(s[2 * 33], s[3 * 33]); o.z = pk2(s[4 * 33], s[5 * 33]); o.w = pk2(s[6 * 33], s[7 * 33]);
            *(GAS u32x4*)((bf16_t*)d.WT + (size_t)(drow0 + n) * d.K + k0 + 8 * c) = o; } }
    LDS_WAIT(); asm volatile("" ::: "memory");
}
template <bool FP8, class Dec>
__device__ __forceinline__ void t_run(const Dec& dec, int first, int last, int stride, LAS float* scr, int lane) {
    int it = first; if (it >= last) return;
    TDesc dA, dB; float tA[32], tB[32]; dec(it, dA); t_load(dA, tA, lane);
    for (;;) {
        const int i1 = it + stride; const bool hasB = i1 < last; dec(hasB ? i1 : it, dB); t_load(dB, tB, lane);
        t_finish<FP8>(dA, tA, scr, lane);
        if (!hasB) break;
        const int i2 = i1 + stride; const bool hasA = i2 < last; dec(hasA ? i2 : i1, dA); t_load(dA, tA, lane);
        t_finish<FP8>(dB, tB, scr, lane);
        if (!hasA) break;
        it = i2;
    }
}
struct Args { const float* in[25]; float* out; unsigned char* ws; int ph_lo, ph_hi; };
constexpr int NPH = 14, NTOT = 2 * NPH;
typedef const __attribute__((address_space(4))) Args* KArgs;
__device__ __forceinline__ KArgs kargs() { auto p = __builtin_amdgcn_kernarg_segment_ptr(); asm volatile("" : "+s"(p)); return (KArgs)p; }
struct Geo { int G, bx, vcu; };
__device__ __forceinline__ Geo opaque_geo(Geo g) { asm volatile("" : "+s"(g.G), "+s"(g.bx), "+s"(g.vcu)); return g; }
enum { I_X = 0, I_C, I_CTX, I_CCTX, I_WMOD, I_BMOD, I_PREMIX, I_POSTMIX, I_PREFFN, I_POSTFFN, I_WIN, I_QN, I_KN, I_HGN, I_LBL, I_WATT, I_WHG, I_WOUT, I_FWG, I_FWU, I_FWD, I_ROUTER, I_MWG, I_MWU, I_MWD };

__device__ __forceinline__ void phase_prologue(LAS unsigned char* lds, const Geo geo_in) {
    const Geo geo = opaque_geo(geo_in);
    KArgs A = kargs(); unsigned char* ws = A->ws;
    const int tid = opaque_tid(), lane = tid & 63, wave = __builtin_amdgcn_readfirstlane(tid >> 6);
    const int G = geo.G, vcu = geo.vcu, gw = vcu * NWAVES + wave, NGW = G * NWAVES;
    LAS float* scr = (LAS float*)(lds + wave * 16384);
    constexpr int I_IN = 16 * (PROJW / 32), I_SQ = 16 * 32, I_GU = 16 * (DFF / 32), I_DN = (DFF / 64) * 32;
    constexpr int I_L = I_IN + 3 * I_SQ, NIT = 2 * I_L + 2 * I_GU + I_DN;
    const int ngv = (G > 96) ? 48 : 0;
    if (vcu >= ngv) {
        const auto dec = [&](int it, TDesc& d) { int r = it; d.il = 0;
            if (r < 2 * I_L) { const int l = r / I_L; r -= l * I_L; unsigned char* wl = ws + WS_W + l * WL_STRIDE; d.K = DM;
                if (r < I_IN) { d.W = A->in[I_WIN] + (size_t)l * DM * PROJW; d.N = PROJW; d.WT = wl + WL_IN; d.item = r; return; } r -= I_IN;
                d.N = DM; d.item = r & (I_SQ - 1); const int which = r / I_SQ;
                d.W = (which == 0 ? A->in[I_WATT] : which == 1 ? A->in[I_WHG] : A->in[I_WOUT]) + (size_t)l * DM * DM; d.WT = wl + (which == 0 ? WL_ATT : which == 1 ? WL_HG : WL_OUT); return; }
            r -= 2 * I_L;
            if (r < 2 * I_GU) { const int up = r >= I_GU; d.W = up ? A->in[I_FWU] : A->in[I_FWG]; d.K = DM; d.N = DFF; d.WT = ws + WS_WGU; d.il = 1 + up; d.item = r - up * I_GU; return; }
            d.W = A->in[I_FWD]; d.K = DFF; d.N = DM; d.WT = ws + WS_WD; d.item = r - 2 * I_GU; };
        t_run<false>(dec, (vcu - ngv) * NWAVES + wave, NIT, (G - ngv) * NWAVES, scr, lane);
    }
    {
        float* cosT = (float*)(ws + WS_COS); float* sinT = (float*)(ws + WS_SIN); float* lbv = (float*)(ws + WS_LBV); const float* lbl = A->in[I_LBL];
        for (int i = (vcu * 512 + tid); i < SEQ * 64; i += G * 512) { const int t = i >> 6, jj = i & 63; const int fi = jj & 31;
            const float inv = powf(10000.f, -(float)fi / 32.f); const float pos = (jj < 32) ? (float)(t >> 6) : (float)(t & 63); const float ang = pos * inv;
            cosT[i] = cosf(ang); sinT[i] = sinf(ang); }
        for (int i = (vcu * 512 + tid); i < 2 * DM; i += G * 512) { const int l = i >> 10, ch = i & 1023;
            lbv[i] = (l == 0) ? 0.f : 1.f / (1.f + expf(lbl[ch] - lbl[DM + ch])); }
    }
    __syncthreads();
    for (int it = vcu; it < 2 * 24; it += G) { const int l = it / 24, n0 = (it % 24) * 256;
        const float* c_in = A->in[I_C]; const float* cctx_in = A->in[I_CCTX]; float* modv = (float*)(ws + WS_MOD);
        LAS float* sv = (LAS float*)(lds + 65536) + wave * 5 * 128;
        const int k0 = wave * 128;
#pragma unroll
        for (int mi = 0; mi < 5; ++mi)
#pragma unroll
            for (int h2 = 0; h2 < 2; ++h2) { const int k = k0 + h2 * 64 + lane; const float cv = (mi < 4) ? c_in[mi * DM + k] : cctx_in[k]; sv[mi * 128 + h2 * 64 + lane] = cv / (1.f + expf(-cv)); }
        LDS_WAIT(); asm volatile("" ::: "memory");
        f32x4 a5[5];
#pragma unroll
        for (int mi = 0; mi < 5; ++mi) a5[mi] = (f32x4){0.f, 0.f, 0.f, 0.f};
        const float* wp = A->in[I_WMOD] + (size_t)l * DM * NMOD + (size_t)k0 * NMOD + n0 + 4 * lane;
        for (int kk0 = 0; kk0 < 128; kk0 += 16) { f32x4 wv[16];
#pragma unroll
            for (int j = 0; j < 16; ++j) wv[j] = *(const f32x4*)(wp + (size_t)(kk0 + j) * NMOD);
#pragma unroll
            for (int j = 0; j < 16; ++j)
#pragma unroll
                for (int mi = 0; mi < 5; ++mi) a5[mi] += wv[j] * sv[mi * 128 + kk0 + j]; }
        LAS float* red = (LAS float*)lds;
#pragma unroll
        for (int mi = 0; mi < 5; ++mi) *(LAS f32x4*)(red + (wave * 5 + mi) * 256 + 4 * lane) = a5[mi];
        __syncthreads();
        const float* b_mod = A->in[I_BMOD];
        for (int o = tid; o < 5 * 256; o += 512) { const int mi = o >> 8, cidx = o & 255; float s = b_mod[l * NMOD + n0 + cidx];
#pragma unroll
            for (int w8 = 0; w8 < 8; ++w8) s += red[(w8 * 5 + mi) * 256 + cidx];
            modv[((size_t)l * 5 + mi) * NMOD + n0 + cidx] = s; }
        __syncthreads();
    }
}

__device__ __forceinline__ void phase_premix0(const Geo geo_in) {
    const Geo geo = opaque_geo(geo_in);
    KArgs A = kargs(); unsigned char* ws = A->ws;
    const int tid = opaque_tid(), lane = tid & 63, wave = __builtin_amdgcn_readfirstlane(tid >> 6);
    const int gw = geo.vcu * NWAVES + wave, NGW = geo.G * NWAVES;
    const float* x_in = A->in[I_X]; const float* ctx_in = A->in[I_CTX]; const float* gain = A->in[I_PREMIX]; const float* modl = (const float*)(ws + WS_MOD);
    bf16_t* Hb = (bf16_t*)(ws + WS_H);
#define SRC_ROW(row_) (((row_) < NLAT) ? x_in + (size_t)(row_) * DM : ctx_in + (size_t)((row_) - NLAT) * DM)
#define P1_ROW(row_, cur_) do { const int rw_ = (row_); const float* md = modl + (size_t)((rw_ < NLAT) ? (rw_ >> 12) : 4) * NMOD;      \
        const Row16 h = norm_mod(cur_, row_rstd(cur_), gain, md + 0 * DM, md + 1 * DM, lane); st_bf16_row(Hb + (size_t)rw_ * DM, lane, h); } while (0)
    const int rc0 = NLAT + gw; Row16 cxc; if (rc0 < R) cxc = ld_f32_row(SRC_ROW(rc0), lane);
    for (int base = gw; base < NLAT; base += 8 * NGW) {
        Row16 rx[8];
#pragma unroll
        for (int k = 0; k < 8; ++k) rx[k] = ld_f32_row(SRC_ROW((base + k * NGW < NLAT) ? base + k * NGW : base), lane);
#pragma unroll
        for (int k = 0; k < 8; ++k) if (base + k * NGW < NLAT) P1_ROW(base + k * NGW, rx[k]);
    }
    if (rc0 < R) P1_ROW(rc0, cxc);
    for (int rc = rc0 + NGW; rc < R; rc += NGW) { const Row16 c2 = ld_f32_row(SRC_ROW(rc), lane); P1_ROW(rc, c2); }
#undef P1_ROW
#undef SRC_ROW
}

__device__ __forceinline__ void phase_proj(LAS unsigned char* lds, const Geo geo_in, int layer) {
    const Geo geo = opaque_geo(geo_in);
    KArgs A = kargs(); unsigned char* ws = A->ws;
    pg8::Gemm g{(const bf16_t*)(ws + WS_H), (const bf16_t*)(ws + WS_W + layer * WL_STRIDE + WL_IN), R, PROJW, DM}; pg8::StaticOrder S; S.init(R, PROJW, geo.G, geo.bx);
    EpiProj E{(bf16_t*)(ws + WS_PROJ), (const float*)(ws + WS_LBV) + layer * DM};
    pg8::gemm_phase<EpiProj, pg8::StaticOrder, true, true>(lds, g, S, E);
    gemm_mini_ks<EpiProj, pg8::StaticOrder>(lds, g, S, E, geo.vcu, geo.G);
}

__device__ __forceinline__ void phase_qknorm(const Geo geo_in, int layer) {
    const Geo geo = opaque_geo(geo_in);
    KArgs A = kargs(); unsigned char* ws = A->ws;
    const int tid = opaque_tid(), lane = tid & 63, wave = __builtin_amdgcn_readfirstlane(tid >> 6);
    const int gw = geo.vcu * NWAVES + wave, NGW = geo.G * NWAVES;
    const float* qn = A->in[I_QN] + layer * 128; const float* kn = A->in[I_KN] + layer * 128;
    const float* cosT = (const float*)(ws + WS_COS); const float* sinT = (const float*)(ws + WS_SIN); bf16_t* proj = (bf16_t*)(ws + WS_PROJ);
    const int nitems = R / 4;
    for (int it = gw; it < nitems; it += NGW) {
        const int row = it * 4 + (lane >> 4);
        const int lr = lane & 15;
        bf16_t* p = proj + PK + (size_t)row * 256 + 16 * lr;
        const float* gn = kn;
        const int j0 = (lr & 7) * 16;
        f32x4 v[4]; { f32x4 a, b2; unpack8(*(const u32x4*)p, a, b2); v[0] = a; v[1] = b2; unpack8(*(const u32x4*)(p + 8), a, b2); v[2] = a; v[3] = b2; }
        float ss = 0.f;
#pragma unroll
        for (int j = 0; j < 4; ++j) ss += (v[j][0] * v[j][0] + v[j][1] * v[j][1]) + (v[j][2] * v[j][2] + v[j][3] * v[j][3]);
        ss += __shfl_xor(ss, 1); ss += __shfl_xor(ss, 2); ss += __shfl_xor(ss, 4);
        const float rstd = rsqrtf(ss * (1.f / 128.f) + NORM_EPS);
#pragma unroll
        for (int j = 0; j < 4; ++j) v[j] = v[j] * rstd * *(const f32x4*)(gn + j0 + 4 * j);
        if (row < NLAT) {
            const int t = row & (SEQ - 1); const int jj0 = (lr & 3) * 16; const bool upper = (lr & 4) != 0;
#pragma unroll
            for (int j = 0; j < 4; ++j) { f32x4 pv;
#pragma unroll
                for (int e = 0; e < 4; ++e) pv[e] = __shfl_xor(v[j][e], 4);
                const f32x4 cs = *(const f32x4*)(cosT + (size_t)t * 64 + jj0 + 4 * j), sn = *(const f32x4*)(sinT + (size_t)t * 64 + jj0 + 4 * j);
                v[j] = upper ? (v[j] * cs + pv * sn) : (v[j] * cs - pv * sn); }
        }
        *(u32x4*)p = pack8(v[0], v[1]); *(u32x4*)(p + 8) = pack8(v[2], v[3]);
    }
}

__device__ __forceinline__ void phase_attn(unsigned char* lds_raw, const Geo geo_in, bool last, int layer) {
    const Geo geo = opaque_geo(geo_in);
    KArgs A = kargs(); unsigned char* ws = A->ws;
    bf16_t* Qp = (bf16_t*)(ws + WS_PROJ) + PQ; const bf16_t* Kp = (const bf16_t*)(ws + WS_PROJ) + PK; const bf16_t* Vp = (const bf16_t*)(ws + WS_PROJ) + PV;
    const float* qn = A->in[I_QN] + layer * 128;
    const int nun = last ? 512 : 544;
#ifndef ATT_UMAP
#define ATT_UMAP 0
#endif
#ifdef ATT_PROBE
    for (int u = (ATT_UMAP ? geo.bx : geo.vcu); u < nun; u += geo.G) {
        int qrow, krow, h, seq, nlat, ctxoff;
        if (u < 512) { const int grp = u >> 6, b = grp >> 1, kvh = grp & 1, gq = (u >> 4) & 3, qb = u & 15; h = kvh * 4 + gq;
            qrow = b * SEQ + qb * 256; krow = b * SEQ; seq = SEQ + CTXL; nlat = SEQ; ctxoff = (NLAT + b * CTXL) - (b * SEQ) - SEQ; }
        else { const int b = (u - 512) >> 3; h = (u - 512) & 7; qrow = NLAT + b * CTXL; krow = qrow; seq = CTXL; nlat = 1 << 30; ctxoff = 0; }
        bf16_t* Qb = Qp + (size_t)qrow * 1024 + h * 128; bf16_t* Os = (bf16_t*)(ws + WS_OF) + (size_t)qrow * 1024 + h * 128;
        const bf16_t* Kh = Kp + (size_t)krow * 256 + (h >> 2) * 128; const bf16_t* Vh = Vp + (size_t)krow * 256 + (h >> 2) * 128;
        att::attn_dense_body<1024, 256, 1024, ATT_PROBE>(Qb, Kh, Vh, Os, seq, nlat, ctxoff, (char*)lds_raw, qn, (const float*)(ws + WS_COS), (const float*)(ws + WS_SIN), qrow & (SEQ - 1), u < 512);
    }
#endif
    for (int u = (ATT_UMAP ? geo.bx : geo.vcu); u < nun; u += geo.G) {
        int qrow, krow, h, seq, nlat, ctxoff;
        if (u < 512) { const int grp = u >> 6, b = grp >> 1, kvh = grp & 1, gq = (u >> 4) & 3, qb = u & 15; h = kvh * 4 + gq;
            qrow = b * SEQ + qb * 256; krow = b * SEQ; seq = SEQ + CTXL; nlat = SEQ; ctxoff = (NLAT + b * CTXL) - (b * SEQ) - SEQ; }
        else { const int b = (u - 512) >> 3; h = (u - 512) & 7; qrow = NLAT + b * CTXL; krow = qrow; seq = CTXL; nlat = 1 << 30; ctxoff = 0; }
        bf16_t* Qb = Qp + (size_t)qrow * 1024 + h * 128;
        const bf16_t* Kh = Kp + (size_t)krow * 256 + (h >> 2) * 128; const bf16_t* Vh = Vp + (size_t)krow * 256 + (h >> 2) * 128;
        att::attn_dense_body<1024, 256, 1024>(Qb, Kh, Vh, Qb, seq, nlat, ctxoff, (char*)lds_raw, qn, (const float*)(ws + WS_COS), (const float*)(ws + WS_SIN), qrow & (SEQ - 1), u < 512);
    }
}
__device__ __forceinline__ void phase_scan(LAS unsigned char* lds, const Geo geo_in, bool last) {
    const Geo geo = opaque_geo(geo_in);
    KArgs A = kargs(); unsigned char* ws = A->ws;
    bf16_t* proj = (bf16_t*)(ws + WS_PROJ);
    for (int u = geo.vcu; u < 256; u += geo.G) {
        const int dvs = u & 3, bwd = (u >> 2) & 1, h = (u >> 3) & 7, b = u >> 6;
        scan::scan_unit(lds, proj + PHQ, bwd ? proj + PGB : proj + PGF, proj + PHV, bwd ? (bf16_t*)(ws + WS_OB) : (bf16_t*)(ws + WS_OF), b, h, bwd, dvs, !last);
    }
}

__device__ __forceinline__ void phase_readout(const Geo geo_in, int layer) {
    const Geo geo = opaque_geo(geo_in);
    KArgs A = kargs(); unsigned char* ws = A->ws;
    const int tid = opaque_tid(), lane = tid & 63, wave = __builtin_amdgcn_readfirstlane(tid >> 6);
    const int gw = geo.vcu * NWAVES + wave, NGW = geo.G * NWAVES;
    const float* hn = A->in[I_HGN] + layer * 128; const int nrows = (layer == 1) ? NLAT : R;
    const bf16_t* OFb = (const bf16_t*)(ws + WS_OF); const bf16_t* OBb = (const bf16_t*)(ws + WS_OB); bf16_t* HG = (bf16_t*)(ws + WS_PROJ) + PHG;
    const int j0 = (lane & 7) * 16;
    struct Raw { u32x4 f0, f1, b0, b1, g0, g1; };
#define RD_LOAD(dst, row_) do { const size_t off_ = (size_t)(row_) * 1024 + 16 * lane; dst.f0 = *(const u32x4*)(OFb + off_); dst.f1 = *(const u32x4*)(OFb + off_ + 8); \
        dst.b0 = *(const u32x4*)(OBb + off_); dst.b1 = *(const u32x4*)(OBb + off_ + 8); dst.g0 = *(const u32x4*)(HG + off_); dst.g1 = *(const u32x4*)(HG + off_ + 8); } while (0)
#define RD_ROW(row_, cur) do { const size_t off = (size_t)(row_) * 1024 + 16 * lane;                                                                   \
        f32x4 a[4], b4[4], g4[4];                                                                                                                  \
        unpack8(cur.f0, a[0], a[1]); unpack8(cur.f1, a[2], a[3]); unpack8(cur.b0, b4[0], b4[1]); unpack8(cur.b1, b4[2], b4[3]); unpack8(cur.g0, g4[0], g4[1]); unpack8(cur.g1, g4[2], g4[3]); \
        float ss = 0.f;                                                                                                                            \
        _Pragma("unroll") for (int j = 0; j < 4; ++j) { a[j] += b4[j]; ss += (a[j][0] * a[j][0] + a[j][1] * a[j][1]) + (a[j][2] * a[j][2] + a[j][3] * a[j][3]); } \
        ss += __shfl_xor(ss, 1); ss += __shfl_xor(ss, 2); ss += __shfl_xor(ss, 4);                                                                   \
        const float rstd = rsqrtf(ss * (1.f / 128.f) + NORM_EPS);                                                                                  \
        _Pragma("unroll") for (int j = 0; j < 4; ++j) a[j] = a[j] * rstd * *(const f32x4*)(hn + j0 + 4 * j) * g4[j];                                 \
        *(u32x4*)(HG + off) = pack8(a[0], a[1]); *(u32x4*)(HG + off + 8) = pack8(a[2], a[3]); } while (0)
    const int rc0 = NLAT + gw; Raw rcc; if (rc0 < nrows) RD_LOAD(rcc, rc0);
    for (int base = gw; base < NLAT; base += 8 * NGW) {
        Raw sl[6];
#define RD_LD(k_) RD_LOAD(sl[(k_) % 6], ((base + (k_) * NGW < NLAT) ? base + (k_) * NGW : base))
#pragma unroll
        for (int k = 0; k < 5; ++k) RD_LD(k);
#pragma unroll
        for (int k = 0; k < 8; ++k) {
            if (k + 5 < 8) RD_LD(k + 5);
            if (base + k * NGW < NLAT) RD_ROW(base + k * NGW, sl[k % 6]);
        }
#undef RD_LD
    }
    if (rc0 < nrows) RD_ROW(rc0, rcc);
    for (int rc = rc0 + NGW; rc < nrows; rc += NGW) { Raw r2; RD_LOAD(r2, rc); RD_ROW(rc, r2); }
#undef RD_ROW
#undef RD_LOAD
}

__device__ __forceinline__ void phase_merge_hg(LAS unsigned char* lds, const Geo geo_in, int layer) {
    const Geo geo = opaque_geo(geo_in);
    KArgs A = kargs(); unsigned char* ws = A->ws; const int M = (layer == 1) ? NLAT : R; bf16_t* proj = (bf16_t*)(ws + WS_PROJ);
    pg8::Gemm g{proj + PHG, (const bf16_t*)(ws + WS_W + layer * WL_STRIDE + WL_HG), M, DM, DM}; pg8::StaticOrder S; S.init(M, DM, geo.G, geo.bx);
    EpiGate<false> E{proj + PGH, nullptr};
    pg8::gemm_phase<EpiGate<false>, pg8::StaticOrder, true, true>(lds, g, S, E);
    gemm_mini_ks<EpiGate<false>, pg8::StaticOrder>(lds, g, S, E, geo.vcu, geo.G);
}
__device__ __forceinline__ void phase_merge_att(LAS unsigned char* lds, const Geo geo_in, int layer) {
    const Geo geo = opaque_geo(geo_in);
    KArgs A = kargs(); unsigned char* ws = A->ws; const int M = (layer == 1) ? NLAT : R; bf16_t* proj = (bf16_t*)(ws + WS_PROJ);
    pg8::Gemm g{proj + PQ, (const bf16_t*)(ws + WS_W + layer * WL_STRIDE + WL_ATT), M, DM, DM}; pg8::StaticOrder S; S.init(M, DM, geo.G, geo.bx);
    EpiGate<true> E{proj + PGA, proj + PGH};
    pg8::gemm_phase<EpiGate<true>, pg8::StaticOrder, true, true>(lds, g, S, E);
    gemm_mini_ks<EpiGate<true>, pg8::StaticOrder>(lds, g, S, E, geo.vcu, geo.G);
}
__device__ __forceinline__ void phase_wout(LAS unsigned char* lds, const Geo geo_in, int layer) {
    const Geo geo = opaque_geo(geo_in);
    KArgs A = kargs(); unsigned char* ws = A->ws; const int M = (layer == 1) ? NLAT : R; bf16_t* proj = (bf16_t*)(ws + WS_PROJ);
    pg8::Gemm g{proj + PGA, (const bf16_t*)(ws + WS_W + layer * WL_STRIDE + WL_OUT), M, DM, DM}; pg8::StaticOrder S; S.init(M, DM, geo.G, geo.bx);
    EpiPlain E{(bf16_t*)(ws + WS_H), DM};
    pg8::gemm_phase<EpiPlain, pg8::StaticOrder, true, true>(lds, g, S, E);
    gemm_mini_ks<EpiPlain, pg8::StaticOrder>(lds, g, S, E, geo.vcu, geo.G);
}

constexpr int XB_SPLIT = 15872;
__device__ __forceinline__ bf16_t* xa_row(unsigned char* ws, int row) { return (bf16_t*)(ws + WS_OB) + (size_t)row * DM; }
__device__ __forceinline__ bf16_t* xb_row(unsigned char* ws, int row) { return row < XB_SPLIT ? (bf16_t*)(ws + WS_END) + (size_t)row * DM : (bf16_t*)(ws + WS_WGU) + (size_t)(row - XB_SPLIT) * DM; }
__device__ __forceinline__ bf16_t* xc_row(unsigned char* ws, int row) { return (bf16_t*)(ws + WS_W) + (size_t)row * DM; }
__device__ __forceinline__ void phase_postmix0(const Geo geo_in, bool probe = false) {
    const Geo geo = opaque_geo(geo_in);
    KArgs A = kargs(); unsigned char* ws = A->ws;
    const int tid = opaque_tid(), lane = tid & 63, wave = __builtin_amdgcn_readfirstlane(tid >> 6);
    const int gw = geo.vcu * NWAVES + wave, NGW = geo.G * NWAVES;
    const float* x_in = A->in[I_X]; const float* ctx_in = A->in[I_CTX]; float* out = A->out; float* xctx = (float*)(ws + WS_XCTX);
    const float* pmn = A->in[I_POSTMIX]; const float* pfn = A->in[I_PREFFN]; const float* modl = (const float*)(ws + WS_MOD); bf16_t* Hb = (bf16_t*)(ws + WS_H);
#define SRC_ROW(row_) (((row_) < NLAT) ? x_in + (size_t)(row_) * DM : ctx_in + (size_t)((row_) - NLAT) * DM)
#define P9_ROW(row_, cx_, cm_) do { const int rw_ = (row_); const float* md = modl + (size_t)((rw_ < NLAT) ? (rw_ >> 12) : 4) * NMOD;      \
        const Row16 x1 = resid_add(cx_, cm_, row_rstd(cm_), pmn, md + 2 * DM, lane);                                                           \
        if (probe) st_bf16_row((bf16_t*)(ws + WS_OB) + (size_t)rw_ * DM, lane, x1);                                                            \
        else if (rw_ < NLAT) st_bf16_row_nt(xa_row(ws, rw_), lane, x1); else st_f32_row(xctx + (size_t)(rw_ - NLAT) * DM, lane, x1);                \
        const Row16 f = norm_mod(x1, row_rstd(x1), pfn, md + 3 * DM, md + 4 * DM, lane);                                                       \
        st_bf16_row((probe ? (bf16_t*)(ws + WS_OF) : Hb) + (size_t)rw_ * DM, lane, f); } while (0)
    const int rc0 = NLAT + gw; Row16 cxc; RawB cmc; if (rc0 < R) { cxc = ld_f32_row(SRC_ROW(rc0), lane); cmc = ld_raw_b(Hb + (size_t)rc0 * DM, lane); }
    for (int base = gw; base < NLAT; base += 8 * NGW) {
        Row16 fx[5]; RawB fm[5];
#define P9_LOAD(k_) do { const int rw_ = (base + (k_) * NGW < NLAT) ? base + (k_) * NGW : base; fx[(k_) % 5] = ld_f32_row_nt(SRC_ROW(rw_), lane); fm[(k_) % 5] = ld_raw_b_nt(Hb + (size_t)rw_ * DM, lane); } while (0)
#pragma unroll
        for (int k = 0; k < 4; ++k) P9_LOAD(k);
#pragma unroll
        for (int k = 0; k < 8; ++k) {
            if (k + 4 < 8) P9_LOAD(k + 4);
            if (base + k * NGW < NLAT) { const Row16 cm = unraw_b(fm[k % 5]); P9_ROW(base + k * NGW, fx[k % 5], cm); }
        }
#undef P9_LOAD
    }
    if (rc0 < R) { const Row16 cm = unraw_b(cmc); P9_ROW(rc0, cxc, cm); }
    for (int rc = rc0 + NGW; rc < R; rc += NGW) { const Row16 c2 = ld_f32_row(SRC_ROW(rc), lane), m2 = ld_bf16_row(Hb + (size_t)rc * DM, lane); P9_ROW(rc, c2, m2); }
#undef P9_ROW
#undef SRC_ROW
}
constexpr int MOE_I_E = 16 * (DFE / 32);
constexpr int MOE_CONV_TAILW = (256 - 16) * NWAVES;
#ifndef MOE_EARLY_PER_WAVE
#define MOE_EARLY_PER_WAVE 16
#endif
constexpr int MOE_CONV_EARLY = MOE_EARLY_PER_WAVE * MOE_CONV_TAILW;
__device__ __forceinline__ void moe_convert(unsigned char* ws, KArgs A, LAS unsigned char* scrbase, int first, int last, int wi, int nw, int wave, int lane) {
    LAS float* scr = (LAS float*)(scrbase + wave * 8704);
    unsigned char* MGU = ws + WS_MGU; unsigned char* MD = ws + WS_MD;
    const auto dec = [&](int it, TDesc& d) { const int e = it / (3 * MOE_I_E), r3 = it - e * 3 * MOE_I_E, m = r3 / MOE_I_E; d.item = r3 - m * MOE_I_E;
        if (m < 2) { d.W = (m == 0 ? A->in[I_MWG] : A->in[I_MWU]) + (size_t)e * DM * DFE; d.K = DM; d.N = DFE; d.WT = MGU + (size_t)e * 2 * DFE * DM; d.il = 1 + m; }
        else { d.W = A->in[I_MWD] + (size_t)e * DFE * DM; d.K = DFE; d.N = DM; d.WT = MD + (size_t)e * DM * DFE; d.il = 0; } };
    t_run<true>(dec, first + wi, last, nw, scr, lane);
}
__device__ __forceinline__ void phase_postmix1(LAS unsigned char* lds, const Geo geo_in) {
    const Geo geo = opaque_geo(geo_in);
    KArgs A = kargs(); unsigned char* ws = A->ws;
    const int tid = opaque_tid(), lane = tid & 63, wave = __builtin_amdgcn_readfirstlane(tid >> 6);
    const int G = geo.G, vcu = geo.vcu, gw = vcu * NWAVES + wave, NGW = G * NWAVES;
    float* out = A->out; const float* pmn = A->in[I_POSTMIX] + DM; const float* pfn = A->in[I_PREFFN] + DM; const float* modl = (const float*)(ws + WS_MOD) + (size_t)5 * NMOD;
    bf16_t* Hb = (bf16_t*)(ws + WS_H); unsigned* route = (unsigned*)(ws + WS_ROUTE); unsigned* wgb = (unsigned*)(ws + WS_WGB); unsigned* cnt = (unsigned*)(ws + WS_CTL) + CW_CNT;
    LAS float* wr = (LAS float*)lds; LAS unsigned* lcnt = (LAS unsigned*)(lds + 32768); LAS unsigned* lbase = lcnt + 8; unsigned char* XB = ws + WS_XB;
    { const float* moe_router = A->in[I_ROUTER]; for (int i = tid; i < DM * NEXP; i += 512) wr[i] = moe_router[i]; }
    if (tid < NEXP) lcnt[tid] = 0u;
    __syncthreads();
    for (int blk = vcu; blk < NLAT / 64; blk += G) {
        RawB rxr[8], rmx[8];
        unsigned fq8[8][4]; int re0[8], re1[8]; unsigned rp0[8], rp1[8];
#pragma unroll
        for (int i = 0; i < 8; ++i) { rxr[i] = ld_raw_b_nt(xb_row(ws, blk * 64 + wave * 8 + i), lane); rmx[i] = ld_raw_b_nt(Hb + (size_t)(blk * 64 + wave * 8 + i) * DM, lane); }
#pragma unroll
        for (int i = 0; i < 8; ++i) {
            const int row = blk * 64 + wave * 8 + i;
            const float* md = modl + (size_t)(row >> 12) * NMOD;
            const Row16 xr = unraw_b(rxr[i]), mx = unraw_b(rmx[i]);
            const Row16 x1 = resid_add(xr, mx, row_rstd(mx), pmn, md + 2 * DM, lane);
            st_bf16_row_nt(xc_row(ws, row), lane, x1);
            const Row16 f = norm_mod(x1, row_rstd(x1), pfn, md + 3 * DM, md + 4 * DM, lane);
#pragma unroll
            for (int j = 0; j < 4; ++j) fq8[i][j] = pk4_fp8(f.v[j][0], f.v[j][1], f.v[j][2], f.v[j][3]);
            float lg[NEXP];
#pragma unroll
            for (int e = 0; e < NEXP; ++e) lg[e] = 0.f;
#pragma unroll
            for (int j = 0; j < 4; ++j)
#pragma unroll
                for (int e4 = 0; e4 < 4; ++e4) { const int cidx = 4 * (lane + 64 * j) + e4; const f32x4 w0 = *(const LAS f32x4*)(wr + cidx * 8), w1 = *(const LAS f32x4*)(wr + cidx * 8 + 4); const float fv = f.v[j][e4];
                    lg[0] += fv * w0[0]; lg[1] += fv * w0[1]; lg[2] += fv * w0[2]; lg[3] += fv * w0[3]; lg[4] += fv * w1[0]; lg[5] += fv * w1[1]; lg[6] += fv * w1[2]; lg[7] += fv * w1[3]; }
#pragma unroll
            for (int e = 0; e < NEXP; ++e) lg[e] = wave_sum(lg[e]);
            int e0 = 0; float l0 = lg[0];
#pragma unroll
            for (int e = 1; e < NEXP; ++e) if (lg[e] > l0) { l0 = lg[e]; e0 = e; }
            int e1 = -1; float l1 = -3.0e38f;
#pragma unroll
            for (int e = 0; e < NEXP; ++e) if (e != e0 && lg[e] > l1) { l1 = lg[e]; e1 = e; }
            unsigned p0 = 0u, p1 = 0u;
            if (lane == 0) {
                p0 = __hip_atomic_fetch_add(lcnt + e0, 1u, __ATOMIC_RELAXED, __HIP_MEMORY_SCOPE_WORKGROUP);
                p1 = __hip_atomic_fetch_add(lcnt + e1, 1u, __ATOMIC_RELAXED, __HIP_MEMORY_SCOPE_WORKGROUP);
                const float w0 = 1.f / (1.f + expf(l1 - l0));
                unsigned* rr = route + (size_t)row * 8;
                rr[0] = (unsigned)e0 | ((unsigned)e1 << 8); rr[3] = __float_as_uint(w0); rr[4] = __float_as_uint(1.f - w0);
            }
            re0[i] = __builtin_amdgcn_readfirstlane(e0); re1[i] = __builtin_amdgcn_readfirstlane(e1); rp0[i] = __builtin_amdgcn_readfirstlane(p0); rp1[i] = __builtin_amdgcn_readfirstlane(p1);
        }
        __syncthreads();
        if (tid < NEXP) { const unsigned n = lcnt[tid]; lbase[tid] = __hip_atomic_fetch_add(cnt + 64 * tid, n, __ATOMIC_RELAXED, __HIP_MEMORY_SCOPE_AGENT); lcnt[tid] = 0u; }
        __syncthreads();
#pragma unroll
        for (int i = 0; i < 8; ++i) { const int row = blk * 64 + wave * 8 + i;
            const unsigned k0 = lbase[re0[i]] + rp0[i], k1 = lbase[re1[i]] + rp1[i];
            unsigned* d0 = (unsigned*)(XB + ((size_t)re0[i] * XB_CAP + k0) * DM); unsigned* d1 = (unsigned*)(XB + ((size_t)re1[i] * XB_CAP + k1) * DM);
#pragma unroll
            for (int j = 0; j < 4; ++j) { d0[lane + 64 * j] = fq8[i][j]; d1[lane + 64 * j] = fq8[i][j]; }
            if (lane == 0) { unsigned* rr = route + (size_t)row * 8; rr[5] = k0; rr[6] = k1; } }
        __syncthreads();
    }
    moe_convert(ws, A, lds + 49152, (G == 256) ? MOE_CONV_EARLY : 0, NEXP * 3 * MOE_I_E, gw, NGW, wave, lane);
}

struct MoeCounts { int nb[NEXP]; };
__device__ __forceinline__ MoeCounts moe_counts(unsigned char* ws) { MoeCounts c; unsigned* cnt = (unsigned*)(ws + WS_CTL) + CW_CNT;
#pragma unroll
    for (int e = 0; e < NEXP; ++e) { const unsigned n = __hip_atomic_load(cnt + 64 * e, __ATOMIC_RELAXED, __HIP_MEMORY_SCOPE_AGENT); c.nb[e] = (int)((n + 255u) >> 8); }
    return c; }

__device__ __forceinline__ void phase_gather(const Geo geo_in) {
    const Geo geo = opaque_geo(geo_in);
    KArgs A = kargs(); unsigned char* ws = A->ws;
    const int tid = opaque_tid(), lane = tid & 63, wave = __builtin_amdgcn_readfirstlane(tid >> 6);
    const int gw = geo.vcu * NWAVES + wave, NGW = geo.G * NWAVES;
    const MoeCounts mc = moe_counts(ws); int pst[NEXP]; { int a_ = 0;
#pragma unroll
        for (int e = 0; e < NEXP; ++e) { pst[e] = a_; a_ += mc.nb[e] * 256; } }
    unsigned* route = (unsigned*)(ws + WS_ROUTE); const unsigned* wgb = (const unsigned*)(ws + WS_WGB); const bf16_t* Hb = (const bf16_t*)(ws + WS_H); unsigned char* XB = ws + WS_XB;
    struct Rec { unsigned ee, p0, p1; }; struct Dat { unsigned b0, b1; u32x4 lo, hi; };
#define G_REC(dst, row_) do { const unsigned* rr_ = route + (size_t)(row_) * 8; dst.ee = rr_[0]; dst.p0 = rr_[1]; dst.p1 = rr_[2]; } while (0)
#define G_DAT(dst, rec, row_) do { dst.b0 = wgb[((row_) >> 6) * 8 + (rec.ee & 255)]; dst.b1 = wgb[((row_) >> 6) * 8 + ((rec.ee >> 8) & 255)]; \
        dst.lo = *(const u32x4*)(Hb + (size_t)(row_) * DM + 16 * lane); dst.hi = *(const u32x4*)(Hb + (size_t)(row_) * DM + 16 * lane + 8); } while (0)
    for (int base = gw; base < NLAT; base += 8 * NGW) {
        Rec rc[8]; Dat dt[8];
#pragma unroll
        for (int k = 0; k < 8; ++k) G_REC(rc[k], ((base + k * NGW < NLAT) ? base + k * NGW : base));
#pragma unroll
        for (int k = 0; k < 8; ++k) G_DAT(dt[k], rc[k], ((base + k * NGW < NLAT) ? base + k * NGW : base));
#pragma unroll
        for (int k = 0; k < 8; ++k) { const int row = base + k * NGW;
            if (row < NLAT) {
                const int e0 = rc[k].ee & 255, e1 = (rc[k].ee >> 8) & 255;
                int ps0 = 0, ps1 = 0;
#pragma unroll
                for (int e = 0; e < NEXP; ++e) { if (e == e0) ps0 = pst[e]; if (e == e1) ps1 = pst[e]; }
                const unsigned d0 = (unsigned)ps0 + dt[k].b0 + rc[k].p0, d1 = (unsigned)ps1 + dt[k].b1 + rc[k].p1;
                f32x4 v0, v1, v2, v3; unpack8(dt[k].lo, v0, v1); unpack8(dt[k].hi, v2, v3);
                const u32x4 q = {pk4_fp8(v0[0], v0[1], v0[2], v0[3]), pk4_fp8(v1[0], v1[1], v1[2], v1[3]), pk4_fp8(v2[0], v2[1], v2[2], v2[3]), pk4_fp8(v3[0], v3[1], v3[2], v3[3])};
                *(u32x4*)(XB + (size_t)d0 * DM + 16 * lane) = q; *(u32x4*)(XB + (size_t)d1 * DM + 16 * lane) = q;
                if (lane == 0) { unsigned* rr = route + (size_t)row * 8; rr[5] = d0; rr[6] = d1; }
            } }
    }
#undef G_REC
#undef G_DAT
}

__device__ __forceinline__ void phase_ffn_up0(LAS unsigned char* lds, const Geo geo_in) {
    const Geo geo = opaque_geo(geo_in);
    KArgs A = kargs(); unsigned char* ws = A->ws;
    pg8::Gemm g{(const bf16_t*)(ws + WS_H), (const bf16_t*)(ws + WS_WGU), R, 2 * DFF, DM}; pg8::StaticOrder S; S.init(R, 2 * DFF, geo.G, geo.bx); S.nfull = S.nwg;
    EpiSwiGLU E{(bf16_t*)(ws + WS_PROJ), DFF};
    pg8::gemm_phase<EpiSwiGLU, pg8::StaticOrder, true, true>(lds, g, S, E);
    gemm_mini<EpiSwiGLU, pg8::StaticOrder>(g, S, E, geo.vcu, geo.G);
}
__device__ __forceinline__ void phase_ffn_down0(LAS unsigned char* lds, const Geo geo_in) {
    const Geo geo = opaque_geo(geo_in);
    KArgs A = kargs(); unsigned char* ws = A->ws;
    pg8::Gemm g{(const bf16_t*)(ws + WS_PROJ), (const bf16_t*)(ws + WS_WD), R, DM, DFF}; pg8::StaticOrder S; S.init(R, DM, geo.G, geo.bx); S.nfull = S.nwg;
    EpiPlain E{(bf16_t*)(ws + WS_OF), DM};
    pg8::gemm_phase<EpiPlain, pg8::StaticOrder, true, true>(lds, g, S, E);
    if (geo.G == 256 && geo.bx >= 16) {
        const int tid = opaque_tid(), lane = tid & 63, wave = __builtin_amdgcn_readfirstlane(tid >> 6);
        moe_convert(ws, A, lds, 0, MOE_CONV_EARLY, (geo.bx - 16) * NWAVES + wave, MOE_CONV_TAILW, wave, lane);
    }
}
__device__ __forceinline__ void phase_ffn_up1(LAS unsigned char* lds, const Geo geo_in) {
    const Geo geo = opaque_geo(geo_in);
    KArgs A = kargs(); unsigned char* ws = A->ws; const MoeCounts mc = moe_counts(ws);
    pg8::Gemm g{(const bf16_t*)(ws + WS_XB), (const bf16_t*)(ws + WS_MGU), MOE_ROWS_MAX, 2 * DFE, DM}; MoeOrder S; S.acap = XB_CAP / 256;
#pragma unroll
    for (int e = 0; e < NEXP; ++e) S.nb[e] = mc.nb[e];
    S.nN = 2 * DFE / 256; S.G = geo.G; S.c = geo.vcu; S.finish(); S.nfull = S.nwg;
    EpiSwiGLU8 E{ws + WS_HIDM, DFE};
    pg8::gemm_phase<EpiSwiGLU8, MoeOrder, true, true, true>(lds, g, S, E);
}
__device__ __forceinline__ void phase_ffn_down1(LAS unsigned char* lds, const Geo geo_in) {
    const Geo geo = opaque_geo(geo_in);
    KArgs A = kargs(); unsigned char* ws = A->ws; const MoeCounts mc = moe_counts(ws);
    pg8::Gemm g{(const bf16_t*)(ws + WS_HIDM), (const bf16_t*)(ws + WS_MD), MOE_ROWS_MAX, DM, DFE}; MoeOrder S;
#pragma unroll
    for (int e = 0; e < NEXP; ++e) S.nb[e] = mc.nb[e];
    S.nN = DM / 256; S.G = geo.G; S.c = geo.vcu; S.finish();
#ifdef MOE_NO_MINI8
    S.nfull = S.nwg;
#endif
    EpiPlain E{(bf16_t*)(ws + WS_YB), DM, 0.015625f};
    pg8::gemm_phase<EpiPlain, MoeOrder, true, true, true>(lds, g, S, E);
    gemm_mini8<DFE, EpiPlain, MoeOrder>(lds, ws + WS_HIDM, ws + WS_MD, S, E, geo.vcu, geo.G);
}

__device__ __forceinline__ void phase_postffn0(const Geo geo_in, bool probe = false) {
    const Geo geo = opaque_geo(geo_in);
    KArgs A = kargs(); unsigned char* ws = A->ws;
    const int tid = opaque_tid(), lane = tid & 63, wave = __builtin_amdgcn_readfirstlane(tid >> 6);
    const int gw = geo.vcu * NWAVES + wave, NGW = geo.G * NWAVES;
    float* out = A->out; float* xctx = (float*)(ws + WS_XCTX); const float* pfn = A->in[I_POSTFFN]; const float* pmx = A->in[I_PREMIX] + DM;
    const float* modl = (const float*)(ws + WS_MOD); const bf16_t* FF = (const bf16_t*)(ws + WS_OF); bf16_t* Hb = (bf16_t*)(ws + WS_H);
#define X_LOAD(row_) (((row_) < NLAT) ? ld_bf16_row(xa_row(ws, (row_)), lane) : ld_f32_row(xctx + (size_t)((row_) - NLAT) * DM, lane))
#define P13_ROW(row_, cx_, cy_) do { const int rw_ = (row_); const int mi = (rw_ < NLAT) ? (rw_ >> 12) : 4;                                        \
        const Row16 x2 = resid_add(cx_, cy_, row_rstd(cy_), pfn, modl + (size_t)mi * NMOD + 5 * DM, lane);                                    \
        if (probe) st_bf16_row((bf16_t*)(ws + WS_PROJ) + (size_t)rw_ * DM, lane, x2);                                                          \
        else if (rw_ < NLAT) st_bf16_row_nt(xb_row(ws, rw_), lane, x2); else st_f32_row(xctx + (size_t)(rw_ - NLAT) * DM, lane, x2);                \
        const float* mdn = modl + (size_t)(5 + mi) * NMOD;                                                                                    \
        const Row16 h = norm_mod(x2, row_rstd(x2), pmx, mdn + 0 * DM, mdn + 1 * DM, lane);                                                    \
        st_bf16_row((probe ? (bf16_t*)(ws + WS_PROJ + 40 * MiB) : Hb) + (size_t)rw_ * DM, lane, h); } while (0)
    const int rc0 = NLAT + gw; Row16 cxc; RawB cyr; if (rc0 < R) { cxc = ld_f32_row(xctx + (size_t)(rc0 - NLAT) * DM, lane); cyr = ld_raw_b(FF + (size_t)rc0 * DM, lane); }
    for (int base = gw; base < NLAT; base += 8 * NGW) {
        RawB rx[8], ry[8];
#pragma unroll
        for (int k = 0; k < 8; ++k) { const int rw = (base + k * NGW < NLAT) ? base + k * NGW : base; rx[k] = ld_raw_b_nt(xa_row(ws, rw), lane); ry[k] = ld_raw_b_nt(FF + (size_t)rw * DM, lane); }
#pragma unroll
        for (int k = 0; k < 8; ++k) if (base + k * NGW < NLAT) { const Row16 cx = unraw_b(rx[k]), cy = unraw_b(ry[k]); P13_ROW(base + k * NGW, cx, cy); }
    }
    if (rc0 < R) { const Row16 cyc = unraw_b(cyr); P13_ROW(rc0, cxc, cyc); }
    for (int rc = rc0 + NGW; rc < R; rc += NGW) { const Row16 c2 = ld_f32_row(xctx + (size_t)(rc - NLAT) * DM, lane), y2 = ld_bf16_row(FF + (size_t)rc * DM, lane); P13_ROW(rc, c2, y2); }
#undef P13_ROW
#undef X_LOAD
}
__device__ __forceinline__ void phase_postffn1(const Geo geo_in) {
    const Geo geo = opaque_geo(geo_in);
    KArgs A = kargs(); unsigned char* ws = A->ws;
    const int tid = opaque_tid(), lane = tid & 63, wave = __builtin_amdgcn_readfirstlane(tid >> 6);
    const int gw = geo.vcu * NWAVES + wave, NGW = geo.G * NWAVES;
    float* out = A->out; const float* pfn = A->in[I_POSTFFN] + DM; const float* modl = (const float*)(ws + WS_MOD) + (size_t)5 * NMOD;
    const unsigned* route = (const unsigned*)(ws + WS_ROUTE); const bf16_t* YB = (const bf16_t*)(ws + WS_YB);
    const MoeCounts mc = moe_counts(ws); int pst[NEXP]; { int a_ = 0;
#pragma unroll
        for (int e = 0; e < NEXP; ++e) { pst[e] = a_; a_ += mc.nb[e] * 256; } }
    for (int base = gw; base < NLAT; base += 8 * NGW) {
        u32x4 rt[8];
#pragma unroll
        for (int k = 0; k < 8; ++k) { const unsigned* rr = route + (size_t)((base + k * NGW < NLAT) ? base + k * NGW : base) * 8; rt[k] = *(const u32x4*)(rr + 3); const unsigned ee = rr[0];
            const int e0 = ee & 255, e1 = (ee >> 8) & 255; int ps0 = 0, ps1 = 0;
#pragma unroll
            for (int e = 0; e < NEXP; ++e) { if (e == e0) ps0 = pst[e]; if (e == e1) ps1 = pst[e]; }
            rt[k].z += (unsigned)ps0; rt[k].w += (unsigned)ps1; }
        RawB fx[5], f0[5], f1[5];
#define P13L_LOAD(k_) do { const int rw_ = (base + (k_) * NGW < NLAT) ? base + (k_) * NGW : base; fx[(k_) % 5] = ld_raw_b_nt(xc_row(ws, rw_), lane);           \
        f0[(k_) % 5] = ld_raw_b_nt(YB + (size_t)rt[k_].z * DM, lane); f1[(k_) % 5] = ld_raw_b_nt(YB + (size_t)rt[k_].w * DM, lane); } while (0)
#pragma unroll
        for (int k = 0; k < 4; ++k) P13L_LOAD(k);
#pragma unroll
        for (int k = 0; k < 8; ++k) {
            if (k + 4 < 8) P13L_LOAD(k + 4);
            const int row = base + k * NGW;
            if (row < NLAT) {
                const float w0 = __uint_as_float(rt[k].x), w1 = __uint_as_float(rt[k].y);
                const Row16 cx = unraw_b(fx[k % 5]), c0 = unraw_b(f0[k % 5]), c1 = unraw_b(f1[k % 5]);
                Row16 y;
#pragma unroll
                for (int j = 0; j < 4; ++j) y.v[j] = c0.v[j] * w0 + c1.v[j] * w1;
                const Row16 x2 = resid_add(cx, y, row_rstd(y), pfn, modl + (size_t)(row >> 12) * NMOD + 5 * DM, lane);
                st_f32_row(out + (size_t)row * DM, lane, x2);
            }
        }
#undef P13L_LOAD
    }
}

__global__ void __launch_bounds__(NWAVES * 64, 2) fwd_kernel(Args args) {
    LAS unsigned char* lds = (LAS unsigned char*)lds_raw;
    volatile LAS unsigned* MISC = (volatile LAS unsigned*)(lds + MISC_OFF);
    Geo geo; geo.G = gridDim.x; geo.bx = blockIdx.x; geo.vcu = (geo.G % 8 == 0) ? (geo.bx % 8) * (geo.G / 8) + geo.bx / 8 : geo.bx;
    for (int u = threadIdx.x; u < (LDS_BYTES - LDS_CTL_OFF) / 4; u += NWAVES * 64) ((LAS unsigned*)(lds + LDS_CTL_OFF))[u] = 0u;
    __syncthreads();
    if ((threadIdx.x & 63) == 0) *(LAS int*)(lds + WAVE_TAB_OFF + 4 * hw_wave_slot()) = (int)(threadIdx.x >> 6);
    __syncthreads();
    const int lo = args.ph_lo, hi = args.ph_hi;
    XcdBarrier bar; bar.bar = (unsigned*)(args.ws + WS_CTL) + CW_BAR; bar.x = 0; bar.st = nullptr;
    if (hi - lo > 1) bar = xcd_barrier_post((unsigned*)(args.ws + WS_CTL) + CW_BAR, MISC + 8);
#ifndef PHASE_MASK
#define PHASE_MASK 0x3fff
#endif
#define IN(k) (((PHASE_MASK >> ((k) % NPH)) & 1) && lo <= (k) && (k) < hi)
#define SEAM(k) do { if (IN((k) + 1)) xcd_barrier(bar); } while (0)
#ifndef REP_ID
#define REP_ID (-1)
#endif
#define REP(k, call) do { call; if (REP_ID >= 0 && REP_ID == (k)) { if (hi - lo > 1) xcd_barrier(bar); call; } } while (0)
#pragma unroll 1
    for (int layer = 0; layer < 2; ++layer) {
        const int P = layer * NPH; const bool last = (layer == 1);
        if (!last && IN(P + 0)) { asm volatile("; PHASE_BEGIN_0" ::: "memory"); REP(P + 0, phase_prologue(lds, geo)); SEAM(P + 0); }
        if (!last && IN(P + 1)) { asm volatile("; PHASE_BEGIN_1" ::: "memory"); phase_premix0(geo); SEAM(P + 1); }
        if (IN(P + 2)) { asm volatile("; PHASE_BEGIN_2" ::: "memory"); REP(P + 2, phase_proj(lds, geo, layer));
            SEAM(P + 2); }
        if (IN(P + 3)) { asm volatile("; PHASE_BEGIN_3" ::: "memory"); phase_qknorm(geo, layer); SEAM(P + 3); }
        if (IN(P + 4)) { asm volatile("; PHASE_BEGIN_4" ::: "memory");
#ifndef NO_ATTN
            REP(P + 4, phase_attn(lds_raw, geo, last, layer));
#endif
#ifndef NO_SCAN
            REP(P + 4 + 100, phase_scan(lds, geo, last));
#endif
            SEAM(P + 4); }
        if (IN(P + 5)) { asm volatile("; PHASE_BEGIN_5" ::: "memory"); phase_readout(geo, layer); SEAM(P + 5); }
        if (IN(P + 6)) { asm volatile("; PHASE_BEGIN_6" ::: "memory"); phase_merge_hg(lds, geo, layer); VM_WAIT(); __syncthreads(); }
        if (IN(P + 7)) { asm volatile("; PHASE_BEGIN_7" ::: "memory"); phase_merge_att(lds, geo, layer); SEAM(P + 7); }
        if (IN(P + 8)) { asm volatile("; PHASE_BEGIN_8" ::: "memory"); REP(P + 8, phase_wout(lds, geo, layer)); SEAM(P + 8); }
        if (IN(P + 9)) { asm volatile("; PHASE_BEGIN_9" ::: "memory");
#if defined(THIN_PROBE)
            if (!last && THIN_PROBE == 9) { phase_postmix0(geo, true); xcd_barrier(bar); }
#endif
            if (!last) phase_postmix0(geo); else phase_postmix1(lds, geo); SEAM(P + 9); }
        if (IN(P + 11)) { asm volatile("; PHASE_BEGIN_11" ::: "memory"); if (!last) REP(P + 11, phase_ffn_up0(lds, geo)); else REP(P + 11, phase_ffn_up1(lds, geo)); SEAM(P + 11); }
        if (IN(P + 12)) { asm volatile("; PHASE_BEGIN_12" ::: "memory"); if (!last) REP(P + 12, phase_ffn_down0(lds, geo)); else REP(P + 12, phase_ffn_down1(lds, geo)); SEAM(P + 12); }
        if (IN(P + 13)) { asm volatile("; PHASE_BEGIN_13" ::: "memory");
#if defined(THIN_PROBE)
            if (!last && THIN_PROBE == 13) { phase_postffn0(geo, true); xcd_barrier(bar); }
#endif
            if (!last) { phase_postffn0(geo); SEAM(P + 13); } else phase_postffn1(geo); }
    }
#undef IN
#undef SEAM
}

__global__ void dump_kernel(const bf16_t* src, int pitch, float* out) {
    for (size_t i = (size_t)blockIdx.x * 256 + threadIdx.x; i < (size_t)NLAT * DM; i += (size_t)gridDim.x * 256) { const size_t row = i >> 10, c = i & 1023; out[i] = bf_lo((unsigned)src[row * pitch + c]); }
}
extern "C" void kernel_launch(void* const* d_in, const int* in_sizes, int n_in, void* d_out, int out_size, void* d_ws, size_t ws_size, hipStream_t stream) {
    static int grid = 0;
    if (grid == 0) {
        if (n_in != 25 || in_sizes[0] != NLAT * DM || out_size != NLAT * DM || ws_size < WS_END + 31 * MiB) { fprintf(stderr, "kernel_launch: unexpected shapes (n_in %d, in0 %d, out %d, ws %zu < %zu)\n", n_in, n_in > 0 ? in_sizes[0] : -1, out_size, ws_size, (size_t)(WS_END + 31 * MiB)); grid = -1; return; }
        int dev = 0, cus = 0, per_cu = 0;
        if (hipGetDevice(&dev) != hipSuccess || hipDeviceGetAttribute(&cus, hipDeviceAttributeMultiprocessorCount, dev) != hipSuccess) { grid = -1; return; }
        if (hipFuncSetAttribute((const void*)fwd_kernel, hipFuncAttributeMaxDynamicSharedMemorySize, LDS_BYTES) != hipSuccess) { fprintf(stderr, "kernel_launch: hipFuncSetAttribute failed\n"); grid = -1; return; }
        if (hipOccupancyMaxActiveBlocksPerMultiprocessor(&per_cu, (const void*)fwd_kernel, NWAVES * 64, LDS_BYTES) != hipSuccess || per_cu < 1) fprintf(stderr, "kernel_launch: occupancy query reports %d\n", per_cu);
        (void)hipGetLastError();
        grid = cus;
    }
    if (grid < 0) return;
    if (hipMemsetAsync((char*)d_ws + WS_CTL, 0, CTL_ZERO_BYTES, stream) != hipSuccess) return;
    Args a{};
    for (int i = 0; i < 25; ++i) a.in[i] = (const float*)d_in[i];
    a.out = (float*)d_out; a.ws = (unsigned char*)d_ws;
#ifndef MK_ONE_LAUNCH
#define MK_ONE_LAUNCH 0
#endif
    if (MK_ONE_LAUNCH) {
        a.ph_lo = 0; a.ph_hi = NTOT;
        hipLaunchKernelGGL(fwd_kernel, dim3(grid), dim3(NWAVES * 64), LDS_BYTES, stream, a);
    } else {
#ifndef LAST_PHASE
#define LAST_PHASE (NTOT - 1)
#endif
        for (int ph = 0; ph <= LAST_PHASE; ++ph) {
            const int p = ph % NPH, l = ph / NPH;
            if ((l == 1 && (p == 0 || p == 1)) || (l == 0 && p == 10)) continue;
            a.ph_lo = ph; a.ph_hi = ph + 1;
            hipLaunchKernelGGL(fwd_kernel, dim3(grid), dim3(NWAVES * 64), LDS_BYTES, stream, a);
        }
    }
#ifdef DUMP_OFF
    hipLaunchKernelGGL(dump_kernel, dim3(1024), dim3(256), 0, stream, (const bf16_t*)((const unsigned char*)d_ws + (size_t)(DUMP_OFF)), (int)(DUMP_PITCH), (float*)d_out);
#endif
    const hipError_t le = hipPeekAtLastError();
    if (le != hipSuccess) fprintf(stderr, "kernel_launch: launch failed: %s\n", hipGetErrorName(le));
}
```

```cpp
#define MK_ONE_LAUNCH 1
#include <hip/hip_runtime.h>
#include <cstdio>
#include <cstdint>
#include <type_traits>

#define GAS __attribute__((address_space(1)))
#define LAS __attribute__((address_space(3)))
typedef unsigned short bf16_t;
typedef float f32x2 __attribute__((ext_vector_type(2)));
typedef unsigned u32x2 __attribute__((ext_vector_type(2)));
typedef GAS unsigned gu32;
#define RLX_AGENT __ATOMIC_RELAXED, __HIP_MEMORY_SCOPE_AGENT
#define LDS_WAIT() asm volatile("s_waitcnt lgkmcnt(0)" ::: "memory")
#define VM_WAIT() asm volatile("s_waitcnt vmcnt(0)" ::: "memory")

constexpr int DM = 1024, NB = 4, SEQ = 4096, CTXL = 256, NLAT = NB * SEQ, NCTX = NB * CTXL, R = NLAT + NCTX;
constexpr int PROJW = 8704, DFF = 2816, NEXP = 8, DFE = 3584, NMOD = 6 * DM;
constexpr int MOE_ROWS_MAX = (2 * NLAT / 256 + NEXP) * 256;
constexpr float NORM_EPS = 1e-6f;

extern __shared__ __attribute__((aligned(16))) unsigned char lds_raw[];
constexpr int LDS_CTL_OFF = 159744, WAVE_TAB_OFF = LDS_CTL_OFF + 1024;
__device__ __forceinline__ int hw_wave_slot() { return (int)__builtin_amdgcn_s_getreg((7 << 11) | 4) & 255; }
__device__ __forceinline__ int opaque_tid() {
    const int wv = *(const __attribute__((address_space(3))) int*)((__attribute__((address_space(3))) unsigned char*)lds_raw + WAVE_TAB_OFF + 4 * hw_wave_slot());
    int t = (wv << 6) | (int)__builtin_amdgcn_mbcnt_hi(~0u, __builtin_amdgcn_mbcnt_lo(~0u, 0u));
    asm volatile("" : "+v"(t)); return t; }
#ifndef PG8_ASM_STAGE
#define PG8_ASM_STAGE 1
#endif
namespace pg8 {
#define PG8_LAS __attribute__((address_space(3)))
typedef unsigned short bf16_t;
typedef short bf16x8 __attribute__((ext_vector_type(8)));
typedef float f32x4 __attribute__((ext_vector_type(4)));
typedef unsigned u32x4 __attribute__((ext_vector_type(4)));
constexpr int BM = 256, BK = 64, HALF = 128, HTB = HALF * BK * 2  , STAGE_BYTES = 8 * HTB, NXCD = 8, WGM = 8;

__host__ __device__ __forceinline__ int lds_byte(int r, int c) { const int st = (r >> 4) * 2 + (c >> 5), rr = r & 15, cc = c & 31, ob = rr * 64 + cc * 2; return st * 1024 + (ob ^ (((ob >> 9) & 1) << 5)); }
__host__ __device__ __forceinline__ void stage_rc(int b, int& R, int& C) { const int st = b / 1024, sb = b % 1024, swz = sb ^ (((sb >> 9) & 1) << 5); R = (st >> 1) * 16 + swz / 64; C = (st & 1) * 32 + (swz % 64) / 2; }
__host__ __device__ __forceinline__ int perm32(int rho) { const int n = rho >> 4, i = rho & 15; return 8 * (i >> 2) + 4 * n + (i & 3); }

struct Unit { int pm, pn, pb, pa; };
struct Gemm { const bf16_t* A; const bf16_t* Bt; int M, N, K; };

struct StaticOrder {
    int nM, nN, nwg, G, c, nfull;
    __host__ __device__ void init(int M, int N, int G_, int c_) { nM = M / BM; nN = N / BM; nwg = nM * nN; G = G_; c = c_; const int rem = nwg % G; nfull = (rem != 0 && rem * 4 <= G && nwg > G) ? nwg - rem : nwg; }
    __host__ __device__ void at(int L, Unit& u) const {
        int wgid = L; { const int q = nwg / NXCD, r = nwg % NXCD, xcd = wgid % NXCD, off = wgid / NXCD; wgid = (xcd < r ? xcd * (q + 1) : r * (q + 1) + (xcd - r) * q) + off; }
        const int nig = WGM * nN, gid = wgid / nig, fm = gid * WGM, gsz = (nM - fm) < WGM ? (nM - fm) : WGM;
        u.pm = fm + ((wgid % nig) % gsz); u.pn = (wgid % nig) / gsz; u.pb = u.pn; u.pa = u.pm;
    }
    __host__ __device__ bool next(int i, Unit& u) const { const long L = (long)i * G + c; if (L >= nfull) return false; at((int)L, u); return true; }
    __device__ __forceinline__ void a_ready(const Unit&) const {}
    __device__ __forceinline__ void done(const Unit&) const {}
};

template <class Epi, class Sched, bool ALIGN_EPI = false, bool SP2 = false, bool FP8 = false>
__device__ __forceinline__ void gemm_phase(PG8_LAS unsigned char* lds, const Gemm g, const Sched& S, const Epi& E) {
    const int tid = opaque_tid(), wid = __builtin_amdgcn_readfirstlane(tid >> 6), lane = tid & 63, wr = wid >> 2, wc = wid & 3, fr = lane & 15, fq = lane >> 4;
    const int K = g.K, RB = FP8 ? K : 2 * K  , nt = RB / (2 * BK);
    unsigned voffA[2], voffB[2];
#pragma unroll
    for (int i = 0; i < 2; ++i) { int R, C; stage_rc(tid * 16 + i * 8192, R, C); const int Rb = Epi::PERM ? ((R & ~31) + perm32(R & 31)) : R;
        voffA[i] = (unsigned)(R * RB + C * 2); voffB[i] = (unsigned)(Rb * RB + C * 2); }
    const size_t kstep = (size_t)(BK * 2);
    const size_t hstep = (size_t)HALF * RB;
    const size_t tstep = 2 * hstep;
    const unsigned ldsw = (unsigned)wid * 1024u;
    const int aoff = lds_byte(wr * 64 + fr, fq * 8), boff = lds_byte(wc * 32 + fr, fq * 8);
#define PG8_SA(b, h) (((b) * 2 + (h)) * HTB)
#define PG8_SB(b, h) ((4 + (b) * 2 + (h)) * HTB)
#define PG8_STAGE(bufoff, gbase, voff) do { _Pragma("unroll") for (int _i = 0; _i < 2; ++_i) { \
        if constexpr (FP8 || PG8_ASM_STAGE) { unsigned keep_; asm volatile("s_mov_b32 %0, m0\n\ts_mov_b32 m0, %3\n\ts_nop 0\n\tglobal_load_lds_dwordx4 %1, %2\n\ts_mov_b32 m0, %0" : "=&s"(keep_) : "v"((voff)[_i]), "s"((const char*)(gbase)), "s"((unsigned)(size_t)(lds + (bufoff) + ldsw + _i * 8192)) : "memory"); } \
        else __builtin_amdgcn_global_load_lds((const unsigned*)((const char*)(gbase) + (voff)[_i]), (PG8_LAS unsigned*)(lds + (bufoff) + ldsw + _i * 8192), 16, 0, 0); } } while (0)
#define PG8_LDA(dst, b, h) do { _Pragma("unroll") for (int m = 0; m < 4; ++m) { \
        if constexpr (FP8) { const v4i_t lo_ = *(const PG8_LAS v4i_t*)(lds + PG8_SA(b, h) + aoff + m * 2048), hi_ = *(const PG8_LAS v4i_t*)(lds + PG8_SA(b, h) + aoff + m * 2048 + 1024); dst[m] = __builtin_shufflevector(lo_, hi_, 0, 1, 2, 3, 4, 5, 6, 7); } \
        else { _Pragma("unroll") for (int k = 0; k < 2; ++k) dst[m].k[k] = *(const PG8_LAS bf16x8*)(lds + PG8_SA(b, h) + aoff + m * 2048 + k * 1024); } } } while (0)
#define PG8_LDB(dst, b, h) do { _Pragma("unroll") for (int n = 0; n < 2; ++n) { \
        if constexpr (FP8) { const v4i_t lo_ = *(const PG8_LAS v4i_t*)(lds + PG8_SB(b, h) + boff + n * 2048), hi_ = *(const PG8_LAS v4i_t*)(lds + PG8_SB(b, h) + boff + n * 2048 + 1024); dst[n] = __builtin_shufflevector(lo_, hi_, 0, 1, 2, 3, 4, 5, 6, 7); } \
        else { _Pragma("unroll") for (int k = 0; k < 2; ++k) dst[n].k[k] = *(const PG8_LAS bf16x8*)(lds + PG8_SB(b, h) + boff + n * 2048 + k * 1024); } } } while (0)
#define PG8_MMA(ai, bj, At, Bt) do { __builtin_amdgcn_s_setprio(1); \
        if constexpr (FP8) { _Pragma("unroll") for (int m = 0; m < 4; ++m) _Pragma("unroll") for (int n = 0; n < 2; ++n) \
            asm volatile("v_mfma_scale_f32_16x16x128_f8f6f4 %0, %1, %2, %0, %3, %3 op_sel_hi:[0,0,0]" : "+v"(acc[ai][bj][m][n]) : "v"(Bt[n]), "v"(At[m]), "v"(sclv)); } \
        else { _Pragma("unroll") for (int m = 0; m < 4; ++m) _Pragma("unroll") for (int n = 0; n < 2; ++n) _Pragma("unroll") for (int k = 0; k < 2; ++k) \
        acc[ai][bj][m][n] = __builtin_amdgcn_mfma_f32_16x16x32_bf16(Bt[n].k[k], At[m].k[k], acc[ai][bj][m][n], 0, 0, 0); } __builtin_amdgcn_s_setprio(0); } while (0)
#define PG8_WAIT_V(n) asm volatile("s_waitcnt vmcnt(" #n ")" ::: "memory")
#define PG8_WAIT_L(n) asm volatile("s_waitcnt lgkmcnt(" #n ")" ::: "memory")
#define PG8_BAR __builtin_amdgcn_s_barrier()
#define PG8_SCHED __builtin_amdgcn_sched_barrier(0)
    Unit cur, nxt; int ui = 0;
    if (!S.next(0, cur)) return;
    f32x4 acc[2][2][4][2];
#pragma unroll
    for (int a = 0; a < 2; ++a)
#pragma unroll
        for (int b = 0; b < 2; ++b)
#pragma unroll
            for (int m = 0; m < 4; ++m)
#pragma unroll
                for (int n = 0; n < 2; ++n) acc[a][b][m][n] = (f32x4){0.f, 0.f, 0.f, 0.f};
    struct Frag2 { bf16x8 k[2]; }; typedef int v8i_t __attribute__((ext_vector_type(8))); typedef int v4i_t __attribute__((ext_vector_type(4)));
    typename std::conditional<FP8, v8i_t, Frag2>::type At[4], B0[2], B1[2]; const int sclv = 0x7F7F7F7F; (void)sclv;
    const char* cA = (const char*)g.A + (size_t)cur.pa * tstep; const char* cB = (const char*)g.Bt + (size_t)cur.pb * tstep;
    S.a_ready(cur);
    if constexpr (SP2) {
        PG8_STAGE(PG8_SB(0, 0), cB, voffB); PG8_STAGE(PG8_SB(0, 1), cB + hstep, voffB); PG8_STAGE(PG8_SA(0, 0), cA, voffA); PG8_STAGE(PG8_SA(0, 1), cA + hstep, voffA);
        if (wr == 1) PG8_BAR;
        PG8_WAIT_V(2); PG8_BAR;
        PG8_STAGE(PG8_SB(1, 0), cB + kstep, voffB); PG8_STAGE(PG8_SA(1, 0), cA + kstep, voffA); PG8_STAGE(PG8_SB(1, 1), cB + hstep + kstep, voffB);
        PG8_WAIT_V(6); PG8_BAR;
    } else {
        PG8_STAGE(PG8_SB(0, 0), cB, voffB); PG8_STAGE(PG8_SA(0, 0), cA, voffA); PG8_STAGE(PG8_SB(0, 1), cB + hstep, voffB); PG8_STAGE(PG8_SA(0, 1), cA + hstep, voffA);
        if (wr == 1) PG8_BAR;
        PG8_WAIT_V(4); PG8_BAR;
        PG8_STAGE(PG8_SB(1, 0), cB + kstep, voffB); PG8_STAGE(PG8_SA(1, 0), cA + kstep, voffA); PG8_STAGE(PG8_SB(1, 1), cB + hstep + kstep, voffB);
        PG8_WAIT_V(6); PG8_BAR;
    }
    for (;;) {
        const bool has_next = S.next(ui + 1, nxt);
        const char* nA = has_next ? (const char*)g.A + (size_t)nxt.pa * tstep : cA; const char* nB = has_next ? (const char*)g.Bt + (size_t)nxt.pb * tstep : cB;
#pragma unroll 1
        for (int t = 0; t < nt; t += 2) {
            const bool last = (t == nt - 2);
            const char* a1 = cA + (size_t)(t + 1) * kstep;
            const char* a2 = last ? nA : cA + (size_t)(t + 2) * kstep; const char* b2 = last ? nB : cB + (size_t)(t + 2) * kstep;
            const char* a3 = a2 + kstep; const char* b3 = b2 + kstep;
            if (last && has_next) S.a_ready(nxt);
            if constexpr (SP2) {
            PG8_LDB(B0, 0, 0); PG8_LDB(B1, 0, 1); PG8_SCHED; PG8_LDA(At, 0, 0); PG8_STAGE(PG8_SA(1, 1), a1 + hstep, voffA);
            PG8_WAIT_V(8); PG8_WAIT_L(0); PG8_BAR; PG8_MMA(0, 0, At, B0); PG8_MMA(0, 1, At, B1); PG8_BAR; PG8_SCHED;
            PG8_LDA(At, 0, 1); PG8_STAGE(PG8_SB(0, 0), b2, voffB); PG8_STAGE(PG8_SB(0, 1), b2 + hstep, voffB); PG8_STAGE(PG8_SA(0, 0), a2, voffA);
            PG8_WAIT_V(8); PG8_WAIT_L(0); PG8_BAR; PG8_MMA(1, 0, At, B0); PG8_MMA(1, 1, At, B1); PG8_BAR; PG8_SCHED;
            PG8_LDB(B0, 1, 0); PG8_LDB(B1, 1, 1); PG8_SCHED; PG8_LDA(At, 1, 0); PG8_STAGE(PG8_SA(0, 1), a2 + hstep, voffA);
            PG8_WAIT_V(8); PG8_WAIT_L(0); PG8_BAR; PG8_MMA(0, 0, At, B0); PG8_MMA(0, 1, At, B1); PG8_BAR; PG8_SCHED;
            PG8_LDA(At, 1, 1); PG8_STAGE(PG8_SB(1, 0), b3, voffB); PG8_STAGE(PG8_SB(1, 1), b3 + hstep, voffB); PG8_STAGE(PG8_SA(1, 0), a3, voffA);
            PG8_WAIT_V(8); PG8_WAIT_L(0); PG8_BAR; PG8_MMA(1, 0, At, B0); PG8_MMA(1, 1, At, B1); PG8_BAR; PG8_SCHED;
            } else {
            PG8_LDB(B0, 0, 0); PG8_SCHED; PG8_LDA(At, 0, 0); PG8_STAGE(PG8_SA(1, 1), a1 + hstep, voffA);
            PG8_WAIT_L(8); PG8_BAR; PG8_WAIT_L(0); PG8_MMA(0, 0, At, B0); PG8_BAR; PG8_SCHED;
            PG8_LDB(B1, 0, 1); PG8_STAGE(PG8_SB(0, 0), b2, voffB);
            PG8_BAR; PG8_WAIT_L(0); PG8_MMA(0, 1, At, B1); PG8_BAR;
            PG8_LDA(At, 0, 1); PG8_STAGE(PG8_SA(0, 0), a2, voffA);
            PG8_BAR; PG8_WAIT_L(0); PG8_MMA(1, 0, At, B0); PG8_BAR; PG8_SCHED;
            PG8_STAGE(PG8_SB(0, 1), b2 + hstep, voffB);
            PG8_WAIT_V(6); PG8_BAR; PG8_MMA(1, 1, At, B1); PG8_BAR;
            PG8_LDB(B0, 1, 0); PG8_SCHED; PG8_LDA(At, 1, 0); PG8_STAGE(PG8_SA(0, 1), a2 + hstep, voffA);
            PG8_WAIT_L(8); PG8_BAR; PG8_WAIT_L(0); PG8_MMA(0, 0, At, B0); PG8_BAR; PG8_SCHED;
            PG8_LDB(B1, 1, 1); PG8_STAGE(PG8_SB(1, 0), b3, voffB);
            PG8_BAR; PG8_WAIT_L(0); PG8_MMA(0, 1, At, B1); PG8_BAR;
            PG8_LDA(At, 1, 1); PG8_STAGE(PG8_SA(1, 0), a3, voffA);
            PG8_BAR; PG8_WAIT_L(0); PG8_MMA(1, 0, At, B0); PG8_BAR; PG8_SCHED;
            PG8_STAGE(PG8_SB(1, 1), b3 + hstep, voffB);
            PG8_WAIT_V(6); PG8_BAR; PG8_MMA(1, 1, At, B1); PG8_BAR;
            }
        }
        if constexpr (ALIGN_EPI) { if (wr == 0) PG8_BAR; }
        if constexpr (FP8) asm volatile("s_nop 15\n\ts_nop 15" ::: "memory");
        if constexpr (!Epi::AFTER_DRAIN) { E(acc, cur, wr, wc, fr, fq); S.done(cur); }
        if (!has_next) break;
#pragma unroll
        for (int a = 0; a < 2; ++a)
#pragma unroll
            for (int b = 0; b < 2; ++b)
#pragma unroll
                for (int m = 0; m < 4; ++m)
#pragma unroll
                    for (int n = 0; n < 2; ++n) acc[a][b][m][n] = (f32x4){0.f, 0.f, 0.f, 0.f};
        cur = nxt; cA = nA; cB = nB; ++ui;
        if constexpr (ALIGN_EPI) { if (wr == 1) PG8_BAR; }
    }
    PG8_WAIT_V(0);
    if constexpr (!ALIGN_EPI) { if (wr == 0) PG8_BAR; }
    PG8_BAR;
    if constexpr (Epi::AFTER_DRAIN) { E.fused(acc, cur, wr, wc, fr, fq, lds, wid, lane); S.done(cur); }
#undef PG8_SA
#undef PG8_SB
#undef PG8_STAGE
#undef PG8_LDA
#undef PG8_LDB
#undef PG8_MMA
#undef PG8_WAIT_V
#undef PG8_WAIT_L
#undef PG8_BAR
#undef PG8_SCHED
}
}

using pg8::f32x4; using pg8::u32x4; using pg8::bf16x8; using pg8::Unit;
typedef __bf16 bf16x2_t __attribute__((ext_vector_type(2)));
__device__ __forceinline__ unsigned pk_bf16(float lo, float hi) { const f32x2 v = {lo, hi}; const bf16x2_t b = __builtin_convertvector(v, bf16x2_t); return __builtin_bit_cast(unsigned, b); }
__device__ __forceinline__ float bf_lo(unsigned u) { return __uint_as_float(u << 16); }
__device__ __forceinline__ float bf_hi(unsigned u) { return __uint_as_float(u & 0xffff0000u); }
typedef _Float16 h2_t __attribute__((ext_vector_type(2)));
__device__ __forceinline__ unsigned pk_f16(float lo, float hi) { h2_t h = {(_Float16)lo, (_Float16)hi}; return __builtin_bit_cast(unsigned, h); }
__device__ __forceinline__ f32x2 unpk_f16(unsigned u) { h2_t h = __builtin_bit_cast(h2_t, u); return (f32x2){(float)h.x, (float)h.y}; }
__device__ __forceinline__ float sigm(float x) { return __builtin_amdgcn_rcpf(1.f + __expf(-x)); }
__device__ __forceinline__ float silu_f(float x) { return x * sigm(x); }
__device__ __forceinline__ u32x4 pack8(const f32x4 a, const f32x4 b) { u32x4 w; w.x = pk_bf16(a[0], a[1]); w.y = pk_bf16(a[2], a[3]); w.z = pk_bf16(b[0], b[1]); w.w = pk_bf16(b[2], b[3]); return w; }
__device__ __forceinline__ void unpack8(const u32x4 w, f32x4& a, f32x4& b) { a = (f32x4){bf_lo(w.x), bf_hi(w.x), bf_lo(w.y), bf_hi(w.y)}; b = (f32x4){bf_lo(w.z), bf_hi(w.z), bf_lo(w.w), bf_hi(w.w)}; }

__device__ __forceinline__ void sigm8(const f32x4 a, const f32x4 b, f32x4& sa, f32x4& sb) {
    f32x4 ea, eb;
#pragma unroll
    for (int j = 0; j < 4; ++j) { ea[j] = __builtin_amdgcn_exp2f(a[j] * -1.4426950408889634f); eb[j] = __builtin_amdgcn_exp2f(b[j] * -1.4426950408889634f); }
#pragma unroll
    for (int j = 0; j < 4; ++j) { sa[j] = __builtin_amdgcn_rcpf(1.f + ea[j]); sb[j] = __builtin_amdgcn_rcpf(1.f + eb[j]); }
}
#ifndef EPI_NT
#define EPI_NT 0
#endif
#ifndef EPI_SC1
#define EPI_SC1 0
#endif
__device__ __forceinline__ void st16(void* p, u32x4 v) { if (EPI_SC1) *(volatile GAS u32x4*)p = v; else if (EPI_NT) __builtin_nontemporal_store(v, (u32x4*)p); else *(u32x4*)p = v; }
__device__ __forceinline__ void st8(void* p, u32x2 v) { if (EPI_SC1) *(volatile GAS u32x2*)p = v; else if (EPI_NT) __builtin_nontemporal_store(v, (u32x2*)p); else *(u32x2*)p = v; }
__device__ __forceinline__ float clamp448(float x) { return fminf(fmaxf(x, -448.f), 448.f); }
__device__ __forceinline__ unsigned pk4_fp8(float a, float b, float c, float d) { int w = 0; w = __builtin_amdgcn_cvt_pk_fp8_f32(clamp448(a), clamp448(b), w, false); w = __builtin_amdgcn_cvt_pk_fp8_f32(clamp448(c), clamp448(d), w, true); return (unsigned)w; }


struct EpiProj {
    static constexpr bool PERM = true, AFTER_DRAIN = false;
    bf16_t* proj; const float* lbv; int probe = 0;
    template <int MODE> __device__ __forceinline__ void emit(const f32x4 (&acc)[2][2][4][2], bf16_t* base, int ldc, const float* lbp) const {
        f32x4 lb[2][2];
        if (MODE == 3) {
#pragma unroll
            for (int bj = 0; bj < 2; ++bj)
#pragma unroll
                for (int n = 0; n < 2; ++n) lb[bj][n] = *(const f32x4*)(lbp + bj * 128 + 4 * n);
        }
#pragma unroll
        for (int ai = 0; ai < 2; ++ai)
#pragma unroll
            for (int m = 0; m < 4; ++m) { bf16_t* rowp = base + (size_t)(ai * 128 + m * 16) * ldc;
#pragma unroll
                for (int bj = 0; bj < 2; ++bj) { f32x4 v[2] = {acc[ai][bj][m][0], acc[ai][bj][m][1]}; u32x4 w;
                    if (MODE == 0) w = pack8(v[0], v[1]);
                    else { f32x4 s0, s1; sigm8(v[0], v[1], s0, s1);
                        if (MODE == 1) w = pack8(v[0] * s0, v[1] * s1);
                        else if (MODE == 2) w = pack8(s0, s1);
                        else { const f32x4 f0 = lb[bj][0] + (1.f - lb[bj][0]) * s0, f1 = lb[bj][1] + (1.f - lb[bj][1]) * s1; f32x4 g0, g1;
#pragma unroll
                            for (int j = 0; j < 4; ++j) { g0[j] = __builtin_amdgcn_logf(f0[j]); g1[j] = __builtin_amdgcn_logf(f1[j]); }
#pragma unroll
                            for (int j = 0; j < 4; ++j) { g0[j] = fmaxf(g0[j], -57.f); g1[j] = fmaxf(g1[j], -57.f); }
                            w.x = pk_f16(g0[0], g0[1]); w.y = pk_f16(g0[2], g0[3]); w.z = pk_f16(g1[0], g1[1]); w.w = pk_f16(g1[2], g1[3]); } }
                    st16(rowp + bj * 128, w); } }
    }
    __device__ __forceinline__ void operator()(const f32x4 (&acc)[2][2][4][2], const Unit& u, int wr, int wc, int fr, int fq) const {
        const int pn = u.pn; int seg, ct;
        if (pn < 4) { seg = 0; ct = pn; } else if (pn < 6) { seg = pn - 3; ct = 0; } else { seg = 3 + ((pn - 6) >> 2); ct = (pn - 6) & 3; }
        const size_t segoff = (seg == 0) ? (size_t)0 : (seg == 1) ? (size_t)R * 1024 : (seg == 2) ? (size_t)R * 1280 : (size_t)R * (size_t)(1536 + 1024 * (seg - 3));
        const int ldc = (seg == 1 || seg == 2) ? 256 : 1024;
        const int mode = (seg == 3 || seg == 7) ? 1 : (seg == 8 || seg == 9) ? 2 : (seg == 4 || seg == 5) ? 3 : 0;
        const int row0 = u.pm * 256 + wr * 64 + fr, col0 = ct * 256 + wc * 32 + 8 * fq;
        bf16_t* base = probe ? proj + (size_t)(wr * 64 + fr) * ldc + col0 : proj + segoff + (size_t)row0 * ldc + col0;
        if (mode == 0) emit<0>(acc, base, ldc, nullptr);
        else if (mode == 1) emit<1>(acc, base, ldc, nullptr);
        else if (mode == 2) emit<2>(acc, base, ldc, nullptr);
        else emit<3>(acc, base, ldc, lbv + col0);
    }
    __device__ __forceinline__ void put8(const Unit& u, int rt, int ctl, f32x4 v0, f32x4 v1) const {
        const int pn = u.pn; int seg, ct;
        if (pn < 4) { seg = 0; ct = pn; } else if (pn < 6) { seg = pn - 3; ct = 0; } else { seg = 3 + ((pn - 6) >> 2); ct = (pn - 6) & 3; }
        const size_t segoff = (seg == 0) ? (size_t)0 : (seg == 1) ? (size_t)R * 1024 : (seg == 2) ? (size_t)R * 1280 : (size_t)R * (size_t)(1536 + 1024 * (seg - 3));
        const int ldc = (seg == 1 || seg == 2) ? 256 : 1024;
        const int mode = (seg == 3 || seg == 7) ? 1 : (seg == 8 || seg == 9) ? 2 : (seg == 4 || seg == 5) ? 3 : 0;
        const int col = ct * 256 + ctl;
        u32x4 w;
        if (mode == 3) { const f32x4 l0 = *(const f32x4*)(lbv + col), l1 = *(const f32x4*)(lbv + col + 4); float g[8];
#pragma unroll
            for (int j = 0; j < 4; ++j) { g[j] = fmaxf(__builtin_amdgcn_logf(l0[j] + (1.f - l0[j]) * sigm(v0[j])), -57.f); g[4 + j] = fmaxf(__builtin_amdgcn_logf(l1[j] + (1.f - l1[j]) * sigm(v1[j])), -57.f); }
            w.x = pk_f16(g[0], g[1]); w.y = pk_f16(g[2], g[3]); w.z = pk_f16(g[4], g[5]); w.w = pk_f16(g[6], g[7]);
        } else {
#pragma unroll
            for (int j = 0; j < 4; ++j) { if (mode == 1) { v0[j] = silu_f(v0[j]); v1[j] = silu_f(v1[j]); } if (mode == 2) { v0[j] = sigm(v0[j]); v1[j] = sigm(v1[j]); } }
            w = pack8(v0, v1);
        }
        *(u32x4*)(proj + segoff + (size_t)(u.pm * 256 + rt) * ldc + col) = w;
    }
};
struct EpiSwiGLU {
    static constexpr bool PERM = true, AFTER_DRAIN = false;
    bf16_t* O; int ldc;
    __device__ __forceinline__ void operator()(const f32x4 (&acc)[2][2][4][2], const Unit& u, int wr, int wc, int fr, int fq) const {
        bf16_t* base = O + (size_t)(u.pm * 256 + wr * 64 + fr) * ldc + u.pn * 128 + wc * 32 + 8 * fq;
#pragma unroll
        for (int ai = 0; ai < 2; ++ai)
#pragma unroll
            for (int m = 0; m < 4; ++m) { f32x4 s0, s1; sigm8(acc[ai][0][m][0], acc[ai][0][m][1], s0, s1);
                st16(base + (size_t)(ai * 128 + m * 16) * ldc, pack8(acc[ai][0][m][0] * s0 * acc[ai][1][m][0], acc[ai][0][m][1] * s1 * acc[ai][1][m][1])); }
    }
    __device__ __forceinline__ void put8(const Unit&, int, int, f32x4, f32x4) const {}
};
struct EpiSwiGLU8 {
    static constexpr bool PERM = true, AFTER_DRAIN = false;
    unsigned char* O; int ldc;
    __device__ __forceinline__ void operator()(const f32x4 (&acc)[2][2][4][2], const Unit& u, int wr, int wc, int fr, int fq) const {
        unsigned char* base = O + (size_t)(u.pm * 256 + wr * 64 + fr) * ldc + u.pn * 128 + wc * 32 + 8 * fq;
#pragma unroll
        for (int ai = 0; ai < 2; ++ai)
#pragma unroll
            for (int m = 0; m < 4; ++m) { const f32x4 g0 = acc[ai][0][m][0] * 0.015625f, g1 = acc[ai][0][m][1] * 0.015625f; f32x4 s0, s1; sigm8(g0, g1, s0, s1);
                const f32x4 h0 = g0 * s0 * (acc[ai][1][m][0] * 0.015625f), h1 = g1 * s1 * (acc[ai][1][m][1] * 0.015625f);
                st8(base + (size_t)(ai * 128 + m * 16) * ldc, (u32x2){pk4_fp8(h0[0], h0[1], h0[2], h0[3]), pk4_fp8(h1[0], h1[1], h1[2], h1[3])}); }
    }
    __device__ __forceinline__ void put8(const Unit&, int, int, f32x4, f32x4) const {}
};
template <bool HAS_ADD> struct EpiGate {
    static constexpr bool PERM = true, AFTER_DRAIN = false;
    bf16_t* G; const bf16_t* ADD;
    __device__ __forceinline__ void operator()(const f32x4 (&acc)[2][2][4][2], const Unit& u, int wr, int wc, int fr, int fq) const {
        const size_t off0 = (size_t)(u.pm * 256 + wr * 64 + fr) * 1024 + u.pn * 256 + wc * 32 + 8 * fq;
#pragma unroll
        for (int ai = 0; ai < 2; ++ai) {
            u32x4 gv[4][2], av[4][2];
#pragma unroll
            for (int m = 0; m < 4; ++m)
#pragma unroll
                for (int bj = 0; bj < 2; ++bj) { const size_t off = off0 + (size_t)(ai * 128 + m * 16) * 1024 + bj * 128;
                    gv[m][bj] = *(const u32x4*)(G + off); if (HAS_ADD) av[m][bj] = *(const u32x4*)(ADD + off); }
#pragma unroll
            for (int m = 0; m < 4; ++m)
#pragma unroll
                for (int bj = 0; bj < 2; ++bj) { const size_t off = off0 + (size_t)(ai * 128 + m * 16) * 1024 + bj * 128;
                    f32x4 g0, g1; unpack8(gv[m][bj], g0, g1);
                    f32x4 o0 = g0 * acc[ai][bj][m][0], o1 = g1 * acc[ai][bj][m][1];
                    if (HAS_ADD) { f32x4 a0, a1; unpack8(av[m][bj], a0, a1); o0 += a0; o1 += a1; }
                    st16(G + off, pack8(o0, o1)); }
        }
    }
    __device__ __forceinline__ void put8(const Unit& u, int rt, int ctl, f32x4 v0, f32x4 v1) const {
        const size_t off = (size_t)(u.pm * 256 + rt) * 1024 + u.pn * 256 + ctl;
        f32x4 g0, g1; unpack8(*(const u32x4*)(G + off), g0, g1);
        f32x4 o0 = g0 * v0, o1 = g1 * v1;
        if (HAS_ADD) { f32x4 a0, a1; unpack8(*(const u32x4*)(ADD + off), a0, a1); o0 += a0; o1 += a1; }
        *(u32x4*)(G + off) = pack8(o0, o1);
    }
};
struct EpiPlain {
    static constexpr bool PERM = true, AFTER_DRAIN = false;
    bf16_t* O; int ldc; float scale = 1.f;
    __device__ __forceinline__ void operator()(const f32x4 (&acc)[2][2][4][2], const Unit& u, int wr, int wc, int fr, int fq) const {
        bf16_t* base = O + (size_t)(u.pm * 256 + wr * 64 + fr) * ldc + u.pn * 256 + wc * 32 + 8 * fq;
#pragma unroll
        for (int ai = 0; ai < 2; ++ai)
#pragma unroll
            for (int m = 0; m < 4; ++m)
#pragma unroll
                for (int bj = 0; bj < 2; ++bj) st16(base + (size_t)(ai * 128 + m * 16) * ldc + bj * 128, pack8(acc[ai][bj][m][0] * scale, acc[ai][bj][m][1] * scale));
    }
    __device__ __forceinline__ void put8(const Unit& u, int rt, int ctl, f32x4 v0, f32x4 v1) const {
        *(u32x4*)(O + (size_t)(u.pm * 256 + rt) * ldc + u.pn * 256 + ctl) = pack8(v0 * scale, v1 * scale);
    }
};
struct EpiNull {
    static constexpr bool PERM = true, AFTER_DRAIN = false;
    __device__ __forceinline__ void operator()(const f32x4 (&acc)[2][2][4][2], const Unit& u, int wr, int wc, int fr, int fq) const {
#pragma unroll
        for (int a = 0; a < 2; ++a)
#pragma unroll
            for (int b = 0; b < 2; ++b)
#pragma unroll
                for (int m = 0; m < 4; ++m) asm volatile("" :: "v"(acc[a][b][m][0]), "v"(acc[a][b][m][1])); }
    __device__ __forceinline__ void put8(const Unit&, int, int, f32x4, f32x4) const {}
};
struct MoeOrder {
    int nb[NEXP]; int nN, G, c, nwg, nfull, acap = 0;
    __device__ __forceinline__ void finish() { int t = 0;
#pragma unroll
        for (int e = 0; e < NEXP; ++e) t += nb[e] * nN;
        nwg = t; const int rem = t % G; nfull = (rem != 0 && rem * 4 <= G && t > G) ? t - rem : t; }
    __device__ __forceinline__ bool at(int L, Unit& u) const {
        int accu = 0, pbase = 0; bool found = false;
#pragma unroll
        for (int e = 0; e < NEXP; ++e) { const int ue = nb[e] * nN;
            if (!found && L < accu + ue) { const int loc = L - accu; const int q = loc / nb[e]; u.pn = q; u.pm = pbase + (loc - q * nb[e]); u.pb = e * nN + q; u.pa = acap ? e * acap + (loc - q * nb[e]) : u.pm; found = true; }
            accu += ue; pbase += nb[e]; }
        return found;
    }
    __device__ __forceinline__ bool next(int i, Unit& u) const { const int L = i * G + c; if (L >= nfull) return false; return at(L, u); }
    __device__ __forceinline__ void a_ready(const Unit&) const {}
    __device__ __forceinline__ void done(const Unit&) const {}
};

template <class Epi, class Sched>
__device__ __forceinline__ void gemm_mini(const pg8::Gemm g, const Sched& S, const Epi& E, int wgi, int nwgs) {
    const int nbig = S.nwg - S.nfull; if (nbig <= 0) return;
    const int tid = opaque_tid(), w = __builtin_amdgcn_readfirstlane(tid >> 6), lane = tid & 63, r = lane & 15, q4 = lane >> 4;
    const int wm = w >> 1, wn = w & 1; const int K = g.K;
    for (int m = wgi; m < nbig * 16; m += nwgs) {
        Unit u; S.at(S.nfull + (m >> 4), u); const int sub = m & 15, rt = (sub >> 2) * 64 + wm * 16 + r, ct = (sub & 3) * 64 + wn * 32;
        const bf16_t* ap = g.A + ((size_t)u.pm * 256 + rt) * K + 8 * q4;
        const bf16_t* bp0 = g.Bt + ((size_t)u.pb * 256 + ct + 8 * (r >> 2) + (r & 3)) * K + 8 * q4;
        const bf16_t* bp1 = bp0 + (size_t)4 * K;
        f32x4 c0 = (f32x4){0.f, 0.f, 0.f, 0.f}, c1 = (f32x4){0.f, 0.f, 0.f, 0.f};
        for (int ks = 0; ks < K / 32; ks += 8) {
            bf16x8 a[8], b0[8], b1[8];
#pragma unroll
            for (int i = 0; i < 8; ++i) { a[i] = *(const bf16x8*)(ap + 32 * (ks + i)); b0[i] = *(const bf16x8*)(bp0 + 32 * (ks + i)); b1[i] = *(const bf16x8*)(bp1 + 32 * (ks + i)); }
#pragma unroll
            for (int i = 0; i < 8; ++i) { c0 = __builtin_amdgcn_mfma_f32_16x16x32_bf16(b0[i], a[i], c0, 0, 0, 0); c1 = __builtin_amdgcn_mfma_f32_16x16x32_bf16(b1[i], a[i], c1, 0, 0, 0); }
        }
        E.put8(u, rt, ct + 8 * q4, c0, c1);
    }
}
template <class Epi, class Sched>
__device__ __forceinline__ void gemm_mini_ks(LAS unsigned char* lds, const pg8::Gemm g, const Sched& S, const Epi& E, int wgi, int nwgs) {
    const int nbig = S.nwg - S.nfull; if (nbig <= 0) return;
    constexpr int K = DM, PP = 68; static_assert(K / 32 == 32, "four K-steps per wave");
    const int tid = opaque_tid(), w = __builtin_amdgcn_readfirstlane(tid >> 6), lane = tid & 63, r = lane & 15, q4 = lane >> 4;
    LAS float* part = (LAS float*)lds + w * 64 * PP;
    __syncthreads();
    for (int m = wgi; m < nbig * 16; m += nwgs) {
        Unit u; S.at(S.nfull + (m >> 4), u); const int sub = m & 15, rt0 = (sub >> 2) * 64, ct0 = (sub & 3) * 64;
        const bf16_t* ap = g.A + ((size_t)u.pm * 256 + rt0) * K + (r * K + 8 * q4);
        const bf16_t* bp = g.Bt + ((size_t)u.pb * 256 + ct0) * K + (r * K + 8 * q4);
        f32x4 acc[4][4];
#pragma unroll
        for (int i = 0; i < 4; ++i)
#pragma unroll
            for (int j = 0; j < 4; ++j) acc[i][j] = (f32x4){0.f, 0.f, 0.f, 0.f};
        bf16x8 fa[2][4], fb[2][4];
#define MK_LOAD(s_, ks_) do { _Pragma("unroll") for (int t = 0; t < 4; ++t) { fa[s_][t] = *(const bf16x8*)(ap + (size_t)16 * t * K + 32 * (ks_)); fb[s_][t] = *(const bf16x8*)(bp + (size_t)16 * t * K + 32 * (ks_)); } } while (0)
#define MK_MMA(s_) do { _Pragma("unroll") for (int tm = 0; tm < 4; ++tm) _Pragma("unroll") for (int tn = 0; tn < 4; ++tn)                      \
            acc[tm][tn] = __builtin_amdgcn_mfma_f32_16x16x32_bf16(fb[s_][tn], fa[s_][tm], acc[tm][tn], 0, 0, 0); } while (0)
        MK_LOAD(0, w); MK_LOAD(1, w + 8);
        MK_MMA(0); MK_LOAD(0, w + 16);
        MK_MMA(1); MK_LOAD(1, w + 24);
        MK_MMA(0); MK_MMA(1);
#undef MK_LOAD
#undef MK_MMA
#pragma unroll
        for (int tm = 0; tm < 4; ++tm)
#pragma unroll
            for (int tn = 0; tn < 4; ++tn) *(LAS f32x4*)(part + (16 * tm + r) * PP + 16 * tn + 4 * q4) = acc[tm][tn];
        __syncthreads();
        { const int row = tid >> 3, cg = tid & 7; f32x4 v0 = (f32x4){0.f, 0.f, 0.f, 0.f}, v1 = v0;
#pragma unroll
          for (int ww = 0; ww < 8; ++ww) { const LAS float* p = (const LAS float*)lds + ww * 64 * PP + row * PP + 8 * cg; v0 += *(const LAS f32x4*)p; v1 += *(const LAS f32x4*)(p + 4); }
          E.put8(u, rt0 + row, ct0 + 8 * cg, v0, v1); }
        __syncthreads();
    }
}
template <int K, class Epi, class Sched>
__device__ __forceinline__ void gemm_mini8(LAS unsigned char* lds, const unsigned char* Ag, const unsigned char* Bg, const Sched& S, const Epi& E, int wgi, int nwgs) {
    const int nbig = S.nwg - S.nfull; if (nbig <= 0) return;
    typedef int v8i_t __attribute__((ext_vector_type(8))); typedef int v4i_t __attribute__((ext_vector_type(4)));
    const int tid = opaque_tid(), w = __builtin_amdgcn_readfirstlane(tid >> 6), lane = tid & 63, r = lane & 15, q4 = lane >> 4;
    const int sclv = 0x7F7F7F7F; constexpr int nks = K / 128; constexpr int PP = 68;
    LAS float* part = (LAS float*)lds + w * 64 * PP;
    __syncthreads();
    for (int m = wgi; m < nbig * 16; m += nwgs) {
        Unit u; S.at(S.nfull + (m >> 4), u); const int sub = m & 15, rt0 = (sub >> 2) * 64, ct0 = (sub & 3) * 64;
        const unsigned char* ap = Ag + ((size_t)u.pm * 256 + rt0) * K + (r * K + 32 * q4);
        const unsigned char* bp = Bg + ((size_t)u.pb * 256 + ct0) * K + (r * K + 32 * q4);
        f32x4 acc[4][4];
#pragma unroll
        for (int i = 0; i < 4; ++i)
#pragma unroll
            for (int j = 0; j < 4; ++j) acc[i][j] = (f32x4){0.f, 0.f, 0.f, 0.f};
        v8i_t fa[2][4], fb[4];
#define M8_LDA(s_, ks_) do { const size_t o = (size_t)128 * (ks_); _Pragma("unroll") for (int t = 0; t < 4; ++t) {                                    \
            const v4i_t al = *(const v4i_t*)(ap + (size_t)16 * t * K + o), ah = *(const v4i_t*)(ap + (size_t)16 * t * K + o + 16);                          \
            fa[s_][t] = __builtin_shufflevector(al, ah, 0, 1, 2, 3, 4, 5, 6, 7); } } while (0)
#define M8_LDB(ks_) do { const size_t o = (size_t)128 * (ks_); _Pragma("unroll") for (int t = 0; t < 4; ++t) {                                         \
            const v4i_t bl = *(const v4i_t*)(bp + (size_t)16 * t * K + o), bh = *(const v4i_t*)(bp + (size_t)16 * t * K + o + 16);                          \
            fb[t] = __builtin_shufflevector(bl, bh, 0, 1, 2, 3, 4, 5, 6, 7); } } while (0)
#define M8_MMA(s_) do { _Pragma("unroll") for (int tm = 0; tm < 4; ++tm) _Pragma("unroll") for (int tn = 0; tn < 4; ++tn)                                 \
            asm volatile("v_mfma_scale_f32_16x16x128_f8f6f4 %0, %1, %2, %0, %3, %3 op_sel_hi:[0,0,0]" : "+v"(acc[tm][tn]) : "v"(fb[tn]), "v"(fa[s_][tm]), "v"(sclv)); } while (0)
        const int k0 = w, k1 = w + 8, k2 = w + 16, k3 = (w + 24 < nks) ? w + 24 : w + 16;
        M8_LDA(0, k0); M8_LDB(k0); M8_LDA(1, k1);
        M8_MMA(0); M8_LDB(k1); M8_LDA(0, k2);
        M8_MMA(1); M8_LDB(k2); M8_LDA(1, k3);
        M8_MMA(0); M8_LDB(k3);
        if (w + 24 < nks) M8_MMA(1);
#undef M8_LDA
#undef M8_LDB
#undef M8_MMA
        asm volatile("s_nop 15\n\ts_nop 15" ::: "memory");
#pragma unroll
        for (int tm = 0; tm < 4; ++tm)
#pragma unroll
            for (int tn = 0; tn < 4; ++tn) *(LAS f32x4*)(part + (16 * tm + r) * PP + 16 * tn + 4 * q4) = acc[tm][tn];
        __syncthreads();
        { const int row = tid >> 3, cg = tid & 7; f32x4 v0 = (f32x4){0.f, 0.f, 0.f, 0.f}, v1 = v0;
#pragma unroll
          for (int ww = 0; ww < 8; ++ww) { const LAS float* p = (const LAS float*)lds + ww * 64 * PP + row * PP + 8 * cg; v0 += *(const LAS f32x4*)p; v1 += *(const LAS f32x4*)(p + 4); }
          E.put8(u, rt0 + row, ct0 + 8 * cg, v0, v1); }
        __syncthreads();
    }
}

namespace att {
using s16x4  = __attribute__((ext_vector_type(4))) short;
using f32x16 = __attribute__((ext_vector_type(16))) float;
constexpr int   D = 128, NW = 8, QBLK = 32, KVBLK = 64;
constexpr float SCALE = 0.088388347648318440f;
constexpr float THR = 8.f;
constexpr int SHM_V = KVBLK * D * 2, SHM_K = KVBLK * D * 2, SHM_ATTN = 2 * SHM_V + 2 * SHM_K + NW * 64 * 4;
#define KSWZ(row, colB) ((row) * 256 + ((colB) ^ (((row) & 15) << 4)))
#define SBAR() __builtin_amdgcn_sched_barrier(0)
__device__ __forceinline__ int crow(int r, int hi) { return (r & 3) + 8 * (r >> 2) + 4 * hi; }
__device__ __forceinline__ unsigned cvtpk(float lo, float hi) { unsigned r; asm volatile("v_cvt_pk_bf16_f32 %0, %1, %2" : "=v"(r) : "v"(lo), "v"(hi)); return r; }
template <int VAR> __device__ __forceinline__ void partialSM(f32x16& p0, f32x16& p1, float& m_reg, float& mn, float& alpha) {
  constexpr float C = SCALE * 1.4426950408889634f;
  if constexpr (VAR == 1) { mn = m_reg; alpha = 1.f; return; }
  float pmax = p0[0];
#pragma unroll
  for (int r = 1; r < 16; ++r) pmax = fmaxf(pmax, p0[r]);
#pragma unroll
  for (int r = 0; r < 16; ++r) pmax = fmaxf(pmax, p1[r]);
  { auto rr = __builtin_amdgcn_permlane32_swap(__float_as_uint(pmax), __float_as_uint(pmax), false, false);
    pmax = fmaxf(__uint_as_float(rr[0]), __uint_as_float(rr[1])); }
  if (__builtin_expect(__all(pmax - m_reg <= THR / SCALE), 1)) { mn = m_reg; alpha = 1.f; }
  else { mn = fmaxf(m_reg, pmax); alpha = __builtin_amdgcn_exp2f((m_reg - mn) * C); m_reg = mn; }
  float mnC = -mn * C;
#pragma unroll
  for (int r = 0; r < 16; ++r) p0[r] = fmaf(p0[r], C, mnC);
#pragma unroll
  for (int r = 0; r < 16; ++r) p1[r] = fmaf(p1[r], C, mnC);
#pragma unroll
  for (int r = 0; r < 16; ++r) p0[r] = __builtin_amdgcn_exp2f(p0[r]);
}
template <int VAR> __device__ __forceinline__ void finishSM(f32x16& p0, f32x16& p1, float alpha, float& l_reg, bf16x8& pa0, bf16x8& pa1, bf16x8& pa2, bf16x8& pa3) {
  float ps = 0;
  if constexpr (VAR != 1) {
#pragma unroll
  for (int r = 0; r < 16; ++r) p1[r] = __builtin_amdgcn_exp2f(p1[r]);
#pragma unroll
  for (int r = 0; r < 16; ++r) ps += p0[r];
#pragma unroll
  for (int r = 0; r < 16; ++r) ps += p1[r]; }
  { auto rr = __builtin_amdgcn_permlane32_swap(__float_as_uint(ps), __float_as_uint(ps), false, false);
    ps = __uint_as_float(rr[0]) + __uint_as_float(rr[1]); }
  l_reg = l_reg * alpha + ps;
#define PK4(P, BASE, OUT) do { unsigned a0 = cvtpk(P[BASE + 0], P[BASE + 1]), a1 = cvtpk(P[BASE + 2], P[BASE + 3]);   \
    unsigned b0 = cvtpk(P[BASE + 4], P[BASE + 5]), b1 = cvtpk(P[BASE + 6], P[BASE + 7]);                              \
    auto r0 = __builtin_amdgcn_permlane32_swap(a0, b0, false, false); auto r1 = __builtin_amdgcn_permlane32_swap(a1, b1, false, false); \
    u32x4 w = {r0[0], r1[0], r0[1], r1[1]}; OUT = *reinterpret_cast<bf16x8*>(&w); } while (0)
  PK4(p0, 0, pa0); PK4(p0, 8, pa1); PK4(p1, 0, pa2); PK4(p1, 8, pa3);
#undef PK4
}
template <int VAR> __device__ __forceinline__ void qkt(f32x16& p0, f32x16& p1, const bf16_t* Ks, const bf16x8* qr, int r32, int hi) {
  p0 = f32x16{}; p1 = f32x16{};
#pragma unroll
  for (int d0 = 0; d0 < 8; ++d0) { int cb = (d0 * 16 + hi * 8) * 2;
    bf16x8 b0, b1; if constexpr (VAR == 2) { b0 = qr[d0]; b1 = qr[7 - d0]; } else {
    b0 = *reinterpret_cast<const bf16x8*>((const char*)Ks + KSWZ(r32, cb));
    b1 = *reinterpret_cast<const bf16x8*>((const char*)Ks + KSWZ(32 + r32, cb)); }
    p0 = __builtin_amdgcn_mfma_f32_32x32x16_bf16(b0, qr[d0], p0, 0, 0, 0);
    p1 = __builtin_amdgcn_mfma_f32_32x32x16_bf16(b1, qr[d0], p1, 0, 0, 0); }
}
__device__ __forceinline__ int v_st(int k, int c) { const int kk = (k & ~0xC) | ((k & 4) << 1) | ((k & 8) >> 1); return ((kk >> 3) * 4 + (c >> 5)) * 512 + ((kk & 7) * 32 + (c & 31)) * 2; }
__device__ __forceinline__ int v_rd_base(int lane) { return ((lane & 3) << 3) | (((lane >> 2) & 3) << 6) | (((lane >> 4) & 1) << 5) | (((lane >> 5) & 1) << 8); }
constexpr int v_rd_off(int d0, int ks, int half) { return d0 * 512 + ks * 4096 + half * 2048; }
template <int OFF> __device__ __forceinline__ s16x4 tr_read(int vb) {
  s16x4 r; asm volatile("ds_read_b64_tr_b16 %0, %1 offset:%2" : "=&v"(r) : "v"(vb), "i"(OFF) : "memory"); return r;
}
template <int VAR, int D0> __device__ __forceinline__ void pv_one(f32x16& od, int vb, bf16x8 pa0, bf16x8 pa1, bf16x8 pa2, bf16x8 pa3) {
  if constexpr (VAR == 4) { od = __builtin_amdgcn_mfma_f32_32x32x16_bf16(pa0, pa1, od, 0, 0, 0); od = __builtin_amdgcn_mfma_f32_32x32x16_bf16(pa1, pa2, od, 0, 0, 0); od = __builtin_amdgcn_mfma_f32_32x32x16_bf16(pa2, pa3, od, 0, 0, 0); od = __builtin_amdgcn_mfma_f32_32x32x16_bf16(pa3, pa0, od, 0, 0, 0); return; }
  const s16x4 l0 = tr_read<v_rd_off(D0, 0, 0)>(vb), h0 = tr_read<v_rd_off(D0, 0, 1)>(vb), l1 = tr_read<v_rd_off(D0, 1, 0)>(vb), h1 = tr_read<v_rd_off(D0, 1, 1)>(vb);
  const s16x4 l2 = tr_read<v_rd_off(D0, 2, 0)>(vb), h2 = tr_read<v_rd_off(D0, 2, 1)>(vb), l3 = tr_read<v_rd_off(D0, 3, 0)>(vb), h3 = tr_read<v_rd_off(D0, 3, 1)>(vb);
  asm volatile("s_waitcnt lgkmcnt(0)" ::: "memory"); SBAR();
#define PK(L, H) (bf16x8){L[0], L[1], L[2], L[3], H[0], H[1], H[2], H[3]}
  od = __builtin_amdgcn_mfma_f32_32x32x16_bf16(pa0, PK(l0, h0), od, 0, 0, 0);
  od = __builtin_amdgcn_mfma_f32_32x32x16_bf16(pa1, PK(l1, h1), od, 0, 0, 0);
  od = __builtin_amdgcn_mfma_f32_32x32x16_bf16(pa2, PK(l2, h2), od, 0, 0, 0);
  od = __builtin_amdgcn_mfma_f32_32x32x16_bf16(pa3, PK(l3, h3), od, 0, 0, 0);
#undef PK
}
template <int VAR> __device__ __forceinline__ void pv_d0(f32x16* o, int vb, bf16x8 pa0, bf16x8 pa1, bf16x8 pa2, bf16x8 pa3) {
  pv_one<VAR, 0>(o[0], vb, pa0, pa1, pa2, pa3); pv_one<VAR, 1>(o[1], vb, pa0, pa1, pa2, pa3); pv_one<VAR, 2>(o[2], vb, pa0, pa1, pa2, pa3); pv_one<VAR, 3>(o[3], vb, pa0, pa1, pa2, pa3);
}
template <int LDQ, int LDK, int LDO, int VAR = 0>
__device__ __forceinline__ void attn_dense_body(const bf16_t* Qb, const bf16_t* __restrict__ Kh, const bf16_t* __restrict__ Vh,
                                                bf16_t* Ob, int seq, int nlat, int ctxoff, char* lds, const float* qgain, const float* cosT, const float* sinT, int t0, bool rope) {
  const int tid = opaque_tid(), wid = tid >> 6, lane = tid & 63, r32 = lane & 31, hi = lane >> 5;
  bf16_t* V_lds = (bf16_t*)lds; bf16_t* K_lds = (bf16_t*)(lds + 2 * SHM_V);
  float* ws = (float*)(lds + 2 * SHM_V + 2 * SHM_K) + wid * 64; float* li_l = ws; float* al_l = ws + 32;
  float m_reg = -1e30f, l_reg = 0; f32x16 o[4] = {}; bf16x8 qr[8];
  const bf16_t* Qw = Qb + (wid * QBLK + r32) * LDQ + hi * 8;
#pragma unroll 1
  for (int rep_ = 0; rep_ < (VAR == 8 ? 2 : 1); ++rep_) {
  asm volatile("" ::: "memory");
#pragma unroll
  for (int d0 = 0; d0 < 8; ++d0) qr[d0] = *reinterpret_cast<const bf16x8*>(Qw + d0 * 16);
  {
    float v[8][8]; float ss = 0.f;
#pragma unroll
    for (int d0 = 0; d0 < 8; ++d0) { const u32x4 w = *reinterpret_cast<const u32x4*>(&qr[d0]);
      v[d0][0] = bf_lo(w.x); v[d0][1] = bf_hi(w.x); v[d0][2] = bf_lo(w.y); v[d0][3] = bf_hi(w.y); v[d0][4] = bf_lo(w.z); v[d0][5] = bf_hi(w.z); v[d0][6] = bf_lo(w.w); v[d0][7] = bf_hi(w.w);
#pragma unroll
      for (int e = 0; e < 8; ++e) ss += v[d0][e] * v[d0][e]; }
    { auto rr = __builtin_amdgcn_permlane32_swap(__float_as_uint(ss), __float_as_uint(ss), false, false); ss = __uint_as_float(rr[0]) + __uint_as_float(rr[1]); }
    const float rstd = rsqrtf(ss * (1.f / 128.f) + 1e-6f);
#pragma unroll
    for (int d0 = 0; d0 < 8; ++d0) { const f32x4 g0 = *reinterpret_cast<const f32x4*>(qgain + d0 * 16 + hi * 8), g1 = *reinterpret_cast<const f32x4*>(qgain + d0 * 16 + hi * 8 + 4);
#pragma unroll
      for (int e = 0; e < 4; ++e) { v[d0][e] *= rstd * g0[e]; v[d0][4 + e] *= rstd * g1[e]; } }
    if (rope) { const float* cs = cosT + (size_t)(t0 + wid * QBLK + r32) * 64 + hi * 8; const float* sn = sinT + (size_t)(t0 + wid * QBLK + r32) * 64 + hi * 8;
#pragma unroll
      for (int d0 = 0; d0 < 4; ++d0) { const f32x4 c0 = *reinterpret_cast<const f32x4*>(cs + d0 * 16), c1 = *reinterpret_cast<const f32x4*>(cs + d0 * 16 + 4), s0 = *reinterpret_cast<const f32x4*>(sn + d0 * 16), s1 = *reinterpret_cast<const f32x4*>(sn + d0 * 16 + 4);
#pragma unroll
        for (int e = 0; e < 8; ++e) { const float c = e < 4 ? c0[e & 3] : c1[e & 3], sv = e < 4 ? s0[e & 3] : s1[e & 3]; const float lo = v[d0][e], hh = v[d0 + 4][e]; v[d0][e] = lo * c - hh * sv; v[d0 + 4][e] = hh * c + lo * sv; } } }
#pragma unroll
    for (int d0 = 0; d0 < 8; ++d0) { const u32x4 w = {cvtpk(v[d0][0], v[d0][1]), cvtpk(v[d0][2], v[d0][3]), cvtpk(v[d0][4], v[d0][5]), cvtpk(v[d0][6], v[d0][7])}; qr[d0] = *reinterpret_cast<const bf16x8*>(&w); }
  }
  }
  const int sr = tid >> 4, sc = (tid & 15) * 8, vst0 = v_st(sr, sc), vst1 = v_st(32 + sr, sc);
  const int vb0 = (int)(uintptr_t)V_lds + v_rd_base(lane);
  struct { bf16x8 vs0, vs1, ks0, ks1; } sr_[2];
#define KROW(k0) ((k0) + (((k0) >= nlat) ? ctxoff : 0))
#define SLOAD(i, k0) do { const int kr_ = KROW(k0); sr_[i].vs0 = *reinterpret_cast<const bf16x8*>(&Vh[(kr_ + sr) * LDK + sc]); sr_[i].vs1 = *reinterpret_cast<const bf16x8*>(&Vh[(kr_ + 32 + sr) * LDK + sc]); \
    sr_[i].ks0 = *reinterpret_cast<const bf16x8*>(&Kh[(kr_ + sr) * LDK + sc]); sr_[i].ks1 = *reinterpret_cast<const bf16x8*>(&Kh[(kr_ + 32 + sr) * LDK + sc]); } while (0)
#define SWRITE(b, i) do { *(bf16x8*)((char*)V_lds + (b) * SHM_V + vst0) = sr_[i].vs0;          \
    *(bf16x8*)((char*)V_lds + (b) * SHM_V + vst1) = sr_[i].vs1; int kc = sc * 2;               \
    *(bf16x8*)((char*)K_lds + (b) * SHM_K + KSWZ(sr, kc)) = sr_[i].ks0;                       \
    *(bf16x8*)((char*)K_lds + (b) * SHM_K + KSWZ(32 + sr, kc)) = sr_[i].ks1; } while (0)
#define SWAIT() asm volatile("s_waitcnt vmcnt(4)" ::: "memory")
#define RESC(a) do { if (__any((a) < 1.f)) { if (hi == 0) al_l[r32] = (a); asm volatile("s_waitcnt lgkmcnt(0)" ::: "memory"); \
    _Pragma("unroll") for (int d = 0; d < 4; ++d) _Pragma("unroll") for (int r = 0; r < 16; ++r) o[d][r] *= al_l[crow(r, hi)]; } } while (0)
#define ATT_SYNC() do { if (VAR != 3 && VAR != 5) __syncthreads(); } while (0)
  f32x16 pA0, pA1, pB0, pB1; float mnA, mnB, alA, alB; bf16x8 pa0, pa1, pa2, pa3; const int NT = seq / KVBLK;
  constexpr int SE = 0, SO = 1;
  SLOAD(SE, 0); asm volatile("s_waitcnt vmcnt(0)" ::: "memory"); SWRITE(0, SE); ATT_SYNC();
  qkt<VAR>(pA0, pA1, K_lds, qr, r32, hi); partialSM<VAR>(pA0, pA1, m_reg, mnA, alA);
  SLOAD(SO, KVBLK); if (2 < NT) SLOAD(SE, 2 * KVBLK);
  if (VAR != 3) { SWAIT(); SWRITE(1, SO); } ATT_SYNC();
  for (int j = 1; j + 1 < NT; j += 2) {
    SBAR(); qkt<VAR>(pB0, pB1, (bf16_t*)((char*)K_lds + SHM_K), qr, r32, hi);
    finishSM<VAR>(pA0, pA1, alA, l_reg, pa0, pa1, pa2, pa3); SBAR();
    if (VAR != 3 && VAR != 6) SLOAD(SO, (j + 2) * KVBLK); SBAR();
    pv_d0<VAR>(o, vb0, pa0, pa1, pa2, pa3); partialSM<VAR>(pB0, pB1, m_reg, mnB, alB);
    ATT_SYNC(); if (VAR != 3 && VAR != 6) { SWAIT(); SWRITE(0, SE); }
    RESC(alB); ATT_SYNC();
    SBAR(); qkt<VAR>(pA0, pA1, K_lds, qr, r32, hi);
    finishSM<VAR>(pB0, pB1, alB, l_reg, pa0, pa1, pa2, pa3); SBAR();
    if (VAR != 3 && VAR != 6 && j + 3 < NT) SLOAD(SE, (j + 3) * KVBLK); SBAR();
    pv_d0<VAR>(o, vb0 + (int)SHM_V, pa0, pa1, pa2, pa3); partialSM<VAR>(pA0, pA1, m_reg, mnA, alA);
    ATT_SYNC(); if (VAR != 3 && VAR != 6) { SWAIT(); SWRITE(1, SO); }
    RESC(alA); ATT_SYNC();
  }
  SBAR(); qkt<VAR>(pB0, pB1, (bf16_t*)((char*)K_lds + SHM_K), qr, r32, hi);
  finishSM<VAR>(pA0, pA1, alA, l_reg, pa0, pa1, pa2, pa3); SBAR();
  pv_d0<VAR>(o, vb0, pa0, pa1, pa2, pa3); partialSM<VAR>(pB0, pB1, m_reg, mnB, alB);
  ATT_SYNC(); RESC(alB);
  finishSM<VAR>(pB0, pB1, alB, l_reg, pa0, pa1, pa2, pa3); SBAR();
  pv_d0<VAR>(o, vb0 + (int)SHM_V, pa0, pa1, pa2, pa3);
#undef ATT_SYNC
  if (hi == 0) li_l[r32] = l_reg; asm volatile("s_waitcnt lgkmcnt(0)" ::: "memory");
  float rli[16];
#pragma unroll
  for (int r = 0; r < 16; ++r) rli[r] = __builtin_amdgcn_rcpf(li_l[crow(r, hi)]);
  bf16_t* Ow = Ob + (wid * QBLK) * LDO;
#pragma unroll
  for (int r = 0; r < 16; ++r) { int orow = crow(r, hi);
#pragma unroll
    for (int d0 = 0; d0 < 4; ++d0) { const __bf16 hb = (__bf16)(o[d0][r] * rli[r]); if constexpr (VAR == 7) { const bf16_t keep_ = __builtin_bit_cast(bf16_t, hb); asm volatile("" :: "v"(keep_)); } else Ow[orow * LDO + d0 * 32 + r32] = __builtin_bit_cast(bf16_t, hb); } }
  asm volatile("s_waitcnt vmcnt(0)" ::: "memory");
  __syncthreads();
#undef KROW
#undef SLOAD
#undef SWRITE
#undef SWAIT
#undef RESC
}
}

namespace scan {
#ifndef SCAN_XOR
#define SCAN_XOR 1
#endif
#if SCAN_XOR
constexpr int TS = 256, CS = 144;
#else
constexpr int TS = 272, CS = 144;
#endif
constexpr int I_QT = 0, I_KT = I_QT + 64 * TS, I_KH = I_KT + 64 * TS, I_VT = I_KH + 128 * CS, I_AV = I_VT + 32 * CS, IMG = I_AV + 512;
constexpr int OFF_ST = 2 * IMG, LDS_SCAN = OFF_ST + 2 * 32 * TS;
static_assert(LDS_SCAN <= LDS_CTL_OFF, "scan LDS");
#define SCAN_BAR() do { asm volatile("s_waitcnt lgkmcnt(0) ; SCANBAR" ::: "memory"); __builtin_amdgcn_s_barrier(); asm volatile("; SCANBAR_END" ::: "memory"); } while (0)
__device__ __forceinline__ float ex2(float x) { return __builtin_amdgcn_exp2f(x); }
typedef unsigned u32x2l __attribute__((ext_vector_type(2)));

__device__ __forceinline__ void scan_unit(LAS unsigned char* lds, const bf16_t* HQ, const bf16_t* G, const bf16_t* HV, bf16_t* O, int b, int h, int bwd, int dvs, bool store_ctx) {
    const int tid = opaque_tid(), w = __builtin_amdgcn_readfirstlane(tid >> 6), lane = tid & 63, r = lane & 15, q4 = lane >> 4;
    const long sgn = bwd ? -1 : 1;
#define SCAN_RB(cc_) (((cc_) < 4) ? (bwd ? (long)(NLAT + b * CTXL + CTXL - 1 - 64 * (cc_)) : (long)(NLAT + b * CTXL + 64 * (cc_))) \
                                  : (bwd ? (long)(b * SEQ + SEQ - 1 - 64 * ((cc_) - 4)) : (long)(b * SEQ + 64 * ((cc_) - 4))))
    for (int i = tid; i < 32 * TS / 4; i += 512) ((LAS unsigned*)(lds + OFF_ST))[i] = 0u;
    if (w < 4) {
#ifndef SCAN_E_PRIO
#define SCAN_E_PRIO 0
#endif
        __builtin_amdgcn_s_setprio(SCAN_E_PRIO);
        const int cp = lane & 15, tg = lane >> 4, et = w * 64 + lane, vtok = et >> 2, vdg = et & 3;
        const size_t colq = (size_t)h * 128 + 32 * w + 2 * cp, colv = (size_t)h * 128 + dvs * 32 + 8 * vdg;
        unsigned graw0[16], qraw0[16], graw1[16], qraw1[16]; u32x4 vraw0, vraw1;
        const unsigned lo_ = (unsigned)((bwd ? 63 - 16 * tg : 16 * tg) * 2048) + (unsigned)colq * 2u;
        const unsigned lov_ = (unsigned)((bwd ? 63 - vtok : vtok) * 2048) + (unsigned)colv * 2u;
#define SCAN_LOAD(cc_, graw, qraw, vraw) do { const long rb_ = SCAN_RB(cc_); const long r0_ = bwd ? rb_ - 63 : rb_; \
        const GAS char* gB_ = (const GAS char*)G + (size_t)r0_ * 2048; const GAS char* qB_ = (const GAS char*)HQ + (size_t)r0_ * 2048; \
        _Pragma("unroll") for (int j = 0; j < 16; ++j) { const long dj_ = (long)(bwd ? -j : j) * 2048; const GAS char* gj_ = gB_ + dj_; const GAS char* qj_ = qB_ + dj_; asm volatile("" : "+s"(gj_), "+s"(qj_)); \
            graw[j] = *(const GAS unsigned*)(gj_ + lo_); qraw[j] = *(const GAS unsigned*)(qj_ + lo_); } \
        vraw = *(const GAS u32x4*)((const GAS char*)HV + (size_t)r0_ * 2048 + lov_); } while (0)
#define SCAN_IMAGE(cc, graw, qraw, vraw) do { \
        LAS unsigned char* img = lds + ((cc) & 1) * IMG; \
        f32x2 cs[16]; f32x2 run = {0.f, 0.f}; \
        _Pragma("unroll") for (int j = 0; j < 16; ++j) { run += unpk_f16(graw[j]); cs[j] = run; } \
          \
        f32x2 off, all; \
        { const auto s1x = __builtin_amdgcn_permlane16_swap(__float_as_uint(run.x), __float_as_uint(run.x), false, false), s1y = __builtin_amdgcn_permlane16_swap(__float_as_uint(run.y), __float_as_uint(run.y), false, false); \
          const f32x2 ev = {__uint_as_float(s1x[0]), __uint_as_float(s1y[0])}, od = {__uint_as_float(s1x[1]), __uint_as_float(s1y[1])}; const f32x2 pr = ev + od; \
          const auto s2x = __builtin_amdgcn_permlane32_swap(__float_as_uint(pr.x), __float_as_uint(pr.x), false, false), s2y = __builtin_amdgcn_permlane32_swap(__float_as_uint(pr.y), __float_as_uint(pr.y), false, false); \
          const f32x2 p01 = {__uint_as_float(s2x[0]), __uint_as_float(s2y[0])}, p23 = {__uint_as_float(s2x[1]), __uint_as_float(s2y[1])}; \
          all = p01 + p23; const f32x2 z2 = {0.f, 0.f}; off = ((tg & 1) ? ev : z2) + ((tg & 2) ? p01 : z2); } \
        f32x2 ekp; ekp.x = ex2(fminf(-off.x, 115.f)); ekp.y = ex2(fminf(-off.y, 115.f)); \
        const f32x2 eall = {ex2(all.x), ex2(all.y)}; \
        unsigned w_kh[2][8]; \
        _Pragma("unroll") for (int j = 0; j < 16; ++j) { \
            const f32x2 q = {bf_lo(qraw[j]), bf_hi(qraw[j])}; \
            const f32x2 c = cs[j] + off; \
            f32x2 eq, ek; eq.x = ex2(c.x); eq.y = ex2(c.y); ek.x = ex2(fminf(-c.x, 115.f)); ek.y = ex2(fminf(-c.y, 115.f)); \
            const f32x2 k = 1.f - eq * ekp;        \
            ekp = ek; \
            const f32x2 qt = q * eq, kt = k * ek, kh = kt * eall; \
            const int tb = (16 * tg + j) * TS + (SCAN_XOR ? (((32 * w + 2 * cp) * 2) ^ (j << 4)) : ((32 * w + 2 * cp) * 2)); \
            *(LAS unsigned*)(img + I_QT + tb) = pk_bf16(qt.x, qt.y); *(LAS unsigned*)(img + I_KT + tb) = pk_bf16(kt.x, kt.y); \
            if ((j & 1) == 0) { w_kh[0][j >> 1] = __float_as_uint(kh.x); w_kh[1][j >> 1] = __float_as_uint(kh.y); } \
            else { w_kh[0][j >> 1] = pk_bf16(__uint_as_float(w_kh[0][j >> 1]), kh.x); w_kh[1][j >> 1] = pk_bf16(__uint_as_float(w_kh[1][j >> 1]), kh.y); } \
        } \
        _Pragma("unroll") for (int c2 = 0; c2 < 2; ++c2) { LAS unsigned char* kp = img + I_KH + (32 * w + 2 * cp + c2) * CS + 32 * tg; \
            *(LAS u32x4*)kp = (u32x4){w_kh[c2][0], w_kh[c2][1], w_kh[c2][2], w_kh[c2][3]}; *(LAS u32x4*)(kp + 16) = (u32x4){w_kh[c2][4], w_kh[c2][5], w_kh[c2][6], w_kh[c2][7]}; } \
        if (tg == 0) *(LAS f32x2*)(img + I_AV + (32 * w + 2 * cp) * 4) = eall; \
        { LAS bf16_t* vt = (LAS bf16_t*)(img + I_VT) + vtok; const unsigned vv[4] = {vraw.x, vraw.y, vraw.z, vraw.w}; \
          _Pragma("unroll") for (int e = 0; e < 4; ++e) { vt[(8 * vdg + 2 * e) * (CS / 2)] = (bf16_t)(vv[e] & 0xffffu); vt[(8 * vdg + 2 * e + 1) * (CS / 2)] = (bf16_t)(vv[e] >> 16); } } \
    } while (0)
        SCAN_LOAD(0, graw0, qraw0, vraw0); SCAN_LOAD(1, graw1, qraw1, vraw1);
        SCAN_IMAGE(0, graw0, qraw0, vraw0); SCAN_LOAD(2, graw0, qraw0, vraw0);
        SCAN_BAR();
        for (int c2 = 0; c2 < 68; c2 += 2) {
            SCAN_IMAGE(c2 + 1, graw1, qraw1, vraw1); if (c2 + 3 < 68) SCAN_LOAD(c2 + 3, graw1, qraw1, vraw1);
            SCAN_BAR();
            if (c2 + 2 < 68) { SCAN_IMAGE(c2 + 2, graw0, qraw0, vraw0); if (c2 + 4 < 68) SCAN_LOAD(c2 + 4, graw0, qraw0, vraw0); }
            SCAN_BAR();
        }
#undef SCAN_LOAD
#undef SCAN_IMAGE
        __builtin_amdgcn_s_setprio(0);
    } else {
        const int it = w - 4;
        int xo[4];
#pragma unroll
        for (int ks = 0; ks < 4; ++ks) xo[ks] = SCAN_XOR ? (((4 * ks + q4) ^ r) << 4) : ((4 * ks + q4) << 4);
        f32x4 sacc[2][2];
#pragma unroll
        for (int a = 0; a < 2; ++a)
#pragma unroll
            for (int d2 = 0; d2 < 2; ++d2) sacc[a][d2] = (f32x4){0.f, 0.f, 0.f, 0.f};
        SCAN_BAR();
        for (int cc = 0; cc < 68; ++cc) {
            const LAS unsigned char* img = lds + (cc & 1) * IMG; const int cur = cc & 1, nxt = cur ^ 1; const long rb = SCAN_RB(cc);
            bf16x8 qb[4];
#pragma unroll
            for (int ks = 0; ks < 4; ++ks) qb[ks] = *(const LAS bf16x8*)(img + I_QT + (16 * it + r) * TS + xo[ks]);
            f32x4 s4[4];
#pragma unroll
            for (int jt = 0; jt < 4; ++jt) { s4[jt] = (f32x4){0.f, 0.f, 0.f, 0.f};
                if (jt <= it) { bf16x8 ka[4];
#pragma unroll
                    for (int ks = 0; ks < 4; ++ks) ka[ks] = *(const LAS bf16x8*)(img + I_KT + (16 * jt + r) * TS + xo[ks]);
#pragma unroll
                    for (int ks = 0; ks < 4; ++ks) s4[jt] = __builtin_amdgcn_mfma_f32_16x16x32_bf16(ka[ks], qb[ks], s4[jt], 0, 0, 0);
                    if (jt == it) {
#pragma unroll
                        for (int e = 0; e < 4; ++e) if (4 * q4 + e > r) s4[jt][e] = 0.f;
                    } } }
            const u32x4 p01 = {pk_bf16(s4[0][0], s4[0][1]), pk_bf16(s4[0][2], s4[0][3]), pk_bf16(s4[1][0], s4[1][1]), pk_bf16(s4[1][2], s4[1][3])};
            const u32x4 p23 = {pk_bf16(s4[2][0], s4[2][1]), pk_bf16(s4[2][2], s4[2][3]), pk_bf16(s4[3][0], s4[3][1]), pk_bf16(s4[3][2], s4[3][3])};
#pragma unroll
            for (int dvt = 0; dvt < 2; ++dvt) {
                const LAS unsigned char* vrow = img + I_VT + (16 * dvt + r) * CS + 8 * q4;
                const u32x2l va0 = *(const LAS u32x2l*)(vrow), va1 = *(const LAS u32x2l*)(vrow + 32), va2 = *(const LAS u32x2l*)(vrow + 64), va3 = *(const LAS u32x2l*)(vrow + 96);
                bf16x8 sa[4];
#pragma unroll
                for (int ks = 0; ks < 4; ++ks) sa[ks] = *(const LAS bf16x8*)(lds + OFF_ST + cur * 32 * TS + (16 * dvt + r) * TS + xo[ks]);
                f32x4 o4 = (f32x4){0.f, 0.f, 0.f, 0.f}, o5 = (f32x4){0.f, 0.f, 0.f, 0.f};
                { const u32x4 a01 = {va0.x, va0.y, va1.x, va1.y}; o4 = __builtin_amdgcn_mfma_f32_16x16x32_bf16(__builtin_bit_cast(bf16x8, a01), __builtin_bit_cast(bf16x8, p01), o4, 0, 0, 0); }
                if (it >= 2) { const u32x4 a23 = {va2.x, va2.y, va3.x, va3.y}; o4 = __builtin_amdgcn_mfma_f32_16x16x32_bf16(__builtin_bit_cast(bf16x8, a23), __builtin_bit_cast(bf16x8, p23), o4, 0, 0, 0); }
                o5 = __builtin_amdgcn_mfma_f32_16x16x32_bf16(sa[0], qb[0], o5, 0, 0, 0); o5 = __builtin_amdgcn_mfma_f32_16x16x32_bf16(sa[1], qb[1], o5, 0, 0, 0);
                o4 = __builtin_amdgcn_mfma_f32_16x16x32_bf16(sa[2], qb[2], o4, 0, 0, 0); o5 = __builtin_amdgcn_mfma_f32_16x16x32_bf16(sa[3], qb[3], o5, 0, 0, 0);
                o4 += o5;
                if (store_ctx || cc >= 4) { const long row = rb + sgn * (16 * it + r);
                    *(u32x2*)(O + (size_t)row * 1024 + h * 128 + dvs * 32 + 16 * dvt + 4 * q4) = (u32x2){pk_bf16(o4[0], o4[1]), pk_bf16(o4[2], o4[3])}; }
            }
            {
                bf16x8 vb[2][2];
#pragma unroll
                for (int ks = 0; ks < 2; ++ks) { vb[0][ks] = *(const LAS bf16x8*)(img + I_VT + r * CS + (32 * ks + 8 * q4) * 2); vb[1][ks] = *(const LAS bf16x8*)(img + I_VT + (16 + r) * CS + (32 * ks + 8 * q4) * 2); }
#pragma unroll
                for (int a = 0; a < 2; ++a) { const int dt = 2 * it + a;
                    const f32x4 a4 = *(const LAS f32x4*)(img + I_AV + (16 * dt + 4 * q4) * 4);
                    const bf16x8 kh0 = *(const LAS bf16x8*)(img + I_KH + (16 * dt + r) * CS + (8 * q4) * 2), kh1 = *(const LAS bf16x8*)(img + I_KH + (16 * dt + r) * CS + (32 + 8 * q4) * 2);
#pragma unroll
                    for (int d2 = 0; d2 < 2; ++d2) { f32x4 s = sacc[a][d2] * a4;
                        s = __builtin_amdgcn_mfma_f32_16x16x32_bf16(kh0, vb[d2][0], s, 0, 0, 0); s = __builtin_amdgcn_mfma_f32_16x16x32_bf16(kh1, vb[d2][1], s, 0, 0, 0);
                        sacc[a][d2] = s;
                        *(LAS u32x2*)(lds + OFF_ST + nxt * 32 * TS + (16 * d2 + r) * TS + (SCAN_XOR ? ((((2 * dt + (q4 >> 1)) ^ r) << 4) | ((q4 & 1) << 3)) : ((16 * dt + 4 * q4) * 2))) = (u32x2){pk_bf16(s[0], s[1]), pk_bf16(s[2], s[3])}; } }
            }
            SCAN_BAR();
        }
    }
    VM_WAIT(); LDS_WAIT();
    __syncthreads();
#undef SCAN_RB
}
}

constexpr size_t MiB = 1u << 20;
constexpr size_t WS_CTL = 0, CTL_ZERO_BYTES = 64 * 1024;
constexpr int CW_TMO = 0, CW_BAR = 4096, CW_CNT = 8192;
constexpr size_t WS_MOD = 256 * 1024;
constexpr size_t WS_LBV = 512 * 1024;
constexpr size_t WS_WGB = 576 * 1024;
constexpr size_t WS_COS = 1 * MiB, WS_SIN = 2 * MiB;
constexpr size_t WS_ROUTE = 3 * MiB;
constexpr size_t WS_XCTX = 4 * MiB;
constexpr size_t WS_H = 8 * MiB;
constexpr size_t WS_W = 42 * MiB;
constexpr size_t WL_STRIDE = 23 * MiB, WL_IN = 0, WL_ATT = 17 * MiB, WL_HG = 19 * MiB, WL_OUT = 21 * MiB;
constexpr size_t WS_WGU = WS_W + 46 * MiB, WS_WD = WS_W + 57 * MiB;
constexpr size_t WS_OF = 105 * MiB, WS_OB = 139 * MiB;
constexpr size_t WS_PROJ = 173 * MiB;
constexpr int XB_CAP = 16384;
constexpr size_t WS_MGU = 462 * MiB, WS_MD = 518 * MiB, WS_YB = 105 * MiB, WS_HIDM = 173 * MiB, WS_XB = 292 * MiB, WS_END = 546 * MiB;
static_assert(WS_WD + (size_t)DM * DFF * 2 <= WS_OF && WS_OB + (size_t)R * DM * 2 <= WS_PROJ && WS_PROJ + (size_t)R * PROJW * 2 <= WS_MGU, "ws map");
static_assert(WS_MGU + (size_t)NEXP * 2 * DFE * DM <= WS_MD && WS_MD + (size_t)NEXP * DM * DFE <= WS_END && WS_YB + (size_t)MOE_ROWS_MAX * DM * 2 <= WS_HIDM && WS_HIDM + (size_t)MOE_ROWS_MAX * DFE <= WS_XB && WS_XB + (size_t)NEXP * XB_CAP * DM <= WS_MGU, "ws map (moe)");
constexpr size_t PQ = 0, PK = (size_t)R * 1024, PV = (size_t)R * 1280, PHQ = (size_t)R * 1536, PGF = (size_t)R * 2560, PGB = (size_t)R * 3584, PHV = (size_t)R * 4608, PHG = (size_t)R * 5632, PGA = (size_t)R * 6656, PGH = (size_t)R * 7680;

constexpr int RING_BYTES = 131072, MISC_OFF = LDS_CTL_OFF + 320, LDS_BYTES = 163840;
constexpr int NWAVES = 8;

#define XB_TMO      128
#define XB_XCNT(j)  (256  + 64 * (j))
#define XB_XSUB(j)  (1280 + 64 * (j))
#define XB_XGEN(j)  (2304 + 64 * (j))
#define XB_TOP      3328
#define XB_TOPGEN   3392
#define XCD_BAR_WORDS 3456
#define XB_SPIN_CAP (1u << 18)
__device__ __forceinline__ unsigned xb_ld(unsigned* p)              { return __hip_atomic_load(p, __ATOMIC_RELAXED, __HIP_MEMORY_SCOPE_AGENT); }
__device__ __forceinline__ unsigned xb_add(unsigned* p, unsigned v) { return __hip_atomic_fetch_add(p, v, __ATOMIC_RELAXED, __HIP_MEMORY_SCOPE_AGENT); }
__device__ __forceinline__ unsigned xb_xcc_id() { return (unsigned)__builtin_amdgcn_s_getreg((3 << 11) | 20) & 0xFu; }
#define XB_SPIN(cond, bar) do { unsigned _sp = 0; while (cond) { __builtin_amdgcn_s_sleep(1); \
    if ((++_sp & 255u) == 0u) { if (xb_ld(&(bar)[XB_TMO])) break; if (_sp > XB_SPIN_CAP) { atomicAdd(&(bar)[XB_TMO], 1u); break; } } } } while (0)
struct XcdBarrier { unsigned* bar; unsigned x; volatile LAS unsigned* st; };
__device__ __forceinline__ XcdBarrier xcd_barrier_post(unsigned* bar, volatile LAS unsigned* st) {
    XcdBarrier b; b.bar = bar; b.x = xb_xcc_id(); b.st = st;
    if (threadIdx.x == 0) (void)xb_add(&bar[XB_XCNT(b.x)], 1u);
    return b;
}
__device__ __forceinline__ void xcd_barrier_complete(unsigned* bar, unsigned x, unsigned& nloc, unsigned& nx) {
    const unsigned G = gridDim.x * gridDim.y * gridDim.z;
    unsigned sum, cnt, mine, sp = 0u;
    for (;;) {
        sum = 0u; cnt = 0u; mine = 0u;
#pragma unroll
        for (unsigned j = 0; j < 16; ++j) { const unsigned c = xb_ld(&bar[XB_XCNT(j)]); sum += c; cnt += (c > 0u) ? 1u : 0u; mine = (j == x) ? c : mine; }
        if (sum == G) break;
        __builtin_amdgcn_s_sleep(1);
        if ((++sp & 255u) == 0u) { if (xb_ld(&bar[XB_TMO])) break; if (sp > XB_SPIN_CAP) { atomicAdd(&bar[XB_TMO], 1u); break; } }
    }
    nloc = mine > 0u ? mine : 1u; nx = cnt > 0u ? cnt : 1u;
}
__device__ __forceinline__ void xcd_barrier(const XcdBarrier& b) {
    asm volatile("s_waitcnt vmcnt(0)" ::: "memory");
    __syncthreads();
    if (opaque_tid() == 0) {
        unsigned* bar = b.bar;
        __builtin_amdgcn_s_waitcnt(0);
        unsigned nloc = b.st[0], nx = b.st[1];
        if (nloc == 0u) { xcd_barrier_complete(bar, b.x, nloc, nx); b.st[0] = nloc; b.st[1] = nx; }
        const unsigned old = xb_add(&bar[XB_XSUB(b.x)], 1u);
        const unsigned gen = old / nloc;
        if (old + 1u == (gen + 1u) * nloc) {
            __builtin_amdgcn_fence(__ATOMIC_RELEASE, "agent");
            asm volatile("s_waitcnt vmcnt(0)" ::: "memory");
            const unsigned og = xb_add(&bar[XB_TOP], 1u);
            const unsigned tg = og / nx;
            if (og + 1u == (tg + 1u) * nx) xb_add(&bar[XB_TOPGEN], 1u);
            else XB_SPIN(xb_ld(&bar[XB_TOPGEN]) == tg, bar);
            __builtin_amdgcn_fence(__ATOMIC_ACQUIRE, "agent");
            xb_add(&bar[XB_XGEN(b.x)], 1u);
            asm volatile("s_waitcnt vmcnt(0)" ::: "memory");
        } else {
            XB_SPIN(xb_ld(&bar[XB_XGEN(b.x)]) == gen, bar);
            __builtin_amdgcn_fence(__ATOMIC_ACQUIRE, "agent");
            asm volatile("s_waitcnt vmcnt(0)" ::: "memory");
        }
    }
    __syncthreads();
}

template <int CTRL> __device__ __forceinline__ float dpp_f(float v) { return __uint_as_float((unsigned)__builtin_amdgcn_update_dpp(0, (int)__float_as_uint(v), CTRL, 0xF, 0xF, true)); }
__device__ __forceinline__ float dpp_xor4(float v) { int t = __builtin_amdgcn_update_dpp(0, (int)__float_as_uint(v), 0x104, 0xF, 0x5, false); t = __builtin_amdgcn_update_dpp(t, (int)__float_as_uint(v), 0x114, 0xF, 0xA, false); return __uint_as_float((unsigned)t); }
__device__ __forceinline__ float wave_sum(float v) {
    v += dpp_f<0xB1>(v); v += dpp_f<0x4E>(v); v += dpp_f<0x141>(v); v += dpp_f<0x140>(v);
    { const auto s = __builtin_amdgcn_permlane16_swap(__float_as_uint(v), __float_as_uint(v), false, false); v = __uint_as_float(s[0]) + __uint_as_float(s[1]); }
    { const auto s = __builtin_amdgcn_permlane32_swap(__float_as_uint(v), __float_as_uint(v), false, false); v = __uint_as_float(s[0]) + __uint_as_float(s[1]); }
    return v;
}
struct Row16 { f32x4 v[4]; };
__device__ __forceinline__ Row16 ld_f32_row(const float* p, int lane) { Row16 r;
#pragma unroll
    for (int j = 0; j < 4; ++j) r.v[j] = ((const f32x4*)p)[lane + 64 * j];
    return r; }
__device__ __forceinline__ void st_f32_row(float* p, int lane, const Row16& r) {
#pragma unroll
    for (int j = 0; j < 4; ++j) ((f32x4*)p)[lane + 64 * j] = r.v[j]; }
__device__ __forceinline__ Row16 ld_bf16_row(const bf16_t* p, int lane) { Row16 r;
#pragma unroll
    for (int j = 0; j < 4; ++j) { const u32x2 w = ((const u32x2*)p)[lane + 64 * j]; r.v[j] = (f32x4){bf_lo(w.x), bf_hi(w.x), bf_lo(w.y), bf_hi(w.y)}; }
    return r; }
#ifndef THIN_NT
#define THIN_NT 1
#endif
__device__ __forceinline__ void st_bf16_row_nt(bf16_t* p, int lane, const Row16& r) {
#pragma unroll
    for (int j = 0; j < 4; ++j) { const u32x2 w = (u32x2){pk_bf16(r.v[j][0], r.v[j][1]), pk_bf16(r.v[j][2], r.v[j][3])};
        if (THIN_NT) __builtin_nontemporal_store(w, (u32x2*)p + lane + 64 * j); else ((u32x2*)p)[lane + 64 * j] = w; } }
struct RawB { u32x2 v[4]; };
__device__ __forceinline__ RawB ld_raw_b(const bf16_t* p, int lane) { RawB r;
#pragma unroll
    for (int j = 0; j < 4; ++j) r.v[j] = ((const u32x2*)p)[lane + 64 * j];
    return r; }
#ifndef THIN_NTL
#define THIN_NTL 0
#endif
__device__ __forceinline__ RawB ld_raw_b_nt(const bf16_t* p, int lane) { RawB r;
#pragma unroll
    for (int j = 0; j < 4; ++j) r.v[j] = THIN_NTL ? __builtin_nontemporal_load((const u32x2*)p + lane + 64 * j) : ((const u32x2*)p)[lane + 64 * j];
    return r; }
__device__ __forceinline__ Row16 ld_f32_row_nt(const float* p, int lane) { Row16 r;
#pragma unroll
    for (int j = 0; j < 4; ++j) r.v[j] = THIN_NTL ? __builtin_nontemporal_load((const f32x4*)p + lane + 64 * j) : ((const f32x4*)p)[lane + 64 * j];
    return r; }
__device__ __forceinline__ Row16 unraw_b(const RawB& w) { Row16 r;
#pragma unroll
    for (int j = 0; j < 4; ++j) r.v[j] = (f32x4){bf_lo(w.v[j].x), bf_hi(w.v[j].x), bf_lo(w.v[j].y), bf_hi(w.v[j].y)};
    return r; }
__device__ __forceinline__ void st_bf16_row(bf16_t* p, int lane, const Row16& r) {
#pragma unroll
    for (int j = 0; j < 4; ++j) ((u32x2*)p)[lane + 64 * j] = (u32x2){pk_bf16(r.v[j][0], r.v[j][1]), pk_bf16(r.v[j][2], r.v[j][3])}; }
__device__ __forceinline__ float row_rstd(const Row16& r) { float s = 0.f;
#pragma unroll
    for (int j = 0; j < 4; ++j) s += (r.v[j][0] * r.v[j][0] + r.v[j][1] * r.v[j][1]) + (r.v[j][2] * r.v[j][2] + r.v[j][3] * r.v[j][3]);
    return rsqrtf(wave_sum(s) * (1.f / DM) + NORM_EPS); }
__device__ __forceinline__ Row16 norm_mod(const Row16& x, float rstd, const float* gain, const float* shift, const float* scale, int lane) { Row16 o;
#pragma unroll
    for (int j = 0; j < 4; ++j) { const f32x4 g = ((const f32x4*)gain)[lane + 64 * j], sh = ((const f32x4*)shift)[lane + 64 * j], sc = ((const f32x4*)scale)[lane + 64 * j];
        o.v[j] = (x.v[j] * rstd * g) * (sc + 1.f) + sh; }
    return o; }
__device__ __forceinline__ Row16 resid_add(const Row16& x, const Row16& y, float rstd, const float* gain, const float* gate, int lane) { Row16 o;
#pragma unroll
    for (int j = 0; j < 4; ++j) { const f32x4 g = ((const f32x4*)gain)[lane + 64 * j], gt = ((const f32x4*)gate)[lane + 64 * j];
        o.v[j] = x.v[j] + gt * (y.v[j] * rstd * g); }
    return o; }

__device__ __forceinline__ unsigned f2bf(float f) { unsigned u = __builtin_bit_cast(unsigned, f); return (u + 0x7fffu + ((u >> 16) & 1u)) >> 16; }
__device__ __forceinline__ unsigned pk2(float lo, float hi) { return f2bf(lo) | (f2bf(hi) << 16); }
struct TDesc { const float* W; unsigned char* WT; int K, N, il, item; };
__device__ __forceinline__ void t_load(const TDesc& d, float (&t_)[32], int lane) {
    const int nblk = d.N / 32, kb = d.item / nblk, nb = d.item - kb * nblk, k0 = 64 * kb, n0 = 32 * nb;
#pragma unroll
    for (int i = 0; i < 32; ++i) t_[i] = d.W[(size_t)(k0 + 2 * i + (lane >> 5)) * d.N + n0 + (lane & 31)];
}
template <bool FP8>
__device__ __forceinline__ void t_finish(const TDesc& d, const float (&t_)[32], LAS float* scr, int lane) {
    const int nblk = d.N / 32, kb = d.item / nblk, nb = d.item - kb * nblk, k0 = 64 * kb, n0 = 32 * nb;
    const int drow0 = d.il ? (256 * (n0 >> 7) + (n0 & 127) + (d.il == 2 ? 128 : 0)) : n0;
#pragma unroll
    for (int i = 0; i < 32; ++i) scr[(2 * i + (lane >> 5)) * 33 + (lane & 31)] = t_[i];
    LDS_WAIT(); asm volatile("" ::: "memory");
    const int c = lane & 7;
#pragma unroll
    for (int j = 0; j < 4; ++j) { const int n = (lane >> 3) + 8 * j; const LAS float* s = scr + (8 * c) * 33 + n;
        if constexpr (FP8) { u32x2 o; o.x = pk4_fp8(64.f * s[0 * 33], 64.f * s[1 * 33], 64.f * s[2 * 33], 64.f * s[3 * 33]); o.y = pk4_fp8(64.f * s[4 * 33], 64.f * s[5 * 33], 64.f * s[6 * 33], 64.f * s[7 * 33]);
            *(GAS u32x2*)(d.WT + (size_t)(drow0 + n) * d.K + k0 + 8 * c) = o; }
        else { u32x4 o; o.x = pk2(s[0 * 33], s[1 * 33]); o.y = pk2(s[2 * 33], s[3 * 33]); o.z = pk2(s[4 * 33], s[5 * 33]); o.w = pk2(s[6 * 33], s[7 * 33]);
            *(GAS u32x4*)((bf16_t*)d.WT + (size_t)(drow0 + n) * d.K + k0 + 8 * c) = o; } }
    LDS_WAIT(); asm volatile("" ::: "memory");
}
template <bool FP8, class Dec>
__device__ __forceinline__ void t_run(const Dec& dec, int first, int last, int stride, LAS float* scr, int lane) {
    int it = first; if (it >= last) return;
    TDesc dA, dB; float tA[32], tB[32]; dec(it, dA); t_load(dA, tA, lane);
    for (;;) {
        const int i1 = it + stride; const bool hasB = i1 < last; dec(hasB ? i1 : it, dB); t_load(dB, tB, lane);
        t_finish<FP8>(dA, tA, scr, lane);
        if (!hasB) break;
        const int i2 = i1 + stride; const bool hasA = i2 < last; dec(hasA ? i2 : i1, dA); t_load(dA, tA, lane);
        t_finish<FP8>(dB, tB, scr, lane);
        if (!hasA) break;
        it = i2;
    }
}
struct Args { const float* in[25]; float* out; unsigned char* ws; int ph_lo, ph_hi; };
constexpr int NPH = 14, NTOT = 2 * NPH;
typedef const __attribute__((address_space(4))) Args* KArgs;
__device__ __forceinline__ KArgs kargs() { auto p = __builtin_amdgcn_kernarg_segment_ptr(); asm volatile("" : "+s"(p)); return (KArgs)p; }
struct Geo { int G, bx, vcu; };
__device__ __forceinline__ Geo opaque_geo(Geo g) { asm volatile("" : "+s"(g.G), "+s"(g.bx), "+s"(g.vcu)); return g; }
enum { I_X = 0, I_C, I_CTX, I_CCTX, I_WMOD, I_BMOD, I_PREMIX, I_POSTMIX, I_PREFFN, I_POSTFFN, I_WIN, I_QN, I_KN, I_HGN, I_LBL, I_WATT, I_WHG, I_WOUT, I_FWG, I_FWU, I_FWD, I_ROUTER, I_MWG, I_MWU, I_MWD };

__device__ __forceinline__ void phase_prologue(LAS unsigned char* lds, const Geo geo_in) {
    const Geo geo = opaque_geo(geo_in);
    KArgs A = kargs(); unsigned char* ws = A->ws;
    const int tid = opaque_tid(), lane = tid & 63, wave = __builtin_amdgcn_readfirstlane(tid >> 6);
    const int G = geo.G, vcu = geo.vcu, gw = vcu * NWAVES + wave, NGW = G * NWAVES;
    LAS float* scr = (LAS float*)(lds + wave * 16384);
    constexpr int I_IN = 16 * (PROJW / 32), I_SQ = 16 * 32, I_GU = 16 * (DFF / 32), I_DN = (DFF / 64) * 32;
    constexpr int I_L = I_IN + 3 * I_SQ, NIT = 2 * I_L + 2 * I_GU + I_DN;
    const int ngv = (G > 96) ? 48 : 0;
    if (vcu >= ngv) {
        const auto dec = [&](int it, TDesc& d) { int r = it; d.il = 0;
            if (r < 2 * I_L) { const int l = r / I_L; r -= l * I_L; unsigned char* wl = ws + WS_W + l * WL_STRIDE; d.K = DM;
                if (r < I_IN) { d.W = A->in[I_WIN] + (size_t)l * DM * PROJW; d.N = PROJW; d.WT = wl + WL_IN; d.item = r; return; } r -= I_IN;
                d.N = DM; d.item = r & (I_SQ - 1); const int which = r / I_SQ;
                d.W = (which == 0 ? A->in[I_WATT] : which == 1 ? A->in[I_WHG] : A->in[I_WOUT]) + (size_t)l * DM * DM; d.WT = wl + (which == 0 ? WL_ATT : which == 1 ? WL_HG : WL_OUT); return; }
            r -= 2 * I_L;
            if (r < 2 * I_GU) { const int up = r >= I_GU; d.W = up ? A->in[I_FWU] : A->in[I_FWG]; d.K = DM; d.N = DFF; d.WT = ws + WS_WGU; d.il = 1 + up; d.item = r - up * I_GU; return; }
            d.W = A->in[I_FWD]; d.K = DFF; d.N = DM; d.WT = ws + WS_WD; d.item = r - 2 * I_GU; };
        t_run<false>(dec, (vcu - ngv) * NWAVES + wave, NIT, (G - ngv) * NWAVES, scr, lane);
    }
    {
        float* cosT = (float*)(ws + WS_COS); float* sinT = (float*)(ws + WS_SIN); float* lbv = (float*)(ws + WS_LBV); const float* lbl = A->in[I_LBL];
        for (int i = (vcu * 512 + tid); i < SEQ * 64; i += G * 512) { const int t = i >> 6, jj = i & 63; const int fi = jj & 31;
            const float inv = powf(10000.f, -(float)fi / 32.f); const float pos = (jj < 32) ? (float)(t >> 6) : (float)(t & 63); const float ang = pos * inv;
            cosT[i] = cosf(ang); sinT[i] = sinf(ang); }
        for (int i = (vcu * 512 + tid); i < 2 * DM; i += G * 512) { const int l = i >> 10, ch = i & 1023;
            lbv[i] = (l == 0) ? 0.f : 1.f / (1.f + expf(lbl[ch] - lbl[DM + ch])); }
    }
    __syncthreads();
    for (int it = vcu; it < 2 * 24; it += G) { const int l = it / 24, n0 = (it % 24) * 256;
        const float* c_in = A->in[I_C]; const float* cctx_in = A->in[I_CCTX]; float* modv = (float*)(ws + WS_MOD);
        LAS float* sv = (LAS float*)(lds + 65536) + wave * 5 * 128;
        const int k0 = wave * 128;
#pragma unroll
        for (int mi = 0; mi < 5; ++mi)
#pragma unroll
            for (int h2 = 0; h2 < 2; ++h2) { const int k = k0 + h2 * 64 + lane; const float cv = (mi < 4) ? c_in[mi * DM + k] : cctx_in[k]; sv[mi * 128 + h2 * 64 + lane] = cv / (1.f + expf(-cv)); }
        LDS_WAIT(); asm volatile("" ::: "memory");
        f32x4 a5[5];
#pragma unroll
        for (int mi = 0; mi < 5; ++mi) a5[mi] = (f32x4){0.f, 0.f, 0.f, 0.f};
        const float* wp = A->in[I_WMOD] + (size_t)l * DM * NMOD + (size_t)k0 * NMOD + n0 + 4 * lane;
        for (int kk0 = 0; kk0 < 128; kk0 += 16) { f32x4 wv[16];
#pragma unroll
            for (int j = 0; j < 16; ++j) wv[j] = *(const f32x4*)(wp + (size_t)(kk0 + j) * NMOD);
#pragma unroll
            for (int j = 0; j < 16; ++j)
#pragma unroll
                for (int mi = 0; mi < 5; ++mi) a5[mi] += wv[j] * sv[mi * 128 + kk0 + j]; }
        LAS float* red = (LAS float*)lds;
#pragma unroll
        for (int mi = 0; mi < 5; ++mi) *(LAS f32x4*)(red + (wave * 5 + mi) * 256 + 4 * lane) = a5[mi];
        __syncthreads();
        const float* b_mod = A->in[I_BMOD];
        for (int o = tid; o < 5 * 256; o += 512) { const int mi = o >> 8, cidx = o & 255; float s = b_mod[l * NMOD + n0 + cidx];
#pragma unroll
            for (int w8 = 0; w8 < 8; ++w8) s += red[(w8 * 5 + mi) * 256 + cidx];
            modv[((size_t)l * 5 + mi) * NMOD + n0 + cidx] = s; }
        __syncthreads();
    }
}

__device__ __forceinline__ void phase_premix0(const Geo geo_in) {
    const Geo geo = opaque_geo(geo_in);
    KArgs A = kargs(); unsigned char* ws = A->ws;
    const int tid = opaque_tid(), lane = tid & 63, wave = __builtin_amdgcn_readfirstlane(tid >> 6);
    const int gw = geo.vcu * NWAVES + wave, NGW = geo.G * NWAVES;
    const float* x_in = A->in[I_X]; const float* ctx_in = A->in[I_CTX]; const float* gain = A->in[I_PREMIX]; const float* modl = (const float*)(ws + WS_MOD);
    bf16_t* Hb = (bf16_t*)(ws + WS_H);
#define SRC_ROW(row_) (((row_) < NLAT) ? x_in + (size_t)(row_) * DM : ctx_in + (size_t)((row_) - NLAT) * DM)
#define P1_ROW(row_, cur_) do { const int rw_ = (row_); const float* md = modl + (size_t)((rw_ < NLAT) ? (rw_ >> 12) : 4) * NMOD;      \
        const Row16 h = norm_mod(cur_, row_rstd(cur_), gain, md + 0 * DM, md + 1 * DM, lane); st_bf16_row(Hb + (size_t)rw_ * DM, lane, h); } while (0)
    const int rc0 = NLAT + gw; Row16 cxc; if (rc0 < R) cxc = ld_f32_row(SRC_ROW(rc0), lane);
    for (int base = gw; base < NLAT; base += 8 * NGW) {
        Row16 rx[8];
#pragma unroll
        for (int k = 0; k < 8; ++k) rx[k] = ld_f32_row(SRC_ROW((base + k * NGW < NLAT) ? base + k * NGW : base), lane);
#pragma unroll
        for (int k = 0; k < 8; ++k) if (base + k * NGW < NLAT) P1_ROW(base + k * NGW, rx[k]);
    }
    if (rc0 < R) P1_ROW(rc0, cxc);
    for (int rc = rc0 + NGW; rc < R; rc += NGW) { const Row16 c2 = ld_f32_row(SRC_ROW(rc), lane); P1_ROW(rc, c2); }
#undef P1_ROW
#undef SRC_ROW
}

__device__ __forceinline__ void phase_proj(LAS unsigned char* lds, const Geo geo_in, int layer) {
    const Geo geo = opaque_geo(geo_in);
    KArgs A = kargs(); unsigned char* ws = A->ws;
    pg8::Gemm g{(const bf16_t*)(ws + WS_H), (const bf16_t*)(ws + WS_W + layer * WL_STRIDE + WL_IN), R, PROJW, DM}; pg8::StaticOrder S; S.init(R, PROJW, geo.G, geo.bx);
    EpiProj E{(bf16_t*)(ws + WS_PROJ), (const float*)(ws + WS_LBV) + layer * DM};
    pg8::gemm_phase<EpiProj, pg8::StaticOrder, true, true>(lds, g, S, E);
    gemm_mini_ks<EpiProj, pg8::StaticOrder>(lds, g, S, E, geo.vcu, geo.G);
}

__device__ __forceinline__ void phase_qknorm(const Geo geo_in, int layer) {
    const Geo geo = opaque_geo(geo_in);
    KArgs A = kargs(); unsigned char* ws = A->ws;
    const int tid = opaque_tid(), lane = tid & 63, wave = __builtin_amdgcn_readfirstlane(tid >> 6);
    const int gw = geo.vcu * NWAVES + wave, NGW = geo.G * NWAVES;
    const float* qn = A->in[I_QN] + layer * 128; const float* kn = A->in[I_KN] + layer * 128;
    const float* cosT = (const float*)(ws + WS_COS); const float* sinT = (const float*)(ws + WS_SIN); bf16_t* proj = (bf16_t*)(ws + WS_PROJ);
    const int nitems = R / 4;
    for (int it = gw; it < nitems; it += NGW) {
        const int row = it * 4 + (lane >> 4);
        const int lr = lane & 15;
        bf16_t* p = proj + PK + (size_t)row * 256 + 16 * lr;
        const float* gn = kn;
        const int j0 = (lr & 7) * 16;
        f32x4 v[4]; { f32x4 a, b2; unpack8(*(const u32x4*)p, a, b2); v[0] = a; v[1] = b2; unpack8(*(const u32x4*)(p + 8), a, b2); v[2] = a; v[3] = b2; }
        float ss = 0.f;
#pragma unroll
        for (int j = 0; j < 4; ++j) ss += (v[j][0] * v[j][0] + v[j][1] * v[j][1]) + (v[j][2] * v[j][2] + v[j][3] * v[j][3]);
        ss += dpp_f<0xB1>(ss); ss += dpp_f<0x4E>(ss); ss += dpp_f<0x141>(ss);
        const float rstd = rsqrtf(ss * (1.f / 128.f) + NORM_EPS);
#pragma unroll
        for (int j = 0; j < 4; ++j) v[j] = v[j] * rstd * *(const f32x4*)(gn + j0 + 4 * j);
        if (row < NLAT) {
            const int t = row & (SEQ - 1); const int jj0 = (lr & 3) * 16; const bool upper = (lr & 4) != 0;
#pragma unroll
            for (int j = 0; j < 4; ++j) { f32x4 pv;
#pragma unroll
                for (int e = 0; e < 4; ++e) pv[e] = dpp_xor4(v[j][e]);
                const f32x4 cs = *(const f32x4*)(cosT + (size_t)t * 64 + jj0 + 4 * j), sn = *(const f32x4*)(sinT + (size_t)t * 64 + jj0 + 4 * j);
                v[j] = upper ? (v[j] * cs + pv * sn) : (v[j] * cs - pv * sn); }
        }
        *(u32x4*)p = pack8(v[0], v[1]); *(u32x4*)(p + 8) = pack8(v[2], v[3]);
    }
}

__device__ __forceinline__ void phase_attn(unsigned char* lds_raw, const Geo geo_in, bool last, int layer) {
    const Geo geo = opaque_geo(geo_in);
    KArgs A = kargs(); unsigned char* ws = A->ws;
    bf16_t* Qp = (bf16_t*)(ws + WS_PROJ) + PQ; const bf16_t* Kp = (const bf16_t*)(ws + WS_PROJ) + PK; const bf16_t* Vp = (const bf16_t*)(ws + WS_PROJ) + PV;
    const float* qn = A->in[I_QN] + layer * 128;
    const int nun = last ? 512 : 544;
#ifndef ATT_UMAP
#define ATT_UMAP 0
#endif
#ifdef ATT_PROBE
    for (int u = (ATT_UMAP ? geo.bx : geo.vcu); u < nun; u += geo.G) {
        int qrow, krow, h, seq, nlat, ctxoff;
        if (u < 512) { const int grp = u >> 6, b = grp >> 1, kvh = grp & 1, gq = (u >> 4) & 3, qb = u & 15; h = kvh * 4 + gq;
            qrow = b * SEQ + qb * 256; krow = b * SEQ; seq = SEQ + CTXL; nlat = SEQ; ctxoff = (NLAT + b * CTXL) - (b * SEQ) - SEQ; }
        else { const int b = (u - 512) >> 3; h = (u - 512) & 7; qrow = NLAT + b * CTXL; krow = qrow; seq = CTXL; nlat = 1 << 30; ctxoff = 0; }
        bf16_t* Qb = Qp + (size_t)qrow * 1024 + h * 128; bf16_t* Os = (bf16_t*)(ws + WS_OF) + (size_t)qrow * 1024 + h * 128;
        const bf16_t* Kh = Kp + (size_t)krow * 256 + (h >> 2) * 128; const bf16_t* Vh = Vp + (size_t)krow * 256 + (h >> 2) * 128;
        att::attn_dense_body<1024, 256, 1024, ATT_PROBE>(Qb, Kh, Vh, Os, seq, nlat, ctxoff, (char*)lds_raw, qn, (const float*)(ws + WS_COS), (const float*)(ws + WS_SIN), qrow & (SEQ - 1), u < 512);
    }
#endif
    for (int u = (ATT_UMAP ? geo.bx : geo.vcu); u < nun; u += geo.G) {
        int qrow, krow, h, seq, nlat, ctxoff;
        if (u < 512) { const int grp = u >> 6, b = grp >> 1, kvh = grp & 1, gq = (u >> 4) & 3, qb = u & 15; h = kvh * 4 + gq;
            qrow = b * SEQ + qb * 256; krow = b * SEQ; seq = SEQ + CTXL; nlat = SEQ; ctxoff = (NLAT + b * CTXL) - (b * SEQ) - SEQ; }
        else { const int b = (u - 512) >> 3; h = (u - 512) & 7; qrow = NLAT + b * CTXL; krow = qrow; seq = CTXL; nlat = 1 << 30; ctxoff = 0; }
        bf16_t* Qb = Qp + (size_t)qrow * 1024 + h * 128;
        const bf16_t* Kh = Kp + (size_t)krow * 256 + (h >> 2) * 128; const bf16_t* Vh = Vp + (size_t)krow * 256 + (h >> 2) * 128;
        att::attn_dense_body<1024, 256, 1024>(Qb, Kh, Vh, Qb, seq, nlat, ctxoff, (char*)lds_raw, qn, (const float*)(ws + WS_COS), (const float*)(ws + WS_SIN), qrow & (SEQ - 1), u < 512);
    }
}
__device__ __forceinline__ void phase_scan(LAS unsigned char* lds, const Geo geo_in, bool last) {
    const Geo geo = opaque_geo(geo_in);
    KArgs A = kargs(); unsigned char* ws = A->ws;
    bf16_t* proj = (bf16_t*)(ws + WS_PROJ);
    for (int u = geo.vcu; u < 256; u += geo.G) {
        const int dvs = u & 3, bwd = (u >> 2) & 1, h = (u >> 3) & 7, b = u >> 6;
        scan::scan_unit(lds, proj + PHQ, bwd ? proj + PGB : proj + PGF, proj + PHV, bwd ? (bf16_t*)(ws + WS_OB) : (bf16_t*)(ws + WS_OF), b, h, bwd, dvs, !last);
    }
}

__device__ __forceinline__ void phase_readout(const Geo geo_in, int layer) {
    const Geo geo = opaque_geo(geo_in);
    KArgs A = kargs(); unsigned char* ws = A->ws;
    const int tid = opaque_tid(), lane = tid & 63, wave = __builtin_amdgcn_readfirstlane(tid >> 6);
    const int gw = geo.vcu * NWAVES + wave, NGW = geo.G * NWAVES;
    const float* hn = A->in[I_HGN] + layer * 128; const int nrows = (layer == 1) ? NLAT : R;
    const bf16_t* OFb = (const bf16_t*)(ws + WS_OF); const bf16_t* OBb = (const bf16_t*)(ws + WS_OB); bf16_t* HG = (bf16_t*)(ws + WS_PROJ) + PHG;
    const int j0 = (lane & 7) * 16;
    struct Raw { u32x4 f0, f1, b0, b1, g0, g1; };
#define RD_LOAD(dst, row_) do { const size_t off_ = (size_t)(row_) * 1024 + 16 * lane; dst.f0 = *(const u32x4*)(OFb + off_); dst.f1 = *(const u32x4*)(OFb + off_ + 8); \
        dst.b0 = *(const u32x4*)(OBb + off_); dst.b1 = *(const u32x4*)(OBb + off_ + 8); dst.g0 = *(const u32x4*)(HG + off_); dst.g1 = *(const u32x4*)(HG + off_ + 8); } while (0)
#define RD_ROW(row_, cur) do { const size_t off = (size_t)(row_) * 1024 + 16 * lane;                                                                   \
        f32x4 a[4], b4[4], g4[4];                                                                                                                  \
        unpack8(cur.f0, a[0], a[1]); unpack8(cur.f1, a[2], a[3]); unpack8(cur.b0, b4[0], b4[1]); unpack8(cur.b1, b4[2], b4[3]); unpack8(cur.g0, g4[0], g4[1]); unpack8(cur.g1, g4[2], g4[3]); \
        float ss = 0.f;                                                                                                                            \
        _Pragma("unroll") for (int j = 0; j < 4; ++j) { a[j] += b4[j]; ss += (a[j][0] * a[j][0] + a[j][1] * a[j][1]) + (a[j][2] * a[j][2] + a[j][3] * a[j][3]); } \
        ss += dpp_f<0xB1>(ss); ss += dpp_f<0x4E>(ss); ss += dpp_f<0x141>(ss);                                                                          \
        const float rstd = rsqrtf(ss * (1.f / 128.f) + NORM_EPS);                                                                                  \
        _Pragma("unroll") for (int j = 0; j < 4; ++j) a[j] = a[j] * rstd * *(const f32x4*)(hn + j0 + 4 * j) * g4[j];                                 \
        *(u32x4*)(HG + off) = pack8(a[0], a[1]); *(u32x4*)(HG + off + 8) = pack8(a[2], a[3]); } while (0)
    const int rc0 = NLAT + gw; Raw rcc; if (rc0 < nrows) RD_LOAD(rcc, rc0);
    for (int base = gw; base < NLAT; base += 8 * NGW) {
        Raw sl[6];
#define RD_LD(k_) RD_LOAD(sl[(k_) % 6], ((base + (k_) * NGW < NLAT) ? base + (k_) * NGW : base))
#pragma unroll
        for (int k = 0; k < 5; ++k) RD_LD(k);
#pragma unroll
        for (int k = 0; k < 8; ++k) {
            if (k + 5 < 8) RD_LD(k + 5);
            if (base + k * NGW < NLAT) RD_ROW(base + k * NGW, sl[k % 6]);
        }
#undef RD_LD
    }
    if (rc0 < nrows) RD_ROW(rc0, rcc);
    for (int rc = rc0 + NGW; rc < nrows; rc += NGW) { Raw r2; RD_LOAD(r2, rc); RD_ROW(rc, r2); }
#undef RD_ROW
#undef RD_LOAD
}

__device__ __forceinline__ void phase_merge_hg(LAS unsigned char* lds, const Geo geo_in, int layer) {
    const Geo geo = opaque_geo(geo_in);
    KArgs A = kargs(); unsigned char* ws = A->ws; const int M = (layer == 1) ? NLAT : R; bf16_t* proj = (bf16_t*)(ws + WS_PROJ);
    pg8::Gemm g{proj + PHG, (const bf16_t*)(ws + WS_W + layer * WL_STRIDE + WL_HG), M, DM, DM}; pg8::StaticOrder S; S.init(M, DM, geo.G, geo.bx);
    EpiGate<false> E{proj + PGH, nullptr};
    pg8::gemm_phase<EpiGate<false>, pg8::StaticOrder, true, true>(lds, g, S, E);
    gemm_mini_ks<EpiGate<false>, pg8::StaticOrder>(lds, g, S, E, geo.vcu, geo.G);
}
__device__ __forceinline__ void phase_merge_att(LAS unsigned char* lds, const Geo geo_in, int layer) {
    const Geo geo = opaque_geo(geo_in);
    KArgs A = kargs(); unsigned char* ws = A->ws; const int M = (layer == 1) ? NLAT : R; bf16_t* proj = (bf16_t*)(ws + WS_PROJ);
    pg8::Gemm g{proj + PQ, (const bf16_t*)(ws + WS_W + layer * WL_STRIDE + WL_ATT), M, DM, DM}; pg8::StaticOrder S; S.init(M, DM, geo.G, geo.bx);
    EpiGate<true> E{proj + PGA, proj + PGH};
    pg8::gemm_phase<EpiGate<true>, pg8::StaticOrder, true, true>(lds, g, S, E);
    gemm_mini_ks<EpiGate<true>, pg8::StaticOrder>(lds, g, S, E, geo.vcu, geo.G);
}
__device__ __forceinline__ void phase_wout(LAS unsigned char* lds, const Geo geo_in, int layer) {
    const Geo geo = opaque_geo(geo_in);
    KArgs A = kargs(); unsigned char* ws = A->ws; const int M = (layer == 1) ? NLAT : R; bf16_t* proj = (bf16_t*)(ws + WS_PROJ);
    pg8::Gemm g{proj + PGA, (const bf16_t*)(ws + WS_W + layer * WL_STRIDE + WL_OUT), M, DM, DM}; pg8::StaticOrder S; S.init(M, DM, geo.G, geo.bx);
    EpiPlain E{(bf16_t*)(ws + WS_H), DM};
    pg8::gemm_phase<EpiPlain, pg8::StaticOrder, true, true>(lds, g, S, E);
    gemm_mini_ks<EpiPlain, pg8::StaticOrder>(lds, g, S, E, geo.vcu, geo.G);
}

constexpr int XB_SPLIT = 15872;
__device__ __forceinline__ bf16_t* xa_row(unsigned char* ws, int row) { return (bf16_t*)(ws + WS_OB) + (size_t)row * DM; }
__device__ __forceinline__ bf16_t* xb_row(unsigned char* ws, int row) { return row < XB_SPLIT ? (bf16_t*)(ws + WS_END) + (size_t)row * DM : (bf16_t*)(ws + WS_WGU) + (size_t)(row - XB_SPLIT) * DM; }
__device__ __forceinline__ bf16_t* xc_row(unsigned char* ws, int row) { return (bf16_t*)(ws + WS_W) + (size_t)row * DM; }
__device__ __forceinline__ void phase_postmix0(const Geo geo_in, bool probe = false) {
    const Geo geo = opaque_geo(geo_in);
    KArgs A = kargs(); unsigned char* ws = A->ws;
    const int tid = opaque_tid(), lane = tid & 63, wave = __builtin_amdgcn_readfirstlane(tid >> 6);
    const int gw = geo.vcu * NWAVES + wave, NGW = geo.G * NWAVES;
    const float* x_in = A->in[I_X]; const float* ctx_in = A->in[I_CTX]; float* out = A->out; float* xctx = (float*)(ws + WS_XCTX);
    const float* pmn = A->in[I_POSTMIX]; const float* pfn = A->in[I_PREFFN]; const float* modl = (const float*)(ws + WS_MOD); bf16_t* Hb = (bf16_t*)(ws + WS_H);
#define SRC_ROW(row_) (((row_) < NLAT) ? x_in + (size_t)(row_) * DM : ctx_in + (size_t)((row_) - NLAT) * DM)
#define P9_ROW(row_, cx_, cm_) do { const int rw_ = (row_); const float* md = modl + (size_t)((rw_ < NLAT) ? (rw_ >> 12) : 4) * NMOD;      \
        const Row16 x1 = resid_add(cx_, cm_, row_rstd(cm_), pmn, md + 2 * DM, lane);                                                           \
        if (probe) st_bf16_row((bf16_t*)(ws + WS_OB) + (size_t)rw_ * DM, lane, x1);                                                            \
        else if (rw_ < NLAT) st_bf16_row_nt(xa_row(ws, rw_), lane, x1); else st_f32_row(xctx + (size_t)(rw_ - NLAT) * DM, lane, x1);                \
        const Row16 f = norm_mod(x1, row_rstd(x1), pfn, md + 3 * DM, md + 4 * DM, lane);                                                       \
        st_bf16_row((probe ? (bf16_t*)(ws + WS_OF) : Hb) + (size_t)rw_ * DM, lane, f); } while (0)
    const int rc0 = NLAT + gw; Row16 cxc; RawB cmc; if (rc0 < R) { cxc = ld_f32_row(SRC_ROW(rc0), lane); cmc = ld_raw_b(Hb + (size_t)rc0 * DM, lane); }
    for (int base = gw; base < NLAT; base += 8 * NGW) {
        Row16 fx[5]; RawB fm[5];
#define P9_LOAD(k_) do { const int rw_ = (base + (k_) * NGW < NLAT) ? base + (k_) * NGW : base; fx[(k_) % 5] = ld_f32_row_nt(SRC_ROW(rw_), lane); fm[(k_) % 5] = ld_raw_b_nt(Hb + (size_t)rw_ * DM, lane); } while (0)
#pragma unroll
        for (int k = 0; k < 4; ++k) P9_LOAD(k);
#pragma unroll
        for (int k = 0; k < 8; ++k) {
            if (k + 4 < 8) P9_LOAD(k + 4);
            if (base + k * NGW < NLAT) { const Row16 cm = unraw_b(fm[k % 5]); P9_ROW(base + k * NGW, fx[k % 5], cm); }
        }
#undef P9_LOAD
    }
    if (rc0 < R) { const Row16 cm = unraw_b(cmc); P9_ROW(rc0, cxc, cm); }
    for (int rc = rc0 + NGW; rc < R; rc += NGW) { const Row16 c2 = ld_f32_row(SRC_ROW(rc), lane), m2 = ld_bf16_row(Hb + (size_t)rc * DM, lane); P9_ROW(rc, c2, m2); }
#undef P9_ROW
#undef SRC_ROW
}
constexpr int MOE_I_E = 16 * (DFE / 32);
constexpr int MOE_CONV_TAILW = (256 - 16) * NWAVES;
#ifndef MOE_EARLY_PER_WAVE
#define MOE_EARLY_PER_WAVE 16
#endif
constexpr int MOE_CONV_EARLY = MOE_EARLY_PER_WAVE * MOE_CONV_TAILW;
__device__ __forceinline__ void moe_convert(unsigned char* ws, KArgs A, LAS unsigned char* scrbase, int first, int last, int wi, int nw, int wave, int lane) {
    LAS float* scr = (LAS float*)(scrbase + wave * 8704);
    unsigned char* MGU = ws + WS_MGU; unsigned char* MD = ws + WS_MD;
    const auto dec = [&](int it, TDesc& d) { const int e = it / (3 * MOE_I_E), r3 = it - e * 3 * MOE_I_E, m = r3 / MOE_I_E; d.item = r3 - m * MOE_I_E;
        if (m < 2) { d.W = (m == 0 ? A->in[I_MWG] : A->in[I_MWU]) + (size_t)e * DM * DFE; d.K = DM; d.N = DFE; d.WT = MGU + (size_t)e * 2 * DFE * DM; d.il = 1 + m; }
        else { d.W = A->in[I_MWD] + (size_t)e * DFE * DM; d.K = DFE; d.N = DM; d.WT = MD + (size_t)e * DM * DFE; d.il = 0; } };
    t_run<true>(dec, first + wi, last, nw, scr, lane);
}
__device__ __forceinline__ void phase_postmix1(LAS unsigned char* lds, const Geo geo_in) {
    const Geo geo = opaque_geo(geo_in);
    KArgs A = kargs(); unsigned char* ws = A->ws;
    const int tid = opaque_tid(), lane = tid & 63, wave = __builtin_amdgcn_readfirstlane(tid >> 6);
    const int G = geo.G, vcu = geo.vcu, gw = vcu * NWAVES + wave, NGW = G * NWAVES;
    float* out = A->out; const float* pmn = A->in[I_POSTMIX] + DM; const float* pfn = A->in[I_PREFFN] + DM; const float* modl = (const float*)(ws + WS_MOD) + (size_t)5 * NMOD;
    bf16_t* Hb = (bf16_t*)(ws + WS_H); unsigned* route = (unsigned*)(ws + WS_ROUTE); unsigned* wgb = (unsigned*)(ws + WS_WGB); unsigned* cnt = (unsigned*)(ws + WS_CTL) + CW_CNT;
    LAS float* wr = (LAS float*)lds; LAS unsigned* lcnt = (LAS unsigned*)(lds + 32768); LAS unsigned* lbase = lcnt + 8; unsigned char* XB = ws + WS_XB;
    { const float* moe_router = A->in[I_ROUTER]; for (int i = tid; i < DM * NEXP; i += 512) wr[i] = moe_router[i]; }
    if (tid < NEXP) lcnt[tid] = 0u;
    __syncthreads();
    for (int blk = vcu; blk < NLAT / 64; blk += G) {
        RawB rxr[8], rmx[8];
        unsigned fq8[8][4]; int re0[8], re1[8]; unsigned rp0[8], rp1[8];
#pragma unroll
        for (int i = 0; i < 8; ++i) { rxr[i] = ld_raw_b_nt(xb_row(ws, blk * 64 + wave * 8 + i), lane); rmx[i] = ld_raw_b_nt(Hb + (size_t)(blk * 64 + wave * 8 + i) * DM, lane); }
#pragma unroll
        for (int i = 0; i < 8; ++i) {
            const int row = blk * 64 + wave * 8 + i;
            const float* md = modl + (size_t)(row >> 12) * NMOD;
            const Row16 xr = unraw_b(rxr[i]), mx = unraw_b(rmx[i]);
            const Row16 x1 = resid_add(xr, mx, row_rstd(mx), pmn, md + 2 * DM, lane);
            st_bf16_row_nt(xc_row(ws, row), lane, x1);
            const Row16 f = norm_mod(x1, row_rstd(x1), pfn, md + 3 * DM, md + 4 * DM, lane);
#pragma unroll
            for (int j = 0; j < 4; ++j) fq8[i][j] = pk4_fp8(f.v[j][0], f.v[j][1], f.v[j][2], f.v[j][3]);
            float lg[NEXP];
#pragma unroll
            for (int e = 0; e < NEXP; ++e) lg[e] = 0.f;
#pragma unroll
            for (int j = 0; j < 4; ++j)
#pragma unroll
                for (int e4 = 0; e4 < 4; ++e4) { const int cidx = 4 * (lane + 64 * j) + e4; const f32x4 w0 = *(const LAS f32x4*)(wr + cidx * 8), w1 = *(const LAS f32x4*)(wr + cidx * 8 + 4); const float fv = f.v[j][e4];
                    lg[0] += fv * w0[0]; lg[1] += fv * w0[1]; lg[2] += fv * w0[2]; lg[3] += fv * w0[3]; lg[4] += fv * w1[0]; lg[5] += fv * w1[1]; lg[6] += fv * w1[2]; lg[7] += fv * w1[3]; }
#pragma unroll
            for (int e = 0; e < NEXP; ++e) lg[e] = wave_sum(lg[e]);
            int e0 = 0; float l0 = lg[0];
#pragma unroll
            for (int e = 1; e < NEXP; ++e) if (lg[e] > l0) { l0 = lg[e]; e0 = e; }
            int e1 = -1; float l1 = -3.0e38f;
#pragma unroll
            for (int e = 0; e < NEXP; ++e) if (e != e0 && lg[e] > l1) { l1 = lg[e]; e1 = e; }
            unsigned p0 = 0u, p1 = 0u;
            if (lane == 0) {
                p0 = __hip_atomic_fetch_add(lcnt + e0, 1u, __ATOMIC_RELAXED, __HIP_MEMORY_SCOPE_WORKGROUP);
                p1 = __hip_atomic_fetch_add(lcnt + e1, 1u, __ATOMIC_RELAXED, __HIP_MEMORY_SCOPE_WORKGROUP);
                const float w0 = 1.f / (1.f + expf(l1 - l0));
                unsigned* rr = route + (size_t)row * 8;
                rr[0] = (unsigned)e0 | ((unsigned)e1 << 8); rr[3] = __float_as_uint(w0); rr[4] = __float_as_uint(1.f - w0);
            }
            re0[i] = __builtin_amdgcn_readfirstlane(e0); re1[i] = __builtin_amdgcn_readfirstlane(e1); rp0[i] = __builtin_amdgcn_readfirstlane(p0); rp1[i] = __builtin_amdgcn_readfirstlane(p1);
        }
        __syncthreads();
        if (tid < NEXP) { const unsigned n = lcnt[tid]; lbase[tid] = __hip_atomic_fetch_add(cnt + 64 * tid, n, __ATOMIC_RELAXED, __HIP_MEMORY_SCOPE_AGENT); lcnt[tid] = 0u; }
        __syncthreads();
#pragma unroll
        for (int i = 0; i < 8; ++i) { const int row = blk * 64 + wave * 8 + i;
            const unsigned k0 = lbase[re0[i]] + rp0[i], k1 = lbase[re1[i]] + rp1[i];
            unsigned* d0 = (unsigned*)(XB + ((size_t)re0[i] * XB_CAP + k0) * DM); unsigned* d1 = (unsigned*)(XB + ((size_t)re1[i] * XB_CAP + k1) * DM);
#pragma unroll
            for (int j = 0; j < 4; ++j) { d0[lane + 64 * j] = fq8[i][j]; d1[lane + 64 * j] = fq8[i][j]; }
            if (lane == 0) { unsigned* rr = route + (size_t)row * 8; rr[5] = k0; rr[6] = k1; } }
        __syncthreads();
    }
    moe_convert(ws, A, lds + 49152, (G == 256) ? MOE_CONV_EARLY : 0, NEXP * 3 * MOE_I_E, gw, NGW, wave, lane);
}

struct MoeCounts { int nb[NEXP]; };
__device__ __forceinline__ MoeCounts moe_counts(unsigned char* ws) { MoeCounts c; unsigned* cnt = (unsigned*)(ws + WS_CTL) + CW_CNT;
#pragma unroll
    for (int e = 0; e < NEXP; ++e) { const unsigned n = __hip_atomic_load(cnt + 64 * e, __ATOMIC_RELAXED, __HIP_MEMORY_SCOPE_AGENT); c.nb[e] = (int)((n + 255u) >> 8); }
    return c; }

__device__ __forceinline__ void phase_gather(const Geo geo_in) {
    const Geo geo = opaque_geo(geo_in);
    KArgs A = kargs(); unsigned char* ws = A->ws;
    const int tid = opaque_tid(), lane = tid & 63, wave = __builtin_amdgcn_readfirstlane(tid >> 6);
    const int gw = geo.vcu * NWAVES + wave, NGW = geo.G * NWAVES;
    const MoeCounts mc = moe_counts(ws); int pst[NEXP]; { int a_ = 0;
#pragma unroll
        for (int e = 0; e < NEXP; ++e) { pst[e] = a_; a_ += mc.nb[e] * 256; } }
    unsigned* route = (unsigned*)(ws + WS_ROUTE); const unsigned* wgb = (const unsigned*)(ws + WS_WGB); const bf16_t* Hb = (const bf16_t*)(ws + WS_H); unsigned char* XB = ws + WS_XB;
    struct Rec { unsigned ee, p0, p1; }; struct Dat { unsigned b0, b1; u32x4 lo, hi; };
#define G_REC(dst, row_) do { const unsigned* rr_ = route + (size_t)(row_) * 8; dst.ee = rr_[0]; dst.p0 = rr_[1]; dst.p1 = rr_[2]; } while (0)
#define G_DAT(dst, rec, row_) do { dst.b0 = wgb[((row_) >> 6) * 8 + (rec.ee & 255)]; dst.b1 = wgb[((row_) >> 6) * 8 + ((rec.ee >> 8) & 255)]; \
        dst.lo = *(const u32x4*)(Hb + (size_t)(row_) * DM + 16 * lane); dst.hi = *(const u32x4*)(Hb + (size_t)(row_) * DM + 16 * lane + 8); } while (0)
    for (int base = gw; base < NLAT; base += 8 * NGW) {
        Rec rc[8]; Dat dt[8];
#pragma unroll
        for (int k = 0; k < 8; ++k) G_REC(rc[k], ((base + k * NGW < NLAT) ? base + k * NGW : base));
#pragma unroll
        for (int k = 0; k < 8; ++k) G_DAT(dt[k], rc[k], ((base + k * NGW < NLAT) ? base + k * NGW : base));
#pragma unroll
        for (int k = 0; k < 8; ++k) { const int row = base + k * NGW;
            if (row < NLAT) {
                const int e0 = rc[k].ee & 255, e1 = (rc[k].ee >> 8) & 255;
                int ps0 = 0, ps1 = 0;
#pragma unroll
                for (int e = 0; e < NEXP; ++e) { if (e == e0) ps0 = pst[e]; if (e == e1) ps1 = pst[e]; }
                const unsigned d0 = (unsigned)ps0 + dt[k].b0 + rc[k].p0, d1 = (unsigned)ps1 + dt[k].b1 + rc[k].p1;
                f32x4 v0, v1, v2, v3; unpack8(dt[k].lo, v0, v1); unpack8(dt[k].hi, v2, v3);
                const u32x4 q = {pk4_fp8(v0[0], v0[1], v0[2], v0[3]), pk4_fp8(v1[0], v1[1], v1[2], v1[3]), pk4_fp8(v2[0], v2[1], v2[2], v2[3]), pk4_fp8(v3[0], v3[1], v3[2], v3[3])};
                *(u32x4*)(XB + (size_t)d0 * DM + 16 * lane) = q; *(u32x4*)(XB + (size_t)d1 * DM + 16 * lane) = q;
                if (lane == 0) { unsigned* rr = route + (size_t)row * 8; rr[5] = d0; rr[6] = d1; }
            } }
    }
#undef G_REC
#undef G_DAT
}

__device__ __forceinline__ void phase_ffn_up0(LAS unsigned char* lds, const Geo geo_in) {
    const Geo geo = opaque_geo(geo_in);
    KArgs A = kargs(); unsigned char* ws = A->ws;
    pg8::Gemm g{(const bf16_t*)(ws + WS_H), (const bf16_t*)(ws + WS_WGU), R, 2 * DFF, DM}; pg8::StaticOrder S; S.init(R, 2 * DFF, geo.G, geo.bx); S.nfull = S.nwg;
    EpiSwiGLU E{(bf16_t*)(ws + WS_PROJ), DFF};
    pg8::gemm_phase<EpiSwiGLU, pg8::StaticOrder, true, true>(lds, g, S, E);
    gemm_mini<EpiSwiGLU, pg8::StaticOrder>(g, S, E, geo.vcu, geo.G);
}
__device__ __forceinline__ void phase_ffn_down0(LAS unsigned char* lds, const Geo geo_in) {
    const Geo geo = opaque_geo(geo_in);
    KArgs A = kargs(); unsigned char* ws = A->ws;
    pg8::Gemm g{(const bf16_t*)(ws + WS_PROJ), (const bf16_t*)(ws + WS_WD), R, DM, DFF}; pg8::StaticOrder S; S.init(R, DM, geo.G, geo.bx); S.nfull = S.nwg;
    EpiPlain E{(bf16_t*)(ws + WS_OF), DM};
    pg8::gemm_phase<EpiPlain, pg8::StaticOrder, true, true>(lds, g, S, E);
    if (geo.G == 256 && geo.bx >= 16) {
        const int tid = opaque_tid(), lane = tid & 63, wave = __builtin_amdgcn_readfirstlane(tid >> 6);
        moe_convert(ws, A, lds, 0, MOE_CONV_EARLY, (geo.bx - 16) * NWAVES + wave, MOE_CONV_TAILW, wave, lane);
    }
}
__device__ __forceinline__ void phase_ffn_up1(LAS unsigned char* lds, const Geo geo_in) {
    const Geo geo = opaque_geo(geo_in);
    KArgs A = kargs(); unsigned char* ws = A->ws; const MoeCounts mc = moe_counts(ws);
    pg8::Gemm g{(const bf16_t*)(ws + WS_XB), (const bf16_t*)(ws + WS_MGU), MOE_ROWS_MAX, 2 * DFE, DM}; MoeOrder S; S.acap = XB_CAP / 256;
#pragma unroll
    for (int e = 0; e < NEXP; ++e) S.nb[e] = mc.nb[e];
    S.nN = 2 * DFE / 256; S.G = geo.G; S.c = geo.vcu; S.finish(); S.nfull = S.nwg;
    EpiSwiGLU8 E{ws + WS_HIDM, DFE};
    pg8::gemm_phase<EpiSwiGLU8, MoeOrder, true, true, true>(lds, g, S, E);
}
__device__ __forceinline__ void phase_ffn_down1(LAS unsigned char* lds, const Geo geo_in) {
    const Geo geo = opaque_geo(geo_in);
    KArgs A = kargs(); unsigned char* ws = A->ws; const MoeCounts mc = moe_counts(ws);
    pg8::Gemm g{(const bf16_t*)(ws + WS_HIDM), (const bf16_t*)(ws + WS_MD), MOE_ROWS_MAX, DM, DFE}; MoeOrder S;
#pragma unroll
    for (int e = 0; e < NEXP; ++e) S.nb[e] = mc.nb[e];
    S.nN = DM / 256; S.G = geo.G; S.c = geo.vcu; S.finish();
#ifdef MOE_NO_MINI8
    S.nfull = S.nwg;
#endif
    EpiPlain E{(bf16_t*)(ws + WS_YB), DM, 0.015625f};
    pg8::gemm_phase<EpiPlain, MoeOrder, true, true, true>(lds, g, S, E);
    gemm_mini8<DFE, EpiPlain, MoeOrder>(lds, ws + WS_HIDM, ws + WS_MD, S, E, geo.vcu, geo.G);
}

__device__ __forceinline__ void phase_postffn0(const Geo geo_in, bool probe = false) {
    const Geo geo = opaque_geo(geo_in);
    KArgs A = kargs(); unsigned char* ws = A->ws;
    const int tid = opaque_tid(), lane = tid & 63, wave = __builtin_amdgcn_readfirstlane(tid >> 6);
    const int gw = geo.vcu * NWAVES + wave, NGW = geo.G * NWAVES;
    float* out = A->out; float* xctx = (float*)(ws + WS_XCTX); const float* pfn = A->in[I_POSTFFN]; const float* pmx = A->in[I_PREMIX] + DM;
    const float* modl = (const float*)(ws + WS_MOD); const bf16_t* FF = (const bf16_t*)(ws + WS_OF); bf16_t* Hb = (bf16_t*)(ws + WS_H);
#define X_LOAD(row_) (((row_) < NLAT) ? ld_bf16_row(xa_row(ws, (row_)), lane) : ld_f32_row(xctx + (size_t)((row_) - NLAT) * DM, lane))
#define P13_ROW(row_, cx_, cy_) do { const int rw_ = (row_); const int mi = (rw_ < NLAT) ? (rw_ >> 12) : 4;                                        \
        const Row16 x2 = resid_add(cx_, cy_, row_rstd(cy_), pfn, modl + (size_t)mi * NMOD + 5 * DM, lane);                                    \
        if (probe) st_bf16_row((bf16_t*)(ws + WS_PROJ) + (size_t)rw_ * DM, lane, x2);                                                          \
        else if (rw_ < NLAT) st_bf16_row_nt(xb_row(ws, rw_), lane, x2); else st_f32_row(xctx + (size_t)(rw_ - NLAT) * DM, lane, x2);                \
        const float* mdn = modl + (size_t)(5 + mi) * NMOD;                                                                                    \
        const Row16 h = norm_mod(x2, row_rstd(x2), pmx, mdn + 0 * DM, mdn + 1 * DM, lane);                                                    \
        st_bf16_row((probe ? (bf16_t*)(ws + WS_PROJ + 40 * MiB) : Hb) + (size_t)rw_ * DM, lane, h); } while (0)
    const int rc0 = NLAT + gw; Row16 cxc; RawB cyr; if (rc0 < R) { cxc = ld_f32_row(xctx + (size_t)(rc0 - NLAT) * DM, lane); cyr = ld_raw_b(FF + (size_t)rc0 * DM, lane); }
    for (int base = gw; base < NLAT; base += 8 * NGW) {
        RawB rx[8], ry[8];
#pragma unroll
        for (int k = 0; k < 8; ++k) { const int rw = (base + k * NGW < NLAT) ? base + k * NGW : base; rx[k] = ld_raw_b_nt(xa_row(ws, rw), lane); ry[k] = ld_raw_b_nt(FF + (size_t)rw * DM, lane); }
#pragma unroll
        for (int k = 0; k < 8; ++k) if (base + k * NGW < NLAT) { const Row16 cx = unraw_b(rx[k]), cy = unraw_b(ry[k]); P13_ROW(base + k * NGW, cx, cy); }
    }
    if (rc0 < R) { const Row16 cyc = unraw_b(cyr); P13_ROW(rc0, cxc, cyc); }
    for (int rc = rc0 + NGW; rc < R; rc += NGW) { const Row16 c2 = ld_f32_row(xctx + (size_t)(rc - NLAT) * DM, lane), y2 = ld_bf16_row(FF + (size_t)rc * DM, lane); P13_ROW(rc, c2, y2); }
#undef P13_ROW
#undef X_LOAD
}
__device__ __forceinline__ void phase_postffn1(const Geo geo_in) {
    const Geo geo = opaque_geo(geo_in);
    KArgs A = kargs(); unsigned char* ws = A->ws;
    const int tid = opaque_tid(), lane = tid & 63, wave = __builtin_amdgcn_readfirstlane(tid >> 6);
    const int gw = geo.vcu * NWAVES + wave, NGW = geo.G * NWAVES;
    float* out = A->out; const float* pfn = A->in[I_POSTFFN] + DM; const float* modl = (const float*)(ws + WS_MOD) + (size_t)5 * NMOD;
    const unsigned* route = (const unsigned*)(ws + WS_ROUTE); const bf16_t* YB = (const bf16_t*)(ws + WS_YB);
    const MoeCounts mc = moe_counts(ws); int pst[NEXP]; { int a_ = 0;
#pragma unroll
        for (int e = 0; e < NEXP; ++e) { pst[e] = a_; a_ += mc.nb[e] * 256; } }
    for (int base = gw; base < NLAT; base += 8 * NGW) {
        u32x4 rt[8];
#pragma unroll
        for (int k = 0; k < 8; ++k) { const unsigned* rr = route + (size_t)((base + k * NGW < NLAT) ? base + k * NGW : base) * 8; rt[k] = *(const u32x4*)(rr + 3); const unsigned ee = rr[0];
            const int e0 = ee & 255, e1 = (ee >> 8) & 255; int ps0 = 0, ps1 = 0;
#pragma unroll
            for (int e = 0; e < NEXP; ++e) { if (e == e0) ps0 = pst[e]; if (e == e1) ps1 = pst[e]; }
            rt[k].z += (unsigned)ps0; rt[k].w += (unsigned)ps1; }
        RawB fx[5], f0[5], f1[5];
#define P13L_LOAD(k_) do { const int rw_ = (base + (k_) * NGW < NLAT) ? base + (k_) * NGW : base; fx[(k_) % 5] = ld_raw_b_nt(xc_row(ws, rw_), lane);           \
        f0[(k_) % 5] = ld_raw_b_nt(YB + (size_t)rt[k_].z * DM, lane); f1[(k_) % 5] = ld_raw_b_nt(YB + (size_t)rt[k_].w * DM, lane); } while (0)
#pragma unroll
        for (int k = 0; k < 4; ++k) P13L_LOAD(k);
#pragma unroll
        for (int k = 0; k < 8; ++k) {
            if (k + 4 < 8) P13L_LOAD(k + 4);
            const int row = base + k * NGW;
            if (row < NLAT) {
                const float w0 = __uint_as_float(rt[k].x), w1 = __uint_as_float(rt[k].y);
                const Row16 cx = unraw_b(fx[k % 5]), c0 = unraw_b(f0[k % 5]), c1 = unraw_b(f1[k % 5]);
                Row16 y;
#pragma unroll
                for (int j = 0; j < 4; ++j) y.v[j] = c0.v[j] * w0 + c1.v[j] * w1;
                const Row16 x2 = resid_add(cx, y, row_rstd(y), pfn, modl + (size_t)(row >> 12) * NMOD + 5 * DM, lane);
                st_f32_row(out + (size_t)row * DM, lane, x2);
            }
        }
#undef P13L_LOAD
    }
}

__global__ void __launch_bounds__(NWAVES * 64, 2) fwd_kernel(Args args) {
    LAS unsigned char* lds = (LAS unsigned char*)lds_raw;
    volatile LAS unsigned* MISC = (volatile LAS unsigned*)(lds + MISC_OFF);
    Geo geo; geo.G = gridDim.x; geo.bx = blockIdx.x; geo.vcu = (geo.G % 8 == 0) ? (geo.bx % 8) * (geo.G / 8) + geo.bx / 8 : geo.bx;
    for (int u = threadIdx.x; u < (LDS_BYTES - LDS_CTL_OFF) / 4; u += NWAVES * 64) ((LAS unsigned*)(lds + LDS_CTL_OFF))[u] = 0u;
    __syncthreads();
    if ((threadIdx.x & 63) == 0) *(LAS int*)(lds + WAVE_TAB_OFF + 4 * hw_wave_slot()) = (int)(threadIdx.x >> 6);
    __syncthreads();
    const int lo = args.ph_lo, hi = args.ph_hi;
    XcdBarrier bar; bar.bar = (unsigned*)(args.ws + WS_CTL) + CW_BAR; bar.x = 0; bar.st = nullptr;
    if (hi - lo > 1) bar = xcd_barrier_post((unsigned*)(args.ws + WS_CTL) + CW_BAR, MISC + 8);
#ifndef PHASE_MASK
#define PHASE_MASK 0x3fff
#endif
#define IN(k) (((PHASE_MASK >> ((k) % NPH)) & 1) && lo <= (k) && (k) < hi)
#define SEAM(k) do { if (IN((k) + 1)) xcd_barrier(bar); } while (0)
#ifndef REP_ID
#define REP_ID (-1)
#endif
#define REP(k, call) do { call; if (REP_ID >= 0 && REP_ID == (k)) { if (hi - lo > 1) xcd_barrier(bar); call; } } while (0)
#pragma unroll 1
    for (int layer = 0; layer < 2; ++layer) {
        const int P = layer * NPH; const bool last = (layer == 1);
        if (!last && IN(P + 0)) { asm volatile("; PHASE_BEGIN_0" ::: "memory"); REP(P + 0, phase_prologue(lds, geo)); SEAM(P + 0); }
        if (!last && IN(P + 1)) { asm volatile("; PHASE_BEGIN_1" ::: "memory"); phase_premix0(geo); SEAM(P + 1); }
        if (IN(P + 2)) { asm volatile("; PHASE_BEGIN_2" ::: "memory"); REP(P + 2, phase_proj(lds, geo, layer));
            SEAM(P + 2); }
        if (IN(P + 3)) { asm volatile("; PHASE_BEGIN_3" ::: "memory"); phase_qknorm(geo, layer); SEAM(P + 3); }
        if (IN(P + 4)) { asm volatile("; PHASE_BEGIN_4" ::: "memory");
#ifndef NO_ATTN
            REP(P + 4, phase_attn(lds_raw, geo, last, layer));
#endif
#ifndef NO_SCAN
            REP(P + 4 + 100, phase_scan(lds, geo, last));
#endif
            SEAM(P + 4); }
        if (IN(P + 5)) { asm volatile("; PHASE_BEGIN_5" ::: "memory"); phase_readout(geo, layer); SEAM(P + 5); }
        if (IN(P + 6)) { asm volatile("; PHASE_BEGIN_6" ::: "memory"); phase_merge_hg(lds, geo, layer); VM_WAIT(); __syncthreads(); }
        if (IN(P + 7)) { asm volatile("; PHASE_BEGIN_7" ::: "memory"); phase_merge_att(lds, geo, layer); SEAM(P + 7); }
        if (IN(P + 8)) { asm volatile("; PHASE_BEGIN_8" ::: "memory"); REP(P + 8, phase_wout(lds, geo, layer)); SEAM(P + 8); }
        if (IN(P + 9)) { asm volatile("; PHASE_BEGIN_9" ::: "memory");
#if defined(THIN_PROBE)
            if (!last && THIN_PROBE == 9) { phase_postmix0(geo, true); xcd_barrier(bar); }
#endif
            if (!last) phase_postmix0(geo); else phase_postmix1(lds, geo); SEAM(P + 9); }
        if (IN(P + 11)) { asm volatile("; PHASE_BEGIN_11" ::: "memory"); if (!last) REP(P + 11, phase_ffn_up0(lds, geo)); else REP(P + 11, phase_ffn_up1(lds, geo)); SEAM(P + 11); }
        if (IN(P + 12)) { asm volatile("; PHASE_BEGIN_12" ::: "memory"); if (!last) REP(P + 12, phase_ffn_down0(lds, geo)); else REP(P + 12, phase_ffn_down1(lds, geo)); SEAM(P + 12); }
        if (IN(P + 13)) { asm volatile("; PHASE_BEGIN_13" ::: "memory");
#if defined(THIN_PROBE)
            if (!last && THIN_PROBE == 13) { phase_postffn0(geo, true); xcd_barrier(bar); }
#endif
            if (!last) { phase_postffn0(geo); SEAM(P + 13); } else phase_postffn1(geo); }
    }
#undef IN
#undef SEAM
}

__global__ void dump_kernel(const bf16_t* src, int pitch, float* out) {
    for (size_t i = (size_t)blockIdx.x * 256 + threadIdx.x; i < (size_t)NLAT * DM; i += (size_t)gridDim.x * 256) { const size_t row = i >> 10, c = i & 1023; out[i] = bf_lo((unsigned)src[row * pitch + c]); }
}
extern "C" void kernel_launch(void* const* d_in, const int* in_sizes, int n_in, void* d_out, int out_size, void* d_ws, size_t ws_size, hipStream_t stream) {
    static int grid = 0;
    if (grid == 0) {
        if (n_in != 25 || in_sizes[0] != NLAT * DM || out_size != NLAT * DM || ws_size < WS_END + 31 * MiB) { fprintf(stderr, "kernel_launch: unexpected shapes (n_in %d, in0 %d, out %d, ws %zu < %zu)\n", n_in, n_in > 0 ? in_sizes[0] : -1, out_size, ws_size, (size_t)(WS_END + 31 * MiB)); grid = -1; return; }
        int dev = 0, cus = 0, per_cu = 0;
        if (hipGetDevice(&dev) != hipSuccess || hipDeviceGetAttribute(&cus, hipDeviceAttributeMultiprocessorCount, dev) != hipSuccess) { grid = -1; return; }
        if (hipFuncSetAttribute((const void*)fwd_kernel, hipFuncAttributeMaxDynamicSharedMemorySize, LDS_BYTES) != hipSuccess) { fprintf(stderr, "kernel_launch: hipFuncSetAttribute failed\n"); grid = -1; return; }
        if (hipOccupancyMaxActiveBlocksPerMultiprocessor(&per_cu, (const void*)fwd_kernel, NWAVES * 64, LDS_BYTES) != hipSuccess || per_cu < 1) fprintf(stderr, "kernel_launch: occupancy query reports %d\n", per_cu);
        (void)hipGetLastError();
        grid = cus;
    }
    if (grid < 0) return;
    if (hipMemsetAsync((char*)d_ws + WS_CTL, 0, CTL_ZERO_BYTES, stream) != hipSuccess) return;
    Args a{};
    for (int i = 0; i < 25; ++i) a.in[i] = (const float*)d_in[i];
    a.out = (float*)d_out; a.ws = (unsigned char*)d_ws;
#ifndef MK_ONE_LAUNCH
#define MK_ONE_LAUNCH 0
#endif
    if (MK_ONE_LAUNCH) {
        a.ph_lo = 0; a.ph_hi = NTOT;
        hipLaunchKernelGGL(fwd_kernel, dim3(grid), dim3(NWAVES * 64), LDS_BYTES, stream, a);
    } else {
#ifndef LAST_PHASE
#define LAST_PHASE (NTOT - 1)
#endif
        for (int ph = 0; ph <= LAST_PHASE; ++ph) {
            const int p = ph % NPH, l = ph / NPH;
            if ((l == 1 && (p == 0 || p == 1)) || (l == 0 && p == 10)) continue;
            a.ph_lo = ph; a.ph_hi = ph + 1;
            hipLaunchKernelGGL(fwd_kernel, dim3(grid), dim3(NWAVES * 64), LDS_BYTES, stream, a);
        }
    }
#ifdef DUMP_OFF
    hipLaunchKernelGGL(dump_kernel, dim3(1024), dim3(256), 0, stream, (const bf16_t*)((const unsigned char*)d_ws + (size_t)(DUMP_OFF)), (int)(DUMP_PITCH), (float*)d_out);
#endif
    const hipError_t le = hipPeekAtLastError();
    if (le != hipSuccess) fprintf(stderr, "kernel_launch: launch failed: %s\n", hipGetErrorName(le));
}
```

```cpp
#define MK_ONE_LAUNCH 1
#include <hip/hip_runtime.h>
#include <cstdio>
#include <cstdint>
#include <type_traits>

#define GAS __attribute__((address_space(1)))
#define LAS __attribute__((address_space(3)))
typedef unsigned short bf16_t;
typedef float f32x2 __attribute__((ext_vector_type(2)));
typedef unsigned u32x2 __attribute__((ext_vector_type(2)));
typedef GAS unsigned gu32;
#define RLX_AGENT __ATOMIC_RELAXED, __HIP_MEMORY_SCOPE_AGENT
#define LDS_WAIT() asm volatile("s_waitcnt lgkmcnt(0)" ::: "memory")
#define VM_WAIT() asm volatile("s_waitcnt vmcnt(0)" ::: "memory")

constexpr int DM = 1024, NB = 4, SEQ = 4096, CTXL = 256, NLAT = NB * SEQ, NCTX = NB * CTXL, R = NLAT + NCTX;
constexpr int PROJW = 8704, DFF = 2816, NEXP = 8, DFE = 3584, NMOD = 6 * DM;
constexpr int MOE_ROWS_MAX = (2 * NLAT / 256 + NEXP) * 256;
constexpr float NORM_EPS = 1e-6f;

extern __shared__ __attribute__((aligned(16))) unsigned char lds_raw[];
constexpr int LDS_CTL_OFF = 159744, WAVE_TAB_OFF = LDS_CTL_OFF + 1024;
__device__ __forceinline__ int hw_wave_slot() { return (int)__builtin_amdgcn_s_getreg((7 << 11) | 4) & 255; }
__device__ __forceinline__ int opaque_tid() {
    const int wv = *(const __attribute__((address_space(3))) int*)((__attribute__((address_space(3))) unsigned char*)lds_raw + WAVE_TAB_OFF + 4 * hw_wave_slot());
    int t = (wv << 6) | (int)__builtin_amdgcn_mbcnt_hi(~0u, __builtin_amdgcn_mbcnt_lo(~0u, 0u));
    asm volatile("" : "+v"(t)); return t; }
#ifndef PG8_ASM_STAGE
#define PG8_ASM_STAGE 1
#endif
namespace pg8 {
#define PG8_LAS __attribute__((address_space(3)))
typedef unsigned short bf16_t;
typedef short bf16x8 __attribute__((ext_vector_type(8)));
typedef float f32x4 __attribute__((ext_vector_type(4)));
typedef unsigned u32x4 __attribute__((ext_vector_type(4)));
constexpr int BM = 256, BK = 64, HALF = 128, HTB = HALF * BK * 2  , STAGE_BYTES = 8 * HTB, NXCD = 8, WGM = 8;

__host__ __device__ __forceinline__ int lds_byte(int r, int c) { const int st = (r >> 4) * 2 + (c >> 5), rr = r & 15, cc = c & 31, ob = rr * 64 + cc * 2; return st * 1024 + (ob ^ (((ob >> 9) & 1) << 5)); }
__host__ __device__ __forceinline__ void stage_rc(int b, int& R, int& C) { const int st = b / 1024, sb = b % 1024, swz = sb ^ (((sb >> 9) & 1) << 5); R = (st >> 1) * 16 + swz / 64; C = (st & 1) * 32 + (swz % 64) / 2; }
__host__ __device__ __forceinline__ int perm32(int rho) { const int n = rho >> 4, i = rho & 15; return 8 * (i >> 2) + 4 * n + (i & 3); }

struct Unit { int pm, pn, pb, pa; };
struct Gemm { const bf16_t* A; const bf16_t* Bt; int M, N, K; };

struct StaticOrder {
    int nM, nN, nwg, G, c, nfull;
    __host__ __device__ void init(int M, int N, int G_, int c_) { nM = M / BM; nN = N / BM; nwg = nM * nN; G = G_; c = c_; const int rem = nwg % G; nfull = (rem != 0 && rem * 4 <= G && nwg > G) ? nwg - rem : nwg; }
    __host__ __device__ void at(int L, Unit& u) const {
        int wgid = L; { const int q = nwg / NXCD, r = nwg % NXCD, xcd = wgid % NXCD, off = wgid / NXCD; wgid = (xcd < r ? xcd * (q + 1) : r * (q + 1) + (xcd - r) * q) + off; }
        const int nig = WGM * nN, gid = wgid / nig, fm = gid * WGM, gsz = (nM - fm) < WGM ? (nM - fm) : WGM;
        u.pm = fm + ((wgid % nig) % gsz); u.pn = (wgid % nig) / gsz; u.pb = u.pn; u.pa = u.pm;
    }
    __host__ __device__ bool next(int i, Unit& u) const { const long L = (long)i * G + c; if (L >= nfull) return false; at((int)L, u); return true; }
    __device__ __forceinline__ void a_ready(const Unit&) const {}
    __device__ __forceinline__ void done(const Unit&) const {}
};

template <class Epi, class Sched, bool ALIGN_EPI = false, bool SP2 = false, bool FP8 = false>
__device__ __forceinline__ void gemm_phase(PG8_LAS unsigned char* lds, const Gemm g, const Sched& S, const Epi& E) {
    const int tid = opaque_tid(), wid = __builtin_amdgcn_readfirstlane(tid >> 6), lane = tid & 63, wr = wid >> 2, wc = wid & 3, fr = lane & 15, fq = lane >> 4;
    const int K = g.K, RB = FP8 ? K : 2 * K  , nt = RB / (2 * BK);
    unsigned voffA[2], voffB[2];
#pragma unroll
    for (int i = 0; i < 2; ++i) { int R, C; stage_rc(tid * 16 + i * 8192, R, C); const int Rb = Epi::PERM ? ((R & ~31) + perm32(R & 31)) : R;
        voffA[i] = (unsigned)(R * RB + C * 2); voffB[i] = (unsigned)(Rb * RB + C * 2); }
    const size_t kstep = (size_t)(BK * 2);
    const size_t hstep = (size_t)HALF * RB;
    const size_t tstep = 2 * hstep;
    const unsigned ldsw = (unsigned)wid * 1024u;
    const int aoff = lds_byte(wr * 64 + fr, fq * 8), boff = lds_byte(wc * 32 + fr, fq * 8);
#define PG8_SA(b, h) (((b) * 2 + (h)) * HTB)
#define PG8_SB(b, h) ((4 + (b) * 2 + (h)) * HTB)
#define PG8_STAGE(bufoff, gbase, voff) do { _Pragma("unroll") for (int _i = 0; _i < 2; ++_i) { \
        if constexpr (FP8 || PG8_ASM_STAGE) { unsigned keep_; asm volatile("s_mov_b32 %0, m0\n\ts_mov_b32 m0, %3\n\ts_nop 0\n\tglobal_load_lds_dwordx4 %1, %2\n\ts_mov_b32 m0, %0" : "=&s"(keep_) : "v"((voff)[_i]), "s"((const char*)(gbase)), "s"((unsigned)(size_t)(lds + (bufoff) + ldsw + _i * 8192)) : "memory"); } \
        else __builtin_amdgcn_global_load_lds((const unsigned*)((const char*)(gbase) + (voff)[_i]), (PG8_LAS unsigned*)(lds + (bufoff) + ldsw + _i * 8192), 16, 0, 0); } } while (0)
#define PG8_LDA(dst, b, h) do { _Pragma("unroll") for (int m = 0; m < 4; ++m) { \
        if constexpr (FP8) { const v4i_t lo_ = *(const PG8_LAS v4i_t*)(lds + PG8_SA(b, h) + aoff + m * 2048), hi_ = *(const PG8_LAS v4i_t*)(lds + PG8_SA(b, h) + aoff + m * 2048 + 1024); dst[m] = __builtin_shufflevector(lo_, hi_, 0, 1, 2, 3, 4, 5, 6, 7); } \
        else { _Pragma("unroll") for (int k = 0; k < 2; ++k) dst[m].k[k] = *(const PG8_LAS bf16x8*)(lds + PG8_SA(b, h) + aoff + m * 2048 + k * 1024); } } } while (0)
#define PG8_LDB(dst, b, h) do { _Pragma("unroll") for (int n = 0; n < 2; ++n) { \
        if constexpr (FP8) { const v4i_t lo_ = *(const PG8_LAS v4i_t*)(lds + PG8_SB(b, h) + boff + n * 2048), hi_ = *(const PG8_LAS v4i_t*)(lds + PG8_SB(b, h) + boff + n * 2048 + 1024); dst[n] = __builtin_shufflevector(lo_, hi_, 0, 1, 2, 3, 4, 5, 6, 7); } \
        else { _Pragma("unroll") for (int k = 0; k < 2; ++k) dst[n].k[k] = *(const PG8_LAS bf16x8*)(lds + PG8_SB(b, h) + boff + n * 2048 + k * 1024); } } } while (0)
#define PG8_MMA(ai, bj, At, Bt) do { __builtin_amdgcn_s_setprio(1); \
        if constexpr (FP8) { _Pragma("unroll") for (int m = 0; m < 4; ++m) _Pragma("unroll") for (int n = 0; n < 2; ++n) \
            asm volatile("v_mfma_scale_f32_16x16x128_f8f6f4 %0, %1, %2, %0, %3, %3 op_sel_hi:[0,0,0]" : "+v"(acc[ai][bj][m][n]) : "v"(Bt[n]), "v"(At[m]), "v"(sclv)); } \
        else { _Pragma("unroll") for (int m = 0; m < 4; ++m) _Pragma("unroll") for (int n = 0; n < 2; ++n) _Pragma("unroll") for (int k = 0; k < 2; ++k) \
        acc[ai][bj][m][n] = __builtin_amdgcn_mfma_f32_16x16x32_bf16(Bt[n].k[k], At[m].k[k], acc[ai][bj][m][n], 0, 0, 0); } __builtin_amdgcn_s_setprio(0); } while (0)
#define PG8_WAIT_V(n) asm volatile("s_waitcnt vmcnt(" #n ")" ::: "memory")
#define PG8_WAIT_L(n) asm volatile("s_waitcnt lgkmcnt(" #n ")" ::: "memory")
#define PG8_BAR __builtin_amdgcn_s_barrier()
#define PG8_SCHED __builtin_amdgcn_sched_barrier(0)
    Unit cur, nxt; int ui = 0;
    if (!S.next(0, cur)) return;
    f32x4 acc[2][2][4][2];
#pragma unroll
    for (int a = 0; a < 2; ++a)
#pragma unroll
        for (int b = 0; b < 2; ++b)
#pragma unroll
            for (int m = 0; m < 4; ++m)
#pragma unroll
                for (int n = 0; n < 2; ++n) acc[a][b][m][n] = (f32x4){0.f, 0.f, 0.f, 0.f};
    struct Frag2 { bf16x8 k[2]; }; typedef int v8i_t __attribute__((ext_vector_type(8))); typedef int v4i_t __attribute__((ext_vector_type(4)));
    typename std::conditional<FP8, v8i_t, Frag2>::type At[4], B0[2], B1[2]; const int sclv = 0x7F7F7F7F; (void)sclv;
    const char* cA = (const char*)g.A + (size_t)cur.pa * tstep; const char* cB = (const char*)g.Bt + (size_t)cur.pb * tstep;
    S.a_ready(cur);
    if constexpr (SP2) {
        PG8_STAGE(PG8_SB(0, 0), cB, voffB); PG8_STAGE(PG8_SB(0, 1), cB + hstep, voffB); PG8_STAGE(PG8_SA(0, 0), cA, voffA); PG8_STAGE(PG8_SA(0, 1), cA + hstep, voffA);
        if (wr == 1) PG8_BAR;
        PG8_WAIT_V(2); PG8_BAR;
        PG8_STAGE(PG8_SB(1, 0), cB + kstep, voffB); PG8_STAGE(PG8_SA(1, 0), cA + kstep, voffA); PG8_STAGE(PG8_SB(1, 1), cB + hstep + kstep, voffB);
        PG8_WAIT_V(6); PG8_BAR;
    } else {
        PG8_STAGE(PG8_SB(0, 0), cB, voffB); PG8_STAGE(PG8_SA(0, 0), cA, voffA); PG8_STAGE(PG8_SB(0, 1), cB + hstep, voffB); PG8_STAGE(PG8_SA(0, 1), cA + hstep, voffA);
        if (wr == 1) PG8_BAR;
        PG8_WAIT_V(4); PG8_BAR;
        PG8_STAGE(PG8_SB(1, 0), cB + kstep, voffB); PG8_STAGE(PG8_SA(1, 0), cA + kstep, voffA); PG8_STAGE(PG8_SB(1, 1), cB + hstep + kstep, voffB);
        PG8_WAIT_V(6); PG8_BAR;
    }
    for (;;) {
        const bool has_next = S.next(ui + 1, nxt);
        const char* nA = has_next ? (const char*)g.A + (size_t)nxt.pa * tstep : cA; const char* nB = has_next ? (const char*)g.Bt + (size_t)nxt.pb * tstep : cB;
#pragma unroll 1
        for (int t = 0; t < nt; t += 2) {
            const bool last = (t == nt - 2);
            const char* a1 = cA + (size_t)(t + 1) * kstep;
            const char* a2 = last ? nA : cA + (size_t)(t + 2) * kstep; const char* b2 = last ? nB : cB + (size_t)(t + 2) * kstep;
            const char* a3 = a2 + kstep; const char* b3 = b2 + kstep;
            if (last && has_next) S.a_ready(nxt);
            if constexpr (SP2) {
            PG8_LDB(B0, 0, 0); PG8_LDB(B1, 0, 1); PG8_SCHED; PG8_LDA(At, 0, 0); PG8_STAGE(PG8_SA(1, 1), a1 + hstep, voffA);
            PG8_WAIT_V(8); PG8_WAIT_L(0); PG8_BAR; PG8_MMA(0, 0, At, B0); PG8_MMA(0, 1, At, B1); PG8_BAR; PG8_SCHED;
            PG8_LDA(At, 0, 1); PG8_STAGE(PG8_SB(0, 0), b2, voffB); PG8_STAGE(PG8_SB(0, 1), b2 + hstep, voffB); PG8_STAGE(PG8_SA(0, 0), a2, voffA);
            PG8_WAIT_V(8); PG8_WAIT_L(0); PG8_BAR; PG8_MMA(1, 0, At, B0); PG8_MMA(1, 1, At, B1); PG8_BAR; PG8_SCHED;
            PG8_LDB(B0, 1, 0); PG8_LDB(B1, 1, 1); PG8_SCHED; PG8_LDA(At, 1, 0); PG8_STAGE(PG8_SA(0, 1), a2 + hstep, voffA);
            PG8_WAIT_V(8); PG8_WAIT_L(0); PG8_BAR; PG8_MMA(0, 0, At, B0); PG8_MMA(0, 1, At, B1); PG8_BAR; PG8_SCHED;
            PG8_LDA(At, 1, 1); PG8_STAGE(PG8_SB(1, 0), b3, voffB); PG8_STAGE(PG8_SB(1, 1), b3 + hstep, voffB); PG8_STAGE(PG8_SA(1, 0), a3, voffA);
            PG8_WAIT_V(8); PG8_WAIT_L(0); PG8_BAR; PG8_MMA(1, 0, At, B0); PG8_MMA(1, 1, At, B1); PG8_BAR; PG8_SCHED;
            } else {
            PG8_LDB(B0, 0, 0); PG8_SCHED; PG8_LDA(At, 0, 0); PG8_STAGE(PG8_SA(1, 1), a1 + hstep, voffA);
            PG8_WAIT_L(8); PG8_BAR; PG8_WAIT_L(0); PG8_MMA(0, 0, At, B0); PG8_BAR; PG8_SCHED;
            PG8_LDB(B1, 0, 1); PG8_STAGE(PG8_SB(0, 0), b2, voffB);
            PG8_BAR; PG8_WAIT_L(0); PG8_MMA(0, 1, At, B1); PG8_BAR;
            PG8_LDA(At, 0, 1); PG8_STAGE(PG8_SA(0, 0), a2, voffA);
            PG8_BAR; PG8_WAIT_L(0); PG8_MMA(1, 0, At, B0); PG8_BAR; PG8_SCHED;
            PG8_STAGE(PG8_SB(0, 1), b2 + hstep, voffB);
            PG8_WAIT_V(6); PG8_BAR; PG8_MMA(1, 1, At, B1); PG8_BAR;
            PG8_LDB(B0, 1, 0); PG8_SCHED; PG8_LDA(At, 1, 0); PG8_STAGE(PG8_SA(0, 1), a2 + hstep, voffA);
            PG8_WAIT_L(8); PG8_BAR; PG8_WAIT_L(0); PG8_MMA(0, 0, At, B0); PG8_BAR; PG8_SCHED;
            PG8_LDB(B1, 1, 1); PG8_STAGE(PG8_SB(1, 0), b3, voffB);
            PG8_BAR; PG8_WAIT_L(0); PG8_MMA(0, 1, At, B1); PG8_BAR;
            PG8_LDA(At, 1, 1); PG8_STAGE(PG8_SA(1, 0), a3, voffA);
            PG8_BAR; PG8_WAIT_L(0); PG8_MMA(1, 0, At, B0); PG8_BAR; PG8_SCHED;
            PG8_STAGE(PG8_SB(1, 1), b3 + hstep, voffB);
            PG8_WAIT_V(6); PG8_BAR; PG8_MMA(1, 1, At, B1); PG8_BAR;
            }
        }
        if constexpr (ALIGN_EPI) { if (wr == 0) PG8_BAR; }
        if constexpr (FP8) asm volatile("s_nop 15\n\ts_nop 15" ::: "memory");
        if constexpr (!Epi::AFTER_DRAIN) { E(acc, cur, wr, wc, fr, fq); S.done(cur); }
        if (!has_next) break;
#pragma unroll
        for (int a = 0; a < 2; ++a)
#pragma unroll
            for (int b = 0; b < 2; ++b)
#pragma unroll
                for (int m = 0; m < 4; ++m)
#pragma unroll
                    for (int n = 0; n < 2; ++n) acc[a][b][m][n] = (f32x4){0.f, 0.f, 0.f, 0.f};
        cur = nxt; cA = nA; cB = nB; ++ui;
        if constexpr (ALIGN_EPI) { if (wr == 1) PG8_BAR; }
    }
    PG8_WAIT_V(0);
    if constexpr (!ALIGN_EPI) { if (wr == 0) PG8_BAR; }
    PG8_BAR;
    if constexpr (Epi::AFTER_DRAIN) { E.fused(acc, cur, wr, wc, fr, fq, lds, wid, lane); S.done(cur); }
#undef PG8_SA
#undef PG8_SB
#undef PG8_STAGE
#undef PG8_LDA
#undef PG8_LDB
#undef PG8_MMA
#undef PG8_WAIT_V
#undef PG8_WAIT_L
#undef PG8_BAR
#undef PG8_SCHED
}
}

using pg8::f32x4; using pg8::u32x4; using pg8::bf16x8; using pg8::Unit;
typedef __bf16 bf16x2_t __attribute__((ext_vector_type(2)));
__device__ __forceinline__ unsigned pk_bf16(float lo, float hi) { const f32x2 v = {lo, hi}; const bf16x2_t b = __builtin_convertvector(v, bf16x2_t); return __builtin_bit_cast(unsigned, b); }
__device__ __forceinline__ float bf_lo(unsigned u) { return __uint_as_float(u << 16); }
__device__ __forceinline__ float bf_hi(unsigned u) { return __uint_as_float(u & 0xffff0000u); }
typedef _Float16 h2_t __attribute__((ext_vector_type(2)));
__device__ __forceinline__ unsigned pk_f16(float lo, float hi) { h2_t h = {(_Float16)lo, (_Float16)hi}; return __builtin_bit_cast(unsigned, h); }
__device__ __forceinline__ f32x2 unpk_f16(unsigned u) { h2_t h = __builtin_bit_cast(h2_t, u); return (f32x2){(float)h.x, (float)h.y}; }
__device__ __forceinline__ float sigm(float x) { return __builtin_amdgcn_rcpf(1.f + __expf(-x)); }
__device__ __forceinline__ float silu_f(float x) { return x * sigm(x); }
__device__ __forceinline__ u32x4 pack8(const f32x4 a, const f32x4 b) { u32x4 w; w.x = pk_bf16(a[0], a[1]); w.y = pk_bf16(a[2], a[3]); w.z = pk_bf16(b[0], b[1]); w.w = pk_bf16(b[2], b[3]); return w; }
__device__ __forceinline__ void unpack8(const u32x4 w, f32x4& a, f32x4& b) { a = (f32x4){bf_lo(w.x), bf_hi(w.x), bf_lo(w.y), bf_hi(w.y)}; b = (f32x4){bf_lo(w.z), bf_hi(w.z), bf_lo(w.w), bf_hi(w.w)}; }

__device__ __forceinline__ void sigm8(const f32x4 a, const f32x4 b, f32x4& sa, f32x4& sb) {
    f32x4 ea, eb;
#pragma unroll
    for (int j = 0; j < 4; ++j) { ea[j] = __builtin_amdgcn_exp2f(a[j] * -1.4426950408889634f); eb[j] = __builtin_amdgcn_exp2f(b[j] * -1.4426950408889634f); }
#pragma unroll
    for (int j = 0; j < 4; ++j) { sa[j] = __builtin_amdgcn_rcpf(1.f + ea[j]); sb[j] = __builtin_amdgcn_rcpf(1.f + eb[j]); }
}
#ifndef EPI_NT
#define EPI_NT 0
#endif
#ifndef EPI_SC1
#define EPI_SC1 0
#endif
__device__ __forceinline__ void st16(void* p, u32x4 v) { if (EPI_SC1) *(volatile GAS u32x4*)p = v; else if (EPI_NT) __builtin_nontemporal_store(v, (u32x4*)p); else *(u32x4*)p = v; }
__device__ __forceinline__ void st8(void* p, u32x2 v) { if (EPI_SC1) *(volatile GAS u32x2*)p = v; else if (EPI_NT) __builtin_nontemporal_store(v, (u32x2*)p); else *(u32x2*)p = v; }
__device__ __forceinline__ float clamp448(float x) { return fminf(fmaxf(x, -448.f), 448.f); }
__device__ __forceinline__ unsigned pk4_fp8(float a, float b, float c, float d) { int w = 0; w = __builtin_amdgcn_cvt_pk_fp8_f32(clamp448(a), clamp448(b), w, false); w = __builtin_amdgcn_cvt_pk_fp8_f32(clamp448(c), clamp448(d), w, true); return (unsigned)w; }


struct EpiProj {
    static constexpr bool PERM = true, AFTER_DRAIN = false;
    bf16_t* proj; const float* lbv; int probe = 0;
    template <int MODE> __device__ __forceinline__ void emit(const f32x4 (&acc)[2][2][4][2], bf16_t* base, int ldc, const float* lbp) const {
        f32x4 lb[2][2];
        if (MODE == 3) {
#pragma unroll
            for (int bj = 0; bj < 2; ++bj)
#pragma unroll
                for (int n = 0; n < 2; ++n) lb[bj][n] = *(const f32x4*)(lbp + bj * 128 + 4 * n);
        }
#pragma unroll
        for (int ai = 0; ai < 2; ++ai)
#pragma unroll
            for (int m = 0; m < 4; ++m) { bf16_t* rowp = base + (size_t)(ai * 128 + m * 16) * ldc;
#pragma unroll
                for (int bj = 0; bj < 2; ++bj) { f32x4 v[2] = {acc[ai][bj][m][0], acc[ai][bj][m][1]}; u32x4 w;
                    if (MODE == 0) w = pack8(v[0], v[1]);
                    else { f32x4 s0, s1; sigm8(v[0], v[1], s0, s1);
                        if (MODE == 1) w = pack8(v[0] * s0, v[1] * s1);
                        else if (MODE == 2) w = pack8(s0, s1);
                        else { const f32x4 f0 = lb[bj][0] + (1.f - lb[bj][0]) * s0, f1 = lb[bj][1] + (1.f - lb[bj][1]) * s1; f32x4 g0, g1;
#pragma unroll
                            for (int j = 0; j < 4; ++j) { g0[j] = __builtin_amdgcn_logf(f0[j]); g1[j] = __builtin_amdgcn_logf(f1[j]); }
#pragma unroll
                            for (int j = 0; j < 4; ++j) { g0[j] = fmaxf(g0[j], -57.f); g1[j] = fmaxf(g1[j], -57.f); }
                            w.x = pk_f16(g0[0], g0[1]); w.y = pk_f16(g0[2], g0[3]); w.z = pk_f16(g1[0], g1[1]); w.w = pk_f16(g1[2], g1[3]); } }
                    st16(rowp + bj * 128, w); } }
    }
    __device__ __forceinline__ void operator()(const f32x4 (&acc)[2][2][4][2], const Unit& u, int wr, int wc, int fr, int fq) const {
        const int pn = u.pn; int seg, ct;
        if (pn < 4) { seg = 0; ct = pn; } else if (pn < 6) { seg = pn - 3; ct = 0; } else { seg = 3 + ((pn - 6) >> 2); ct = (pn - 6) & 3; }
        const size_t segoff = (seg == 0) ? (size_t)0 : (seg == 1) ? (size_t)R * 1024 : (seg == 2) ? (size_t)R * 1280 : (size_t)R * (size_t)(1536 + 1024 * (seg - 3));
        const int ldc = (seg == 1 || seg == 2) ? 256 : 1024;
        const int mode = (seg == 3 || seg == 7) ? 1 : (seg == 8 || seg == 9) ? 2 : (seg == 4 || seg == 5) ? 3 : 0;
        const int row0 = u.pm * 256 + wr * 64 + fr, col0 = ct * 256 + wc * 32 + 8 * fq;
        bf16_t* base = probe ? proj + (size_t)(wr * 64 + fr) * ldc + col0 : proj + segoff + (size_t)row0 * ldc + col0;
        if (mode == 0) emit<0>(acc, base, ldc, nullptr);
        else if (mode == 1) emit<1>(acc, base, ldc, nullptr);
        else if (mode == 2) emit<2>(acc, base, ldc, nullptr);
        else emit<3>(acc, base, ldc, lbv + col0);
    }
    __device__ __forceinline__ void put8(const Unit& u, int rt, int ctl, f32x4 v0, f32x4 v1) const {
        const int pn = u.pn; int seg, ct;
        if (pn < 4) { seg = 0; ct = pn; } else if (pn < 6) { seg = pn - 3; ct = 0; } else { seg = 3 + ((pn - 6) >> 2); ct = (pn - 6) & 3; }
        const size_t segoff = (seg == 0) ? (size_t)0 : (seg == 1) ? (size_t)R * 1024 : (seg == 2) ? (size_t)R * 1280 : (size_t)R * (size_t)(1536 + 1024 * (seg - 3));
        const int ldc = (seg == 1 || seg == 2) ? 256 : 1024;
        const int mode = (seg == 3 || seg == 7) ? 1 : (seg == 8 || seg == 9) ? 2 : (seg == 4 || seg == 5) ? 3 : 0;
        const int col = ct * 256 + ctl;
        u32x4 w;
        if (mode == 3) { const f32x4 l0 = *(const f32x4*)(lbv + col), l1 = *(const f32x4*)(lbv + col + 4); float g[8];
#pragma unroll
            for (int j = 0; j < 4; ++j) { g[j] = fmaxf(__builtin_amdgcn_logf(l0[j] + (1.f - l0[j]) * sigm(v0[j])), -57.f); g[4 + j] = fmaxf(__builtin_amdgcn_logf(l1[j] + (1.f - l1[j]) * sigm(v1[j])), -57.f); }
            w.x = pk_f16(g[0], g[1]); w.y = pk_f16(g[2], g[3]); w.z = pk_f16(g[4], g[5]); w.w = pk_f16(g[6], g[7]);
        } else {
#pragma unroll
            for (int j = 0; j < 4; ++j) { if (mode == 1) { v0[j] = silu_f(v0[j]); v1[j] = silu_f(v1[j]); } if (mode == 2) { v0[j] = sigm(v0[j]); v1[j] = sigm(v1[j]); } }
            w = pack8(v0, v1);
        }
        *(u32x4*)(proj + segoff + (size_t)(u.pm * 256 + rt) * ldc + col) = w;
    }
};
struct EpiSwiGLU {
    static constexpr bool PERM = true, AFTER_DRAIN = false;
    bf16_t* O; int ldc;
    __device__ __forceinline__ void operator()(const f32x4 (&acc)[2][2][4][2], const Unit& u, int wr, int wc, int fr, int fq) const {
        bf16_t* base = O + (size_t)(u.pm * 256 + wr * 64 + fr) * ldc + u.pn * 128 + wc * 32 + 8 * fq;
#pragma unroll
        for (int ai = 0; ai < 2; ++ai)
#pragma unroll
            for (int m = 0; m < 4; ++m) { f32x4 s0, s1; sigm8(acc[ai][0][m][0], acc[ai][0][m][1], s0, s1);
                st16(base + (size_t)(ai * 128 + m * 16) * ldc, pack8(acc[ai][0][m][0] * s0 * acc[ai][1][m][0], acc[ai][0][m][1] * s1 * acc[ai][1][m][1])); }
    }
    __device__ __forceinline__ void put8(const Unit&, int, int, f32x4, f32x4) const {}
};
struct EpiSwiGLU8 {
    static constexpr bool PERM = true, AFTER_DRAIN = false;
    unsigned char* O; int ldc;
    __device__ __forceinline__ void operator()(const f32x4 (&acc)[2][2][4][2], const Unit& u, int wr, int wc, int fr, int fq) const {
        unsigned char* base = O + (size_t)(u.pm * 256 + wr * 64 + fr) * ldc + u.pn * 128 + wc * 32 + 8 * fq;
#pragma unroll
        for (int ai = 0; ai < 2; ++ai)
#pragma unroll
            for (int m = 0; m < 4; ++m) { const f32x4 g0 = acc[ai][0][m][0] * 0.015625f, g1 = acc[ai][0][m][1] * 0.015625f; f32x4 s0, s1; sigm8(g0, g1, s0, s1);
                const f32x4 h0 = g0 * s0 * (acc[ai][1][m][0] * 0.015625f), h1 = g1 * s1 * (acc[ai][1][m][1] * 0.015625f);
                st8(base + (size_t)(ai * 128 + m * 16) * ldc, (u32x2){pk4_fp8(h0[0], h0[1], h0[2], h0[3]), pk4_fp8(h1[0], h1[1], h1[2], h1[3])}); }
    }
    __device__ __forceinline__ void put8(const Unit&, int, int, f32x4, f32x4) const {}
};
template <bool HAS_ADD> struct EpiGate {
    static constexpr bool PERM = true, AFTER_DRAIN = false;
    bf16_t* G; const bf16_t* ADD;
    __device__ __forceinline__ void operator()(const f32x4 (&acc)[2][2][4][2], const Unit& u, int wr, int wc, int fr, int fq) const {
        const size_t off0 = (size_t)(u.pm * 256 + wr * 64 + fr) * 1024 + u.pn * 256 + wc * 32 + 8 * fq;
#pragma unroll
        for (int ai = 0; ai < 2; ++ai) {
            u32x4 gv[4][2], av[4][2];
#pragma unroll
            for (int m = 0; m < 4; ++m)
#pragma unroll
                for (int bj = 0; bj < 2; ++bj) { const size_t off = off0 + (size_t)(ai * 128 + m * 16) * 1024 + bj * 128;
                    gv[m][bj] = *(const u32x4*)(G + off); if (HAS_ADD) av[m][bj] = *(const u32x4*)(ADD + off); }
#pragma unroll
            for (int m = 0; m < 4; ++m)
#pragma unroll
                for (int bj = 0; bj < 2; ++bj) { const size_t off = off0 + (size_t)(ai * 128 + m * 16) * 1024 + bj * 128;
                    f32x4 g0, g1; unpack8(gv[m][bj], g0, g1);
                    f32x4 o0 = g0 * acc[ai][bj][m][0], o1 = g1 * acc[ai][bj][m][1];
                    if (HAS_ADD) { f32x4 a0, a1; unpack8(av[m][bj], a0, a1); o0 += a0; o1 += a1; }
                    st16(G + off, pack8(o0, o1)); }
        }
    }
    __device__ __forceinline__ void put8(const Unit& u, int rt, int ctl, f32x4 v0, f32x4 v1) const {
        const size_t off = (size_t)(u.pm * 256 + rt) * 1024 + u.pn * 256 + ctl;
        f32x4 g0, g1; unpack8(*(const u32x4*)(G + off), g0, g1);
        f32x4 o0 = g0 * v0, o1 = g1 * v1;
        if (HAS_ADD) { f32x4 a0, a1; unpack8(*(const u32x4*)(ADD + off), a0, a1); o0 += a0; o1 += a1; }
        *(u32x4*)(G + off) = pack8(o0, o1);
    }
};
struct EpiPlain {
    static constexpr bool PERM = true, AFTER_DRAIN = false;
    bf16_t* O; int ldc; float scale = 1.f;
    __device__ __forceinline__ void operator()(const f32x4 (&acc)[2][2][4][2], const Unit& u, int wr, int wc, int fr, int fq) const {
        bf16_t* base = O + (size_t)(u.pm * 256 + wr * 64 + fr) * ldc + u.pn * 256 + wc * 32 + 8 * fq;
#pragma unroll
        for (int ai = 0; ai < 2; ++ai)
#pragma unroll
            for (int m = 0; m < 4; ++m)
#pragma unroll
                for (int bj = 0; bj < 2; ++bj) st16(base + (size_t)(ai * 128 + m * 16) * ldc + bj * 128, pack8(acc[ai][bj][m][0] * scale, acc[ai][bj][m][1] * scale));
    }
    __device__ __forceinline__ void put8(const Unit& u, int rt, int ctl, f32x4 v0, f32x4 v1) const {
        *(u32x4*)(O + (size_t)(u.pm * 256 + rt) * ldc + u.pn * 256 + ctl) = pack8(v0 * scale, v1 * scale);
    }
};
struct EpiNull {
    static constexpr bool PERM = true, AFTER_DRAIN = false;
    __device__ __forceinline__ void operator()(const f32x4 (&acc)[2][2][4][2], const Unit& u, int wr, int wc, int fr, int fq) const {
#pragma unroll
        for (int a = 0; a < 2; ++a)
#pragma unroll
            for (int b = 0; b < 2; ++b)
#pragma unroll
                for (int m = 0; m < 4; ++m) asm volatile("" :: "v"(acc[a][b][m][0]), "v"(acc[a][b][m][1])); }
    __device__ __forceinline__ void put8(const Unit&, int, int, f32x4, f32x4) const {}
};
struct MoeOrder {
    int nb[NEXP]; int nN, G, c, nwg, nfull, acap = 0;
    __device__ __forceinline__ void finish() { int t = 0;
#pragma unroll
        for (int e = 0; e < NEXP; ++e) t += nb[e] * nN;
        nwg = t; const int rem = t % G; nfull = (rem != 0 && rem * 4 <= G && t > G) ? t - rem : t; }
    __device__ __forceinline__ bool at(int L, Unit& u) const {
        int accu = 0, pbase = 0; bool found = false;
#pragma unroll
        for (int e = 0; e < NEXP; ++e) { const int ue = nb[e] * nN;
            if (!found && L < accu + ue) { const int loc = L - accu; const int q = loc / nb[e]; u.pn = q; u.pm = pbase + (loc - q * nb[e]); u.pb = e * nN + q; u.pa = acap ? e * acap + (loc - q * nb[e]) : u.pm; found = true; }
            accu += ue; pbase += nb[e]; }
        return found;
    }
    __device__ __forceinline__ bool next(int i, Unit& u) const { const int L = i * G + c; if (L >= nfull) return false; return at(L, u); }
    __device__ __forceinline__ void a_ready(const Unit&) const {}
    __device__ __forceinline__ void done(const Unit&) const {}
};

template <class Epi, class Sched>
__device__ __forceinline__ void gemm_mini(const pg8::Gemm g, const Sched& S, const Epi& E, int wgi, int nwgs) {
    const int nbig = S.nwg - S.nfull; if (nbig <= 0) return;
    const int tid = opaque_tid(), w = __builtin_amdgcn_readfirstlane(tid >> 6), lane = tid & 63, r = lane & 15, q4 = lane >> 4;
    const int wm = w >> 1, wn = w & 1; const int K = g.K;
    for (int m = wgi; m < nbig * 16; m += nwgs) {
        Unit u; S.at(S.nfull + (m >> 4), u); const int sub = m & 15, rt = (sub >> 2) * 64 + wm * 16 + r, ct = (sub & 3) * 64 + wn * 32;
        const bf16_t* ap = g.A + ((size_t)u.pm * 256 + rt) * K + 8 * q4;
        const bf16_t* bp0 = g.Bt + ((size_t)u.pb * 256 + ct + 8 * (r >> 2) + (r & 3)) * K + 8 * q4;
        const bf16_t* bp1 = bp0 + (size_t)4 * K;
        f32x4 c0 = (f32x4){0.f, 0.f, 0.f, 0.f}, c1 = (f32x4){0.f, 0.f, 0.f, 0.f};
        for (int ks = 0; ks < K / 32; ks += 8) {
            bf16x8 a[8], b0[8], b1[8];
#pragma unroll
            for (int i = 0; i < 8; ++i) { a[i] = *(const bf16x8*)(ap + 32 * (ks + i)); b0[i] = *(const bf16x8*)(bp0 + 32 * (ks + i)); b1[i] = *(const bf16x8*)(bp1 + 32 * (ks + i)); }
#pragma unroll
            for (int i = 0; i < 8; ++i) { c0 = __builtin_amdgcn_mfma_f32_16x16x32_bf16(b0[i], a[i], c0, 0, 0, 0); c1 = __builtin_amdgcn_mfma_f32_16x16x32_bf16(b1[i], a[i], c1, 0, 0, 0); }
        }
        E.put8(u, rt, ct + 8 * q4, c0, c1);
    }
}
template <class Epi, class Sched>
__device__ __forceinline__ void gemm_mini_ks(LAS unsigned char* lds, const pg8::Gemm g, const Sched& S, const Epi& E, int wgi, int nwgs) {
    const int nbig = S.nwg - S.nfull; if (nbig <= 0) return;
    constexpr int K = DM, PP = 68; static_assert(K / 32 == 32, "four K-steps per wave");
    const int tid = opaque_tid(), w = __builtin_amdgcn_readfirstlane(tid >> 6), lane = tid & 63, r = lane & 15, q4 = lane >> 4;
    LAS float* part = (LAS float*)lds + w * 64 * PP;
    __syncthreads();
    for (int m = wgi; m < nbig * 16; m += nwgs) {
        Unit u; S.at(S.nfull + (m >> 4), u); const int sub = m & 15, rt0 = (sub >> 2) * 64, ct0 = (sub & 3) * 64;
        const bf16_t* ap = g.A + ((size_t)u.pm * 256 + rt0) * K + (r * K + 8 * q4);
        const bf16_t* bp = g.Bt + ((size_t)u.pb * 256 + ct0) * K + (r * K + 8 * q4);
        f32x4 acc[4][4];
#pragma unroll
        for (int i = 0; i < 4; ++i)
#pragma unroll
            for (int j = 0; j < 4; ++j) acc[i][j] = (f32x4){0.f, 0.f, 0.f, 0.f};
        bf16x8 fa[2][4], fb[2][4];
#define MK_LOAD(s_, ks_) do { _Pragma("unroll") for (int t = 0; t < 4; ++t) { fa[s_][t] = *(const bf16x8*)(ap + (size_t)16 * t * K + 32 * (ks_)); fb[s_][t] = *(const bf16x8*)(bp + (size_t)16 * t * K + 32 * (ks_)); } } while (0)
#define MK_MMA(s_) do { _Pragma("unroll") for (int tm = 0; tm < 4; ++tm) _Pragma("unroll") for (int tn = 0; tn < 4; ++tn)                      \
            acc[tm][tn] = __builtin_amdgcn_mfma_f32_16x16x32_bf16(fb[s_][tn], fa[s_][tm], acc[tm][tn], 0, 0, 0); } while (0)
        MK_LOAD(0, w); MK_LOAD(1, w + 8);
        MK_MMA(0); MK_LOAD(0, w + 16);
        MK_MMA(1); MK_LOAD(1, w + 24);
        MK_MMA(0); MK_MMA(1);
#undef MK_LOAD
#undef MK_MMA
#pragma unroll
        for (int tm = 0; tm < 4; ++tm)
#pragma unroll
            for (int tn = 0; tn < 4; ++tn) *(LAS f32x4*)(part + (16 * tm + r) * PP + 16 * tn + 4 * q4) = acc[tm][tn];
        __syncthreads();
        { const int row = tid >> 3, cg = tid & 7; f32x4 v0 = (f32x4){0.f, 0.f, 0.f, 0.f}, v1 = v0;
#pragma unroll
          for (int ww = 0; ww < 8; ++ww) { const LAS float* p = (const LAS float*)lds + ww * 64 * PP + row * PP + 8 * cg; v0 += *(const LAS f32x4*)p; v1 += *(const LAS f32x4*)(p + 4); }
          E.put8(u, rt0 + row, ct0 + 8 * cg, v0, v1); }
        __syncthreads();
    }
}
template <int K, class Epi, class Sched>
__device__ __forceinline__ void gemm_mini8(LAS unsigned char* lds, const unsigned char* Ag, const unsigned char* Bg, const Sched& S, const Epi& E, int wgi, int nwgs) {
    const int nbig = S.nwg - S.nfull; if (nbig <= 0) return;
    typedef int v8i_t __attribute__((ext_vector_type(8))); typedef int v4i_t __attribute__((ext_vector_type(4)));
    const int tid = opaque_tid(), w = __builtin_amdgcn_readfirstlane(tid >> 6), lane = tid & 63, r = lane & 15, q4 = lane >> 4;
    const int sclv = 0x7F7F7F7F; constexpr int nks = K / 128; constexpr int PP = 68;
    LAS float* part = (LAS float*)lds + w * 64 * PP;
    __syncthreads();
    for (int m = wgi; m < nbig * 16; m += nwgs) {
        Unit u; S.at(S.nfull + (m >> 4), u); const int sub = m & 15, rt0 = (sub >> 2) * 64, ct0 = (sub & 3) * 64;
        const unsigned char* ap = Ag + ((size_t)u.pm * 256 + rt0) * K + (r * K + 32 * q4);
        const unsigned char* bp = Bg + ((size_t)u.pb * 256 + ct0) * K + (r * K + 32 * q4);
        f32x4 acc[4][4];
#pragma unroll
        for (int i = 0; i < 4; ++i)
#pragma unroll
            for (int j = 0; j < 4; ++j) acc[i][j] = (f32x4){0.f, 0.f, 0.f, 0.f};
        v8i_t fa[2][4], fb[4];
#define M8_LDA(s_, ks_) do { const size_t o = (size_t)128 * (ks_); _Pragma("unroll") for (int t = 0; t < 4; ++t) {                                    \
            const v4i_t al = *(const v4i_t*)(ap + (size_t)16 * t * K + o), ah = *(const v4i_t*)(ap + (size_t)16 * t * K + o + 16);                          \
            fa[s_][t] = __builtin_shufflevector(al, ah, 0, 1, 2, 3, 4, 5, 6, 7); } } while (0)
#define M8_LDB(ks_) do { const size_t o = (size_t)128 * (ks_); _Pragma("unroll") for (int t = 0; t < 4; ++t) {                                         \
            const v4i_t bl = *(const v4i_t*)(bp + (size_t)16 * t * K + o), bh = *(const v4i_t*)(bp + (size_t)16 * t * K + o + 16);                          \
            fb[t] = __builtin_shufflevector(bl, bh, 0, 1, 2, 3, 4, 5, 6, 7); } } while (0)
#define M8_MMA(s_) do { _Pragma("unroll") for (int tm = 0; tm < 4; ++tm) _Pragma("unroll") for (int tn = 0; tn < 4; ++tn)                                 \
            asm volatile("v_mfma_scale_f32_16x16x128_f8f6f4 %0, %1, %2, %0, %3, %3 op_sel_hi:[0,0,0]" : "+v"(acc[tm][tn]) : "v"(fb[tn]), "v"(fa[s_][tm]), "v"(sclv)); } while (0)
        const int k0 = w, k1 = w + 8, k2 = w + 16, k3 = (w + 24 < nks) ? w + 24 : w + 16;
        M8_LDA(0, k0); M8_LDB(k0); M8_LDA(1, k1);
        M8_MMA(0); M8_LDB(k1); M8_LDA(0, k2);
        M8_MMA(1); M8_LDB(k2); M8_LDA(1, k3);
        M8_MMA(0); M8_LDB(k3);
        if (w + 24 < nks) M8_MMA(1);
#undef M8_LDA
#undef M8_LDB
#undef M8_MMA
        asm volatile("s_nop 15\n\ts_nop 15" ::: "memory");
#pragma unroll
        for (int tm = 0; tm < 4; ++tm)
#pragma unroll
            for (int tn = 0; tn < 4; ++tn) *(LAS f32x4*)(part + (16 * tm + r) * PP + 16 * tn + 4 * q4) = acc[tm][tn];
        __syncthreads();
        { const int row = tid >> 3, cg = tid & 7; f32x4 v0 = (f32x4){0.f, 0.f, 0.f, 0.f}, v1 = v0;
#pragma unroll
          for (int ww = 0; ww < 8; ++ww) { const LAS float* p = (const LAS float*)lds + ww * 64 * PP + row * PP + 8 * cg; v0 += *(const LAS f32x4*)p; v1 += *(const LAS f32x4*)(p + 4); }
          E.put8(u, rt0 + row, ct0 + 8 * cg, v0, v1); }
        __syncthreads();
    }
}

namespace att {
using s16x4  = __attribute__((ext_vector_type(4))) short;
using f32x16 = __attribute__((ext_vector_type(16))) float;
constexpr int   D = 128, NW = 8, QBLK = 32, KVBLK = 64;
constexpr float SCALE = 0.088388347648318440f;
constexpr float THR = 8.f;
constexpr int SHM_V = KVBLK * D * 2, SHM_K = KVBLK * D * 2, SHM_ATTN = 2 * SHM_V + 2 * SHM_K + NW * 64 * 4;
#define KSWZ(row, colB) ((row) * 256 + ((colB) ^ (((row) & 15) << 4)))
#define SBAR() __builtin_amdgcn_sched_barrier(0)
__device__ __forceinline__ int crow(int r, int hi) { return (r & 3) + 8 * (r >> 2) + 4 * hi; }
__device__ __forceinline__ unsigned cvtpk(float lo, float hi) { unsigned r; asm volatile("v_cvt_pk_bf16_f32 %0, %1, %2" : "=v"(r) : "v"(lo), "v"(hi)); return r; }
template <int VAR> __device__ __forceinline__ void partialSM(f32x16& p0, f32x16& p1, float& m_reg, float& mn, float& alpha) {
  constexpr float C = SCALE * 1.4426950408889634f;
  if constexpr (VAR == 1) { mn = m_reg; alpha = 1.f; return; }
  float pmax = p0[0];
#pragma unroll
  for (int r = 1; r < 16; ++r) pmax = fmaxf(pmax, p0[r]);
#pragma unroll
  for (int r = 0; r < 16; ++r) pmax = fmaxf(pmax, p1[r]);
  { auto rr = __builtin_amdgcn_permlane32_swap(__float_as_uint(pmax), __float_as_uint(pmax), false, false);
    pmax = fmaxf(__uint_as_float(rr[0]), __uint_as_float(rr[1])); }
  if (__builtin_expect(__all(pmax - m_reg <= THR / SCALE), 1)) { mn = m_reg; alpha = 1.f; }
  else { mn = fmaxf(m_reg, pmax); alpha = __builtin_amdgcn_exp2f((m_reg - mn) * C); m_reg = mn; }
  float mnC = -mn * C;
#pragma unroll
  for (int r = 0; r < 16; ++r) p0[r] = fmaf(p0[r], C, mnC);
#pragma unroll
  for (int r = 0; r < 16; ++r) p1[r] = fmaf(p1[r], C, mnC);
#pragma unroll
  for (int r = 0; r < 16; ++r) p0[r] = __builtin_amdgcn_exp2f(p0[r]);
}
template <int VAR> __device__ __forceinline__ void finishSM(f32x16& p0, f32x16& p1, float alpha, float& l_reg, bf16x8& pa0, bf16x8& pa1, bf16x8& pa2, bf16x8& pa3) {
  float ps = 0;
  if constexpr (VAR != 1) {
#pragma unroll
  for (int r = 0; r < 16; ++r) p1[r] = __builtin_amdgcn_exp2f(p1[r]);
#pragma unroll
  for (int r = 0; r < 16; ++r) ps += p0[r];
#pragma unroll
  for (int r = 0; r < 16; ++r) ps += p1[r]; }
  { auto rr = __builtin_amdgcn_permlane32_swap(__float_as_uint(ps), __float_as_uint(ps), false, false);
    ps = __uint_as_float(rr[0]) + __uint_as_float(rr[1]); }
  l_reg = l_reg * alpha + ps;
#define PK4(P, BASE, OUT) do { unsigned a0 = cvtpk(P[BASE + 0], P[BASE + 1]), a1 = cvtpk(P[BASE + 2], P[BASE + 3]);   \
    unsigned b0 = cvtpk(P[BASE + 4], P[BASE + 5]), b1 = cvtpk(P[BASE + 6], P[BASE + 7]);                              \
    auto r0 = __builtin_amdgcn_permlane32_swap(a0, b0, false, false); auto r1 = __builtin_amdgcn_permlane32_swap(a1, b1, false, false); \
    u32x4 w = {r0[0], r1[0], r0[1], r1[1]}; OUT = *reinterpret_cast<bf16x8*>(&w); } while (0)
  PK4(p0, 0, pa0); PK4(p0, 8, pa1); PK4(p1, 0, pa2); PK4(p1, 8, pa3);
#undef PK4
}
template <int VAR> __device__ __forceinline__ void qkt(f32x16& p0, f32x16& p1, const bf16_t* Ks, const bf16x8* qr, int r32, int hi) {
  p0 = f32x16{}; p1 = f32x16{};
#pragma unroll
  for (int d0 = 0; d0 < 8; ++d0) { int cb = (d0 * 16 + hi * 8) * 2;
    bf16x8 b0, b1; if constexpr (VAR == 2) { b0 = qr[d0]; b1 = qr[7 - d0]; } else {
    b0 = *reinterpret_cast<const bf16x8*>((const char*)Ks + KSWZ(r32, cb));
    b1 = *reinterpret_cast<const bf16x8*>((const char*)Ks + KSWZ(32 + r32, cb)); }
    p0 = __builtin_amdgcn_mfma_f32_32x32x16_bf16(b0, qr[d0], p0, 0, 0, 0);
    p1 = __builtin_amdgcn_mfma_f32_32x32x16_bf16(b1, qr[d0], p1, 0, 0, 0); }
}
__device__ __forceinline__ int v_st(int k, int c) { const int kk = (k & ~0xC) | ((k & 4) << 1) | ((k & 8) >> 1); return ((kk >> 3) * 4 + (c >> 5)) * 512 + ((kk & 7) * 32 + (c & 31)) * 2; }
__device__ __forceinline__ int v_rd_base(int lane) { return ((lane & 3) << 3) | (((lane >> 2) & 3) << 6) | (((lane >> 4) & 1) << 5) | (((lane >> 5) & 1) << 8); }
constexpr int v_rd_off(int d0, int ks, int half) { return d0 * 512 + ks * 4096 + half * 2048; }
template <int OFF> __device__ __forceinline__ s16x4 tr_read(int vb) {
  s16x4 r; asm volatile("ds_read_b64_tr_b16 %0, %1 offset:%2" : "=&v"(r) : "v"(vb), "i"(OFF) : "memory"); return r;
}
template <int VAR, int D0> __device__ __forceinline__ void pv_one(f32x16& od, int vb, bf16x8 pa0, bf16x8 pa1, bf16x8 pa2, bf16x8 pa3) {
  if constexpr (VAR == 4) { od = __builtin_amdgcn_mfma_f32_32x32x16_bf16(pa0, pa1, od, 0, 0, 0); od = __builtin_amdgcn_mfma_f32_32x32x16_bf16(pa1, pa2, od, 0, 0, 0); od = __builtin_amdgcn_mfma_f32_32x32x16_bf16(pa2, pa3, od, 0, 0, 0); od = __builtin_amdgcn_mfma_f32_32x32x16_bf16(pa3, pa0, od, 0, 0, 0); return; }
  const s16x4 l0 = tr_read<v_rd_off(D0, 0, 0)>(vb), h0 = tr_read<v_rd_off(D0, 0, 1)>(vb), l1 = tr_read<v_rd_off(D0, 1, 0)>(vb), h1 = tr_read<v_rd_off(D0, 1, 1)>(vb);
  const s16x4 l2 = tr_read<v_rd_off(D0, 2, 0)>(vb), h2 = tr_read<v_rd_off(D0, 2, 1)>(vb), l3 = tr_read<v_rd_off(D0, 3, 0)>(vb), h3 = tr_read<v_rd_off(D0, 3, 1)>(vb);
  asm volatile("s_waitcnt lgkmcnt(0)" ::: "memory"); SBAR();
#define PK(L, H) (bf16x8){L[0], L[1], L[2], L[3], H[0], H[1], H[2], H[3]}
  od = __builtin_amdgcn_mfma_f32_32x32x16_bf16(pa0, PK(l0, h0), od, 0, 0, 0);
  od = __builtin_amdgcn_mfma_f32_32x32x16_bf16(pa1, PK(l1, h1), od, 0, 0, 0);
  od = __builtin_amdgcn_mfma_f32_32x32x16_bf16(pa2, PK(l2, h2), od, 0, 0, 0);
  od = __builtin_amdgcn_mfma_f32_32x32x16_bf16(pa3, PK(l3, h3), od, 0, 0, 0);
#undef PK
}
template <int VAR> __device__ __forceinline__ void pv_d0(f32x16* o, int vb, bf16x8 pa0, bf16x8 pa1, bf16x8 pa2, bf16x8 pa3) {
  pv_one<VAR, 0>(o[0], vb, pa0, pa1, pa2, pa3); pv_one<VAR, 1>(o[1], vb, pa0, pa1, pa2, pa3); pv_one<VAR, 2>(o[2], vb, pa0, pa1, pa2, pa3); pv_one<VAR, 3>(o[3], vb, pa0, pa1, pa2, pa3);
}
template <int LDQ, int LDK, int LDO, int VAR = 0>
__device__ __forceinline__ void attn_dense_body(const bf16_t* Qb, const bf16_t* __restrict__ Kh, const bf16_t* __restrict__ Vh,
                                                bf16_t* Ob, int seq, int nlat, int ctxoff, char* lds, const float* qgain, const float* cosT, const float* sinT, int t0, bool rope) {
  const int tid = opaque_tid(), wid = tid >> 6, lane = tid & 63, r32 = lane & 31, hi = lane >> 5;
  bf16_t* V_lds = (bf16_t*)lds; bf16_t* K_lds = (bf16_t*)(lds + 2 * SHM_V);
  float* ws = (float*)(lds + 2 * SHM_V + 2 * SHM_K) + wid * 64; float* li_l = ws; float* al_l = ws + 32;
  float m_reg = -1e30f, l_reg = 0; f32x16 o[4] = {}; bf16x8 qr[8];
  const bf16_t* Qw = Qb + (wid * QBLK + r32) * LDQ + hi * 8;
#pragma unroll 1
  for (int rep_ = 0; rep_ < (VAR == 8 ? 2 : 1); ++rep_) {
  asm volatile("" ::: "memory");
#pragma unroll
  for (int d0 = 0; d0 < 8; ++d0) qr[d0] = *reinterpret_cast<const bf16x8*>(Qw + d0 * 16);
  {
    float v[8][8]; float ss = 0.f;
#pragma unroll
    for (int d0 = 0; d0 < 8; ++d0) { const u32x4 w = *reinterpret_cast<const u32x4*>(&qr[d0]);
      v[d0][0] = bf_lo(w.x); v[d0][1] = bf_hi(w.x); v[d0][2] = bf_lo(w.y); v[d0][3] = bf_hi(w.y); v[d0][4] = bf_lo(w.z); v[d0][5] = bf_hi(w.z); v[d0][6] = bf_lo(w.w); v[d0][7] = bf_hi(w.w);
#pragma unroll
      for (int e = 0; e < 8; ++e) ss += v[d0][e] * v[d0][e]; }
    { auto rr = __builtin_amdgcn_permlane32_swap(__float_as_uint(ss), __float_as_uint(ss), false, false); ss = __uint_as_float(rr[0]) + __uint_as_float(rr[1]); }
    const float rstd = rsqrtf(ss * (1.f / 128.f) + 1e-6f);
#pragma unroll
    for (int d0 = 0; d0 < 8; ++d0) { const f32x4 g0 = *reinterpret_cast<const f32x4*>(qgain + d0 * 16 + hi * 8), g1 = *reinterpret_cast<const f32x4*>(qgain + d0 * 16 + hi * 8 + 4);
#pragma unroll
      for (int e = 0; e < 4; ++e) { v[d0][e] *= rstd * g0[e]; v[d0][4 + e] *= rstd * g1[e]; } }
    if (rope) { const float* cs = cosT + (size_t)(t0 + wid * QBLK + r32) * 64 + hi * 8; const float* sn = sinT + (size_t)(t0 + wid * QBLK + r32) * 64 + hi * 8;
#pragma unroll
      for (int d0 = 0; d0 < 4; ++d0) { const f32x4 c0 = *reinterpret_cast<const f32x4*>(cs + d0 * 16), c1 = *reinterpret_cast<const f32x4*>(cs + d0 * 16 + 4), s0 = *reinterpret_cast<const f32x4*>(sn + d0 * 16), s1 = *reinterpret_cast<const f32x4*>(sn + d0 * 16 + 4);
#pragma unroll
        for (int e = 0; e < 8; ++e) { const float c = e < 4 ? c0[e & 3] : c1[e & 3], sv = e < 4 ? s0[e & 3] : s1[e & 3]; const float lo = v[d0][e], hh = v[d0 + 4][e]; v[d0][e] = lo * c - hh * sv; v[d0 + 4][e] = hh * c + lo * sv; } } }
#pragma unroll
    for (int d0 = 0; d0 < 8; ++d0) { const u32x4 w = {cvtpk(v[d0][0], v[d0][1]), cvtpk(v[d0][2], v[d0][3]), cvtpk(v[d0][4], v[d0][5]), cvtpk(v[d0][6], v[d0][7])}; qr[d0] = *reinterpret_cast<const bf16x8*>(&w); }
  }
  }
  const int sr = tid >> 4, sc = (tid & 15) * 8, vst0 = v_st(sr, sc), vst1 = v_st(32 + sr, sc);
  const int vb0 = (int)(uintptr_t)V_lds + v_rd_base(lane);
  struct { bf16x8 vs0, vs1, ks0, ks1; } sr_[2];
#define KROW(k0) ((k0) + (((k0) >= nlat) ? ctxoff : 0))
#define SLOAD(i, k0) do { const int kr_ = KROW(k0); sr_[i].vs0 = *reinterpret_cast<const bf16x8*>(&Vh[(kr_ + sr) * LDK + sc]); sr_[i].vs1 = *reinterpret_cast<const bf16x8*>(&Vh[(kr_ + 32 + sr) * LDK + sc]); \
    sr_[i].ks0 = *reinterpret_cast<const bf16x8*>(&Kh[(kr_ + sr) * LDK + sc]); sr_[i].ks1 = *reinterpret_cast<const bf16x8*>(&Kh[(kr_ + 32 + sr) * LDK + sc]); } while (0)
#define SWRITE(b, i) do { *(bf16x8*)((char*)V_lds + (b) * SHM_V + vst0) = sr_[i].vs0;          \
    *(bf16x8*)((char*)V_lds + (b) * SHM_V + vst1) = sr_[i].vs1; int kc = sc * 2;               \
    *(bf16x8*)((char*)K_lds + (b) * SHM_K + KSWZ(sr, kc)) = sr_[i].ks0;                       \
    *(bf16x8*)((char*)K_lds + (b) * SHM_K + KSWZ(32 + sr, kc)) = sr_[i].ks1; } while (0)
#define SWAIT() asm volatile("s_waitcnt vmcnt(4)" ::: "memory")
#define RESC(a) do { if (__any((a) < 1.f)) { if (hi == 0) al_l[r32] = (a); asm volatile("s_waitcnt lgkmcnt(0)" ::: "memory"); \
    _Pragma("unroll") for (int d = 0; d < 4; ++d) _Pragma("unroll") for (int r = 0; r < 16; ++r) o[d][r] *= al_l[crow(r, hi)]; } } while (0)
#define ATT_SYNC() do { if (VAR != 3 && VAR != 5) __syncthreads(); } while (0)
  f32x16 pA0, pA1, pB0, pB1; float mnA, mnB, alA, alB; bf16x8 pa0, pa1, pa2, pa3; const int NT = seq / KVBLK;
  constexpr int SE = 0, SO = 1;
  SLOAD(SE, 0); asm volatile("s_waitcnt vmcnt(0)" ::: "memory"); SWRITE(0, SE); ATT_SYNC();
  qkt<VAR>(pA0, pA1, K_lds, qr, r32, hi); partialSM<VAR>(pA0, pA1, m_reg, mnA, alA);
  SLOAD(SO, KVBLK); if (2 < NT) SLOAD(SE, 2 * KVBLK);
  if (VAR != 3) { SWAIT(); SWRITE(1, SO); } ATT_SYNC();
  for (int j = 1; j + 1 < NT; j += 2) {
    SBAR(); qkt<VAR>(pB0, pB1, (bf16_t*)((char*)K_lds + SHM_K), qr, r32, hi);
    finishSM<VAR>(pA0, pA1, alA, l_reg, pa0, pa1, pa2, pa3); SBAR();
    if (VAR != 3 && VAR != 6) SLOAD(SO, (j + 2) * KVBLK); SBAR();
    pv_d0<VAR>(o, vb0, pa0, pa1, pa2, pa3); partialSM<VAR>(pB0, pB1, m_reg, mnB, alB);
    ATT_SYNC(); if (VAR != 3 && VAR != 6) { SWAIT(); SWRITE(0, SE); }
    RESC(alB); ATT_SYNC();
    SBAR(); qkt<VAR>(pA0, pA1, K_lds, qr, r32, hi);
    finishSM<VAR>(pB0, pB1, alB, l_reg, pa0, pa1, pa2, pa3); SBAR();
    if (VAR != 3 && VAR != 6 && j + 3 < NT) SLOAD(SE, (j + 3) * KVBLK); SBAR();
    pv_d0<VAR>(o, vb0 + (int)SHM_V, pa0, pa1, pa2, pa3); partialSM<VAR>(pA0, pA1, m_reg, mnA, alA);
    ATT_SYNC(); if (VAR != 3 && VAR != 6) { SWAIT(); SWRITE(1, SO); }
    RESC(alA); ATT_SYNC();
  }
  SBAR(); qkt<VAR>(pB0, pB1, (bf16_t*)((char*)K_lds + SHM_K), qr, r32, hi);
  finishSM<VAR>(pA0, pA1, alA, l_reg, pa0, pa1, pa2, pa3); SBAR();
  pv_d0<VAR>(o, vb0, pa0, pa1, pa2, pa3); partialSM<VAR>(pB0, pB1, m_reg, mnB, alB);
  ATT_SYNC(); RESC(alB);
  finishSM<VAR>(pB0, pB1, alB, l_reg, pa0, pa1, pa2, pa3); SBAR();
  pv_d0<VAR>(o, vb0 + (int)SHM_V, pa0, pa1, pa2, pa3);
#undef ATT_SYNC
  if (hi == 0) li_l[r32] = l_reg; asm volatile("s_waitcnt lgkmcnt(0)" ::: "memory");
  float rli[16];
#pragma unroll
  for (int r = 0; r < 16; ++r) rli[r] = __builtin_amdgcn_rcpf(li_l[crow(r, hi)]);
  bf16_t* Ow = Ob + (wid * QBLK) * LDO;
#pragma unroll
  for (int r = 0; r < 16; ++r) { int orow = crow(r, hi);
#pragma unroll
    for (int d0 = 0; d0 < 4; ++d0) { const __bf16 hb = (__bf16)(o[d0][r] * rli[r]); if constexpr (VAR == 7) { const bf16_t keep_ = __builtin_bit_cast(bf16_t, hb); asm volatile("" :: "v"(keep_)); } else Ow[orow * LDO + d0 * 32 + r32] = __builtin_bit_cast(bf16_t, hb); } }
  asm volatile("s_waitcnt vmcnt(0)" ::: "memory");
  __syncthreads();
#undef KROW
#undef SLOAD
#undef SWRITE
#undef SWAIT
#undef RESC
}
}

namespace scan {
#ifndef SCAN_XOR
#define SCAN_XOR 1
#endif
#if SCAN_XOR
constexpr int TS = 256, CS = 144;
#else
constexpr int TS = 272, CS = 144;
#endif
constexpr int I_QT = 0, I_KT = 64 * TS, IMGT = 2 * 64 * TS, I_KH = 0, I_VT = I_KH + 128 * CS, I_AV = I_VT + 32 * CS, IMGR = I_AV + 512;
constexpr int OFF_R = 2 * IMGT, OFF_ST = OFF_R + 2 * IMGR, LDS_SCAN = OFF_ST + 2 * 32 * TS;
static_assert(LDS_SCAN <= LDS_CTL_OFF, "scan LDS");
#define SCAN_BAR() do { asm volatile("s_waitcnt lgkmcnt(0) ; SCANBAR" ::: "memory"); __builtin_amdgcn_s_barrier(); asm volatile("; SCANBAR_END" ::: "memory"); } while (0)
__device__ __forceinline__ float ex2(float x) { return __builtin_amdgcn_exp2f(x); }
typedef unsigned u32x2l __attribute__((ext_vector_type(2)));

__device__ __forceinline__ void scan_unit(LAS unsigned char* lds, const bf16_t* HQ, const bf16_t* G, const bf16_t* HV, bf16_t* O, int b, int h, int bwd, int dvs, bool store_ctx) {
    const int tid = opaque_tid(), w = __builtin_amdgcn_readfirstlane(tid >> 6), lane = tid & 63, r = lane & 15, q4 = lane >> 4;
    const long sgn = bwd ? -1 : 1;
#define SCAN_RB(cc_) (((cc_) < 4) ? (bwd ? (long)(NLAT + b * CTXL + CTXL - 1 - 64 * (cc_)) : (long)(NLAT + b * CTXL + 64 * (cc_))) \
                                  : (bwd ? (long)(b * SEQ + SEQ - 1 - 64 * ((cc_) - 4)) : (long)(b * SEQ + 64 * ((cc_) - 4))))
    for (int i = tid; i < 32 * TS / 4; i += 512) ((LAS unsigned*)(lds + OFF_ST))[i] = 0u;
    if (w < 4) {
#ifndef SCAN_E_PRIO
#define SCAN_E_PRIO 0
#endif
        __builtin_amdgcn_s_setprio(SCAN_E_PRIO);
        const int cp = lane & 15, tg = lane >> 4, et = w * 64 + lane, vtok = et >> 2, vdg = et & 3;
        const size_t colq = (size_t)h * 128 + 32 * w + 2 * cp, colv = (size_t)h * 128 + dvs * 32 + 8 * vdg;
        unsigned graw0[16], qraw0[16], graw1[16], qraw1[16]; u32x4 vraw0, vraw1;
        int xw[16];
#pragma unroll
        for (int j = 0; j < 16; ++j) xw[j] = (16 * tg + j) * TS + (SCAN_XOR ? (((32 * w + 2 * cp) * 2) ^ (j << 4)) : ((32 * w + 2 * cp) * 2));
        const unsigned lo_ = (unsigned)((bwd ? 63 - 16 * tg : 16 * tg) * 2048) + (unsigned)colq * 2u;
        const unsigned lov_ = (unsigned)((bwd ? 63 - vtok : vtok) * 2048) + (unsigned)colv * 2u;
#define SCAN_LOAD(cc_, graw, qraw, vraw) do { const long rb_ = SCAN_RB(cc_); const long r0_ = bwd ? rb_ - 63 : rb_; \
        const GAS char* gB_ = (const GAS char*)G + (size_t)r0_ * 2048; const GAS char* qB_ = (const GAS char*)HQ + (size_t)r0_ * 2048; \
        _Pragma("unroll") for (int j = 0; j < 16; ++j) { const long dj_ = (long)(bwd ? -j : j) * 2048; const GAS char* gj_ = gB_ + dj_; const GAS char* qj_ = qB_ + dj_; asm volatile("" : "+s"(gj_), "+s"(qj_)); \
            graw[j] = *(const GAS unsigned*)(gj_ + lo_); qraw[j] = *(const GAS unsigned*)(qj_ + lo_); } \
        vraw = *(const GAS u32x4*)((const GAS char*)HV + (size_t)r0_ * 2048 + lov_); } while (0)
#define SCAN_IMAGE(cc, graw, qraw, vraw) do { \
        LAS unsigned char* imgT = lds + ((cc) & 1) * IMGT; LAS unsigned char* img = lds + OFF_R + ((cc) & 1) * IMGR; \
        f32x2 cs[16]; f32x2 run = {0.f, 0.f}; \
        _Pragma("unroll") for (int j = 0; j < 16; ++j) { run += unpk_f16(graw[j]); cs[j] = run; } \
          \
        f32x2 off, all; \
        { const auto s1x = __builtin_amdgcn_permlane16_swap(__float_as_uint(run.x), __float_as_uint(run.x), false, false), s1y = __builtin_amdgcn_permlane16_swap(__float_as_uint(run.y), __float_as_uint(run.y), false, false); \
          const f32x2 ev = {__uint_as_float(s1x[0]), __uint_as_float(s1y[0])}, od = {__uint_as_float(s1x[1]), __uint_as_float(s1y[1])}; const f32x2 pr = ev + od; \
          const auto s2x = __builtin_amdgcn_permlane32_swap(__float_as_uint(pr.x), __float_as_uint(pr.x), false, false), s2y = __builtin_amdgcn_permlane32_swap(__float_as_uint(pr.y), __float_as_uint(pr.y), false, false); \
          const f32x2 p01 = {__uint_as_float(s2x[0]), __uint_as_float(s2y[0])}, p23 = {__uint_as_float(s2x[1]), __uint_as_float(s2y[1])}; \
          all = p01 + p23; const f32x2 z2 = {0.f, 0.f}; off = ((tg & 1) ? ev : z2) + ((tg & 2) ? p01 : z2); } \
        f32x2 ekp; ekp.x = ex2(fminf(-off.x, 115.f)); ekp.y = ex2(fminf(-off.y, 115.f)); \
        const f32x2 eall = {ex2(all.x), ex2(all.y)}; \
        unsigned w_kh[2][8]; \
        _Pragma("unroll") for (int j = 0; j < 16; ++j) { \
            const f32x2 q = {bf_lo(qraw[j]), bf_hi(qraw[j])}; \
            const f32x2 c = cs[j] + off; \
            f32x2 eq, ek; eq.x = ex2(c.x); eq.y = ex2(c.y); ek.x = ex2(fminf(-c.x, 115.f)); ek.y = ex2(fminf(-c.y, 115.f)); \
            const f32x2 k = 1.f - eq * ekp;        \
            ekp = ek; \
            const f32x2 qt = q * eq, kt = k * ek, kh = kt * eall; \
            *(LAS unsigned*)(imgT + I_QT + xw[j]) = pk_bf16(qt.x, qt.y); *(LAS unsigned*)(imgT + I_KT + xw[j]) = pk_bf16(kt.x, kt.y); \
            if ((j & 1) == 0) { w_kh[0][j >> 1] = __float_as_uint(kh.x); w_kh[1][j >> 1] = __float_as_uint(kh.y); } \
            else { w_kh[0][j >> 1] = pk_bf16(__uint_as_float(w_kh[0][j >> 1]), kh.x); w_kh[1][j >> 1] = pk_bf16(__uint_as_float(w_kh[1][j >> 1]), kh.y); } \
        } \
        _Pragma("unroll") for (int c2 = 0; c2 < 2; ++c2) { LAS unsigned char* kp = img + I_KH + (32 * w + 2 * cp + c2) * CS + 32 * tg; \
            *(LAS u32x4*)kp = (u32x4){w_kh[c2][0], w_kh[c2][1], w_kh[c2][2], w_kh[c2][3]}; *(LAS u32x4*)(kp + 16) = (u32x4){w_kh[c2][4], w_kh[c2][5], w_kh[c2][6], w_kh[c2][7]}; } \
        if (tg == 0) *(LAS f32x2*)(img + I_AV + (32 * w + 2 * cp) * 4) = eall; \
        { LAS bf16_t* vt = (LAS bf16_t*)(img + I_VT) + vtok; const unsigned vv[4] = {vraw.x, vraw.y, vraw.z, vraw.w}; \
          _Pragma("unroll") for (int e = 0; e < 4; ++e) { vt[(8 * vdg + 2 * e) * (CS / 2)] = (bf16_t)(vv[e] & 0xffffu); vt[(8 * vdg + 2 * e + 1) * (CS / 2)] = (bf16_t)(vv[e] >> 16); } } \
    } while (0)
        SCAN_LOAD(0, graw0, qraw0, vraw0); SCAN_LOAD(1, graw1, qraw1, vraw1);
        SCAN_IMAGE(0, graw0, qraw0, vraw0); SCAN_LOAD(2, graw0, qraw0, vraw0);
        SCAN_BAR();
        for (int c2 = 0; c2 < 68; c2 += 2) {
            SCAN_IMAGE(c2 + 1, graw1, qraw1, vraw1); if (c2 + 3 < 68) SCAN_LOAD(c2 + 3, graw1, qraw1, vraw1);
            SCAN_BAR();
            if (c2 + 2 < 68) { SCAN_IMAGE(c2 + 2, graw0, qraw0, vraw0); if (c2 + 4 < 68) SCAN_LOAD(c2 + 4, graw0, qraw0, vraw0); }
            SCAN_BAR();
        }
#undef SCAN_LOAD
#undef SCAN_IMAGE
        __builtin_amdgcn_s_setprio(0);
    } else {
        const int it = w - 4;
        int xo[4];
#pragma unroll
        for (int ks = 0; ks < 4; ++ks) xo[ks] = SCAN_XOR ? (((4 * ks + q4) ^ r) << 4) : ((4 * ks + q4) << 4);
        f32x4 sacc[2][2];
#pragma unroll
        for (int a = 0; a < 2; ++a)
#pragma unroll
            for (int d2 = 0; d2 < 2; ++d2) sacc[a][d2] = (f32x4){0.f, 0.f, 0.f, 0.f};
        SCAN_BAR();
        for (int cc = 0; cc < 68; ++cc) {
            const LAS unsigned char* imgT = lds + (cc & 1) * IMGT; const LAS unsigned char* img = lds + OFF_R + (cc & 1) * IMGR; const int cur = cc & 1, nxt = cur ^ 1; const long rb = SCAN_RB(cc);
            bf16x8 qb[4];
#pragma unroll
            for (int ks = 0; ks < 4; ++ks) qb[ks] = *(const LAS bf16x8*)(imgT + I_QT + (16 * it + r) * TS + xo[ks]);
            f32x4 s4[4];
#pragma unroll
            for (int jt = 0; jt < 4; ++jt) { s4[jt] = (f32x4){0.f, 0.f, 0.f, 0.f};
                if (jt <= it) { bf16x8 ka[4];
#pragma unroll
                    for (int ks = 0; ks < 4; ++ks) ka[ks] = *(const LAS bf16x8*)(imgT + I_KT + (16 * jt + r) * TS + xo[ks]);
#pragma unroll
                    for (int ks = 0; ks < 4; ++ks) s4[jt] = __builtin_amdgcn_mfma_f32_16x16x32_bf16(ka[ks], qb[ks], s4[jt], 0, 0, 0);
                    if (jt == it) {
#pragma unroll
                        for (int e = 0; e < 4; ++e) if (4 * q4 + e > r) s4[jt][e] = 0.f;
                    } } }
            const u32x4 p01 = {pk_bf16(s4[0][0], s4[0][1]), pk_bf16(s4[0][2], s4[0][3]), pk_bf16(s4[1][0], s4[1][1]), pk_bf16(s4[1][2], s4[1][3])};
            const u32x4 p23 = {pk_bf16(s4[2][0], s4[2][1]), pk_bf16(s4[2][2], s4[2][3]), pk_bf16(s4[3][0], s4[3][1]), pk_bf16(s4[3][2], s4[3][3])};
#pragma unroll
            for (int dvt = 0; dvt < 2; ++dvt) {
                const LAS unsigned char* vrow = img + I_VT + (16 * dvt + r) * CS + 8 * q4;
                const u32x2l va0 = *(const LAS u32x2l*)(vrow), va1 = *(const LAS u32x2l*)(vrow + 32), va2 = *(const LAS u32x2l*)(vrow + 64), va3 = *(const LAS u32x2l*)(vrow + 96);
                bf16x8 sa[4];
#pragma unroll
                for (int ks = 0; ks < 4; ++ks) sa[ks] = *(const LAS bf16x8*)(lds + OFF_ST + cur * 32 * TS + (16 * dvt + r) * TS + xo[ks]);
                f32x4 o4 = (f32x4){0.f, 0.f, 0.f, 0.f}, o5 = (f32x4){0.f, 0.f, 0.f, 0.f};
                { const u32x4 a01 = {va0.x, va0.y, va1.x, va1.y}; o4 = __builtin_amdgcn_mfma_f32_16x16x32_bf16(__builtin_bit_cast(bf16x8, a01), __builtin_bit_cast(bf16x8, p01), o4, 0, 0, 0); }
                if (it >= 2) { const u32x4 a23 = {va2.x, va2.y, va3.x, va3.y}; o4 = __builtin_amdgcn_mfma_f32_16x16x32_bf16(__builtin_bit_cast(bf16x8, a23), __builtin_bit_cast(bf16x8, p23), o4, 0, 0, 0); }
                o5 = __builtin_amdgcn_mfma_f32_16x16x32_bf16(sa[0], qb[0], o5, 0, 0, 0); o5 = __builtin_amdgcn_mfma_f32_16x16x32_bf16(sa[1], qb[1], o5, 0, 0, 0);
                o4 = __builtin_amdgcn_mfma_f32_16x16x32_bf16(sa[2], qb[2], o4, 0, 0, 0); o5 = __builtin_amdgcn_mfma_f32_16x16x32_bf16(sa[3], qb[3], o5, 0, 0, 0);
                o4 += o5;
                if (store_ctx || cc >= 4) { const long row = rb + sgn * (16 * it + r);
                    *(u32x2*)(O + (size_t)row * 1024 + h * 128 + dvs * 32 + 16 * dvt + 4 * q4) = (u32x2){pk_bf16(o4[0], o4[1]), pk_bf16(o4[2], o4[3])}; }
            }
            {
                bf16x8 vb[2][2];
#pragma unroll
                for (int ks = 0; ks < 2; ++ks) { vb[0][ks] = *(const LAS bf16x8*)(img + I_VT + r * CS + (32 * ks + 8 * q4) * 2); vb[1][ks] = *(const LAS bf16x8*)(img + I_VT + (16 + r) * CS + (32 * ks + 8 * q4) * 2); }
#pragma unroll
                for (int a = 0; a < 2; ++a) { const int dt = 2 * it + a;
                    const f32x4 a4 = *(const LAS f32x4*)(img + I_AV + (16 * dt + 4 * q4) * 4);
                    const bf16x8 kh0 = *(const LAS bf16x8*)(img + I_KH + (16 * dt + r) * CS + (8 * q4) * 2), kh1 = *(const LAS bf16x8*)(img + I_KH + (16 * dt + r) * CS + (32 + 8 * q4) * 2);
#pragma unroll
                    for (int d2 = 0; d2 < 2; ++d2) { f32x4 s = sacc[a][d2] * a4;
                        s = __builtin_amdgcn_mfma_f32_16x16x32_bf16(kh0, vb[d2][0], s, 0, 0, 0); s = __builtin_amdgcn_mfma_f32_16x16x32_bf16(kh1, vb[d2][1], s, 0, 0, 0);
                        sacc[a][d2] = s;
                        *(LAS u32x2*)(lds + OFF_ST + nxt * 32 * TS + (16 * d2 + r) * TS + (SCAN_XOR ? ((((2 * dt + (q4 >> 1)) ^ r) << 4) | ((q4 & 1) << 3)) : ((16 * dt + 4 * q4) * 2))) = (u32x2){pk_bf16(s[0], s[1]), pk_bf16(s[2], s[3])}; } }
            }
            SCAN_BAR();
        }
    }
    VM_WAIT(); LDS_WAIT();
    __syncthreads();
#undef SCAN_RB
}
}

constexpr size_t MiB = 1u << 20;
constexpr size_t WS_CTL = 0, CTL_ZERO_BYTES = 64 * 1024;
constexpr int CW_TMO = 0, CW_BAR = 4096, CW_CNT = 8192;
constexpr size_t WS_MOD = 256 * 1024;
constexpr size_t WS_LBV = 512 * 1024;
constexpr size_t WS_WGB = 576 * 1024;
constexpr size_t WS_COS = 1 * MiB, WS_SIN = 2 * MiB;
constexpr size_t WS_ROUTE = 3 * MiB;
constexpr size_t WS_XCTX = 4 * MiB;
constexpr size_t WS_H = 8 * MiB;
constexpr size_t WS_W = 42 * MiB;
constexpr size_t WL_STRIDE = 23 * MiB, WL_IN = 0, WL_ATT = 17 * MiB, WL_HG = 19 * MiB, WL_OUT = 21 * MiB;
constexpr size_t WS_WGU = WS_W + 46 * MiB, WS_WD = WS_W + 57 * MiB;
constexpr size_t WS_OF = 105 * MiB, WS_OB = 139 * MiB;
constexpr size_t WS_PROJ = 173 * MiB;
constexpr int XB_CAP = 16384;
constexpr size_t WS_MGU = 462 * MiB, WS_MD = 518 * MiB, WS_YB = 105 * MiB, WS_HIDM = 173 * MiB, WS_XB = 292 * MiB, WS_END = 546 * MiB;
static_assert(WS_WD + (size_t)DM * DFF * 2 <= WS_OF && WS_OB + (size_t)R * DM * 2 <= WS_PROJ && WS_PROJ + (size_t)R * PROJW * 2 <= WS_MGU, "ws map");
static_assert(WS_MGU + (size_t)NEXP * 2 * DFE * DM <= WS_MD && WS_MD + (size_t)NEXP * DM * DFE <= WS_END && WS_YB + (size_t)MOE_ROWS_MAX * DM * 2 <= WS_HIDM && WS_HIDM + (size_t)MOE_ROWS_MAX * DFE <= WS_XB && WS_XB + (size_t)NEXP * XB_CAP * DM <= WS_MGU, "ws map (moe)");
constexpr size_t PQ = 0, PK = (size_t)R * 1024, PV = (size_t)R * 1280, PHQ = (size_t)R * 1536, PGF = (size_t)R * 2560, PGB = (size_t)R * 3584, PHV = (size_t)R * 4608, PHG = (size_t)R * 5632, PGA = (size_t)R * 6656, PGH = (size_t)R * 7680;

constexpr int RING_BYTES = 131072, MISC_OFF = LDS_CTL_OFF + 320, LDS_BYTES = 163840;
constexpr int NWAVES = 8;

#define XB_TMO      128
#define XB_XCNT(j)  (256  + 64 * (j))
#define XB_XSUB(j)  (1280 + 64 * (j))
#define XB_XGEN(j)  (2304 + 64 * (j))
#define XB_TOP      3328
#define XB_TOPGEN   3392
#define XCD_BAR_WORDS 3456
#define XB_SPIN_CAP (1u << 18)
__device__ __forceinline__ unsigned xb_ld(unsigned* p)              { return __hip_atomic_load(p, __ATOMIC_RELAXED, __HIP_MEMORY_SCOPE_AGENT); }
__device__ __forceinline__ unsigned xb_add(unsigned* p, unsigned v) { return __hip_atomic_fetch_add(p, v, __ATOMIC_RELAXED, __HIP_MEMORY_SCOPE_AGENT); }
__device__ __forceinline__ unsigned xb_xcc_id() { return (unsigned)__builtin_amdgcn_s_getreg((3 << 11) | 20) & 0xFu; }
#define XB_SPIN(cond, bar) do { unsigned _sp = 0; while (cond) { __builtin_amdgcn_s_sleep(1); \
    if ((++_sp & 255u) == 0u) { if (xb_ld(&(bar)[XB_TMO])) break; if (_sp > XB_SPIN_CAP) { atomicAdd(&(bar)[XB_TMO], 1u); break; } } } } while (0)
struct XcdBarrier { unsigned* bar; unsigned x; volatile LAS unsigned* st; };
__device__ __forceinline__ XcdBarrier xcd_barrier_post(unsigned* bar, volatile LAS unsigned* st) {
    XcdBarrier b; b.bar = bar; b.x = xb_xcc_id(); b.st = st;
    if (threadIdx.x == 0) (void)xb_add(&bar[XB_XCNT(b.x)], 1u);
    return b;
}
__device__ __forceinline__ void xcd_barrier_complete(unsigned* bar, unsigned x, unsigned& nloc, unsigned& nx) {
    const unsigned G = gridDim.x * gridDim.y * gridDim.z;
    unsigned sum, cnt, mine, sp = 0u;
    for (;;) {
        sum = 0u; cnt = 0u; mine = 0u;
#pragma unroll
        for (unsigned j = 0; j < 16; ++j) { const unsigned c = xb_ld(&bar[XB_XCNT(j)]); sum += c; cnt += (c > 0u) ? 1u : 0u; mine = (j == x) ? c : mine; }
        if (sum == G) break;
        __builtin_amdgcn_s_sleep(1);
        if ((++sp & 255u) == 0u) { if (xb_ld(&bar[XB_TMO])) break; if (sp > XB_SPIN_CAP) { atomicAdd(&bar[XB_TMO], 1u); break; } }
    }
    nloc = mine > 0u ? mine : 1u; nx = cnt > 0u ? cnt : 1u;
}
__device__ __forceinline__ void xcd_barrier(const XcdBarrier& b) {
    asm volatile("s_waitcnt vmcnt(0)" ::: "memory");
    __syncthreads();
    if (opaque_tid() == 0) {
        unsigned* bar = b.bar;
        __builtin_amdgcn_s_waitcnt(0);
        unsigned nloc = b.st[0], nx = b.st[1];
        if (nloc == 0u) { xcd_barrier_complete(bar, b.x, nloc, nx); b.st[0] = nloc; b.st[1] = nx; }
        const unsigned old = xb_add(&bar[XB_XSUB(b.x)], 1u);
        const unsigned gen = old / nloc;
        if (old + 1u == (gen + 1u) * nloc) {
            __builtin_amdgcn_fence(__ATOMIC_RELEASE, "agent");
            asm volatile("s_waitcnt vmcnt(0)" ::: "memory");
            const unsigned og = xb_add(&bar[XB_TOP], 1u);
            const unsigned tg = og / nx;
            if (og + 1u == (tg + 1u) * nx) xb_add(&bar[XB_TOPGEN], 1u);
            else XB_SPIN(xb_ld(&bar[XB_TOPGEN]) == tg, bar);
            __builtin_amdgcn_fence(__ATOMIC_ACQUIRE, "agent");
            xb_add(&bar[XB_XGEN(b.x)], 1u);
            asm volatile("s_waitcnt vmcnt(0)" ::: "memory");
        } else {
            XB_SPIN(xb_ld(&bar[XB_XGEN(b.x)]) == gen, bar);
            __builtin_amdgcn_fence(__ATOMIC_ACQUIRE, "agent");
            asm volatile("s_waitcnt vmcnt(0)" ::: "memory");
        }
    }
    __syncthreads();
}

template <int CTRL> __device__ __forceinline__ float dpp_f(float v) { return __uint_as_float((unsigned)__builtin_amdgcn_update_dpp(0, (int)__float_as_uint(v), CTRL, 0xF, 0xF, true)); }
__device__ __forceinline__ float dpp_xor4(float v) { int t = __builtin_amdgcn_update_dpp(0, (int)__float_as_uint(v), 0x104, 0xF, 0x5, false); t = __builtin_amdgcn_update_dpp(t, (int)__float_as_uint(v), 0x114, 0xF, 0xA, false); return __uint_as_float((unsigned)t); }
__device__ __forceinline__ float wave_sum(float v) {
    v += dpp_f<0xB1>(v); v += dpp_f<0x4E>(v); v += dpp_f<0x141>(v); v += dpp_f<0x140>(v);
    { const auto s = __builtin_amdgcn_permlane16_swap(__float_as_uint(v), __float_as_uint(v), false, false); v = __uint_as_float(s[0]) + __uint_as_float(s[1]); }
    { const auto s = __builtin_amdgcn_permlane32_swap(__float_as_uint(v), __float_as_uint(v), false, false); v = __uint_as_float(s[0]) + __uint_as_float(s[1]); }
    return v;
}
struct Row16 { f32x4 v[4]; };
__device__ __forceinline__ Row16 ld_f32_row(const float* p, int lane) { Row16 r;
#pragma unroll
    for (int j = 0; j < 4; ++j) r.v[j] = ((const f32x4*)p)[lane + 64 * j];
    return r; }
__device__ __forceinline__ void st_f32_row(float* p, int lane, const Row16& r) {
#pragma unroll
    for (int j = 0; j < 4; ++j) ((f32x4*)p)[lane + 64 * j] = r.v[j]; }
__device__ __forceinline__ Row16 ld_bf16_row(const bf16_t* p, int lane) { Row16 r;
#pragma unroll
    for (int j = 0; j < 4; ++j) { const u32x2 w = ((const u32x2*)p)[lane + 64 * j]; r.v[j] = (f32x4){bf_lo(w.x), bf_hi(w.x), bf_lo(w.y), bf_hi(w.y)}; }
    return r; }
#ifndef THIN_NT
#define THIN_NT 1
#endif
__device__ __forceinline__ void st_bf16_row_nt(bf16_t* p, int lane, const Row16& r) {
#pragma unroll
    for (int j = 0; j < 4; ++j) { const u32x2 w = (u32x2){pk_bf16(r.v[j][0], r.v[j][1]), pk_bf16(r.v[j][2], r.v[j][3])};
        if (THIN_NT) __builtin_nontemporal_store(w, (u32x2*)p + lane + 64 * j); else ((u32x2*)p)[lane + 64 * j] = w; } }
struct RawB { u32x2 v[4]; };
__device__ __forceinline__ RawB ld_raw_b(const bf16_t* p, int lane) { RawB r;
#pragma unroll
    for (int j = 0; j < 4; ++j) r.v[j] = ((const u32x2*)p)[lane + 64 * j];
    return r; }
#ifndef THIN_NTL
#define THIN_NTL 0
#endif
__device__ __forceinline__ RawB ld_raw_b_nt(const bf16_t* p, int lane) { RawB r;
#pragma unroll
    for (int j = 0; j < 4; ++j) r.v[j] = THIN_NTL ? __builtin_nontemporal_load((const u32x2*)p + lane + 64 * j) : ((const u32x2*)p)[lane + 64 * j];
    return r; }
__device__ __forceinline__ Row16 ld_f32_row_nt(const float* p, int lane) { Row16 r;
#pragma unroll
    for (int j = 0; j < 4; ++j) r.v[j] = THIN_NTL ? __builtin_nontemporal_load((const f32x4*)p + lane + 64 * j) : ((const f32x4*)p)[lane + 64 * j];
    return r; }
__device__ __forceinline__ Row16 unraw_b(const RawB& w) { Row16 r;
#pragma unroll
    for (int j = 0; j < 4; ++j) r.v[j] = (f32x4){bf_lo(w.v[j].x), bf_hi(w.v[j].x), bf_lo(w.v[j].y), bf_hi(w.v[j].y)};
    return r; }
__device__ __forceinline__ void st_bf16_row(bf16_t* p, int lane, const Row16& r) {
#pragma unroll
    for (int j = 0; j < 4; ++j) ((u32x2*)p)[lane + 64 * j] = (u32x2){pk_bf16(r.v[j][0], r.v[j][1]), pk_bf16(r.v[j][2], r.v[j][3])}; }
__device__ __forceinline__ float row_rstd(const Row16& r) { float s = 0.f;
#pragma unroll
    for (int j = 0; j < 4; ++j) s += (r.v[j][0] * r.v[j][0] + r.v[j][1] * r.v[j][1]) + (r.v[j][2] * r.v[j][2] + r.v[j][3] * r.v[j][3]);
    return rsqrtf(wave_sum(s) * (1.f / DM) + NORM_EPS); }
__device__ __forceinline__ Row16 norm_mod(const Row16& x, float rstd, const float* gain, const float* shift, const float* scale, int lane) { Row16 o;
#pragma unroll
    for (int j = 0; j < 4; ++j) { const f32x4 g = ((const f32x4*)gain)[lane + 64 * j], sh = ((const f32x4*)shift)[lane + 64 * j], sc = ((const f32x4*)scale)[lane + 64 * j];
        o.v[j] = (x.v[j] * rstd * g) * (sc + 1.f) + sh; }
    return o; }
__device__ __forceinline__ Row16 resid_add(const Row16& x, const Row16& y, float rstd, const float* gain, const float* gate, int lane) { Row16 o;
#pragma unroll
    for (int j = 0; j < 4; ++j) { const f32x4 g = ((const f32x4*)gain)[lane + 64 * j], gt = ((const f32x4*)gate)[lane + 64 * j];
        o.v[j] = x.v[j] + gt * (y.v[j] * rstd * g); }
    return o; }

__device__ __forceinline__ unsigned f2bf(float f) { unsigned u = __builtin_bit_cast(unsigned, f); return (u + 0x7fffu + ((u >> 16) & 1u)) >> 16; }
__device__ __forceinline__ unsigned pk2(float lo, float hi) { return f2bf(lo) | (f2bf(hi) << 16); }
struct TDesc { const float* W; unsigned char* WT; int K, N, il, item; };
__device__ __forceinline__ void t_load(const TDesc& d, float (&t_)[32], int lane) {
    const int nblk = d.N / 32, kb = d.item / nblk, nb = d.item - kb * nblk, k0 = 64 * kb, n0 = 32 * nb;
#pragma unroll
    for (int i = 0; i < 32; ++i) t_[i] = d.W[(size_t)(k0 + 2 * i + (lane >> 5)) * d.N + n0 + (lane & 31)];
}
template <bool FP8>
__device__ __forceinline__ void t_finish(const TDesc& d, const float (&t_)[32], LAS float* scr, int lane) {
    const int nblk = d.N / 32, kb = d.item / nblk, nb = d.item - kb * nblk, k0 = 64 * kb, n0 = 32 * nb;
    const int drow0 = d.il ? (256 * (n0 >> 7) + (n0 & 127) + (d.il == 2 ? 128 : 0)) : n0;
#pragma unroll
    for (int i = 0; i < 32; ++i) scr[(2 * i + (lane >> 5)) * 33 + (lane & 31)] = t_[i];
    LDS_WAIT(); asm volatile("" ::: "memory");
    const int c = lane & 7;
#pragma unroll
    for (int j = 0; j < 4; ++j) { const int n = (lane >> 3) + 8 * j; const LAS float* s = scr + (8 * c) * 33 + n;
        if constexpr (FP8) { u32x2 o; o.x = pk4_fp8(64.f * s[0 * 33], 64.f * s[1 * 33], 64.f * s[2 * 33], 64.f * s[3 * 33]); o.y = pk4_fp8(64.f * s[4 * 33], 64.f * s[5 * 33], 64.f * s[6 * 33], 64.f * s[7 * 33]);
            *(GAS u32x2*)(d.WT + (size_t)(drow0 + n) * d.K + k0 + 8 * c) = o; }
        else { u32x4 o; o.x = pk2(s[0 * 33], s[1 * 33]); o.y = pk2(s[2 * 33], s[3 * 33]); o.z = pk2(s[4 * 33], s[5 * 33]); o.w = pk2(s[6 * 33], s[7 * 33]);
            *(GAS u32x4*)((bf16_t*)d.WT + (size_t)(drow0 + n) * d.K + k0 + 8 * c) = o; } }
    LDS_WAIT(); asm volatile("" ::: "memory");
}
template <bool FP8, class Dec>
__device__ __forceinline__ void t_run(const Dec& dec, int first, int last, int stride, LAS float* scr, int lane) {
    int it = first; if (it >= last) return;
    TDesc dA, dB; float tA[32], tB[32]; dec(it, dA); t_load(dA, tA, lane);
    for (;;) {
        const int i1 = it + stride; const bool hasB = i1 < last; dec(hasB ? i1 : it, dB); t_load(dB, tB, lane);
        t_finish<FP8>(dA, tA, scr, lane);
        if (!hasB) break;
        const int i2 = i1 + stride; const bool hasA = i2 < last; dec(hasA ? i2 : i1, dA); t_load(dA, tA, lane);
        t_finish<FP8>(dB, tB, scr, lane);
        if (!hasA) break;
        it = i2;
    }
}
struct Args { const float* in[25]; float* out; unsigned char* ws; int ph_lo, ph_hi; };
constexpr int NPH = 14, NTOT = 2 * NPH;
typedef const __attribute__((address_space(4))) Args* KArgs;
__device__ __forceinline__ KArgs kargs() { auto p = __builtin_amdgcn_kernarg_segment_ptr(); asm volatile("" : "+s"(p)); return (KArgs)p; }
struct Geo { int G, bx, vcu; };
__device__ __forceinline__ Geo opaque_geo(Geo g) { asm volatile("" : "+s"(g.G), "+s"(g.bx), "+s"(g.vcu)); return g; }
enum { I_X = 0, I_C, I_CTX, I_CCTX, I_WMOD, I_BMOD, I_PREMIX, I_POSTMIX, I_PREFFN, I_POSTFFN, I_WIN, I_QN, I_KN, I_HGN, I_LBL, I_WATT, I_WHG, I_WOUT, I_FWG, I_FWU, I_FWD, I_ROUTER, I_MWG, I_MWU, I_MWD };

__device__ __forceinline__ void phase_prologue(LAS unsigned char* lds, const Geo geo_in) {
    const Geo geo = opaque_geo(geo_in);
    KArgs A = kargs(); unsigned char* ws = A->ws;
    const int tid = opaque_tid(), lane = tid & 63, wave = __builtin_amdgcn_readfirstlane(tid >> 6);
    const int G = geo.G, vcu = geo.vcu, gw = vcu * NWAVES + wave, NGW = G * NWAVES;
    LAS float* scr = (LAS float*)(lds + wave * 16384);
    constexpr int I_IN = 16 * (PROJW / 32), I_SQ = 16 * 32, I_GU = 16 * (DFF / 32), I_DN = (DFF / 64) * 32;
    constexpr int I_L = I_IN + 3 * I_SQ, NIT = 2 * I_L + 2 * I_GU + I_DN;
    const int ngv = (G > 96) ? 48 : 0;
    if (vcu >= ngv) {
        const auto dec = [&](int it, TDesc& d) { int r = it; d.il = 0;
            if (r < 2 * I_L) { const int l = r / I_L; r -= l * I_L; unsigned char* wl = ws + WS_W + l * WL_STRIDE; d.K = DM;
                if (r < I_IN) { d.W = A->in[I_WIN] + (size_t)l * DM * PROJW; d.N = PROJW; d.WT = wl + WL_IN; d.item = r; return; } r -= I_IN;
                d.N = DM; d.item = r & (I_SQ - 1); const int which = r / I_SQ;
                d.W = (which == 0 ? A->in[I_WATT] : which == 1 ? A->in[I_WHG] : A->in[I_WOUT]) + (size_t)l * DM * DM; d.WT = wl + (which == 0 ? WL_ATT : which == 1 ? WL_HG : WL_OUT); return; }
            r -= 2 * I_L;
            if (r < 2 * I_GU) { const int up = r >= I_GU; d.W = up ? A->in[I_FWU] : A->in[I_FWG]; d.K = DM; d.N = DFF; d.WT = ws + WS_WGU; d.il = 1 + up; d.item = r - up * I_GU; return; }
            d.W = A->in[I_FWD]; d.K = DFF; d.N = DM; d.WT = ws + WS_WD; d.item = r - 2 * I_GU; };
        t_run<false>(dec, (vcu - ngv) * NWAVES + wave, NIT, (G - ngv) * NWAVES, scr, lane);
    }
    {
        float* cosT = (float*)(ws + WS_COS); float* sinT = (float*)(ws + WS_SIN); float* lbv = (float*)(ws + WS_LBV); const float* lbl = A->in[I_LBL];
        for (int i = (vcu * 512 + tid); i < SEQ * 64; i += G * 512) { const int t = i >> 6, jj = i & 63; const int fi = jj & 31;
            const float inv = powf(10000.f, -(float)fi / 32.f); const float pos = (jj < 32) ? (float)(t >> 6) : (float)(t & 63); const float ang = pos * inv;
            cosT[i] = cosf(ang); sinT[i] = sinf(ang); }
        for (int i = (vcu * 512 + tid); i < 2 * DM; i += G * 512) { const int l = i >> 10, ch = i & 1023;
            lbv[i] = (l == 0) ? 0.f : 1.f / (1.f + expf(lbl[ch] - lbl[DM + ch])); }
    }
    __syncthreads();
    for (int it = vcu; it < 2 * 24; it += G) { const int l = it / 24, n0 = (it % 24) * 256;
        const float* c_in = A->in[I_C]; const float* cctx_in = A->in[I_CCTX]; float* modv = (float*)(ws + WS_MOD);
        LAS float* sv = (LAS float*)(lds + 65536) + wave * 5 * 128;
        const int k0 = wave * 128;
#pragma unroll
        for (int mi = 0; mi < 5; ++mi)
#pragma unroll
            for (int h2 = 0; h2 < 2; ++h2) { const int k = k0 + h2 * 64 + lane; const float cv = (mi < 4) ? c_in[mi * DM + k] : cctx_in[k]; sv[mi * 128 + h2 * 64 + lane] = cv / (1.f + expf(-cv)); }
        LDS_WAIT(); asm volatile("" ::: "memory");
        f32x4 a5[5];
#pragma unroll
        for (int mi = 0; mi < 5; ++mi) a5[mi] = (f32x4){0.f, 0.f, 0.f, 0.f};
        const float* wp = A->in[I_WMOD] + (size_t)l * DM * NMOD + (size_t)k0 * NMOD + n0 + 4 * lane;
        for (int kk0 = 0; kk0 < 128; kk0 += 16) { f32x4 wv[16];
#pragma unroll
            for (int j = 0; j < 16; ++j) wv[j] = *(const f32x4*)(wp + (size_t)(kk0 + j) * NMOD);
#pragma unroll
            for (int j = 0; j < 16; ++j)
#pragma unroll
                for (int mi = 0; mi < 5; ++mi) a5[mi] += wv[j] * sv[mi * 128 + kk0 + j]; }
        LAS float* red = (LAS float*)lds;
#pragma unroll
        for (int mi = 0; mi < 5; ++mi) *(LAS f32x4*)(red + (wave * 5 + mi) * 256 + 4 * lane) = a5[mi];
        __syncthreads();
        const float* b_mod = A->in[I_BMOD];
        for (int o = tid; o < 5 * 256; o += 512) { const int mi = o >> 8, cidx = o & 255; float s = b_mod[l * NMOD + n0 + cidx];
#pragma unroll
            for (int w8 = 0; w8 < 8; ++w8) s += red[(w8 * 5 + mi) * 256 + cidx];
            modv[((size_t)l * 5 + mi) * NMOD + n0 + cidx] = s; }
        __syncthreads();
    }
}

__device__ __forceinline__ void phase_premix0(const Geo geo_in) {
    const Geo geo = opaque_geo(geo_in);
    KArgs A = kargs(); unsigned char* ws = A->ws;
    const int tid = opaque_tid(), lane = tid & 63, wave = __builtin_amdgcn_readfirstlane(tid >> 6);
    const int gw = geo.vcu * NWAVES + wave, NGW = geo.G * NWAVES;
    const float* x_in = A->in[I_X]; const float* ctx_in = A->in[I_CTX]; const float* gain = A->in[I_PREMIX]; const float* modl = (const float*)(ws + WS_MOD);
    bf16_t* Hb = (bf16_t*)(ws + WS_H);
#define SRC_ROW(row_) (((row_) < NLAT) ? x_in + (size_t)(row_) * DM : ctx_in + (size_t)((row_) - NLAT) * DM)
#define P1_ROW(row_, cur_) do { const int rw_ = (row_); const float* md = modl + (size_t)((rw_ < NLAT) ? (rw_ >> 12) : 4) * NMOD;      \
        const Row16 h = norm_mod(cur_, row_rstd(cur_), gain, md + 0 * DM, md + 1 * DM, lane); st_bf16_row(Hb + (size_t)rw_ * DM, lane, h); } while (0)
    const int rc0 = NLAT + gw; Row16 cxc; if (rc0 < R) cxc = ld_f32_row(SRC_ROW(rc0), lane);
    for (int base = gw; base < NLAT; base += 8 * NGW) {
        Row16 rx[8];
#pragma unroll
        for (int k = 0; k < 8; ++k) rx[k] = ld_f32_row(SRC_ROW((base + k * NGW < NLAT) ? base + k * NGW : base), lane);
#pragma unroll
        for (int k = 0; k < 8; ++k) if (base + k * NGW < NLAT) P1_ROW(base + k * NGW, rx[k]);
    }
    if (rc0 < R) P1_ROW(rc0, cxc);
    for (int rc = rc0 + NGW; rc < R; rc += NGW) { const Row16 c2 = ld_f32_row(SRC_ROW(rc), lane); P1_ROW(rc, c2); }
#undef P1_ROW
#undef SRC_ROW
}

__device__ __forceinline__ void phase_proj(LAS unsigned char* lds, const Geo geo_in, int layer) {
    const Geo geo = opaque_geo(geo_in);
    KArgs A = kargs(); unsigned char* ws = A->ws;
    pg8::Gemm g{(const bf16_t*)(ws + WS_H), (const bf16_t*)(ws + WS_W + layer * WL_STRIDE + WL_IN), R, PROJW, DM}; pg8::StaticOrder S; S.init(R, PROJW, geo.G, geo.bx);
    EpiProj E{(bf16_t*)(ws + WS_PROJ), (const float*)(ws + WS_LBV) + layer * DM};
    pg8::gemm_phase<EpiProj, pg8::StaticOrder, true, true>(lds, g, S, E);
    gemm_mini_ks<EpiProj, pg8::StaticOrder>(lds, g, S, E, geo.vcu, geo.G);
}

__device__ __forceinline__ void phase_qknorm(const Geo geo_in, int layer) {
    const Geo geo = opaque_geo(geo_in);
    KArgs A = kargs(); unsigned char* ws = A->ws;
    const int tid = opaque_tid(), lane = tid & 63, wave = __builtin_amdgcn_readfirstlane(tid >> 6);
    const int gw = geo.vcu * NWAVES + wave, NGW = geo.G * NWAVES;
    const float* qn = A->in[I_QN] + layer * 128; const float* kn = A->in[I_KN] + layer * 128;
    const float* cosT = (const float*)(ws + WS_COS); const float* sinT = (const float*)(ws + WS_SIN); bf16_t* proj = (bf16_t*)(ws + WS_PROJ);
    const int nitems = R / 4;
    for (int it = gw; it < nitems; it += NGW) {
        const int row = it * 4 + (lane >> 4);
        const int lr = lane & 15;
        bf16_t* p = proj + PK + (size_t)row * 256 + 16 * lr;
        const float* gn = kn;
        const int j0 = (lr & 7) * 16;
        f32x4 v[4]; { f32x4 a, b2; unpack8(*(const u32x4*)p, a, b2); v[0] = a; v[1] = b2; unpack8(*(const u32x4*)(p + 8), a, b2); v[2] = a; v[3] = b2; }
        float ss = 0.f;
#pragma unroll
        for (int j = 0; j < 4; ++j) ss += (v[j][0] * v[j][0] + v[j][1] * v[j][1]) + (v[j][2] * v[j][2] + v[j][3] * v[j][3]);
        ss += dpp_f<0xB1>(ss); ss += dpp_f<0x4E>(ss); ss += dpp_f<0x141>(ss);
        const float rstd = rsqrtf(ss * (1.f / 128.f) + NORM_EPS);
#pragma unroll
        for (int j = 0; j < 4; ++j) v[j] = v[j] * rstd * *(const f32x4*)(gn + j0 + 4 * j);
        if (row < NLAT) {
            const int t = row & (SEQ - 1); const int jj0 = (lr & 3) * 16; const bool upper = (lr & 4) != 0;
#pragma unroll
            for (int j = 0; j < 4; ++j) { f32x4 pv;
#pragma unroll
                for (int e = 0; e < 4; ++e) pv[e] = dpp_xor4(v[j][e]);
                const f32x4 cs = *(const f32x4*)(cosT + (size_t)t * 64 + jj0 + 4 * j), sn = *(const f32x4*)(sinT + (size_t)t * 64 + jj0 + 4 * j);
                v[j] = upper ? (v[j] * cs + pv * sn) : (v[j] * cs - pv * sn); }
        }
        *(u32x4*)p = pack8(v[0], v[1]); *(u32x4*)(p + 8) = pack8(v[2], v[3]);
    }
}

__device__ __forceinline__ void phase_attn(unsigned char* lds_raw, const Geo geo_in, bool last, int layer) {
    const Geo geo = opaque_geo(geo_in);
    KArgs A = kargs(); unsigned char* ws = A->ws;
    bf16_t* Qp = (bf16_t*)(ws + WS_PROJ) + PQ; const bf16_t* Kp = (const bf16_t*)(ws + WS_PROJ) + PK; const bf16_t* Vp = (const bf16_t*)(ws + WS_PROJ) + PV;
    const float* qn = A->in[I_QN] + layer * 128;
    const int nun = last ? 512 : 544;
#ifndef ATT_UMAP
#define ATT_UMAP 0
#endif
#ifdef ATT_PROBE
    for (int u = (ATT_UMAP ? geo.bx : geo.vcu); u < nun; u += geo.G) {
        int qrow, krow, h, seq, nlat, ctxoff;
        if (u < 512) { const int grp = u >> 6, b = grp >> 1, kvh = grp & 1, gq = (u >> 4) & 3, qb = u & 15; h = kvh * 4 + gq;
            qrow = b * SEQ + qb * 256; krow = b * SEQ; seq = SEQ + CTXL; nlat = SEQ; ctxoff = (NLAT + b * CTXL) - (b * SEQ) - SEQ; }
        else { const int b = (u - 512) >> 3; h = (u - 512) & 7; qrow = NLAT + b * CTXL; krow = qrow; seq = CTXL; nlat = 1 << 30; ctxoff = 0; }
        bf16_t* Qb = Qp + (size_t)qrow * 1024 + h * 128; bf16_t* Os = (bf16_t*)(ws + WS_OF) + (size_t)qrow * 1024 + h * 128;
        const bf16_t* Kh = Kp + (size_t)krow * 256 + (h >> 2) * 128; const bf16_t* Vh = Vp + (size_t)krow * 256 + (h >> 2) * 128;
        att::attn_dense_body<1024, 256, 1024, ATT_PROBE>(Qb, Kh, Vh, Os, seq, nlat, ctxoff, (char*)lds_raw, qn, (const float*)(ws + WS_COS), (const float*)(ws + WS_SIN), qrow & (SEQ - 1), u < 512);
    }
#endif
    for (int u = (ATT_UMAP ? geo.bx : geo.vcu); u < nun; u += geo.G) {
        int qrow, krow, h, seq, nlat, ctxoff;
        if (u < 512) { const int grp = u >> 6, b = grp >> 1, kvh = grp & 1, gq = (u >> 4) & 3, qb = u & 15; h = kvh * 4 + gq;
            qrow = b * SEQ + qb * 256; krow = b * SEQ; seq = SEQ + CTXL; nlat = SEQ; ctxoff = (NLAT + b * CTXL) - (b * SEQ) - SEQ; }
        else { const int b = (u - 512) >> 3; h = (u - 512) & 7; qrow = NLAT + b * CTXL; krow = qrow; seq = CTXL; nlat = 1 << 30; ctxoff = 0; }
        bf16_t* Qb = Qp + (size_t)qrow * 1024 + h * 128;
        const bf16_t* Kh = Kp + (size_t)krow * 256 + (h >> 2) * 128; const bf16_t* Vh = Vp + (size_t)krow * 256 + (h >> 2) * 128;
        att::attn_dense_body<1024, 256, 1024>(Qb, Kh, Vh, Qb, seq, nlat, ctxoff, (char*)lds_raw, qn, (const float*)(ws + WS_COS), (const float*)(ws + WS_SIN), qrow & (SEQ - 1), u < 512);
    }
}
__device__ __forceinline__ void phase_scan(LAS unsigned char* lds, const Geo geo_in, bool last) {
    const Geo geo = opaque_geo(geo_in);
    KArgs A = kargs(); unsigned char* ws = A->ws;
    bf16_t* proj = (bf16_t*)(ws + WS_PROJ);
    for (int u = geo.vcu; u < 256; u += geo.G) {
        const int dvs = u & 3, bwd = (u >> 2) & 1, h = (u >> 3) & 7, b = u >> 6;
        scan::scan_unit(lds, proj + PHQ, bwd ? proj + PGB : proj + PGF, proj + PHV, bwd ? (bf16_t*)(ws + WS_OB) : (bf16_t*)(ws + WS_OF), b, h, bwd, dvs, !last);
    }
}

__device__ __forceinline__ void phase_readout(const Geo geo_in, int layer) {
    const Geo geo = opaque_geo(geo_in);
    KArgs A = kargs(); unsigned char* ws = A->ws;
    const int tid = opaque_tid(), lane = tid & 63, wave = __builtin_amdgcn_readfirstlane(tid >> 6);
    const int gw = geo.vcu * NWAVES + wave, NGW = geo.G * NWAVES;
    const float* hn = A->in[I_HGN] + layer * 128; const int nrows = (layer == 1) ? NLAT : R;
    const bf16_t* OFb = (const bf16_t*)(ws + WS_OF); const bf16_t* OBb = (const bf16_t*)(ws + WS_OB); bf16_t* HG = (bf16_t*)(ws + WS_PROJ) + PHG;
    const int j0 = (lane & 7) * 16;
    struct Raw { u32x4 f0, f1, b0, b1, g0, g1; };
#define RD_LOAD(dst, row_) do { const size_t off_ = (size_t)(row_) * 1024 + 16 * lane; dst.f0 = *(const u32x4*)(OFb + off_); dst.f1 = *(const u32x4*)(OFb + off_ + 8); \
        dst.b0 = *(const u32x4*)(OBb + off_); dst.b1 = *(const u32x4*)(OBb + off_ + 8); dst.g0 = *(const u32x4*)(HG + off_); dst.g1 = *(const u32x4*)(HG + off_ + 8); } while (0)
#define RD_ROW(row_, cur) do { const size_t off = (size_t)(row_) * 1024 + 16 * lane;                                                                   \
        f32x4 a[4], b4[4], g4[4];                                                                                                                  \
        unpack8(cur.f0, a[0], a[1]); unpack8(cur.f1, a[2], a[3]); unpack8(cur.b0, b4[0], b4[1]); unpack8(cur.b1, b4[2], b4[3]); unpack8(cur.g0, g4[0], g4[1]); unpack8(cur.g1, g4[2], g4[3]); \
        float ss = 0.f;                                                                                                                            \
        _Pragma("unroll") for (int j = 0; j < 4; ++j) { a[j] += b4[j]; ss += (a[j][0] * a[j][0] + a[j][1] * a[j][1]) + (a[j][2] * a[j][2] + a[j][3] * a[j][3]); } \
        ss += dpp_f<0xB1>(ss); ss += dpp_f<0x4E>(ss); ss += dpp_f<0x141>(ss);                                                                          \
        const float rstd = rsqrtf(ss * (1.f / 128.f) + NORM_EPS);                                                                                  \
        _Pragma("unroll") for (int j = 0; j < 4; ++j) a[j] = a[j] * rstd * *(const f32x4*)(hn + j0 + 4 * j) * g4[j];                                 \
        *(u32x4*)(HG + off) = pack8(a[0], a[1]); *(u32x4*)(HG + off + 8) = pack8(a[2], a[3]); } while (0)
    const int rc0 = NLAT + gw; Raw rcc; if (rc0 < nrows) RD_LOAD(rcc, rc0);
    for (int base = gw; base < NLAT; base += 8 * NGW) {
        Raw sl[6];
#define RD_LD(k_) RD_LOAD(sl[(k_) % 6], ((base + (k_) * NGW < NLAT) ? base + (k_) * NGW : base))
#pragma unroll
        for (int k = 0; k < 5; ++k) RD_LD(k);
#pragma unroll
        for (int k = 0; k < 8; ++k) {
            if (k + 5 < 8) RD_LD(k + 5);
            if (base + k * NGW < NLAT) RD_ROW(base + k * NGW, sl[k % 6]);
        }
#undef RD_LD
    }
    if (rc0 < nrows) RD_ROW(rc0, rcc);
    for (int rc = rc0 + NGW; rc < nrows; rc += NGW) { Raw r2; RD_LOAD(r2, rc); RD_ROW(rc, r2); }
#undef RD_ROW
#undef RD_LOAD
}

__device__ __forceinline__ void phase_merge_hg(LAS unsigned char* lds, const Geo geo_in, int layer) {
    const Geo geo = opaque_geo(geo_in);
    KArgs A = kargs(); unsigned char* ws = A->ws; const int M = (layer == 1) ? NLAT : R; bf16_t* proj = (bf16_t*)(ws + WS_PROJ);
    pg8::Gemm g{proj + PHG, (const bf16_t*)(ws + WS_W + layer * WL_STRIDE + WL_HG), M, DM, DM}; pg8::StaticOrder S; S.init(M, DM, geo.G, geo.bx);
    EpiGate<false> E{proj + PGH, nullptr};
    pg8::gemm_phase<EpiGate<false>, pg8::StaticOrder, true, true>(lds, g, S, E);
    gemm_mini_ks<EpiGate<false>, pg8::StaticOrder>(lds, g, S, E, geo.vcu, geo.G);
}
__device__ __forceinline__ void phase_merge_att(LAS unsigned char* lds, const Geo geo_in, int layer) {
    const Geo geo = opaque_geo(geo_in);
    KArgs A = kargs(); unsigned char* ws = A->ws; const int M = (layer == 1) ? NLAT : R; bf16_t* proj = (bf16_t*)(ws + WS_PROJ);
    pg8::Gemm g{proj + PQ, (const bf16_t*)(ws + WS_W + layer * WL_STRIDE + WL_ATT), M, DM, DM}; pg8::StaticOrder S; S.init(M, DM, geo.G, geo.bx);
    EpiGate<true> E{proj + PGA, proj + PGH};
    pg8::gemm_phase<EpiGate<true>, pg8::StaticOrder, true, true>(lds, g, S, E);
    gemm_mini_ks<EpiGate<true>, pg8::StaticOrder>(lds, g, S, E, geo.vcu, geo.G);
}
__device__ __forceinline__ void phase_wout(LAS unsigned char* lds, const Geo geo_in, int layer) {
    const Geo geo = opaque_geo(geo_in);
    KArgs A = kargs(); unsigned char* ws = A->ws; const int M = (layer == 1) ? NLAT : R; bf16_t* proj = (bf16_t*)(ws + WS_PROJ);
    pg8::Gemm g{proj + PGA, (const bf16_t*)(ws + WS_W + layer * WL_STRIDE + WL_OUT), M, DM, DM}; pg8::StaticOrder S; S.init(M, DM, geo.G, geo.bx);
    EpiPlain E{(bf16_t*)(ws + WS_H), DM};
    pg8::gemm_phase<EpiPlain, pg8::StaticOrder, true, true>(lds, g, S, E);
    gemm_mini_ks<EpiPlain, pg8::StaticOrder>(lds, g, S, E, geo.vcu, geo.G);
}

constexpr int XB_SPLIT = 15872;
__device__ __forceinline__ bf16_t* xa_row(unsigned char* ws, int row) { return (bf16_t*)(ws + WS_OB) + (size_t)row * DM; }
__device__ __forceinline__ bf16_t* xb_row(unsigned char* ws, int row) { return row < XB_SPLIT ? (bf16_t*)(ws + WS_END) + (size_t)row * DM : (bf16_t*)(ws + WS_WGU) + (size_t)(row - XB_SPLIT) * DM; }
__device__ __forceinline__ bf16_t* xc_row(unsigned char* ws, int row) { return (bf16_t*)(ws + WS_W) + (size_t)row * DM; }
__device__ __forceinline__ void phase_postmix0(const Geo geo_in, bool probe = false) {
    const Geo geo = opaque_geo(geo_in);
    KArgs A = kargs(); unsigned char* ws = A->ws;
    const int tid = opaque_tid(), lane = tid & 63, wave = __builtin_amdgcn_readfirstlane(tid >> 6);
    const int gw = geo.vcu * NWAVES + wave, NGW = geo.G * NWAVES;
    const float* x_in = A->in[I_X]; const float* ctx_in = A->in[I_CTX]; float* out = A->out; float* xctx = (float*)(ws + WS_XCTX);
    const float* pmn = A->in[I_POSTMIX]; const float* pfn = A->in[I_PREFFN]; const float* modl = (const float*)(ws + WS_MOD); bf16_t* Hb = (bf16_t*)(ws + WS_H);
#define SRC_ROW(row_) (((row_) < NLAT) ? x_in + (size_t)(row_) * DM : ctx_in + (size_t)((row_) - NLAT) * DM)
#define P9_ROW(row_, cx_, cm_) do { const int rw_ = (row_); const float* md = modl + (size_t)((rw_ < NLAT) ? (rw_ >> 12) : 4) * NMOD;      \
        const Row16 x1 = resid_add(cx_, cm_, row_rstd(cm_), pmn, md + 2 * DM, lane);                                                           \
        if (probe) st_bf16_row((bf16_t*)(ws + WS_OB) + (size_t)rw_ * DM, lane, x1);                                                            \
        else if (rw_ < NLAT) st_bf16_row_nt(xa_row(ws, rw_), lane, x1); else st_f32_row(xctx + (size_t)(rw_ - NLAT) * DM, lane, x1);                \
        const Row16 f = norm_mod(x1, row_rstd(x1), pfn, md + 3 * DM, md + 4 * DM, lane);                                                       \
        st_bf16_row((probe ? (bf16_t*)(ws + WS_OF) : Hb) + (size_t)rw_ * DM, lane, f); } while (0)
    const int rc0 = NLAT + gw; Row16 cxc; RawB cmc; if (rc0 < R) { cxc = ld_f32_row(SRC_ROW(rc0), lane); cmc = ld_raw_b(Hb + (size_t)rc0 * DM, lane); }
    for (int base = gw; base < NLAT; base += 8 * NGW) {
        Row16 fx[5]; RawB fm[5];
#define P9_LOAD(k_) do { const int rw_ = (base + (k_) * NGW < NLAT) ? base + (k_) * NGW : base; fx[(k_) % 5] = ld_f32_row_nt(SRC_ROW(rw_), lane); fm[(k_) % 5] = ld_raw_b_nt(Hb + (size_t)rw_ * DM, lane); } while (0)
#pragma unroll
        for (int k = 0; k < 4; ++k) P9_LOAD(k);
#pragma unroll
        for (int k = 0; k < 8; ++k) {
            if (k + 4 < 8) P9_LOAD(k + 4);
            if (base + k * NGW < NLAT) { const Row16 cm = unraw_b(fm[k % 5]); P9_ROW(base + k * NGW, fx[k % 5], cm); }
        }
#undef P9_LOAD
    }
    if (rc0 < R) { const Row16 cm = unraw_b(cmc); P9_ROW(rc0, cxc, cm); }
    for (int rc = rc0 + NGW; rc < R; rc += NGW) { const Row16 c2 = ld_f32_row(SRC_ROW(rc), lane), m2 = ld_bf16_row(Hb + (size_t)rc * DM, lane); P9_ROW(rc, c2, m2); }
#undef P9_ROW
#undef SRC_ROW
}
constexpr int MOE_I_E = 16 * (DFE / 32);
constexpr int MOE_CONV_TAILW = (256 - 16) * NWAVES;
#ifndef MOE_EARLY_PER_WAVE
#define MOE_EARLY_PER_WAVE 16
#endif
constexpr int MOE_CONV_EARLY = MOE_EARLY_PER_WAVE * MOE_CONV_TAILW;
__device__ __forceinline__ void moe_convert(unsigned char* ws, KArgs A, LAS unsigned char* scrbase, int first, int last, int wi, int nw, int wave, int lane) {
    LAS float* scr = (LAS float*)(scrbase + wave * 8704);
    unsigned char* MGU = ws + WS_MGU; unsigned char* MD = ws + WS_MD;
    const auto dec = [&](int it, TDesc& d) { const int e = it / (3 * MOE_I_E), r3 = it - e * 3 * MOE_I_E, m = r3 / MOE_I_E; d.item = r3 - m * MOE_I_E;
        if (m < 2) { d.W = (m == 0 ? A->in[I_MWG] : A->in[I_MWU]) + (size_t)e * DM * DFE; d.K = DM; d.N = DFE; d.WT = MGU + (size_t)e * 2 * DFE * DM; d.il = 1 + m; }
        else { d.W = A->in[I_MWD] + (size_t)e * DFE * DM; d.K = DFE; d.N = DM; d.WT = MD + (size_t)e * DM * DFE; d.il = 0; } };
    t_run<true>(dec, first + wi, last, nw, scr, lane);
}
__device__ __forceinline__ void phase_postmix1(LAS unsigned char* lds, const Geo geo_in) {
    const Geo geo = opaque_geo(geo_in);
    KArgs A = kargs(); unsigned char* ws = A->ws;
    const int tid = opaque_tid(), lane = tid & 63, wave = __builtin_amdgcn_readfirstlane(tid >> 6);
    const int G = geo.G, vcu = geo.vcu, gw = vcu * NWAVES + wave, NGW = G * NWAVES;
    float* out = A->out; const float* pmn = A->in[I_POSTMIX] + DM; const float* pfn = A->in[I_PREFFN] + DM; const float* modl = (const float*)(ws + WS_MOD) + (size_t)5 * NMOD;
    bf16_t* Hb = (bf16_t*)(ws + WS_H); unsigned* route = (unsigned*)(ws + WS_ROUTE); unsigned* wgb = (unsigned*)(ws + WS_WGB); unsigned* cnt = (unsigned*)(ws + WS_CTL) + CW_CNT;
    LAS float* wr = (LAS float*)lds; LAS unsigned* lcnt = (LAS unsigned*)(lds + 32768); LAS unsigned* lbase = lcnt + 8; unsigned char* XB = ws + WS_XB;
    { const float* moe_router = A->in[I_ROUTER]; for (int i = tid; i < DM * NEXP; i += 512) wr[i] = moe_router[i]; }
    if (tid < NEXP) lcnt[tid] = 0u;
    __syncthreads();
    for (int blk = vcu; blk < NLAT / 64; blk += G) {
        RawB rxr[8], rmx[8];
        unsigned fq8[8][4]; int re0[8], re1[8]; unsigned rp0[8], rp1[8];
#pragma unroll
        for (int i = 0; i < 8; ++i) { rxr[i] = ld_raw_b_nt(xb_row(ws, blk * 64 + wave * 8 + i), lane); rmx[i] = ld_raw_b_nt(Hb + (size_t)(blk * 64 + wave * 8 + i) * DM, lane); }
#pragma unroll
        for (int i = 0; i < 8; ++i) {
            const int row = blk * 64 + wave * 8 + i;
            const float* md = modl + (size_t)(row >> 12) * NMOD;
            const Row16 xr = unraw_b(rxr[i]), mx = unraw_b(rmx[i]);
            const Row16 x1 = resid_add(xr, mx, row_rstd(mx), pmn, md + 2 * DM, lane);
            st_bf16_row_nt(xc_row(ws, row), lane, x1);
            const Row16 f = norm_mod(x1, row_rstd(x1), pfn, md + 3 * DM, md + 4 * DM, lane);
#pragma unroll
            for (int j = 0; j < 4; ++j) fq8[i][j] = pk4_fp8(f.v[j][0], f.v[j][1], f.v[j][2], f.v[j][3]);
            float lg[NEXP];
#pragma unroll
            for (int e = 0; e < NEXP; ++e) lg[e] = 0.f;
#pragma unroll
            for (int j = 0; j < 4; ++j)
#pragma unroll
                for (int e4 = 0; e4 < 4; ++e4) { const int cidx = 4 * (lane + 64 * j) + e4; const f32x4 w0 = *(const LAS f32x4*)(wr + cidx * 8), w1 = *(const LAS f32x4*)(wr + cidx * 8 + 4); const float fv = f.v[j][e4];
                    lg[0] += fv * w0[0]; lg[1] += fv * w0[1]; lg[2] += fv * w0[2]; lg[3] += fv * w0[3]; lg[4] += fv * w1[0]; lg[5] += fv * w1[1]; lg[6] += fv * w1[2]; lg[7] += fv * w1[3]; }
#pragma unroll
            for (int e = 0; e < NEXP; ++e) lg[e] = wave_sum(lg[e]);
            int e0 = 0; float l0 = lg[0];
#pragma unroll
            for (int e = 1; e < NEXP; ++e) if (lg[e] > l0) { l0 = lg[e]; e0 = e; }
            int e1 = -1; float l1 = -3.0e38f;
#pragma unroll
            for (int e = 0; e < NEXP; ++e) if (e != e0 && lg[e] > l1) { l1 = lg[e]; e1 = e; }
            unsigned p0 = 0u, p1 = 0u;
            if (lane == 0) {
                p0 = __hip_atomic_fetch_add(lcnt + e0, 1u, __ATOMIC_RELAXED, __HIP_MEMORY_SCOPE_WORKGROUP);
                p1 = __hip_atomic_fetch_add(lcnt + e1, 1u, __ATOMIC_RELAXED, __HIP_MEMORY_SCOPE_WORKGROUP);
                const float w0 = 1.f / (1.f + expf(l1 - l0));
                unsigned* rr = route + (size_t)row * 8;
                rr[0] = (unsigned)e0 | ((unsigned)e1 << 8); rr[3] = __float_as_uint(w0); rr[4] = __float_as_uint(1.f - w0);
            }
            re0[i] = __builtin_amdgcn_readfirstlane(e0); re1[i] = __builtin_amdgcn_readfirstlane(e1); rp0[i] = __builtin_amdgcn_readfirstlane(p0); rp1[i] = __builtin_amdgcn_readfirstlane(p1);
        }
        __syncthreads();
        if (tid < NEXP) { const unsigned n = lcnt[tid]; lbase[tid] = __hip_atomic_fetch_add(cnt + 64 * tid, n, __ATOMIC_RELAXED, __HIP_MEMORY_SCOPE_AGENT); lcnt[tid] = 0u; }
        __syncthreads();
#pragma unroll
        for (int i = 0; i < 8; ++i) { const int row = blk * 64 + wave * 8 + i;
            const unsigned k0 = lbase[re0[i]] + rp0[i], k1 = lbase[re1[i]] + rp1[i];
            unsigned* d0 = (unsigned*)(XB + ((size_t)re0[i] * XB_CAP + k0) * DM); unsigned* d1 = (unsigned*)(XB + ((size_t)re1[i] * XB_CAP + k1) * DM);
#pragma unroll
            for (int j = 0; j < 4; ++j) { d0[lane + 64 * j] = fq8[i][j]; d1[lane + 64 * j] = fq8[i][j]; }
            if (lane == 0) { unsigned* rr = route + (size_t)row * 8; rr[5] = k0; rr[6] = k1; } }
        __syncthreads();
    }
    moe_convert(ws, A, lds + 49152, (G == 256) ? MOE_CONV_EARLY : 0, NEXP * 3 * MOE_I_E, gw, NGW, wave, lane);
}

struct MoeCounts { int nb[NEXP]; };
__device__ __forceinline__ MoeCounts moe_counts(unsigned char* ws) { MoeCounts c; unsigned* cnt = (unsigned*)(ws + WS_CTL) + CW_CNT;
#pragma unroll
    for (int e = 0; e < NEXP; ++e) { const unsigned n = __hip_atomic_load(cnt + 64 * e, __ATOMIC_RELAXED, __HIP_MEMORY_SCOPE_AGENT); c.nb[e] = (int)((n + 255u) >> 8); }
    return c; }

__device__ __forceinline__ void phase_gather(const Geo geo_in) {
    const Geo geo = opaque_geo(geo_in);
    KArgs A = kargs(); unsigned char* ws = A->ws;
    const int tid = opaque_tid(), lane = tid & 63, wave = __builtin_amdgcn_readfirstlane(tid >> 6);
    const int gw = geo.vcu * NWAVES + wave, NGW = geo.G * NWAVES;
    const MoeCounts mc = moe_counts(ws); int pst[NEXP]; { int a_ = 0;
#pragma unroll
        for (int e = 0; e < NEXP; ++e) { pst[e] = a_; a_ += mc.nb[e] * 256; } }
    unsigned* route = (unsigned*)(ws + WS_ROUTE); const unsigned* wgb = (const unsigned*)(ws + WS_WGB); const bf16_t* Hb = (const bf16_t*)(ws + WS_H); unsigned char* XB = ws + WS_XB;
    struct Rec { unsigned ee, p0, p1; }; struct Dat { unsigned b0, b1; u32x4 lo, hi; };
#define G_REC(dst, row_) do { const unsigned* rr_ = route + (size_t)(row_) * 8; dst.ee = rr_[0]; dst.p0 = rr_[1]; dst.p1 = rr_[2]; } while (0)
#define G_DAT(dst, rec, row_) do { dst.b0 = wgb[((row_) >> 6) * 8 + (rec.ee & 255)]; dst.b1 = wgb[((row_) >> 6) * 8 + ((rec.ee >> 8) & 255)]; \
        dst.lo = *(const u32x4*)(Hb + (size_t)(row_) * DM + 16 * lane); dst.hi = *(const u32x4*)(Hb + (size_t)(row_) * DM + 16 * lane + 8); } while (0)
    for (int base = gw; base < NLAT; base += 8 * NGW) {
        Rec rc[8]; Dat dt[8];
#pragma unroll
        for (int k = 0; k < 8; ++k) G_REC(rc[k], ((base + k * NGW < NLAT) ? base + k * NGW : base));
#pragma unroll
        for (int k = 0; k < 8; ++k) G_DAT(dt[k], rc[k], ((base + k * NGW < NLAT) ? base + k * NGW : base));
#pragma unroll
        for (int k = 0; k < 8; ++k) { const int row = base + k * NGW;
            if (row < NLAT) {
                const int e0 = rc[k].ee & 255, e1 = (rc[k].ee >> 8) & 255;
                int ps0 = 0, ps1 = 0;
#pragma unroll
                for (int e = 0; e < NEXP; ++e) { if (e == e0) ps0 = pst[e]; if (e == e1) ps1 = pst[e]; }
                const unsigned d0 = (unsigned)ps0 + dt[k].b0 + rc[k].p0, d1 = (unsigned)ps1 + dt[k].b1 + rc[k].p1;
                f32x4 v0, v1, v2, v3; unpack8(dt[k].lo, v0, v1); unpack8(dt[k].hi, v2, v3);
                const u32x4 q = {pk4_fp8(v0[0], v0[1], v0[2], v0[3]), pk4_fp8(v1[0], v1[1], v1[2], v1[3]), pk4_fp8(v2[0], v2[1], v2[2], v2[3]), pk4_fp8(v3[0], v3[1], v3[2], v3[3])};
                *(u32x4*)(XB + (size_t)d0 * DM + 16 * lane) = q; *(u32x4*)(XB + (size_t)d1 * DM + 16 * lane) = q;
                if (lane == 0) { unsigned* rr = route + (size_t)row * 8; rr[5] = d0; rr[6] = d1; }
            } }
    }
#undef G_REC
#undef G_DAT
}

__device__ __forceinline__ void phase_ffn_up0(LAS unsigned char* lds, const Geo geo_in) {
    const Geo geo = opaque_geo(geo_in);
    KArgs A = kargs(); unsigned char* ws = A->ws;
    pg8::Gemm g{(const bf16_t*)(ws + WS_H), (const bf16_t*)(ws + WS_WGU), R, 2 * DFF, DM}; pg8::StaticOrder S; S.init(R, 2 * DFF, geo.G, geo.bx); S.nfull = S.nwg;
    EpiSwiGLU E{(bf16_t*)(ws + WS_PROJ), DFF};
    pg8::gemm_phase<EpiSwiGLU, pg8::StaticOrder, true, true>(lds, g, S, E);
    gemm_mini<EpiSwiGLU, pg8::StaticOrder>(g, S, E, geo.vcu, geo.G);
}
__device__ __forceinline__ void phase_ffn_down0(LAS unsigned char* lds, const Geo geo_in) {
    const Geo geo = opaque_geo(geo_in);
    KArgs A = kargs(); unsigned char* ws = A->ws;
    pg8::Gemm g{(const bf16_t*)(ws + WS_PROJ), (const bf16_t*)(ws + WS_WD), R, DM, DFF}; pg8::StaticOrder S; S.init(R, DM, geo.G, geo.bx); S.nfull = S.nwg;
    EpiPlain E{(bf16_t*)(ws + WS_OF), DM};
    pg8::gemm_phase<EpiPlain, pg8::StaticOrder, true, true>(lds, g, S, E);
    if (geo.G == 256 && geo.bx >= 16) {
        const int tid = opaque_tid(), lane = tid & 63, wave = __builtin_amdgcn_readfirstlane(tid >> 6);
        moe_convert(ws, A, lds, 0, MOE_CONV_EARLY, (geo.bx - 16) * NWAVES + wave, MOE_CONV_TAILW, wave, lane);
    }
}
__device__ __forceinline__ void phase_ffn_up1(LAS unsigned char* lds, const Geo geo_in) {
    const Geo geo = opaque_geo(geo_in);
    KArgs A = kargs(); unsigned char* ws = A->ws; const MoeCounts mc = moe_counts(ws);
    pg8::Gemm g{(const bf16_t*)(ws + WS_XB), (const bf16_t*)(ws + WS_MGU), MOE_ROWS_MAX, 2 * DFE, DM}; MoeOrder S; S.acap = XB_CAP / 256;
#pragma unroll
    for (int e = 0; e < NEXP; ++e) S.nb[e] = mc.nb[e];
    S.nN = 2 * DFE / 256; S.G = geo.G; S.c = geo.vcu; S.finish(); S.nfull = S.nwg;
    EpiSwiGLU8 E{ws + WS_HIDM, DFE};
    pg8::gemm_phase<EpiSwiGLU8, MoeOrder, true, true, true>(lds, g, S, E);
}
__device__ __forceinline__ void phase_ffn_down1(LAS unsigned char* lds, const Geo geo_in) {
    const Geo geo = opaque_geo(geo_in);
    KArgs A = kargs(); unsigned char* ws = A->ws; const MoeCounts mc = moe_counts(ws);
    pg8::Gemm g{(const bf16_t*)(ws + WS_HIDM), (const bf16_t*)(ws + WS_MD), MOE_ROWS_MAX, DM, DFE}; MoeOrder S;
#pragma unroll
    for (int e = 0; e < NEXP; ++e) S.nb[e] = mc.nb[e];
    S.nN = DM / 256; S.G = geo.G; S.c = geo.vcu; S.finish();
#ifdef MOE_NO_MINI8
    S.nfull = S.nwg;
#endif
    EpiPlain E{(bf16_t*)(ws + WS_YB), DM, 0.015625f};
    pg8::gemm_phase<EpiPlain, MoeOrder, true, true, true>(lds, g, S, E);
    gemm_mini8<DFE, EpiPlain, MoeOrder>(lds, ws + WS_HIDM, ws + WS_MD, S, E, geo.vcu, geo.G);
}

__device__ __forceinline__ void phase_postffn0(const Geo geo_in, bool probe = false) {
    const Geo geo = opaque_geo(geo_in);
    KArgs A = kargs(); unsigned char* ws = A->ws;
    const int tid = opaque_tid(), lane = tid & 63, wave = __builtin_amdgcn_readfirstlane(tid >> 6);
    const int gw = geo.vcu * NWAVES + wave, NGW = geo.G * NWAVES;
    float* out = A->out; float* xctx = (float*)(ws + WS_XCTX); const float* pfn = A->in[I_POSTFFN]; const float* pmx = A->in[I_PREMIX] + DM;
    const float* modl = (const float*)(ws + WS_MOD); const bf16_t* FF = (const bf16_t*)(ws + WS_OF); bf16_t* Hb = (bf16_t*)(ws + WS_H);
#define X_LOAD(row_) (((row_) < NLAT) ? ld_bf16_row(xa_row(ws, (row_)), lane) : ld_f32_row(xctx + (size_t)((row_) - NLAT) * DM, lane))
#define P13_ROW(row_, cx_, cy_) do { const int rw_ = (row_); const int mi = (rw_ < NLAT) ? (rw_ >> 12) : 4;                                        \
        const Row16 x2 = resid_add(cx_, cy_, row_rstd(cy_), pfn, modl + (size_t)mi * NMOD + 5 * DM, lane);                                    \
        if (probe) st_bf16_row((bf16_t*)(ws + WS_PROJ) + (size_t)rw_ * DM, lane, x2);                                                          \
        else if (rw_ < NLAT) st_bf16_row_nt(xb_row(ws, rw_), lane, x2); else st_f32_row(xctx + (size_t)(rw_ - NLAT) * DM, lane, x2);                \
        const float* mdn = modl + (size_t)(5 + mi) * NMOD;                                                                                    \
        const Row16 h = norm_mod(x2, row_rstd(x2), pmx, mdn + 0 * DM, mdn + 1 * DM, lane);                                                    \
        st_bf16_row((probe ? (bf16_t*)(ws + WS_PROJ + 40 * MiB) : Hb) + (size_t)rw_ * DM, lane, h); } while (0)
    const int rc0 = NLAT + gw; Row16 cxc; RawB cyr; if (rc0 < R) { cxc = ld_f32_row(xctx + (size_t)(rc0 - NLAT) * DM, lane); cyr = ld_raw_b(FF + (size_t)rc0 * DM, lane); }
    for (int base = gw; base < NLAT; base += 8 * NGW) {
        RawB rx[8], ry[8];
#pragma unroll
        for (int k = 0; k < 8; ++k) { const int rw = (base + k * NGW < NLAT) ? base + k * NGW : base; rx[k] = ld_raw_b_nt(xa_row(ws, rw), lane); ry[k] = ld_raw_b_nt(FF + (size_t)rw * DM, lane); }
#pragma unroll
        for (int k = 0; k < 8; ++k) if (base + k * NGW < NLAT) { const Row16 cx = unraw_b(rx[k]), cy = unraw_b(ry[k]); P13_ROW(base + k * NGW, cx, cy); }
    }
    if (rc0 < R) { const Row16 cyc = unraw_b(cyr); P13_ROW(rc0, cxc, cyc); }
    for (int rc = rc0 + NGW; rc < R; rc += NGW) { const Row16 c2 = ld_f32_row(xctx + (size_t)(rc - NLAT) * DM, lane), y2 = ld_bf16_row(FF + (size_t)rc * DM, lane); P13_ROW(rc, c2, y2); }
#undef P13_ROW
#undef X_LOAD
}
__device__ __forceinline__ void phase_postffn1(const Geo geo_in) {
    const Geo geo = opaque_geo(geo_in);
    KArgs A = kargs(); unsigned char* ws = A->ws;
    const int tid = opaque_tid(), lane = tid & 63, wave = __builtin_amdgcn_readfirstlane(tid >> 6);
    const int gw = geo.vcu * NWAVES + wave, NGW = geo.G * NWAVES;
    float* out = A->out; const float* pfn = A->in[I_POSTFFN] + DM; const float* modl = (const float*)(ws + WS_MOD) + (size_t)5 * NMOD;
    const unsigned* route = (const unsigned*)(ws + WS_ROUTE); const bf16_t* YB = (const bf16_t*)(ws + WS_YB);
    const MoeCounts mc = moe_counts(ws); int pst[NEXP]; { int a_ = 0;
#pragma unroll
        for (int e = 0; e < NEXP; ++e) { pst[e] = a_; a_ += mc.nb[e] * 256; } }
    for (int base = gw; base < NLAT; base += 8 * NGW) {
        u32x4 rt[8];
#pragma unroll
        for (int k = 0; k < 8; ++k) { const unsigned* rr = route + (size_t)((base + k * NGW < NLAT) ? base + k * NGW : base) * 8; rt[k] = *(const u32x4*)(rr + 3); const unsigned ee = rr[0];
            const int e0 = ee & 255, e1 = (ee >> 8) & 255; int ps0 = 0, ps1 = 0;
#pragma unroll
            for (int e = 0; e < NEXP; ++e) { if (e == e0) ps0 = pst[e]; if (e == e1) ps1 = pst[e]; }
            rt[k].z += (unsigned)ps0; rt[k].w += (unsigned)ps1; }
        RawB fx[5], f0[5], f1[5];
#define P13L_LOAD(k_) do { const int rw_ = (base + (k_) * NGW < NLAT) ? base + (k_) * NGW : base; fx[(k_) % 5] = ld_raw_b_nt(xc_row(ws, rw_), lane);           \
        f0[(k_) % 5] = ld_raw_b_nt(YB + (size_t)rt[k_].z * DM, lane); f1[(k_) % 5] = ld_raw_b_nt(YB + (size_t)rt[k_].w * DM, lane); } while (0)
#pragma unroll
        for (int k = 0; k < 4; ++k) P13L_LOAD(k);
#pragma unroll
        for (int k = 0; k < 8; ++k) {
            if (k + 4 < 8) P13L_LOAD(k + 4);
            const int row = base + k * NGW;
            if (row < NLAT) {
                const float w0 = __uint_as_float(rt[k].x), w1 = __uint_as_float(rt[k].y);
                const Row16 cx = unraw_b(fx[k % 5]), c0 = unraw_b(f0[k % 5]), c1 = unraw_b(f1[k % 5]);
                Row16 y;
#pragma unroll
                for (int j = 0; j < 4; ++j) y.v[j] = c0.v[j] * w0 + c1.v[j] * w1;
                const Row16 x2 = resid_add(cx, y, row_rstd(y), pfn, modl + (size_t)(row >> 12) * NMOD + 5 * DM, lane);
                st_f32_row(out + (size_t)row * DM, lane, x2);
            }
        }
#undef P13L_LOAD
    }
}

__global__ void __launch_bounds__(NWAVES * 64, 2) fwd_kernel(Args args) {
    LAS unsigned char* lds = (LAS unsigned char*)lds_raw;
    volatile LAS unsigned* MISC = (volatile LAS unsigned*)(lds + MISC_OFF);
    Geo geo; geo.G = gridDim.x; geo.bx = blockIdx.x; geo.vcu = (geo.G % 8 == 0) ? (geo.bx % 8) * (geo.G / 8) + geo.bx / 8 : geo.bx;
    for (int u = threadIdx.x; u < (LDS_BYTES - LDS_CTL_OFF) / 4; u += NWAVES * 64) ((LAS unsigned*)(lds + LDS_CTL_OFF))[u] = 0u;
    __syncthreads();
    if ((threadIdx.x & 63) == 0) *(LAS int*)(lds + WAVE_TAB_OFF + 4 * hw_wave_slot()) = (int)(threadIdx.x >> 6);
    __syncthreads();
    const int lo = args.ph_lo, hi = args.ph_hi;
    XcdBarrier bar; bar.bar = (unsigned*)(args.ws + WS_CTL) + CW_BAR; bar.x = 0; bar.st = nullptr;
    if (hi - lo > 1) bar = xcd_barrier_post((unsigned*)(args.ws + WS_CTL) + CW_BAR, MISC + 8);
#ifndef PHASE_MASK
#define PHASE_MASK 0x3fff
#endif
#define IN(k) (((PHASE_MASK >> ((k) % NPH)) & 1) && lo <= (k) && (k) < hi)
#define SEAM(k) do { if (IN((k) + 1)) xcd_barrier(bar); } while (0)
#ifndef REP_ID
#define REP_ID (-1)
#endif
#define REP(k, call) do { call; if (REP_ID >= 0 && REP_ID == (k)) { if (hi - lo > 1) xcd_barrier(bar); call; } } while (0)
#pragma unroll 1
    for (int layer = 0; layer < 2; ++layer) {
        const int P = layer * NPH; const bool last = (layer == 1);
        if (!last && IN(P + 0)) { asm volatile("; PHASE_BEGIN_0" ::: "memory"); REP(P + 0, phase_prologue(lds, geo)); SEAM(P + 0); }
        if (!last && IN(P + 1)) { asm volatile("; PHASE_BEGIN_1" ::: "memory"); phase_premix0(geo); SEAM(P + 1); }
        if (IN(P + 2)) { asm volatile("; PHASE_BEGIN_2" ::: "memory"); REP(P + 2, phase_proj(lds, geo, layer));
            SEAM(P + 2); }
        if (IN(P + 3)) { asm volatile("; PHASE_BEGIN_3" ::: "memory"); phase_qknorm(geo, layer); SEAM(P + 3); }
        if (IN(P + 4)) { asm volatile("; PHASE_BEGIN_4" ::: "memory");
#ifndef NO_ATTN
            REP(P + 4, phase_attn(lds_raw, geo, last, layer));
#endif
#ifndef NO_SCAN
            REP(P + 4 + 100, phase_scan(lds, geo, last));
#endif
            SEAM(P + 4); }
        if (IN(P + 5)) { asm volatile("; PHASE_BEGIN_5" ::: "memory"); phase_readout(geo, layer); SEAM(P + 5); }
        if (IN(P + 6)) { asm volatile("; PHASE_BEGIN_6" ::: "memory"); phase_merge_hg(lds, geo, layer); VM_WAIT(); __syncthreads(); }
        if (IN(P + 7)) { asm volatile("; PHASE_BEGIN_7" ::: "memory"); phase_merge_att(lds, geo, layer); SEAM(P + 7); }
        if (IN(P + 8)) { asm volatile("; PHASE_BEGIN_8" ::: "memory"); REP(P + 8, phase_wout(lds, geo, layer)); SEAM(P + 8); }
        if (IN(P + 9)) { asm volatile("; PHASE_BEGIN_9" ::: "memory");
#if defined(THIN_PROBE)
            if (!last && THIN_PROBE == 9) { phase_postmix0(geo, true); xcd_barrier(bar); }
#endif
            if (!last) phase_postmix0(geo); else phase_postmix1(lds, geo); SEAM(P + 9); }
        if (IN(P + 11)) { asm volatile("; PHASE_BEGIN_11" ::: "memory"); if (!last) REP(P + 11, phase_ffn_up0(lds, geo)); else REP(P + 11, phase_ffn_up1(lds, geo)); SEAM(P + 11); }
        if (IN(P + 12)) { asm volatile("; PHASE_BEGIN_12" ::: "memory"); if (!last) REP(P + 12, phase_ffn_down0(lds, geo)); else REP(P + 12, phase_ffn_down1(lds, geo)); SEAM(P + 12); }
        if (IN(P + 13)) { asm volatile("; PHASE_BEGIN_13" ::: "memory");
#if defined(THIN_PROBE)
            if (!last && THIN_PROBE == 13) { phase_postffn0(geo, true); xcd_barrier(bar); }
#endif
            if (!last) { phase_postffn0(geo); SEAM(P + 13); } else phase_postffn1(geo); }
    }
#undef IN
#undef SEAM
}

__global__ void dump_kernel(const bf16_t* src, int pitch, float* out) {
    for (size_t i = (size_t)blockIdx.x * 256 + threadIdx.x; i < (size_t)NLAT * DM; i += (size_t)gridDim.x * 256) { const size_t row = i >> 10, c = i & 1023; out[i] = bf_lo((unsigned)src[row * pitch + c]); }
}
extern "C" void kernel_launch(void* const* d_in, const int* in_sizes, int n_in, void* d_out, int out_size, void* d_ws, size_t ws_size, hipStream_t stream) {
    static int grid = 0;
    if (grid == 0) {
        if (n_in != 25 || in_sizes[0] != NLAT * DM || out_size != NLAT * DM || ws_size < WS_END + 31 * MiB) { fprintf(stderr, "kernel_launch: unexpected shapes (n_in %d, in0 %d, out %d, ws %zu < %zu)\n", n_in, n_in > 0 ? in_sizes[0] : -1, out_size, ws_size, (size_t)(WS_END + 31 * MiB)); grid = -1; return; }
        int dev = 0, cus = 0, per_cu = 0;
        if (hipGetDevice(&dev) != hipSuccess || hipDeviceGetAttribute(&cus, hipDeviceAttributeMultiprocessorCount, dev) != hipSuccess) { grid = -1; return; }
        if (hipFuncSetAttribute((const void*)fwd_kernel, hipFuncAttributeMaxDynamicSharedMemorySize, LDS_BYTES) != hipSuccess) { fprintf(stderr, "kernel_launch: hipFuncSetAttribute failed\n"); grid = -1; return; }
        if (hipOccupancyMaxActiveBlocksPerMultiprocessor(&per_cu, (const void*)fwd_kernel, NWAVES * 64, LDS_BYTES) != hipSuccess || per_cu < 1) fprintf(stderr, "kernel_launch: occupancy query reports %d\n", per_cu);
        (void)hipGetLastError();
        grid = cus;
    }
    if (grid < 0) return;
    if (hipMemsetAsync((char*)d_ws + WS_CTL, 0, CTL_ZERO_BYTES, stream) != hipSuccess) return;
    Args a{};
    for (int i = 0; i < 25; ++i) a.in[i] = (const float*)d_in[i];
    a.out = (float*)d_out; a.ws = (unsigned char*)d_ws;
#ifndef MK_ONE_LAUNCH
#define MK_ONE_LAUNCH 0
#endif
    if (MK_ONE_LAUNCH) {
        a.ph_lo = 0; a.ph_hi = NTOT;
        hipLaunchKernelGGL(fwd_kernel, dim3(grid), dim3(NWAVES * 64), LDS_BYTES, stream, a);
    } else {
#ifndef LAST_PHASE
#define LAST_PHASE (NTOT - 1)
#endif
        for (int ph = 0; ph <= LAST_PHASE; ++ph) {
            const int p = ph % NPH, l = ph / NPH;
            if ((l == 1 && (p == 0 || p == 1)) || (l == 0 && p == 10)) continue;
            a.ph_lo = ph; a.ph_hi = ph + 1;
            hipLaunchKernelGGL(fwd_kernel, dim3(grid), dim3(NWAVES * 64), LDS_BYTES, stream, a);
        }
    }
#ifdef DUMP_OFF
    hipLaunchKernelGGL(dump_kernel, dim3(1024), dim3(256), 0, stream, (const bf16_t*)((const unsigned char*)d_ws + (size_t)(DUMP_OFF)), (int)(DUMP_PITCH), (float*)d_out);
#endif
    const hipError_t le = hipPeekAtLastError();
    if (le != hipSuccess) fprintf(stderr, "kernel_launch: launch failed: %s\n", hipGetErrorName(le));
}
```
